# Optimizing an MI355X kernel written in HIP

```python
import jax, jax.numpy as jnp
from jax import lax
import numpy as np

D_MODEL = 1024
BATCH = 8
SEQ = 4096
DEPTH = 4
DEC_BATCH = 8
DEC_SEQ = 16
PAST_LEN = 2048

CHUNK = 64
N_PREV_CHUNKS = 8
WINDOW = N_PREV_CHUNKS * CHUNK
BAND = (N_PREV_CHUNKS + 1) * CHUNK
N_HEADS = 8
HEAD_DIM = 64
ATTN_W = N_HEADS * HEAD_DIM
CONV_W = 512
CONV_K = 3
REL_CLIP = 128
N_REL = 2 * REL_CLIP + 1
D_FF = 2816
EPS = 1e-6
NEG_INF = -1e30
IN_COLS = 3 * CONV_W + 3 * ATTN_W + 2 * D_MODEL

kernel_name = "hybrid_shortconv_chunkband_macaron_step"


def _rmsnorm(x, g):
    xf = x.astype(jnp.float32)
    y = xf * lax.rsqrt(jnp.mean(xf * xf, axis=-1, keepdims=True) + EPS)
    return y.astype(x.dtype) * g


def _swiglu(h, w_gu, w_down):
    gu = h @ w_gu
    g, u = jnp.split(gu, 2, axis=-1)
    return (jax.nn.silu(g) * u) @ w_down


def _short_conv(cb, cc, cv, conv_prev, w_conv):
    u = cc * cv
    up = jnp.concatenate([conv_prev, u], axis=1)
    t = u.shape[1]
    y = w_conv[0] * up[:, 0:t]
    for j in range(1, CONV_K):
        y = y + w_conv[j] * up[:, j:j + t]
    return cb * y, up[:, -(CONV_K - 1):]


def _band_attention(q, k, v, q_pos, k_pos, rel_bias):
    s = jnp.einsum('bqhd,bkhd->bhqk', q, k).astype(jnp.float32) * (HEAD_DIM ** -0.5)
    dist = q_pos[:, None] - k_pos[None, :]
    idx = jnp.clip(dist, -REL_CLIP, REL_CLIP) + REL_CLIP
    s = s + rel_bias[:, idx].astype(jnp.float32)[None]
    qc = jnp.floor_divide(q_pos, CHUNK)[:, None]
    kc = jnp.floor_divide(k_pos, CHUNK)[None, :]
    valid = (k_pos[None, :] >= 0) & (kc <= qc) & (kc >= qc - N_PREV_CHUNKS)
    s = jnp.where(valid[None, None], s, NEG_INF)
    p = jax.nn.softmax(s, axis=-1).astype(v.dtype)
    return jnp.einsum('bhqk,bkhd->bqhd', p, v)


def _prompt_attention(q, k, v, rel_bias):
    b, s, h, d = q.shape
    nc = s // CHUNK
    pad = N_PREV_CHUNKS * CHUNK
    kp = jnp.pad(k, ((0, 0), (pad, 0), (0, 0), (0, 0)))
    vp = jnp.pad(v, ((0, 0), (pad, 0), (0, 0), (0, 0)))

    def one_chunk(c):
        qs = c * CHUNK
        qb = lax.dynamic_slice_in_dim(q, qs, CHUNK, axis=1)
        kb = lax.dynamic_slice_in_dim(kp, qs, BAND, axis=1)
        vb = lax.dynamic_slice_in_dim(vp, qs, BAND, axis=1)
        q_pos = qs + jnp.arange(CHUNK, dtype=jnp.int32)
        k_pos = qs - pad + jnp.arange(BAND, dtype=jnp.int32)
        return _band_attention(qb, kb, vb, q_pos, k_pos, rel_bias)

    out = lax.map(one_chunk, jnp.arange(nc, dtype=jnp.int32))
    out = jnp.transpose(out, (1, 0, 2, 3, 4)).reshape(b, s, h, d)
    rows = min(WINDOW, s)
    return out, k[:, -rows:], v[:, -rows:]


def _sample_attention(q, k, v, ck, cv, rel_bias):
    t = q.shape[1]
    r = ck.shape[1]
    k_all = jnp.concatenate([ck, k], axis=1)
    v_all = jnp.concatenate([cv, v], axis=1)
    q_pos = PAST_LEN + jnp.arange(t, dtype=jnp.int32)
    k_pos = jnp.concatenate([PAST_LEN - r + jnp.arange(r, dtype=jnp.int32), q_pos])
    out = _band_attention(q, k_all, v_all, q_pos, k_pos, rel_bias)
    return out, k, v


def _mixer(h, conv_prev, attn_fn, w_in, b_gate, w_conv, w_conv_out, w_attn_out, w_o):
    b, t, _ = h.shape
    z = h @ w_in
    splits = [CONV_W, 2 * CONV_W, 3 * CONV_W, 3 * CONV_W + ATTN_W,
              3 * CONV_W + 2 * ATTN_W, 3 * CONV_W + 3 * ATTN_W]
    cb, cc, cv, q, k, v, g = jnp.split(z, splits, axis=-1)
    g = jax.nn.sigmoid(g + b_gate)
    g_conv, g_attn = jnp.split(g, 2, axis=-1)
    y_conv, conv_new = _short_conv(cb, cc, cv, conv_prev, w_conv)
    q = q.reshape(b, t, N_HEADS, HEAD_DIM)
    k = k.reshape(b, t, N_HEADS, HEAD_DIM)
    v = v.reshape(b, t, N_HEADS, HEAD_DIM)
    y_attn, k_new, v_new = attn_fn(q, k, v)
    y_attn = y_attn.reshape(b, t, ATTN_W)
    m = g_conv * (y_conv @ w_conv_out) + g_attn * (y_attn @ w_attn_out)
    return m @ w_o, conv_new, k_new, v_new


def setup_inputs(seed: int = 0) -> dict:
    key = jax.random.key(seed)
    ks = jax.random.split(key, 24)
    f32 = jnp.float32
    kv_rows = min(WINDOW, PAST_LEN)

    def nrm(k, shape, scale):
        return jax.random.normal(k, shape, f32) * scale

    def gain(k, shape):
        return 1.0 + 0.02 * jax.random.normal(k, shape, f32)

    return {
        "x_prompt": nrm(ks[0], (BATCH, SEQ, D_MODEL), 1.0),
        "x_sample": nrm(ks[1], (DEC_BATCH, DEC_SEQ, D_MODEL), 1.0),
        "cache_k": nrm(ks[2], (DEPTH, DEC_BATCH, kv_rows, N_HEADS, HEAD_DIM), 1.0),
        "cache_v": nrm(ks[3], (DEPTH, DEC_BATCH, kv_rows, N_HEADS, HEAD_DIM), 1.0),
        "state_conv": nrm(ks[4], (DEPTH, DEC_BATCH, CONV_K - 1, CONV_W), 1.0),
        "norm_ffn1": gain(ks[5], (DEPTH, D_MODEL)),
        "w_ffn1_gu": nrm(ks[6], (DEPTH, D_MODEL, 2 * D_FF), D_MODEL ** -0.5),
        "w_ffn1_down": nrm(ks[7], (DEPTH, D_FF, D_MODEL), D_FF ** -0.5),
        "norm_mix": gain(ks[8], (DEPTH, D_MODEL)),
        "w_in": nrm(ks[9], (DEPTH, D_MODEL, IN_COLS), D_MODEL ** -0.5),
        "b_gate": nrm(ks[10], (DEPTH, 2 * D_MODEL), 0.02),
        "w_conv": nrm(ks[11], (DEPTH, CONV_K, CONV_W), CONV_K ** -0.5),
        "rel_bias": nrm(ks[12], (DEPTH, N_HEADS, N_REL), 0.1),
        "w_conv_out": nrm(ks[13], (DEPTH, CONV_W, D_MODEL), CONV_W ** -0.5),
        "w_attn_out": nrm(ks[14], (DEPTH, ATTN_W, D_MODEL), ATTN_W ** -0.5),
        "w_o": nrm(ks[15], (DEPTH, D_MODEL, D_MODEL), D_MODEL ** -0.5),
        "norm_ffn2": gain(ks[16], (DEPTH, D_MODEL)),
        "w_ffn2_gu": nrm(ks[17], (DEPTH, D_MODEL, 2 * D_FF), D_MODEL ** -0.5),
        "w_ffn2_down": nrm(ks[18], (DEPTH, D_FF, D_MODEL), D_FF ** -0.5),
        "norm_final": gain(ks[19], (D_MODEL,)),
    }


def reference(x_prompt, x_sample, cache_k, cache_v, state_conv,
              norm_ffn1, w_ffn1_gu, w_ffn1_down, norm_mix, w_in, b_gate, w_conv,
              rel_bias, w_conv_out, w_attn_out, w_o, norm_ffn2, w_ffn2_gu, w_ffn2_down,
              norm_final):
    xp = x_prompt
    xs = x_sample
    conv_prev_p = jnp.zeros((xp.shape[0], CONV_K - 1, CONV_W), xp.dtype)
    kp_list, vp_list, cp_list = [], [], []
    ks_list, vs_list, cs_list = [], [], []
    for l in range(DEPTH):
        rb = rel_bias[l]
        xp = xp + 0.5 * _swiglu(_rmsnorm(xp, norm_ffn1[l]), w_ffn1_gu[l], w_ffn1_down[l])
        xs = xs + 0.5 * _swiglu(_rmsnorm(xs, norm_ffn1[l]), w_ffn1_gu[l], w_ffn1_down[l])
        mp, cnp, knp, vnp = _mixer(
            _rmsnorm(xp, norm_mix[l]), conv_prev_p,
            lambda q, k, v: _prompt_attention(q, k, v, rb),
            w_in[l], b_gate[l], w_conv[l], w_conv_out[l], w_attn_out[l], w_o[l])
        ck_l = cache_k[l]
        cv_l = cache_v[l]
        ms, cns, kns, vns = _mixer(
            _rmsnorm(xs, norm_mix[l]), state_conv[l],
            lambda q, k, v: _sample_attention(q, k, v, ck_l, cv_l, rb),
            w_in[l], b_gate[l], w_conv[l], w_conv_out[l], w_attn_out[l], w_o[l])
        xp = xp + mp
        xs = xs + ms
        xp = xp + 0.5 * _swiglu(_rmsnorm(xp, norm_ffn2[l]), w_ffn2_gu[l], w_ffn2_down[l])
        xs = xs + 0.5 * _swiglu(_rmsnorm(xs, norm_ffn2[l]), w_ffn2_gu[l], w_ffn2_down[l])
        kp_list.append(knp); vp_list.append(vnp); cp_list.append(cnp)
        ks_list.append(kns); vs_list.append(vns); cs_list.append(cns)
    y_prompt = _rmsnorm(xp, norm_final)
    y_sample = _rmsnorm(xs, norm_final)
    new_k_prompt = jnp.stack(kp_list, axis=0)
    new_v_prompt = jnp.stack(vp_list, axis=0)
    new_conv_prompt = jnp.stack(cp_list, axis=0)
    new_k_sample = jnp.stack(ks_list, axis=0)
    new_v_sample = jnp.stack(vs_list, axis=0)
    new_conv_sample = jnp.stack(cs_list, axis=0)
    return (y_prompt, y_sample, new_k_prompt, new_v_prompt, new_conv_prompt,
            new_k_sample, new_v_sample, new_conv_sample)
```

```cpp
#include <hip/hip_runtime.h>
#include <hip/hip_cooperative_groups.h>
#include <cstdio>
#include <cstdint>
namespace cg = cooperative_groups;

#define LAS __attribute__((address_space(3)))
typedef unsigned short bf16_t;
typedef short bf16x8 __attribute__((ext_vector_type(8)));
typedef short s16x4 __attribute__((ext_vector_type(4)));
typedef float f32x4 __attribute__((ext_vector_type(4)));
typedef unsigned u32x4 __attribute__((ext_vector_type(4)));
typedef unsigned u32x2 __attribute__((ext_vector_type(2)));

constexpr int DM = 1024, NBATCH = 8, SEQ = 4096, DEPTH = 4, DSEQ = 16;
constexpr int NH = 8, DFF = 2816, INC = 5120, NREL = 257;
constexpr int MP = NBATCH * SEQ;
constexpr int MS = NBATCH * DSEQ;
constexpr int MR = MP + MS;
constexpr int MPAD = 33024;
constexpr int NTM = MPAD / 256;
constexpr float EPS = 1e-6f;
constexpr float LOG2E = 1.4426950408889634f;
constexpr float QSCALE = 0.125f * LOG2E;
constexpr int ZC_CB = 0, ZC_Q = 512, ZC_CC = 1024, ZC_CV = 1536, ZC_K = 2048, ZC_V = 2560, ZC_GC = 3072, ZC_GA = 4096, ZC_MB = 1024;

constexpr size_t O_Y = 0;
constexpr size_t O_KP = (size_t)MR * DM;
constexpr size_t O_VP = O_KP + (size_t)DEPTH * NBATCH * 512 * 512;
constexpr size_t O_CP = O_VP + (size_t)DEPTH * NBATCH * 512 * 512;
constexpr size_t O_KS = O_CP + (size_t)DEPTH * NBATCH * 2 * 512;
constexpr size_t O_VS = O_KS + (size_t)DEPTH * NBATCH * DSEQ * 512;
constexpr size_t O_CS = O_VS + (size_t)DEPTH * NBATCH * DSEQ * 512;
constexpr size_t O_END = O_CS + (size_t)DEPTH * NBATCH * 2 * 512;

constexpr size_t W_GU1 = 0;
constexpr size_t W_D1 = W_GU1 + (size_t)2 * DFF * DM;
constexpr size_t W_IN = W_D1 + (size_t)DM * DFF;
constexpr size_t W_CAT = W_IN + (size_t)INC * DM;
constexpr size_t W_O = W_CAT + (size_t)DM * DM;
constexpr size_t W_GU2 = W_O + (size_t)DM * DM;
constexpr size_t W_D2 = W_GU2 + (size_t)2 * DFF * DM;
constexpr size_t W_TOTAL = W_D2 + (size_t)DM * DFF;

constexpr size_t WS_WT = 0;
constexpr size_t WS_XB = WS_WT + ((W_TOTAL * 2 + 4095) / 4096) * 4096;
constexpr size_t WS_SSQ = WS_XB + (size_t)MPAD * DM * 2;
constexpr size_t WS_CK = WS_SSQ + (size_t)MPAD * 16 * 4;
constexpr size_t WS_CV = WS_CK + (size_t)NBATCH * 512 * 512 * 2;
constexpr size_t WS_Z = WS_CV + (size_t)NBATCH * 512 * 512 * 2;
constexpr size_t WS_END = WS_Z + (size_t)MPAD * INC * 2;

constexpr int NWAVES = 8;
constexpr int RING_BYTES = 131072;
constexpr int RB_OFF = RING_BYTES + 1024;
constexpr int LDS_BYTES = 147456;

__device__ __forceinline__ unsigned cvt_pk_bf16(float lo, float hi) { unsigned r; asm volatile("v_cvt_pk_bf16_f32 %0, %1, %2" : "=v"(r) : "v"(lo), "v"(hi)); return r; }
__device__ __forceinline__ float bf_lo(unsigned w) { return __uint_as_float(w << 16); }
__device__ __forceinline__ float bf_hi(unsigned w) { return __uint_as_float(w & 0xffff0000u); }
__device__ __forceinline__ unsigned f2bf(float f) { unsigned u = __float_as_uint(f); return (u + 0x7fffu + ((u >> 16) & 1u)) >> 16; }
__device__ __forceinline__ unsigned pk2(float lo, float hi) { return f2bf(lo) | (f2bf(hi) << 16); }
__device__ __forceinline__ float fast_sigmoid(float x) { return __builtin_amdgcn_rcpf(1.0f + __builtin_amdgcn_exp2f(-x * LOG2E)); }

namespace pg8 {
constexpr int BM = 256, BK = 64, HALF = 128, HTB = HALF * BK * 2, STAGE_BYTES = 8 * HTB, NXCD = 8, WGM = 8;
__host__ __device__ __forceinline__ int lds_byte(int r, int c) { const int st = (r >> 4) * 2 + (c >> 5), rr = r & 15, cc = c & 31, ob = rr * 64 + cc * 2; return st * 1024 + (ob ^ (((ob >> 9) & 1) << 5)); }
__host__ __device__ __forceinline__ void stage_rc(int b, int& R, int& C) { const int st = b / 1024, sb = b % 1024, swz = sb ^ (((sb >> 9) & 1) << 5); R = (st >> 1) * 16 + swz / 64; C = (st & 1) * 32 + (swz % 64) / 2; }
__host__ __device__ __forceinline__ int perm32(int rho) { const int n = rho >> 4, i = rho & 15; return 8 * (i >> 2) + 4 * n + (i & 3); }

struct Unit { int pm, pn, z; };
struct Gemm { const bf16_t* A; const bf16_t* Bt; int lda, ldb, K; long zA, zB; };

struct StaticOrder {
    int nM, nN, nwg, G, c, nz;
    __device__ void init(int nM_, int nN_, int G_, int c_, int nz_) { nM = nM_; nN = nN_; nwg = nM * nN; G = G_; c = c_; nz = nz_; }
    __device__ bool next(int i, Unit& u) const {
        const int it = i / nz; u.z = i - it * nz;
        const long L = (long)it * G + c; if (L >= nwg) return false;
        int wgid = (int)L; { const int q = nwg / NXCD, r = nwg % NXCD, xcd = wgid % NXCD, off = wgid / NXCD; wgid = (xcd < r ? xcd * (q + 1) : r * (q + 1) + (xcd - r) * q) + off; }
        const int nig = WGM * nN, gid = wgid / nig, fm = gid * WGM, gsz = (nM - fm) < WGM ? (nM - fm) : WGM;
        u.pm = fm + ((wgid % nig) % gsz); u.pn = (wgid % nig) / gsz; return true;
    }
};

template <class Epi>
__device__ __forceinline__ void gemm_phase(LAS unsigned char* lds, const Gemm g, const StaticOrder& S, const Epi& E, const int tid) {
    const int wid = __builtin_amdgcn_readfirstlane(tid >> 6), lane = tid & 63, wr = wid >> 2, wc = wid & 3, fr = lane & 15, fq = lane >> 4;
    const int K = g.K, nt = K / BK;
    unsigned voffA[2], voffB[2];
#pragma unroll
    for (int i = 0; i < 2; ++i) { int R, C; stage_rc(tid * 16 + i * 8192, R, C); const int Rb = (R & ~31) + perm32(R & 31);
        voffA[i] = (unsigned)(R * g.lda + C) * 2u; voffB[i] = (unsigned)(Rb * g.ldb + C) * 2u; }
    const size_t kstep = (size_t)(BK * 2);
    const size_t hstepA = (size_t)HALF * g.lda * 2, hstepB = (size_t)HALF * g.ldb * 2;
    const size_t tstepA = 2 * hstepA, tstepB = 2 * hstepB;
    const unsigned ldsw = (unsigned)wid * 1024u;
    const int aoff = lds_byte(wr * 64 + fr, fq * 8), boff = lds_byte(wc * 32 + fr, fq * 8);
#define PG8_SA(b, h) (((b) * 2 + (h)) * HTB)
#define PG8_SB(b, h) ((4 + (b) * 2 + (h)) * HTB)
#define PG8_STAGE(bufoff, gbase, voff) do { _Pragma("unroll") for (int _i = 0; _i < 2; ++_i) \
        __builtin_amdgcn_global_load_lds((const unsigned*)((const char*)(gbase) + (voff)[_i]), (LAS unsigned*)(lds + (bufoff) + ldsw + _i * 8192), 16, 0, 0); } while (0)
#define PG8_LDA(dst, b, h) do { _Pragma("unroll") for (int m = 0; m < 4; ++m) _Pragma("unroll") for (int k = 0; k < 2; ++k) dst[m][k] = *(const LAS bf16x8*)(lds + PG8_SA(b, h) + aoff + m * 2048 + k * 1024); } while (0)
#define PG8_LDB(dst, b, h) do { _Pragma("unroll") for (int n = 0; n < 2; ++n) _Pragma("unroll") for (int k = 0; k < 2; ++k) dst[n][k] = *(const LAS bf16x8*)(lds + PG8_SB(b, h) + boff + n * 2048 + k * 1024); } while (0)
#define PG8_MMA(ai, bj, At, Bt) do { __builtin_amdgcn_s_setprio(1); _Pragma("unroll") for (int m = 0; m < 4; ++m) _Pragma("unroll") for (int n = 0; n < 2; ++n) _Pragma("unroll") for (int k = 0; k < 2; ++k) \
        acc[ai][bj][m][n] = __builtin_amdgcn_mfma_f32_16x16x32_bf16(Bt[n][k], At[m][k], acc[ai][bj][m][n], 0, 0, 0); __builtin_amdgcn_s_setprio(0); } while (0)
#define PG8_WAIT_V(n) asm volatile("s_waitcnt vmcnt(" #n ")" ::: "memory")
#define PG8_WAIT_L(n) asm volatile("s_waitcnt lgkmcnt(" #n ")" ::: "memory")
#define PG8_BAR __builtin_amdgcn_s_barrier()
#define PG8_SCHED __builtin_amdgcn_sched_barrier(0)
    Unit cur, nxt; int ui = 0;
    if (!S.next(0, cur)) return;
    f32x4 acc[2][2][4][2];
#pragma unroll
    for (int a = 0; a < 2; ++a)
#pragma unroll
        for (int b = 0; b < 2; ++b)
#pragma unroll
            for (int m = 0; m < 4; ++m)
#pragma unroll
                for (int n = 0; n < 2; ++n) acc[a][b][m][n] = (f32x4){0.f, 0.f, 0.f, 0.f};
    bf16x8 At[4][2], B0[2][2], B1[2][2];
    const char* cA = (const char*)g.A + (size_t)cur.pm * tstepA + (size_t)cur.z * g.zA; const char* cB = (const char*)g.Bt + (size_t)cur.pn * tstepB + (size_t)cur.z * g.zB;
    PG8_STAGE(PG8_SB(0, 0), cB, voffB); PG8_STAGE(PG8_SB(0, 1), cB + hstepB, voffB); PG8_STAGE(PG8_SA(0, 0), cA, voffA); PG8_STAGE(PG8_SA(0, 1), cA + hstepA, voffA);
    if (wr == 1) PG8_BAR;
    PG8_WAIT_V(2); PG8_BAR;
    PG8_STAGE(PG8_SB(1, 0), cB + kstep, voffB); PG8_STAGE(PG8_SA(1, 0), cA + kstep, voffA); PG8_STAGE(PG8_SB(1, 1), cB + hstepB + kstep, voffB);
    PG8_WAIT_V(6); PG8_BAR;
    for (;;) {
        const bool has_next = S.next(ui + 1, nxt);
        const char* nA = has_next ? (const char*)g.A + (size_t)nxt.pm * tstepA + (size_t)nxt.z * g.zA : cA; const char* nB = has_next ? (const char*)g.Bt + (size_t)nxt.pn * tstepB + (size_t)nxt.z * g.zB : cB;
        for (int t = 0; t < nt; t += 2) {
            const bool last = (t == nt - 2);
            const char* a1 = cA + (size_t)(t + 1) * kstep;
            const char* a2 = last ? nA : cA + (size_t)(t + 2) * kstep; const char* b2 = last ? nB : cB + (size_t)(t + 2) * kstep;
            const char* a3 = a2 + kstep; const char* b3 = b2 + kstep;
            PG8_LDB(B0, 0, 0); PG8_LDB(B1, 0, 1); PG8_SCHED; PG8_LDA(At, 0, 0); PG8_STAGE(PG8_SA(1, 1), a1 + hstepA, voffA);
            PG8_WAIT_V(8); PG8_WAIT_L(0); PG8_BAR; PG8_MMA(0, 0, At, B0); PG8_MMA(0, 1, At, B1); PG8_BAR; PG8_SCHED;
            PG8_LDA(At, 0, 1); PG8_STAGE(PG8_SB(0, 0), b2, voffB); PG8_STAGE(PG8_SB(0, 1), b2 + hstepB, voffB); PG8_STAGE(PG8_SA(0, 0), a2, voffA);
            PG8_WAIT_V(8); PG8_WAIT_L(0); PG8_BAR; PG8_MMA(1, 0, At, B0); PG8_MMA(1, 1, At, B1); PG8_BAR; PG8_SCHED;
            PG8_LDB(B0, 1, 0); PG8_LDB(B1, 1, 1); PG8_SCHED; PG8_LDA(At, 1, 0); PG8_STAGE(PG8_SA(0, 1), a2 + hstepA, voffA);
            PG8_WAIT_V(8); PG8_WAIT_L(0); PG8_BAR; PG8_MMA(0, 0, At, B0); PG8_MMA(0, 1, At, B1); PG8_BAR; PG8_SCHED;
            PG8_LDA(At, 1, 1); PG8_STAGE(PG8_SB(1, 0), b3, voffB); PG8_STAGE(PG8_SB(1, 1), b3 + hstepB, voffB); PG8_STAGE(PG8_SA(1, 0), a3, voffA);
            PG8_WAIT_V(8); PG8_WAIT_L(0); PG8_BAR; PG8_MMA(1, 0, At, B0); PG8_MMA(1, 1, At, B1); PG8_BAR; PG8_SCHED;
        }
        if (wr == 0) PG8_BAR;
        E(acc, cur, wr, wc, fr, fq);
        if (!has_next) break;
#pragma unroll
        for (int a = 0; a < 2; ++a)
#pragma unroll
            for (int b = 0; b < 2; ++b)
#pragma unroll
                for (int m = 0; m < 4; ++m)
#pragma unroll
                    for (int n = 0; n < 2; ++n) acc[a][b][m][n] = (f32x4){0.f, 0.f, 0.f, 0.f};
        cur = nxt; cA = nA; cB = nB; ++ui;
        if (wr == 1) PG8_BAR;
    }
    PG8_WAIT_V(0);
    PG8_BAR;
#undef PG8_SA
#undef PG8_SB
#undef PG8_STAGE
#undef PG8_LDA
#undef PG8_LDB
#undef PG8_MMA
#undef PG8_WAIT_V
#undef PG8_WAIT_L
#undef PG8_BAR
#undef PG8_SCHED
}
}

__device__ __forceinline__ float row_rs(const float* ssq, int row, int fq) {
    const f32x4 v = *(const f32x4*)(ssq + (size_t)row * 16 + 4 * fq);
    float s = (v[0] + v[1]) + (v[2] + v[3]);
    s += __shfl_xor(s, 16); s += __shfl_xor(s, 32);
    return __builtin_amdgcn_rsqf(s * (1.0f / 1024.0f) + EPS);
}

struct EpiUp {
    bf16_t* H; const float* ssq;
    __device__ __forceinline__ void operator()(const f32x4 (&acc)[2][2][4][2], const pg8::Unit& u, int wr, int wc, int fr, int fq) const {
        const int row0 = u.pm * 256 + wr * 64 + fr, hc0 = u.pn * 128 + wc * 16 + 4 * fq;
#pragma unroll
        for (int ai = 0; ai < 2; ++ai)
#pragma unroll
            for (int m = 0; m < 4; ++m) {
                const int row = row0 + ai * 128 + m * 16; const float rs = row_rs(ssq, row, fq);
#pragma unroll
                for (int bj = 0; bj < 2; ++bj) {
                    const f32x4 gg = acc[ai][bj][m][0] * rs, uu = acc[ai][bj][m][1] * rs; float h[4];
#pragma unroll
                    for (int i = 0; i < 4; ++i) h[i] = gg[i] * fast_sigmoid(gg[i]) * uu[i];
                    u32x2 w; w.x = cvt_pk_bf16(h[0], h[1]); w.y = cvt_pk_bf16(h[2], h[3]);
                    *(u32x2*)(H + (size_t)row * DFF + hc0 + bj * 64) = w;
                }
            }
    }
};

struct EpiRes {
    float* X; bf16_t* XB; float* ssq; float scale;
    __device__ __forceinline__ void operator()(const f32x4 (&acc)[2][2][4][2], const pg8::Unit& u, int wr, int wc, int fr, int fq) const {
        const int row0 = u.pm * 256 + wr * 64 + fr, col0 = u.pn * 256 + wc * 32 + 8 * fq;
#pragma unroll
        for (int ai = 0; ai < 2; ++ai)
#pragma unroll
            for (int m = 0; m < 4; ++m) {
                const int row = row0 + ai * 128 + m * 16;
                if (u.pm * 256 + ai * 128 < MR) {
                    float s = 0.f;
#pragma unroll
                    for (int bj = 0; bj < 2; ++bj) {
                        float* xp = X + (size_t)row * DM + col0 + bj * 128;
                        f32x4 x0 = *(const f32x4*)xp, x1 = *(const f32x4*)(xp + 4);
                        x0 += acc[ai][bj][m][0] * scale; x1 += acc[ai][bj][m][1] * scale;
                        *(f32x4*)xp = x0; *(f32x4*)(xp + 4) = x1;
                        u32x4 w; w.x = cvt_pk_bf16(x0[0], x0[1]); w.y = cvt_pk_bf16(x0[2], x0[3]); w.z = cvt_pk_bf16(x1[0], x1[1]); w.w = cvt_pk_bf16(x1[2], x1[3]);
                        *(u32x4*)(XB + (size_t)row * DM + col0 + bj * 128) = w;
                        s += (x0[0] * x0[0] + x0[1] * x0[1]) + (x0[2] * x0[2] + x0[3] * x0[3]) + (x1[0] * x1[0] + x1[1] * x1[1]) + (x1[2] * x1[2] + x1[3] * x1[3]);
                    }
                    s += __shfl_xor(s, 16); s += __shfl_xor(s, 32);
                    if (fq == 0) ssq[(size_t)row * 16 + u.pn * 4 + wc] = s;
                }
                if (m & 1) asm volatile("" ::: "memory");
            }
    }
};

struct EpiIn {
    bf16_t* Z; const float* ssq; const float* bgate; float* okp; float* ovp; float* oks; float* ovs;
    __device__ __forceinline__ void operator()(const f32x4 (&acc)[2][2][4][2], const pg8::Unit& u, int wr, int wc, int fr, int fq) const {
        const int row0 = u.pm * 256 + wr * 64 + fr, col0 = u.pn * 256 + wc * 32 + 8 * fq;
        const int pn = u.pn;
        const bool isq = (pn == 2 || pn == 3), iskv = (pn >= 8 && pn < 12), isg = (pn >= 12);
        const bool kvp = iskv && (u.pm < 128) && ((u.pm & 15) >= 14), kvs = iskv && (u.pm == 128);
        f32x4 bg[2][2];
#pragma unroll
        for (int bj = 0; bj < 2; ++bj) { if (isg) { bg[bj][0] = *(const f32x4*)(bgate + col0 - ZC_GC + bj * 128); bg[bj][1] = *(const f32x4*)(bgate + col0 - ZC_GC + bj * 128 + 4); } else { bg[bj][0] = (f32x4){0.f, 0.f, 0.f, 0.f}; bg[bj][1] = bg[bj][0]; } }
#pragma unroll
        for (int ai = 0; ai < 2; ++ai)
#pragma unroll
            for (int m = 0; m < 4; ++m) {
                const int row = row0 + ai * 128 + m * 16; float rs = row_rs(ssq, row, fq);
                if (isq) rs *= QSCALE;
#pragma unroll
                for (int bj = 0; bj < 2; ++bj) {
                    f32x4 v0 = acc[ai][bj][m][0] * rs, v1 = acc[ai][bj][m][1] * rs;
                    const int c = col0 + bj * 128;
                    if (isg) {
                        v0 += bg[bj][0]; v1 += bg[bj][1];
#pragma unroll
                        for (int i = 0; i < 4; ++i) { v0[i] = fast_sigmoid(v0[i]); v1[i] = fast_sigmoid(v1[i]); }
                    }
                    u32x4 w; w.x = cvt_pk_bf16(v0[0], v0[1]); w.y = cvt_pk_bf16(v0[2], v0[3]); w.z = cvt_pk_bf16(v1[0], v1[1]); w.w = cvt_pk_bf16(v1[2], v1[3]);
                    *(u32x4*)(Z + (size_t)row * INC + c) = w;
                    if (kvp) {
                        const int b = row >> 12, t = row & 4095;
                        float* dst = ((pn < 10) ? okp : ovp) + ((size_t)(b * 512 + (t - 3584)) * 512 + (c - ((pn < 10) ? ZC_K : ZC_V)));
                        *(f32x4*)dst = v0; *(f32x4*)(dst + 4) = v1;
                    } else if (kvs && ai == 0) {
                        float* dst = ((pn < 10) ? oks : ovs) + ((size_t)(row - MP) * 512 + (c - ((pn < 10) ? ZC_K : ZC_V)));
                        *(f32x4*)dst = v0; *(f32x4*)(dst + 4) = v1;
                    }
                }
            }
    }
};

struct EpiMix {
    bf16_t* Z;
    __device__ __forceinline__ void operator()(const f32x4 (&acc)[2][2][4][2], const pg8::Unit& u, int wr, int wc, int fr, int fq) const {
        const int row0 = u.pm * 256 + wr * 64 + fr, col0 = u.pn * 256 + wc * 32 + 8 * fq;
        const int gcol = (u.z == 0) ? ZC_GC : ZC_GA;
#pragma unroll
        for (int ai = 0; ai < 2; ++ai)
#pragma unroll
            for (int m = 0; m < 4; ++m) {
                const int row = row0 + ai * 128 + m * 16;
#pragma unroll
                for (int bj = 0; bj < 2; ++bj) {
                    const int c = col0 + bj * 128;
                    const u32x4 gw = *(const u32x4*)(Z + (size_t)row * INC + gcol + c);
                    f32x4 v0 = acc[ai][bj][m][0], v1 = acc[ai][bj][m][1];
                    v0[0] *= bf_lo(gw.x); v0[1] *= bf_hi(gw.x); v0[2] *= bf_lo(gw.y); v0[3] *= bf_hi(gw.y);
                    v1[0] *= bf_lo(gw.z); v1[1] *= bf_hi(gw.z); v1[2] *= bf_lo(gw.w); v1[3] *= bf_hi(gw.w);
                    bf16_t* mp = Z + (size_t)row * INC + ZC_MB + c;
                    if (u.z != 0) {
                        const u32x4 pw = *(const u32x4*)mp;
                        v0[0] += bf_lo(pw.x); v0[1] += bf_hi(pw.x); v0[2] += bf_lo(pw.y); v0[3] += bf_hi(pw.y);
                        v1[0] += bf_lo(pw.z); v1[1] += bf_hi(pw.z); v1[2] += bf_lo(pw.w); v1[3] += bf_hi(pw.w);
                    }
                    u32x4 w; w.x = cvt_pk_bf16(v0[0], v0[1]); w.y = cvt_pk_bf16(v0[2], v0[3]); w.z = cvt_pk_bf16(v1[0], v1[1]); w.w = cvt_pk_bf16(v1[2], v1[3]);
                    *(u32x4*)mp = w;
                }
            }
    }
};

struct TileD { const bf16_t* K; const bf16_t* V; int pitch; int nkeys; int delta0; };

__device__ __forceinline__ void attn_dma_v(const TileD& td, LAS unsigned char* vb, int lane) {
#pragma unroll
    for (int i = 0; i < 8; ++i) {
        const int row = 8 * i + (lane >> 3), chs = lane & 7, ch = chs ^ (((row >> 1) & 3) << 1);
        __builtin_amdgcn_global_load_lds((const unsigned*)(td.V + (size_t)row * td.pitch + ch * 8), (LAS unsigned*)(vb + i * 1024), 16, 0, 0);
    }
}
template <int NQB, class TF>
__device__ __forceinline__ void attn_wave(const bf16_t* Qp, bf16_t* Op, int qpitch, int nt, const TF& tilef, LAS unsigned char* vbuf, const LAS float* rb, int lane) {
    const int fr = lane & 15, fq = lane >> 4;
    bf16x8 qf[NQB][2];
#pragma unroll
    for (int qb = 0; qb < NQB; ++qb)
#pragma unroll
        for (int dh = 0; dh < 2; ++dh) qf[qb][dh] = *(const bf16x8*)(Qp + (size_t)(16 * qb + fr) * qpitch + dh * 32 + 8 * fq);
    f32x4 O[NQB][4]; float mrow[NQB], lrow[NQB];
#pragma unroll
    for (int qb = 0; qb < NQB; ++qb) { mrow[qb] = -1e30f; lrow[qb] = 0.f;
#pragma unroll
        for (int db = 0; db < 4; ++db) O[qb][db] = (f32x4){0.f, 0.f, 0.f, 0.f}; }
    const int qp = fr >> 2, pp = fr & 3, rowl = 4 * fq + qp, sw = ((rowl >> 1) & 3) << 1;
    const int vrow = rowl * 128 + (pp & 1) * 8, vch = (pp >> 1) ^ sw;
    bf16x8 kf[2][2];
    { const TileD td = tilef(0); attn_dma_v(td, vbuf, lane);
#pragma unroll
      for (int kb = 0; kb < 2; ++kb)
#pragma unroll
          for (int dh = 0; dh < 2; ++dh) kf[kb][dh] = *(const bf16x8*)(td.K + (size_t)(16 * kb + fr) * td.pitch + dh * 32 + 8 * fq); }
    const int nht = 2 * nt;
#pragma unroll 1
    for (int ht = 0; ht < nht; ++ht) {
        const int t = ht >> 1, half = ht & 1;
        asm volatile("s_waitcnt vmcnt(0)" ::: "memory");
        const TileD td = tilef(t);
        if (half == 0 && t + 1 < nt) { const TileD tn = tilef(t + 1); attn_dma_v(tn, vbuf + ((t + 1) & 1) * 8192, lane); }
        f32x4 S[2][NQB];
#pragma unroll
        for (int kb = 0; kb < 2; ++kb)
#pragma unroll
            for (int qb = 0; qb < NQB; ++qb) {
                f32x4 s = __builtin_amdgcn_mfma_f32_16x16x32_bf16(kf[kb][0], qf[qb][0], (f32x4){0.f, 0.f, 0.f, 0.f}, 0, 0, 0);
                S[kb][qb] = __builtin_amdgcn_mfma_f32_16x16x32_bf16(kf[kb][1], qf[qb][1], s, 0, 0, 0);
            }
        if (ht + 1 < nht) {
            const TileD tk = tilef((ht + 1) >> 1); const int r0 = 32 * ((ht + 1) & 1);
#pragma unroll
            for (int kb = 0; kb < 2; ++kb)
#pragma unroll
                for (int dh = 0; dh < 2; ++dh) kf[kb][dh] = *(const bf16x8*)(tk.K + (size_t)(r0 + 16 * kb + fr) * tk.pitch + dh * 32 + 8 * fq);
        }
        const int delta0 = td.delta0 - 32 * half, nkeys = td.nkeys - 32 * half;
        if (delta0 >= 160) {
            const float bc = rb[256];
#pragma unroll
            for (int kb = 0; kb < 2; ++kb)
#pragma unroll
                for (int qb = 0; qb < NQB; ++qb) S[kb][qb] += bc;
        } else {
#pragma unroll
            for (int kb = 0; kb < 2; ++kb)
#pragma unroll
                for (int qb = 0; qb < NQB; ++qb)
#pragma unroll
                    for (int i = 0; i < 4; ++i) {
                        int d = delta0 + (16 * qb + fr) - (16 * kb + 4 * fq + i);
                        d = d < -128 ? -128 : (d > 128 ? 128 : d);
                        S[kb][qb][i] += rb[d + 128];
                    }
        }
        if (nkeys < 32) {
#pragma unroll
            for (int kb = 0; kb < 2; ++kb)
#pragma unroll
                for (int qb = 0; qb < NQB; ++qb)
#pragma unroll
                    for (int i = 0; i < 4; ++i) if (16 * kb + 4 * fq + i >= nkeys) S[kb][qb][i] = -INFINITY;
        }
        bf16x8 pf[NQB];
#pragma unroll
        for (int qb = 0; qb < NQB; ++qb) {
            float mx = fmaxf(fmaxf(fmaxf(S[0][qb][0], S[0][qb][1]), fmaxf(S[0][qb][2], S[0][qb][3])), fmaxf(fmaxf(S[1][qb][0], S[1][qb][1]), fmaxf(S[1][qb][2], S[1][qb][3])));
            mx = fmaxf(mx, __shfl_xor(mx, 16)); mx = fmaxf(mx, __shfl_xor(mx, 32));
            const float mn = fmaxf(mrow[qb], mx), alpha = __builtin_amdgcn_exp2f(mrow[qb] - mn);
            mrow[qb] = mn; float ps = 0.f; float p[2][4];
#pragma unroll
            for (int kb = 0; kb < 2; ++kb)
#pragma unroll
                for (int i = 0; i < 4; ++i) { p[kb][i] = __builtin_amdgcn_exp2f(S[kb][qb][i] - mn); ps += p[kb][i]; }
            lrow[qb] = lrow[qb] * alpha + ps;
#pragma unroll
            for (int db = 0; db < 4; ++db) O[qb][db] *= alpha;
            u32x4 w; w.x = cvt_pk_bf16(p[0][0], p[0][1]); w.y = cvt_pk_bf16(p[0][2], p[0][3]); w.z = cvt_pk_bf16(p[1][0], p[1][1]); w.w = cvt_pk_bf16(p[1][2], p[1][3]);
            pf[qb] = __builtin_bit_cast(bf16x8, w);
        }
        const LAS unsigned char* vb = vbuf + (t & 1) * 8192 + half * 4096 + vrow;
#pragma unroll
        for (int db = 0; db < 4; ++db) {
            const int off = ((2 * db) ^ vch) << 4;
            const s16x4 lo = __builtin_amdgcn_ds_read_tr16_b64_v4i16((LAS s16x4*)(vb + off));
            const s16x4 hi = __builtin_amdgcn_ds_read_tr16_b64_v4i16((LAS s16x4*)(vb + off + 2048));
            const bf16x8 vf = (bf16x8){lo[0], lo[1], lo[2], lo[3], hi[0], hi[1], hi[2], hi[3]};
#pragma unroll
            for (int qb = 0; qb < NQB; ++qb) O[qb][db] = __builtin_amdgcn_mfma_f32_16x16x32_bf16(vf, pf[qb], O[qb][db], 0, 0, 0);
        }
    }
    asm volatile("s_waitcnt lgkmcnt(0)" ::: "memory");
#pragma unroll
    for (int qb = 0; qb < NQB; ++qb) {
        float l = lrow[qb]; l += __shfl_xor(l, 16); l += __shfl_xor(l, 32);
        const float inv = 1.0f / l;
#pragma unroll
        for (int db = 0; db < 4; ++db) {
            const f32x4 o = O[qb][db] * inv; u32x2 w; w.x = cvt_pk_bf16(o[0], o[1]); w.y = cvt_pk_bf16(o[2], o[3]);
            *(u32x2*)(Op + (size_t)(16 * qb + fr) * qpitch + 16 * db + 4 * fq) = w;
        }
    }
}

struct Args {
    const float* x_prompt; const float* x_sample; const float* cache_k; const float* cache_v; const float* state_conv;
    const float* norm_ffn1; const float* w_ffn1_gu; const float* w_ffn1_down; const float* norm_mix; const float* w_in; const float* b_gate; const float* w_conv;
    const float* rel_bias; const float* w_conv_out; const float* w_attn_out; const float* w_o; const float* norm_ffn2; const float* w_ffn2_gu; const float* w_ffn2_down; const float* norm_final;
    float* out; unsigned char* ws; int ph_lo, ph_hi;
};

__device__ __forceinline__ void transpose_item(const float* W, int N, const float* gain, bf16_t* WT, int dpitch, int dkoff, int mode, int kb, int nb, int scol0, LAS float* scr, int lane) {
    const int k0 = 64 * kb, n0 = 32 * nb, c = lane & 31;
    const int scol = (mode == 1) ? ((c < 16) ? 16 * nb + c : DFF + 16 * nb + (c - 16)) : scol0 + c;
#pragma unroll 8
    for (int i = 0; i < 32; ++i) { const int kk = 2 * i + (lane >> 5); float v = W[(size_t)(k0 + kk) * N + scol]; if (gain) v *= gain[k0 + kk]; scr[kk * 33 + c] = v; }
    asm volatile("s_waitcnt lgkmcnt(0)" ::: "memory");
    const int c8 = lane & 7;
#pragma unroll
    for (int j = 0; j < 4; ++j) { const int n = (lane >> 3) + 8 * j; const LAS float* s = scr + (8 * c8) * 33 + n;
        u32x4 o; o.x = pk2(s[0 * 33], s[1 * 33]); o.y = pk2(s[2 * 33], s[3 * 33]); o.z = pk2(s[4 * 33], s[5 * 33]); o.w = pk2(s[6 * 33], s[7 * 33]);
        int drow;
        if (mode == 1) { const int jj = n & 15, isu = n >> 4; drow = n0 + 8 * (jj >> 2) + 4 * isu + (jj & 3); } else drow = n0 + n;
        *(u32x4*)(WT + (size_t)drow * dpitch + dkoff + k0 + 8 * c8) = o; }
    asm volatile("s_waitcnt lgkmcnt(0)" ::: "memory");
}

__device__ __forceinline__ float wave_sum(float v) {
#pragma unroll
    for (int o = 1; o < 64; o <<= 1) v += __shfl_xor(v, o);
    return v;
}

__global__ void __launch_bounds__(NWAVES * 64, 2) mega_fwd(Args a) {
    extern __shared__ __attribute__((aligned(16))) unsigned char lds_raw[];
    LAS unsigned char* lds = (LAS unsigned char*)lds_raw;
    cg::grid_group grid = cg::this_grid();
    typedef const __attribute__((address_space(4))) Args* ArgP;
    ArgP ap = (ArgP)__builtin_amdgcn_kernarg_segment_ptr();
    const int G = gridDim.x, bx = blockIdx.x;
    const int wave0 = __builtin_amdgcn_readfirstlane((int)threadIdx.x >> 6);
    const int lo = ap->ph_lo, hi = ap->ph_hi;
#define PHASE_VARS \
    asm volatile("" : "+s"(ap)); \
    int lane_ = (int)__builtin_amdgcn_mbcnt_hi(~0u, __builtin_amdgcn_mbcnt_lo(~0u, 0u)); asm volatile("" : "+v"(lane_)); \
    int wave_ = wave0; asm volatile("" : "+s"(wave_)); \
    const int lane = lane_, wave = wave_, tid = wave * 64 + lane; \
    const int vcu = (G % 8 == 0) ? (bx % 8) * (G / 8) + bx / 8 : bx; \
    const int gw = vcu * NWAVES + wave, NGW = G * NWAVES; \
    const int gt = gw * 64 + lane, NGT = NGW * 64; \
    unsigned char* ws = ap->ws; \
    bf16_t* WT = (bf16_t*)(ws + WS_WT); bf16_t* XB = (bf16_t*)(ws + WS_XB); float* SSQ = (float*)(ws + WS_SSQ); \
    bf16_t* CK = (bf16_t*)(ws + WS_CK); bf16_t* CV = (bf16_t*)(ws + WS_CV); bf16_t* Z = (bf16_t*)(ws + WS_Z); bf16_t* HB = Z; \
    float* X = ap->out; \
    (void)tid; (void)lane; (void)wave; (void)gw; (void)NGW; (void)gt; (void)NGT; (void)WT; (void)XB; (void)SSQ; (void)CK; (void)CV; (void)Z; (void)HB; (void)X;
#define IN(k) (lo <= (k) && (k) < hi)
#define SEAM(k) do { if (IN(k) && IN((k) + 1)) grid.sync(); } while (0)

#pragma unroll 1
    for (int l = 0; l < DEPTH; ++l) {
        const int pb = 9 * l;
        if (IN(pb + 0)) { PHASE_VARS
            LAS float* scr = (LAS float*)(lds + wave * 16384);
            constexpr int I_GU = 16 * 176, I_D = 44 * 32, I_IN = 16 * 160, I_C = 8 * 32, I_O = 16 * 32;
            constexpr int NITEMS = 2 * I_GU + 2 * I_D + I_IN + 2 * I_C + I_O;
            for (int it = gw; it < NITEMS; it += NGW) {
                int r = it;
                if (r < I_GU) { transpose_item(ap->w_ffn1_gu + (size_t)l * DM * 2 * DFF, 2 * DFF, ap->norm_ffn1 + l * DM, WT + W_GU1, DM, 0, 1, r / 176, r % 176, 0, scr, lane); continue; } r -= I_GU;
                if (r < I_GU) { transpose_item(ap->w_ffn2_gu + (size_t)l * DM * 2 * DFF, 2 * DFF, ap->norm_ffn2 + l * DM, WT + W_GU2, DM, 0, 1, r / 176, r % 176, 0, scr, lane); continue; } r -= I_GU;
                if (r < I_D) { transpose_item(ap->w_ffn1_down + (size_t)l * DFF * DM, DM, nullptr, WT + W_D1, DFF, 0, 0, r / 32, r % 32, 32 * (r % 32), scr, lane); continue; } r -= I_D;
                if (r < I_D) { transpose_item(ap->w_ffn2_down + (size_t)l * DFF * DM, DM, nullptr, WT + W_D2, DFF, 0, 0, r / 32, r % 32, 32 * (r % 32), scr, lane); continue; } r -= I_D;
                if (r < I_IN) { const int nb = r % 160, kb = r / 160, blk = nb >> 4;
                    const int ob = (blk == 1) ? 3 : (blk == 2) ? 1 : (blk == 3) ? 2 : blk;
                    transpose_item(ap->w_in + (size_t)l * DM * INC, INC, ap->norm_mix + l * DM, WT + W_IN, DM, 0, 0, kb, nb, ob * 512 + 32 * (nb & 15), scr, lane); continue; } r -= I_IN;
                if (r < I_C) { transpose_item(ap->w_conv_out + (size_t)l * 512 * DM, DM, nullptr, WT + W_CAT, DM, 0, 0, r / 32, r % 32, 32 * (r % 32), scr, lane); continue; } r -= I_C;
                if (r < I_C) { transpose_item(ap->w_attn_out + (size_t)l * 512 * DM, DM, nullptr, WT + W_CAT, DM, 512, 0, r / 32, r % 32, 32 * (r % 32), scr, lane); continue; } r -= I_C;
                transpose_item(ap->w_o + (size_t)l * DM * DM, DM, nullptr, WT + W_O, DM, 0, 0, r / 32, r % 32, 32 * (r % 32), scr, lane);
            }
            for (int i = gt; i < 2 * (NBATCH * 512 * 512 / 8); i += NGT) {
                const int which = i / (NBATCH * 512 * 512 / 8), e = (i % (NBATCH * 512 * 512 / 8)) * 8;
                const float* src = (which ? ap->cache_v : ap->cache_k) + (size_t)l * NBATCH * 512 * 512 + e;
                const f32x4 v0 = *(const f32x4*)src, v1 = *(const f32x4*)(src + 4);
                u32x4 w; w.x = pk2(v0[0], v0[1]); w.y = pk2(v0[2], v0[3]); w.z = pk2(v1[0], v1[1]); w.w = pk2(v1[2], v1[3]);
                *(u32x4*)((which ? CV : CK) + e) = w;
            }
            if (l == 0) {
                for (int m = gw; m < MPAD; m += NGW) {
                    bf16_t* xb = XB + (size_t)m * DM; float* sq = SSQ + (size_t)m * 16;
                    if (m < MR) {
                        const float* src = (m < MP) ? ap->x_prompt + (size_t)m * DM : ap->x_sample + (size_t)(m - MP) * DM;
                        float* dst = X + (size_t)m * DM; float s = 0.f;
#pragma unroll
                        for (int j = 0; j < 4; ++j) { const f32x4 v = *(const f32x4*)(src + 256 * j + 4 * lane); *(f32x4*)(dst + 256 * j + 4 * lane) = v;
                            u32x2 w; w.x = pk2(v[0], v[1]); w.y = pk2(v[2], v[3]); *(u32x2*)(xb + 256 * j + 4 * lane) = w; s += (v[0] * v[0] + v[1] * v[1]) + (v[2] * v[2] + v[3] * v[3]); }
                        s = wave_sum(s);
                        if (lane < 16) sq[lane] = (lane == 0) ? s : 0.f;
                    } else {
#pragma unroll
                        for (int j = 0; j < 4; ++j) *(u32x2*)(xb + 256 * j + 4 * lane) = (u32x2){0u, 0u};
                        if (lane < 16) sq[lane] = 0.f;
                    }
                }
            }
        }
        SEAM(pb + 0);
        if (IN(pb + 1)) { PHASE_VARS
            pg8::Gemm g{XB, WT + W_GU1, DM, DM, DM, 0, 0}; pg8::StaticOrder S; S.init(NTM, 2 * DFF / 256, G, bx, 1);
            EpiUp E{HB, SSQ}; pg8::gemm_phase<EpiUp>(lds, g, S, E, tid);
        }
        SEAM(pb + 1);
        if (IN(pb + 2)) { PHASE_VARS
            pg8::Gemm g{HB, WT + W_D1, DFF, DFF, DFF, 0, 0}; pg8::StaticOrder S; S.init(NTM, DM / 256, G, bx, 1);
            EpiRes E{X, XB, SSQ, 0.5f}; pg8::gemm_phase<EpiRes>(lds, g, S, E, tid);
        }
        SEAM(pb + 2);
        if (IN(pb + 3)) { PHASE_VARS
            pg8::Gemm g{XB, WT + W_IN, DM, DM, DM, 0, 0}; pg8::StaticOrder S; S.init(NTM, INC / 256, G, bx, 1);
            EpiIn E{Z, SSQ, ap->b_gate + (size_t)l * 2 * DM, ap->out + O_KP + (size_t)l * NBATCH * 512 * 512, ap->out + O_VP + (size_t)l * NBATCH * 512 * 512,
                    ap->out + O_KS + (size_t)l * MS * 512, ap->out + O_VS + (size_t)l * MS * 512};
            pg8::gemm_phase<EpiIn>(lds, g, S, E, tid);
        }
        SEAM(pb + 3);
        if (IN(pb + 4)) { PHASE_VARS
            LAS float* rbl = (LAS float*)(lds + RB_OFF);
            for (int i = tid; i < NH * NREL; i += NWAVES * 64) { const int h = i / NREL, j = i - h * NREL; rbl[h * 264 + j] = ap->rel_bias[(size_t)l * NH * NREL + i] * LOG2E; }
            __syncthreads();
            LAS unsigned char* vbuf = lds + wave * 16384;
#pragma unroll 1
            for (int u = gw; u < 4096; u += NGW) {
                const int c = u & 63, h = (u >> 6) & 7, b = u >> 9;
                const int jlo = (c > 8) ? c - 8 : 0;
                const bf16_t* base = Z + (size_t)(b * SEQ) * INC + h * 64;
                auto tf = [&](int j) { TileD td; const size_t ro = (size_t)(64 * (jlo + j)) * INC; td.K = base + ro + ZC_K; td.V = base + ro + ZC_V; td.pitch = INC; td.nkeys = 64; td.delta0 = 64 * (c - jlo - j); return td; };
                bf16_t* qp = Z + (size_t)(b * SEQ + 64 * c) * INC + ZC_Q + h * 64;
                attn_wave<4>(qp, qp, INC, c - jlo + 1, tf, vbuf, rbl + h * 264, lane);
            }
            { int l2 = lane; asm volatile("" : "+v"(l2)); asm volatile("" : "+s"(Z), "+s"(CK), "+s"(CV));
#pragma unroll 1
            for (int us = gw; us < 64; us += NGW) {
                const int h = us & 7, b = us >> 3;
                const bf16_t* zrow = Z + (size_t)(MP + 16 * b) * INC + h * 64;
                auto tf = [&](int j) { TileD td;
                    if (j < 8) { const size_t ro = (size_t)(b * 512 + 64 * j) * 512 + h * 64; td.K = CK + ro; td.V = CV + ro; td.pitch = 512; td.nkeys = 64; td.delta0 = 512 - 64 * j; }
                    else { td.K = zrow + ZC_K; td.V = zrow + ZC_V; td.pitch = INC; td.nkeys = 16; td.delta0 = 0; }
                    return td; };
                bf16_t* qp = Z + (size_t)(MP + 16 * b) * INC + ZC_Q + h * 64;
                attn_wave<1>(qp, qp, INC, 9, tf, vbuf, rbl + h * 264, l2);
            } }
            for (int cu = (NGW - 1 - gw); cu < MR / 16; cu += NGW) {
                const int row0 = cu * 16, ch = 8 * lane;
                const bool samp = (row0 >= MP);
                const int bb = samp ? (row0 - MP) / 16 : (row0 >> 12), t0 = samp ? 0 : (row0 & 4095);
                float w0[8], w1[8], w2[8], um2[8], um1[8];
                { const float* wc = ap->w_conv + (size_t)l * 3 * 512 + ch;
#pragma unroll
                  for (int i = 0; i < 8; ++i) { w0[i] = wc[i]; w1[i] = wc[512 + i]; w2[i] = wc[1024 + i]; } }
                if (samp) { const float* sc = ap->state_conv + ((size_t)(l * NBATCH + bb) * 2) * 512 + ch;
#pragma unroll
                    for (int i = 0; i < 8; ++i) { um2[i] = sc[i]; um1[i] = sc[512 + i]; }
                } else if (t0 == 0) {
#pragma unroll
                    for (int i = 0; i < 8; ++i) { um2[i] = 0.f; um1[i] = 0.f; }
                } else {
                    const bf16_t* z2 = Z + (size_t)(row0 - 2) * INC + ch; const bf16_t* z1 = Z + (size_t)(row0 - 1) * INC + ch;
                    const u32x4 c2 = *(const u32x4*)(z2 + ZC_CC), v2 = *(const u32x4*)(z2 + ZC_CV), c1 = *(const u32x4*)(z1 + ZC_CC), v1 = *(const u32x4*)(z1 + ZC_CV);
#pragma unroll
                    for (int i = 0; i < 4; ++i) { um2[2 * i] = bf_lo(c2[i]) * bf_lo(v2[i]); um2[2 * i + 1] = bf_hi(c2[i]) * bf_hi(v2[i]); um1[2 * i] = bf_lo(c1[i]) * bf_lo(v1[i]); um1[2 * i + 1] = bf_hi(c1[i]) * bf_hi(v1[i]); }
                }
#pragma unroll 4
                for (int r = 0; r < 16; ++r) {
                    bf16_t* zr = Z + (size_t)(row0 + r) * INC + ch;
                    const u32x4 cbw = *(const u32x4*)(zr + ZC_CB), ccw = *(const u32x4*)(zr + ZC_CC), cvw = *(const u32x4*)(zr + ZC_CV);
                    float y[8];
#pragma unroll
                    for (int i = 0; i < 4; ++i) {
                        const float u0 = bf_lo(ccw[i]) * bf_lo(cvw[i]), u1 = bf_hi(ccw[i]) * bf_hi(cvw[i]);
                        y[2 * i] = bf_lo(cbw[i]) * (w0[2 * i] * um2[2 * i] + w1[2 * i] * um1[2 * i] + w2[2 * i] * u0);
                        y[2 * i + 1] = bf_hi(cbw[i]) * (w0[2 * i + 1] * um2[2 * i + 1] + w1[2 * i + 1] * um1[2 * i + 1] + w2[2 * i + 1] * u1);
                        um2[2 * i] = um1[2 * i]; um1[2 * i] = u0; um2[2 * i + 1] = um1[2 * i + 1]; um1[2 * i + 1] = u1;
                    }
                    u32x4 w; w.x = cvt_pk_bf16(y[0], y[1]); w.y = cvt_pk_bf16(y[2], y[3]); w.z = cvt_pk_bf16(y[4], y[5]); w.w = cvt_pk_bf16(y[6], y[7]);
                    *(u32x4*)(zr + ZC_CB) = w;
                }
                if (samp || t0 == SEQ - 16) {
                    float* dst = ap->out + (samp ? O_CS : O_CP) + ((size_t)(l * NBATCH + bb) * 2) * 512 + ch;
                    *(f32x4*)dst = (f32x4){um2[0], um2[1], um2[2], um2[3]}; *(f32x4*)(dst + 4) = (f32x4){um2[4], um2[5], um2[6], um2[7]};
                    *(f32x4*)(dst + 512) = (f32x4){um1[0], um1[1], um1[2], um1[3]}; *(f32x4*)(dst + 516) = (f32x4){um1[4], um1[5], um1[6], um1[7]};
                }
            }
            asm volatile("s_waitcnt vmcnt(0) lgkmcnt(0)" ::: "memory");
            __syncthreads();
        }
        SEAM(pb + 4);
        if (IN(pb + 5)) { PHASE_VARS
            pg8::Gemm g{Z, WT + W_CAT, INC, DM, 512, 512 * 2, 512 * 2}; pg8::StaticOrder S; S.init(NTM, DM / 256, G, bx, 2);
            EpiMix E{Z}; pg8::gemm_phase<EpiMix>(lds, g, S, E, tid);
        }
        SEAM(pb + 5);
        if (IN(pb + 6)) { PHASE_VARS
            pg8::Gemm g{Z + ZC_MB, WT + W_O, INC, DM, DM, 0, 0}; pg8::StaticOrder S; S.init(NTM, DM / 256, G, bx, 1);
            EpiRes E{X, XB, SSQ, 1.0f}; pg8::gemm_phase<EpiRes>(lds, g, S, E, tid);
        }
        SEAM(pb + 6);
        if (IN(pb + 7)) { PHASE_VARS
            pg8::Gemm g{XB, WT + W_GU2, DM, DM, DM, 0, 0}; pg8::StaticOrder S; S.init(NTM, 2 * DFF / 256, G, bx, 1);
            EpiUp E{HB, SSQ}; pg8::gemm_phase<EpiUp>(lds, g, S, E, tid);
        }
        SEAM(pb + 7);
        if (IN(pb + 8)) { PHASE_VARS
            pg8::Gemm g{HB, WT + W_D2, DFF, DFF, DFF, 0, 0}; pg8::StaticOrder S; S.init(NTM, DM / 256, G, bx, 1);
            EpiRes E{X, XB, SSQ, 0.5f}; pg8::gemm_phase<EpiRes>(lds, g, S, E, tid);
        }
        SEAM(pb + 8);
    }
    if (IN(36)) { PHASE_VARS
        for (int m = gw; m < MR; m += NGW) {
            float* xr = X + (size_t)m * DM;
            const float sv = (lane < 16) ? SSQ[(size_t)m * 16 + lane] : 0.f;
            const float rs = __builtin_amdgcn_rsqf(wave_sum(sv) * (1.0f / 1024.0f) + EPS);
#pragma unroll
            for (int j = 0; j < 4; ++j) { const f32x4 v = *(const f32x4*)(xr + 256 * j + 4 * lane), gn = *(const f32x4*)(ap->norm_final + 256 * j + 4 * lane); *(f32x4*)(xr + 256 * j + 4 * lane) = v * rs * gn; }
        }
    }
#undef IN
#undef SEAM
}

extern "C" void kernel_launch(void* const* d_in, const int* in_sizes, int n_in, void* d_out, int out_size, void* d_ws, size_t ws_size, hipStream_t stream) {
    static int grid = 0;
    if (grid == 0) {
        if (n_in != 20 || (size_t)out_size != O_END || ws_size < WS_END) { fprintf(stderr, "kernel_launch: unexpected shapes: n_in %d out %d (want %zu) ws %zu (need %zu)\n", n_in, out_size, (size_t)O_END, ws_size, (size_t)WS_END); grid = -1; return; }
        int dev = 0, cus = 0, per_cu = 0;
        hipGetDevice(&dev); hipDeviceGetAttribute(&cus, hipDeviceAttributeMultiprocessorCount, dev);
        if (hipFuncSetAttribute((const void*)mega_fwd, hipFuncAttributeMaxDynamicSharedMemorySize, LDS_BYTES) != hipSuccess) { fprintf(stderr, "kernel_launch: hipFuncSetAttribute failed\n"); grid = -1; return; }
        if (hipOccupancyMaxActiveBlocksPerMultiprocessor(&per_cu, (const void*)mega_fwd, NWAVES * 64, LDS_BYTES) != hipSuccess || per_cu < 1) { fprintf(stderr, "kernel_launch: occupancy query says %d\n", per_cu); per_cu = 1; }
        (void)hipGetLastError();
        grid = cus;
    }
    if (grid < 0) return;
    Args a{};
    const float** ap = (const float**)&a;
    for (int i = 0; i < 20; ++i) ap[i] = (const float*)d_in[i];
    a.out = (float*)d_out; a.ws = (unsigned char*)d_ws; a.ph_lo = 0; a.ph_hi = 37;
    void* args[] = {&a};
    hipError_t e = hipLaunchCooperativeKernel((const void*)mega_fwd, dim3(grid), dim3(NWAVES * 64), args, LDS_BYTES, stream);
    if (e != hipSuccess) fprintf(stderr, "kernel_launch: cooperative launch failed: %s (grid %d)\n", hipGetErrorString(e), grid);
}
```

```cpp
#include <hip/hip_runtime.h>
#include <hip/hip_cooperative_groups.h>
#include <cstdio>
#include <cstdint>
namespace cg = cooperative_groups;

#define LAS __attribute__((address_space(3)))
typedef unsigned short bf16_t;
typedef short bf16x8 __attribute__((ext_vector_type(8)));
typedef short s16x4 __attribute__((ext_vector_type(4)));
typedef float f32x4 __attribute__((ext_vector_type(4)));
typedef unsigned u32x4 __attribute__((ext_vector_type(4)));
typedef unsigned u32x2 __attribute__((ext_vector_type(2)));

constexpr int DM = 1024, NBATCH = 8, SEQ = 4096, DEPTH = 4, DSEQ = 16;
constexpr int NH = 8, DFF = 2816, INC = 5120, NREL = 257;
constexpr int MP = NBATCH * SEQ;
constexpr int MS = NBATCH * DSEQ;
constexpr int MR = MP + MS;
constexpr int MPAD = 33024;
constexpr int NTM = MP / 256;
constexpr float EPS = 1e-6f;
constexpr float LOG2E = 1.4426950408889634f;
constexpr float QSCALE = 0.125f * LOG2E;
constexpr int ZC_CB = 0, ZC_Q = 512, ZC_CC = 1024, ZC_CV = 1536, ZC_K = 2048, ZC_V = 2560, ZC_GC = 3072, ZC_GA = 4096, ZC_MB = 1024;

constexpr size_t O_Y = 0;
constexpr size_t O_KP = (size_t)MR * DM;
constexpr size_t O_VP = O_KP + (size_t)DEPTH * NBATCH * 512 * 512;
constexpr size_t O_CP = O_VP + (size_t)DEPTH * NBATCH * 512 * 512;
constexpr size_t O_KS = O_CP + (size_t)DEPTH * NBATCH * 2 * 512;
constexpr size_t O_VS = O_KS + (size_t)DEPTH * NBATCH * DSEQ * 512;
constexpr size_t O_CS = O_VS + (size_t)DEPTH * NBATCH * DSEQ * 512;
constexpr size_t O_END = O_CS + (size_t)DEPTH * NBATCH * 2 * 512;

constexpr size_t W_GU1 = 0;
constexpr size_t W_D1 = W_GU1 + (size_t)2 * DFF * DM;
constexpr size_t W_IN = W_D1 + (size_t)DM * DFF;
constexpr size_t W_CAT = W_IN + (size_t)INC * DM;
constexpr size_t W_O = W_CAT + (size_t)DM * DM;
constexpr size_t W_GU2 = W_O + (size_t)DM * DM;
constexpr size_t W_D2 = W_GU2 + (size_t)2 * DFF * DM;
constexpr size_t W_TOTAL = W_D2 + (size_t)DM * DFF;

constexpr size_t WS_WT = 0;
constexpr size_t WS_XB = WS_WT + ((W_TOTAL * 2 + 4095) / 4096) * 4096;
constexpr size_t WS_SSQ = WS_XB + (size_t)MPAD * DM * 2;
constexpr size_t WS_CK = WS_SSQ + (size_t)MPAD * 16 * 4;
constexpr size_t WS_CV = WS_CK + (size_t)NBATCH * 512 * 512 * 2;
constexpr size_t WS_Z = WS_CV + (size_t)NBATCH * 512 * 512 * 2;
constexpr size_t WS_END = WS_Z + (size_t)MPAD * INC * 2;

constexpr int NWAVES = 8;
constexpr int RING_BYTES = 131072;
constexpr int RB_OFF = RING_BYTES + 1024;
constexpr int LDS_BYTES = 147456;

__device__ __forceinline__ unsigned cvt_pk_bf16(float lo, float hi) { unsigned r; asm volatile("v_cvt_pk_bf16_f32 %0, %1, %2" : "=v"(r) : "v"(lo), "v"(hi)); return r; }
__device__ __forceinline__ float bf_lo(unsigned w) { return __uint_as_float(w << 16); }
__device__ __forceinline__ float bf_hi(unsigned w) { return __uint_as_float(w & 0xffff0000u); }
__device__ __forceinline__ unsigned f2bf(float f) { unsigned u = __float_as_uint(f); return (u + 0x7fffu + ((u >> 16) & 1u)) >> 16; }
__device__ __forceinline__ unsigned pk2(float lo, float hi) { return f2bf(lo) | (f2bf(hi) << 16); }
__device__ __forceinline__ float fast_sigmoid(float x) { return __builtin_amdgcn_rcpf(1.0f + __builtin_amdgcn_exp2f(-x * LOG2E)); }

namespace pg8 {
constexpr int BM = 256, BK = 64, HALF = 128, HTB = HALF * BK * 2, STAGE_BYTES = 8 * HTB, NXCD = 8, WGM = 8;
__host__ __device__ __forceinline__ int lds_byte(int r, int c) { const int st = (r >> 4) * 2 + (c >> 5), rr = r & 15, cc = c & 31, ob = rr * 64 + cc * 2; return st * 1024 + (ob ^ (((ob >> 9) & 1) << 5)); }
__host__ __device__ __forceinline__ void stage_rc(int b, int& R, int& C) { const int st = b / 1024, sb = b % 1024, swz = sb ^ (((sb >> 9) & 1) << 5); R = (st >> 1) * 16 + swz / 64; C = (st & 1) * 32 + (swz % 64) / 2; }
__host__ __device__ __forceinline__ int perm32(int rho) { const int n = rho >> 4, i = rho & 15; return 8 * (i >> 2) + 4 * n + (i & 3); }

struct Unit { int pm, pn, z; };
struct Gemm { const bf16_t* A; const bf16_t* Bt; int lda, ldb, K; long zA, zB; };

struct StaticOrder {
    int nM, nN, nwg, G, c, nz;
    __device__ void init(int nM_, int nN_, int G_, int c_, int nz_) { nM = nM_; nN = nN_; nwg = nM * nN; G = G_; c = c_; nz = nz_; }
    __device__ bool next(int i, Unit& u) const {
        const int it = i / nz; u.z = i - it * nz;
        const long L = (long)it * G + c; if (L >= nwg) return false;
        int wgid = (int)L; { const int q = nwg / NXCD, r = nwg % NXCD, xcd = wgid % NXCD, off = wgid / NXCD; wgid = (xcd < r ? xcd * (q + 1) : r * (q + 1) + (xcd - r) * q) + off; }
        const int nig = WGM * nN, gid = wgid / nig, fm = gid * WGM, gsz = (nM - fm) < WGM ? (nM - fm) : WGM;
        u.pm = fm + ((wgid % nig) % gsz); u.pn = (wgid % nig) / gsz; return true;
    }
};

template <class Epi>
__device__ __forceinline__ void gemm_phase(LAS unsigned char* lds, const Gemm g, const StaticOrder& S, const Epi& E, const int tid) {
    const int wid = __builtin_amdgcn_readfirstlane(tid >> 6), lane = tid & 63, wr = wid >> 2, wc = wid & 3, fr = lane & 15, fq = lane >> 4;
    const int K = g.K, nt = K / BK;
    unsigned voffA[2], voffB[2];
#pragma unroll
    for (int i = 0; i < 2; ++i) { int R, C; stage_rc(tid * 16 + i * 8192, R, C); const int Rb = (R & ~31) + perm32(R & 31);
        voffA[i] = (unsigned)(R * g.lda + C) * 2u; voffB[i] = (unsigned)(Rb * g.ldb + C) * 2u; }
    const size_t kstep = (size_t)(BK * 2);
    const size_t hstepA = (size_t)HALF * g.lda * 2, hstepB = (size_t)HALF * g.ldb * 2;
    const size_t tstepA = 2 * hstepA, tstepB = 2 * hstepB;
    const unsigned ldsw = (unsigned)wid * 1024u;
    const int aoff = lds_byte(wr * 64 + fr, fq * 8), boff = lds_byte(wc * 32 + fr, fq * 8);
#define PG8_SA(b, h) (((b) * 2 + (h)) * HTB)
#define PG8_SB(b, h) ((4 + (b) * 2 + (h)) * HTB)
#define PG8_STAGE(bufoff, gbase, voff) do { _Pragma("unroll") for (int _i = 0; _i < 2; ++_i) \
        __builtin_amdgcn_global_load_lds((const unsigned*)((const char*)(gbase) + (voff)[_i]), (LAS unsigned*)(lds + (bufoff) + ldsw + _i * 8192), 16, 0, 0); } while (0)
#define PG8_LDA(dst, b, h) do { _Pragma("unroll") for (int m = 0; m < 4; ++m) _Pragma("unroll") for (int k = 0; k < 2; ++k) dst[m][k] = *(const LAS bf16x8*)(lds + PG8_SA(b, h) + aoff + m * 2048 + k * 1024); } while (0)
#define PG8_LDB(dst, b, h) do { _Pragma("unroll") for (int n = 0; n < 2; ++n) _Pragma("unroll") for (int k = 0; k < 2; ++k) dst[n][k] = *(const LAS bf16x8*)(lds + PG8_SB(b, h) + boff + n * 2048 + k * 1024); } while (0)
#define PG8_MMA(ai, bj, At, Bt) do { __builtin_amdgcn_s_setprio(1); _Pragma("unroll") for (int m = 0; m < 4; ++m) _Pragma("unroll") for (int n = 0; n < 2; ++n) _Pragma("unroll") for (int k = 0; k < 2; ++k) \
        acc[ai][bj][m][n] = __builtin_amdgcn_mfma_f32_16x16x32_bf16(Bt[n][k], At[m][k], acc[ai][bj][m][n], 0, 0, 0); __builtin_amdgcn_s_setprio(0); } while (0)
#define PG8_WAIT_V(n) asm volatile("s_waitcnt vmcnt(" #n ")" ::: "memory")
#define PG8_WAIT_L(n) asm volatile("s_waitcnt lgkmcnt(" #n ")" ::: "memory")
#define PG8_BAR __builtin_amdgcn_s_barrier()
#define PG8_SCHED __builtin_amdgcn_sched_barrier(0)
    Unit cur, nxt; int ui = 0;
    if (!S.next(0, cur)) return;
    f32x4 acc[2][2][4][2];
#pragma unroll
    for (int a = 0; a < 2; ++a)
#pragma unroll
        for (int b = 0; b < 2; ++b)
#pragma unroll
            for (int m = 0; m < 4; ++m)
#pragma unroll
                for (int n = 0; n < 2; ++n) acc[a][b][m][n] = (f32x4){0.f, 0.f, 0.f, 0.f};
    bf16x8 At[4][2], B0[2][2], B1[2][2];
    const char* cA = (const char*)g.A + (size_t)cur.pm * tstepA + (size_t)cur.z * g.zA; const char* cB = (const char*)g.Bt + (size_t)cur.pn * tstepB + (size_t)cur.z * g.zB;
    PG8_STAGE(PG8_SB(0, 0), cB, voffB); PG8_STAGE(PG8_SB(0, 1), cB + hstepB, voffB); PG8_STAGE(PG8_SA(0, 0), cA, voffA); PG8_STAGE(PG8_SA(0, 1), cA + hstepA, voffA);
    if (wr == 1) PG8_BAR;
    PG8_WAIT_V(2); PG8_BAR;
    PG8_STAGE(PG8_SB(1, 0), cB + kstep, voffB); PG8_STAGE(PG8_SA(1, 0), cA + kstep, voffA); PG8_STAGE(PG8_SB(1, 1), cB + hstepB + kstep, voffB);
    PG8_WAIT_V(6); PG8_BAR;
    for (;;) {
        const bool has_next = S.next(ui + 1, nxt);
        const char* nA = has_next ? (const char*)g.A + (size_t)nxt.pm * tstepA + (size_t)nxt.z * g.zA : cA; const char* nB = has_next ? (const char*)g.Bt + (size_t)nxt.pn * tstepB + (size_t)nxt.z * g.zB : cB;
        for (int t = 0; t < nt; t += 2) {
            const bool last = (t == nt - 2);
            const char* a1 = cA + (size_t)(t + 1) * kstep;
            const char* a2 = last ? nA : cA + (size_t)(t + 2) * kstep; const char* b2 = last ? nB : cB + (size_t)(t + 2) * kstep;
            const char* a3 = a2 + kstep; const char* b3 = b2 + kstep;
            PG8_LDB(B0, 0, 0); PG8_LDB(B1, 0, 1); PG8_SCHED; PG8_LDA(At, 0, 0); PG8_STAGE(PG8_SA(1, 1), a1 + hstepA, voffA);
            PG8_WAIT_V(8); PG8_WAIT_L(0); PG8_BAR; PG8_MMA(0, 0, At, B0); PG8_MMA(0, 1, At, B1); PG8_BAR; PG8_SCHED;
            PG8_LDA(At, 0, 1); PG8_STAGE(PG8_SB(0, 0), b2, voffB); PG8_STAGE(PG8_SB(0, 1), b2 + hstepB, voffB); PG8_STAGE(PG8_SA(0, 0), a2, voffA);
            PG8_WAIT_V(8); PG8_WAIT_L(0); PG8_BAR; PG8_MMA(1, 0, At, B0); PG8_MMA(1, 1, At, B1); PG8_BAR; PG8_SCHED;
            PG8_LDB(B0, 1, 0); PG8_LDB(B1, 1, 1); PG8_SCHED; PG8_LDA(At, 1, 0); PG8_STAGE(PG8_SA(0, 1), a2 + hstepA, voffA);
            PG8_WAIT_V(8); PG8_WAIT_L(0); PG8_BAR; PG8_MMA(0, 0, At, B0); PG8_MMA(0, 1, At, B1); PG8_BAR; PG8_SCHED;
            PG8_LDA(At, 1, 1); PG8_STAGE(PG8_SB(1, 0), b3, voffB); PG8_STAGE(PG8_SB(1, 1), b3 + hstepB, voffB); PG8_STAGE(PG8_SA(1, 0), a3, voffA);
            PG8_WAIT_V(8); PG8_WAIT_L(0); PG8_BAR; PG8_MMA(1, 0, At, B0); PG8_MMA(1, 1, At, B1); PG8_BAR; PG8_SCHED;
        }
        if (wr == 0) PG8_BAR;
        E(acc, cur, wr, wc, fr, fq);
        if (!has_next) break;
#pragma unroll
        for (int a = 0; a < 2; ++a)
#pragma unroll
            for (int b = 0; b < 2; ++b)
#pragma unroll
                for (int m = 0; m < 4; ++m)
#pragma unroll
                    for (int n = 0; n < 2; ++n) acc[a][b][m][n] = (f32x4){0.f, 0.f, 0.f, 0.f};
        cur = nxt; cA = nA; cB = nB; ++ui;
        if (wr == 1) PG8_BAR;
    }
    PG8_WAIT_V(0);
    PG8_BAR;
#undef PG8_SA
#undef PG8_SB
#undef PG8_STAGE
#undef PG8_LDA
#undef PG8_LDB
#undef PG8_MMA
#undef PG8_WAIT_V
#undef PG8_WAIT_L
#undef PG8_BAR
#undef PG8_SCHED
}
}

__device__ __forceinline__ float row_rs(const float* ssq, int row, int fq) {
    const f32x4 v = *(const f32x4*)(ssq + (size_t)row * 16 + 4 * fq);
    float s = (v[0] + v[1]) + (v[2] + v[3]);
    s += __shfl_xor(s, 16); s += __shfl_xor(s, 32);
    return __builtin_amdgcn_rsqf(s * (1.0f / 1024.0f) + EPS);
}

struct EpiUp {
    bf16_t* H; const float* ssq;
    __device__ __forceinline__ void operator()(const f32x4 (&acc)[2][2][4][2], const pg8::Unit& u, int wr, int wc, int fr, int fq) const {
        const int row0 = u.pm * 256 + wr * 64 + fr, hc0 = u.pn * 128 + wc * 16 + 4 * fq;
#pragma unroll
        for (int ai = 0; ai < 2; ++ai)
#pragma unroll
            for (int m = 0; m < 4; ++m) {
                const int row = row0 + ai * 128 + m * 16; const float rs = row_rs(ssq, row, fq);
#pragma unroll
                for (int bj = 0; bj < 2; ++bj) {
                    const f32x4 gg = acc[ai][bj][m][0] * rs, uu = acc[ai][bj][m][1] * rs; float h[4];
#pragma unroll
                    for (int i = 0; i < 4; ++i) h[i] = gg[i] * fast_sigmoid(gg[i]) * uu[i];
                    u32x2 w; w.x = cvt_pk_bf16(h[0], h[1]); w.y = cvt_pk_bf16(h[2], h[3]);
                    *(u32x2*)(H + (size_t)row * DFF + hc0 + bj * 64) = w;
                }
            }
    }
    __device__ __forceinline__ void small(const f32x4 (&acc)[1][2][2], int row, int c0, int fr, int fq) const {
        const float rs = row_rs(ssq, row, fq);
#pragma unroll
        for (int j = 0; j < 2; ++j) {
            const f32x4 gg = acc[0][j][0] * rs, uu = acc[0][j][1] * rs; float h[4];
#pragma unroll
            for (int i = 0; i < 4; ++i) h[i] = gg[i] * fast_sigmoid(gg[i]) * uu[i];
            u32x2 w; w.x = cvt_pk_bf16(h[0], h[1]); w.y = cvt_pk_bf16(h[2], h[3]);
            *(u32x2*)(H + (size_t)row * DFF + (c0 >> 1) + 16 * j + 4 * fq) = w;
        }
    }
};

struct EpiRes {
    float* X; bf16_t* XB; float* ssq; float scale;
    __device__ __forceinline__ void operator()(const f32x4 (&acc)[2][2][4][2], const pg8::Unit& u, int wr, int wc, int fr, int fq) const {
        const int row0 = u.pm * 256 + wr * 64 + fr, col0 = u.pn * 256 + wc * 32 + 8 * fq;
#pragma unroll
        for (int ai = 0; ai < 2; ++ai)
#pragma unroll
            for (int m = 0; m < 4; ++m) {
                const int row = row0 + ai * 128 + m * 16;
                {
                    float s = 0.f;
#pragma unroll
                    for (int bj = 0; bj < 2; ++bj) {
                        float* xp = X + (size_t)row * DM + col0 + bj * 128;
                        f32x4 x0 = *(const f32x4*)xp, x1 = *(const f32x4*)(xp + 4);
                        x0 += acc[ai][bj][m][0] * scale; x1 += acc[ai][bj][m][1] * scale;
                        *(f32x4*)xp = x0; *(f32x4*)(xp + 4) = x1;
                        u32x4 w; w.x = cvt_pk_bf16(x0[0], x0[1]); w.y = cvt_pk_bf16(x0[2], x0[3]); w.z = cvt_pk_bf16(x1[0], x1[1]); w.w = cvt_pk_bf16(x1[2], x1[3]);
                        *(u32x4*)(XB + (size_t)row * DM + col0 + bj * 128) = w;
                        s += (x0[0] * x0[0] + x0[1] * x0[1]) + (x0[2] * x0[2] + x0[3] * x0[3]) + (x1[0] * x1[0] + x1[1] * x1[1]) + (x1[2] * x1[2] + x1[3] * x1[3]);
                    }
                    s += __shfl_xor(s, 16); s += __shfl_xor(s, 32);
                    if (fq == 0) ssq[(size_t)row * 16 + u.pn * 4 + wc] = s;
                }
                if (m & 1) asm volatile("" ::: "memory");
            }
    }
    __device__ __forceinline__ void small(const f32x4 (&acc)[1][2][2], int row, int c0, int fr, int fq) const {
        float s = 0.f;
#pragma unroll
        for (int j = 0; j < 2; ++j) {
            float* xp = X + (size_t)row * DM + c0 + 32 * j + 8 * fq;
            f32x4 x0 = *(const f32x4*)xp, x1 = *(const f32x4*)(xp + 4);
            x0 += acc[0][j][0] * scale; x1 += acc[0][j][1] * scale;
            *(f32x4*)xp = x0; *(f32x4*)(xp + 4) = x1;
            u32x4 w; w.x = cvt_pk_bf16(x0[0], x0[1]); w.y = cvt_pk_bf16(x0[2], x0[3]); w.z = cvt_pk_bf16(x1[0], x1[1]); w.w = cvt_pk_bf16(x1[2], x1[3]);
            *(u32x4*)(XB + (size_t)row * DM + c0 + 32 * j + 8 * fq) = w;
            s += (x0[0] * x0[0] + x0[1] * x0[1]) + (x0[2] * x0[2] + x0[3] * x0[3]) + (x1[0] * x1[0] + x1[1] * x1[1]) + (x1[2] * x1[2] + x1[3] * x1[3]);
        }
        s += __shfl_xor(s, 16); s += __shfl_xor(s, 32);
        if (fq == 0) ssq[(size_t)row * 16 + (c0 >> 6)] = s;
    }
};

struct EpiIn {
    bf16_t* Z; const float* ssq; const float* bgate; float* okp; float* ovp; float* oks; float* ovs;
    __device__ __forceinline__ void operator()(const f32x4 (&acc)[2][2][4][2], const pg8::Unit& u, int wr, int wc, int fr, int fq) const {
        const int row0 = u.pm * 256 + wr * 64 + fr, col0 = u.pn * 256 + wc * 32 + 8 * fq;
        const int pn = u.pn;
        const bool isq = (pn == 2 || pn == 3), iskv = (pn >= 8 && pn < 12), isg = (pn >= 12);
        const bool kvp = iskv && ((u.pm & 15) >= 14);
        f32x4 bg[2][2];
#pragma unroll
        for (int bj = 0; bj < 2; ++bj) { if (isg) { bg[bj][0] = *(const f32x4*)(bgate + col0 - ZC_GC + bj * 128); bg[bj][1] = *(const f32x4*)(bgate + col0 - ZC_GC + bj * 128 + 4); } else { bg[bj][0] = (f32x4){0.f, 0.f, 0.f, 0.f}; bg[bj][1] = bg[bj][0]; } }
#pragma unroll
        for (int ai = 0; ai < 2; ++ai)
#pragma unroll
            for (int m = 0; m < 4; ++m) {
                const int row = row0 + ai * 128 + m * 16; float rs = row_rs(ssq, row, fq);
                if (isq) rs *= QSCALE;
#pragma unroll
                for (int bj = 0; bj < 2; ++bj) {
                    f32x4 v0 = acc[ai][bj][m][0] * rs, v1 = acc[ai][bj][m][1] * rs;
                    const int c = col0 + bj * 128;
                    if (isg) {
                        v0 += bg[bj][0]; v1 += bg[bj][1];
#pragma unroll
                        for (int i = 0; i < 4; ++i) { v0[i] = fast_sigmoid(v0[i]); v1[i] = fast_sigmoid(v1[i]); }
                    }
                    u32x4 w; w.x = cvt_pk_bf16(v0[0], v0[1]); w.y = cvt_pk_bf16(v0[2], v0[3]); w.z = cvt_pk_bf16(v1[0], v1[1]); w.w = cvt_pk_bf16(v1[2], v1[3]);
                    *(u32x4*)(Z + (size_t)row * INC + c) = w;
                    if (kvp) {
                        const int b = row >> 12, t = row & 4095;
                        float* dst = ((pn < 10) ? okp : ovp) + ((size_t)(b * 512 + (t - 3584)) * 512 + (c - ((pn < 10) ? ZC_K : ZC_V)));
                        *(f32x4*)dst = v0; *(f32x4*)(dst + 4) = v1;
                    }
                }
            }
    }
    __device__ __forceinline__ void small(const f32x4 (&acc)[1][2][2], int row, int c0, int fr, int fq) const {
        const int pn = c0 >> 8;
        const bool isq = (pn == 2 || pn == 3), iskv = (pn >= 8 && pn < 12), isg = (pn >= 12);
        float rs = row_rs(ssq, row, fq);
        if (isq) rs *= QSCALE;
#pragma unroll
        for (int j = 0; j < 2; ++j) {
            f32x4 v0 = acc[0][j][0] * rs, v1 = acc[0][j][1] * rs;
            const int c = c0 + 32 * j + 8 * fq;
            if (isg) {
                v0 += *(const f32x4*)(bgate + c - ZC_GC); v1 += *(const f32x4*)(bgate + c - ZC_GC + 4);
#pragma unroll
                for (int i = 0; i < 4; ++i) { v0[i] = fast_sigmoid(v0[i]); v1[i] = fast_sigmoid(v1[i]); }
            }
            u32x4 w; w.x = cvt_pk_bf16(v0[0], v0[1]); w.y = cvt_pk_bf16(v0[2], v0[3]); w.z = cvt_pk_bf16(v1[0], v1[1]); w.w = cvt_pk_bf16(v1[2], v1[3]);
            *(u32x4*)(Z + (size_t)row * INC + c) = w;
            if (iskv) {
                float* dst = ((pn < 10) ? oks : ovs) + ((size_t)(row - MP) * 512 + (c - ((pn < 10) ? ZC_K : ZC_V)));
                *(f32x4*)dst = v0; *(f32x4*)(dst + 4) = v1;
            }
        }
    }
};

struct EpiMix {
    bf16_t* Z;
    __device__ __forceinline__ void operator()(const f32x4 (&acc)[2][2][4][2], const pg8::Unit& u, int wr, int wc, int fr, int fq) const {
        const int row0 = u.pm * 256 + wr * 64 + fr, col0 = u.pn * 256 + wc * 32 + 8 * fq;
        const int gcol = (u.z == 0) ? ZC_GC : ZC_GA;
#pragma unroll
        for (int ai = 0; ai < 2; ++ai)
#pragma unroll
            for (int m = 0; m < 4; ++m) {
                const int row = row0 + ai * 128 + m * 16;
#pragma unroll
                for (int bj = 0; bj < 2; ++bj) {
                    const int c = col0 + bj * 128;
                    const u32x4 gw = *(const u32x4*)(Z + (size_t)row * INC + gcol + c);
                    f32x4 v0 = acc[ai][bj][m][0], v1 = acc[ai][bj][m][1];
                    v0[0] *= bf_lo(gw.x); v0[1] *= bf_hi(gw.x); v0[2] *= bf_lo(gw.y); v0[3] *= bf_hi(gw.y);
                    v1[0] *= bf_lo(gw.z); v1[1] *= bf_hi(gw.z); v1[2] *= bf_lo(gw.w); v1[3] *= bf_hi(gw.w);
                    bf16_t* mp = Z + (size_t)row * INC + ZC_MB + c;
                    if (u.z != 0) {
                        const u32x4 pw = *(const u32x4*)mp;
                        v0[0] += bf_lo(pw.x); v0[1] += bf_hi(pw.x); v0[2] += bf_lo(pw.y); v0[3] += bf_hi(pw.y);
                        v1[0] += bf_lo(pw.z); v1[1] += bf_hi(pw.z); v1[2] += bf_lo(pw.w); v1[3] += bf_hi(pw.w);
                    }
                    u32x4 w; w.x = cvt_pk_bf16(v0[0], v0[1]); w.y = cvt_pk_bf16(v0[2], v0[3]); w.z = cvt_pk_bf16(v1[0], v1[1]); w.w = cvt_pk_bf16(v1[2], v1[3]);
                    *(u32x4*)mp = w;
                }
            }
    }
    __device__ __forceinline__ void small(const f32x4 (&acc)[2][2][2], int row, int c0, int fr, int fq) const {
#pragma unroll
        for (int j = 0; j < 2; ++j) {
            const int c = c0 + 32 * j + 8 * fq;
            const u32x4 gc = *(const u32x4*)(Z + (size_t)row * INC + ZC_GC + c), ga = *(const u32x4*)(Z + (size_t)row * INC + ZC_GA + c);
            const f32x4 a0 = acc[0][j][0], a1 = acc[0][j][1], b0 = acc[1][j][0], b1 = acc[1][j][1];
            float m[8];
            m[0] = a0[0] * bf_lo(gc.x) + b0[0] * bf_lo(ga.x); m[1] = a0[1] * bf_hi(gc.x) + b0[1] * bf_hi(ga.x);
            m[2] = a0[2] * bf_lo(gc.y) + b0[2] * bf_lo(ga.y); m[3] = a0[3] * bf_hi(gc.y) + b0[3] * bf_hi(ga.y);
            m[4] = a1[0] * bf_lo(gc.z) + b1[0] * bf_lo(ga.z); m[5] = a1[1] * bf_hi(gc.z) + b1[1] * bf_hi(ga.z);
            m[6] = a1[2] * bf_lo(gc.w) + b1[2] * bf_lo(ga.w); m[7] = a1[3] * bf_hi(gc.w) + b1[3] * bf_hi(ga.w);
            u32x4 w; w.x = cvt_pk_bf16(m[0], m[1]); w.y = cvt_pk_bf16(m[2], m[3]); w.z = cvt_pk_bf16(m[4], m[5]); w.w = cvt_pk_bf16(m[6], m[7]);
            *(u32x4*)(Z + (size_t)row * INC + ZC_MB + c) = w;
        }
    }
};

template <int NSET, int NSTEP  , class Epi>
__device__ __forceinline__ void small_gemm(LAS unsigned char* lds, const bf16_t* A0, const bf16_t* A1, int lda, const bf16_t* W0, const bf16_t* W1, int ldb, int ncg, const Epi& E, int bx, int G, int wave, int lane) {
    const int fr = lane & 15, fq = lane >> 4;
    LAS f32x4* part = (LAS f32x4*)lds;
#pragma unroll 1
    for (int u = bx; u < 8 * ncg; u += G) {
        const int rb = u & 7, cg = u >> 3;
        const int row = MP + 16 * rb + fr;
        f32x4 acc[NSET][2][2];
#pragma unroll
        for (int st = 0; st < NSET; ++st) {
            const bf16_t* Ap = (st ? A1 : A0) + (size_t)row * lda + wave * (NSTEP * 32) + 8 * fq;
            const bf16_t* Wp = (st ? W1 : W0) + (size_t)(64 * cg + 8 * (fr >> 2) + (fr & 3)) * ldb + wave * (NSTEP * 32) + 8 * fq;
#pragma unroll
            for (int j = 0; j < 2; ++j)
#pragma unroll
                for (int n = 0; n < 2; ++n) acc[st][j][n] = (f32x4){0.f, 0.f, 0.f, 0.f};
#pragma unroll 4
            for (int k = 0; k < NSTEP; ++k) {
                const bf16x8 av = *(const bf16x8*)(Ap + 32 * k);
#pragma unroll
                for (int j = 0; j < 2; ++j)
#pragma unroll
                    for (int n = 0; n < 2; ++n) {
                        const bf16x8 bv = *(const bf16x8*)(Wp + (size_t)(32 * j + 4 * n) * ldb + 32 * k);
                        acc[st][j][n] = __builtin_amdgcn_mfma_f32_16x16x32_bf16(bv, av, acc[st][j][n], 0, 0, 0);
                    }
            }
        }
#pragma unroll
        for (int st = 0; st < NSET; ++st)
#pragma unroll
            for (int j = 0; j < 2; ++j)
#pragma unroll
                for (int n = 0; n < 2; ++n) part[((wave * NSET + st) * 4 + j * 2 + n) * 64 + lane] = acc[st][j][n];
        __syncthreads();
        if (wave == 0) {
#pragma unroll
            for (int w = 1; w < 8; ++w)
#pragma unroll
                for (int st = 0; st < NSET; ++st)
#pragma unroll
                    for (int j = 0; j < 2; ++j)
#pragma unroll
                        for (int n = 0; n < 2; ++n) acc[st][j][n] += part[((w * NSET + st) * 4 + j * 2 + n) * 64 + lane];
            E.small(acc, row, 64 * cg, fr, fq);
        }
        __syncthreads();
    }
}

struct TileD { const bf16_t* K; const bf16_t* V; int pitch; int nkeys; int delta0; };

__device__ __forceinline__ void attn_dma_v(const TileD& td, LAS unsigned char* vb, int lane) {
#pragma unroll
    for (int i = 0; i < 8; ++i) {
        const int row = 8 * i + (lane >> 3), chs = lane & 7, ch = chs ^ (((row >> 1) & 3) << 1);
        __builtin_amdgcn_global_load_lds((const unsigned*)(td.V + (size_t)row * td.pitch + ch * 8), (LAS unsigned*)(vb + i * 1024), 16, 0, 0);
    }
}
template <int NQB, class TF>
__device__ __forceinline__ void attn_wave(const bf16_t* Qp, bf16_t* Op, int qpitch, int nt, const TF& tilef, LAS unsigned char* vbuf, const LAS float* rb, int lane) {
    const int fr = lane & 15, fq = lane >> 4;
    bf16x8 qf[NQB][2];
#pragma unroll
    for (int qb = 0; qb < NQB; ++qb)
#pragma unroll
        for (int dh = 0; dh < 2; ++dh) qf[qb][dh] = *(const bf16x8*)(Qp + (size_t)(16 * qb + fr) * qpitch + dh * 32 + 8 * fq);
    f32x4 O[NQB][4]; float mrow[NQB], lrow[NQB];
#pragma unroll
    for (int qb = 0; qb < NQB; ++qb) { mrow[qb] = -1e30f; lrow[qb] = 0.f;
#pragma unroll
        for (int db = 0; db < 4; ++db) O[qb][db] = (f32x4){0.f, 0.f, 0.f, 0.f}; }
    const int qp = fr >> 2, pp = fr & 3, rowl = 4 * fq + qp, sw = ((rowl >> 1) & 3) << 1;
    const int vrow = rowl * 128 + (pp & 1) * 8, vch = (pp >> 1) ^ sw;
    bf16x8 kf[2][2];
    { const TileD td = tilef(0); attn_dma_v(td, vbuf, lane);
#pragma unroll
      for (int kb = 0; kb < 2; ++kb)
#pragma unroll
          for (int dh = 0; dh < 2; ++dh) kf[kb][dh] = *(const bf16x8*)(td.K + (size_t)(16 * kb + fr) * td.pitch + dh * 32 + 8 * fq); }
    const int nht = 2 * nt;
#pragma unroll 1
    for (int ht = 0; ht < nht; ++ht) {
        const int t = ht >> 1, half = ht & 1;
        asm volatile("s_waitcnt vmcnt(0)" ::: "memory");
        const TileD td = tilef(t);
        if (half == 0 && t + 1 < nt) { const TileD tn = tilef(t + 1); attn_dma_v(tn, vbuf + ((t + 1) & 1) * 8192, lane); }
        f32x4 S[2][NQB];
#pragma unroll
        for (int kb = 0; kb < 2; ++kb)
#pragma unroll
            for (int qb = 0; qb < NQB; ++qb) {
                f32x4 s = __builtin_amdgcn_mfma_f32_16x16x32_bf16(kf[kb][0], qf[qb][0], (f32x4){0.f, 0.f, 0.f, 0.f}, 0, 0, 0);
                S[kb][qb] = __builtin_amdgcn_mfma_f32_16x16x32_bf16(kf[kb][1], qf[qb][1], s, 0, 0, 0);
            }
        if (ht + 1 < nht) {
            const TileD tk = tilef((ht + 1) >> 1); const int r0 = 32 * ((ht + 1) & 1);
#pragma unroll
            for (int kb = 0; kb < 2; ++kb)
#pragma unroll
                for (int dh = 0; dh < 2; ++dh) kf[kb][dh] = *(const bf16x8*)(tk.K + (size_t)(r0 + 16 * kb + fr) * tk.pitch + dh * 32 + 8 * fq);
        }
        const int delta0 = td.delta0 - 32 * half, nkeys = td.nkeys - 32 * half;
        if (delta0 >= 160) {
            const float bc = rb[256];
#pragma unroll
            for (int kb = 0; kb < 2; ++kb)
#pragma unroll
                for (int qb = 0; qb < NQB; ++qb) S[kb][qb] += bc;
        } else {
#pragma unroll
            for (int kb = 0; kb < 2; ++kb)
#pragma unroll
                for (int qb = 0; qb < NQB; ++qb)
#pragma unroll
                    for (int i = 0; i < 4; ++i) {
                        int d = delta0 + (16 * qb + fr) - (16 * kb + 4 * fq + i);
                        d = d < -128 ? -128 : (d > 128 ? 128 : d);
                        S[kb][qb][i] += rb[d + 128];
                    }
        }
        if (nkeys < 32) {
#pragma unroll
            for (int kb = 0; kb < 2; ++kb)
#pragma unroll
                for (int qb = 0; qb < NQB; ++qb)
#pragma unroll
                    for (int i = 0; i < 4; ++i) if (16 * kb + 4 * fq + i >= nkeys) S[kb][qb][i] = -INFINITY;
        }
        bf16x8 pf[NQB];
#pragma unroll
        for (int qb = 0; qb < NQB; ++qb) {
            float mx = fmaxf(fmaxf(fmaxf(S[0][qb][0], S[0][qb][1]), fmaxf(S[0][qb][2], S[0][qb][3])), fmaxf(fmaxf(S[1][qb][0], S[1][qb][1]), fmaxf(S[1][qb][2], S[1][qb][3])));
            mx = fmaxf(mx, __shfl_xor(mx, 16)); mx = fmaxf(mx, __shfl_xor(mx, 32));
            const float mn = fmaxf(mrow[qb], mx), alpha = __builtin_amdgcn_exp2f(mrow[qb] - mn);
            mrow[qb] = mn; float ps = 0.f; float p[2][4];
#pragma unroll
            for (int kb = 0; kb < 2; ++kb)
#pragma unroll
                for (int i = 0; i < 4; ++i) { p[kb][i] = __builtin_amdgcn_exp2f(S[kb][qb][i] - mn); ps += p[kb][i]; }
            lrow[qb] = lrow[qb] * alpha + ps;
#pragma unroll
            for (int db = 0; db < 4; ++db) O[qb][db] *= alpha;
            u32x4 w; w.x = cvt_pk_bf16(p[0][0], p[0][1]); w.y = cvt_pk_bf16(p[0][2], p[0][3]); w.z = cvt_pk_bf16(p[1][0], p[1][1]); w.w = cvt_pk_bf16(p[1][2], p[1][3]);
            pf[qb] = __builtin_bit_cast(bf16x8, w);
        }
        const LAS unsigned char* vb = vbuf + (t & 1) * 8192 + half * 4096 + vrow;
#pragma unroll
        for (int db = 0; db < 4; ++db) {
            const int off = ((2 * db) ^ vch) << 4;
            const s16x4 lo = __builtin_amdgcn_ds_read_tr16_b64_v4i16((LAS s16x4*)(vb + off));
            const s16x4 hi = __builtin_amdgcn_ds_read_tr16_b64_v4i16((LAS s16x4*)(vb + off + 2048));
            const bf16x8 vf = (bf16x8){lo[0], lo[1], lo[2], lo[3], hi[0], hi[1], hi[2], hi[3]};
#pragma unroll
            for (int qb = 0; qb < NQB; ++qb) O[qb][db] = __builtin_amdgcn_mfma_f32_16x16x32_bf16(vf, pf[qb], O[qb][db], 0, 0, 0);
        }
    }
    asm volatile("s_waitcnt lgkmcnt(0)" ::: "memory");
#pragma unroll
    for (int qb = 0; qb < NQB; ++qb) {
        float l = lrow[qb]; l += __shfl_xor(l, 16); l += __shfl_xor(l, 32);
        const float inv = 1.0f / l;
#pragma unroll
        for (int db = 0; db < 4; ++db) {
            const f32x4 o = O[qb][db] * inv; u32x2 w; w.x = cvt_pk_bf16(o[0], o[1]); w.y = cvt_pk_bf16(o[2], o[3]);
            *(u32x2*)(Op + (size_t)(16 * qb + fr) * qpitch + 16 * db + 4 * fq) = w;
        }
    }
}

struct Args {
    const float* x_prompt; const float* x_sample; const float* cache_k; const float* cache_v; const float* state_conv;
    const float* norm_ffn1; const float* w_ffn1_gu; const float* w_ffn1_down; const float* norm_mix; const float* w_in; const float* b_gate; const float* w_conv;
    const float* rel_bias; const float* w_conv_out; const float* w_attn_out; const float* w_o; const float* norm_ffn2; const float* w_ffn2_gu; const float* w_ffn2_down; const float* norm_final;
    float* out; unsigned char* ws; int ph_lo, ph_hi;
};

__device__ __forceinline__ void transpose_item(const float* W, int N, const float* gain, bf16_t* WT, int dpitch, int dkoff, int mode, int kb, int nb, int scol0, LAS float* scr, int lane) {
    const int k0 = 64 * kb, n0 = 32 * nb, c = lane & 31;
    const int scol = (mode == 1) ? ((c < 16) ? 16 * nb + c : DFF + 16 * nb + (c - 16)) : scol0 + c;
#pragma unroll 8
    for (int i = 0; i < 32; ++i) { const int kk = 2 * i + (lane >> 5); float v = W[(size_t)(k0 + kk) * N + scol]; if (gain) v *= gain[k0 + kk]; scr[kk * 33 + c] = v; }
    asm volatile("s_waitcnt lgkmcnt(0)" ::: "memory");
    const int c8 = lane & 7;
#pragma unroll
    for (int j = 0; j < 4; ++j) { const int n = (lane >> 3) + 8 * j; const LAS float* s = scr + (8 * c8) * 33 + n;
        u32x4 o; o.x = pk2(s[0 * 33], s[1 * 33]); o.y = pk2(s[2 * 33], s[3 * 33]); o.z = pk2(s[4 * 33], s[5 * 33]); o.w = pk2(s[6 * 33], s[7 * 33]);
        int drow;
        if (mode == 1) { const int jj = n & 15, isu = n >> 4; drow = n0 + 8 * (jj >> 2) + 4 * isu + (jj & 3); } else drow = n0 + n;
        *(u32x4*)(WT + (size_t)drow * dpitch + dkoff + k0 + 8 * c8) = o; }
    asm volatile("s_waitcnt lgkmcnt(0)" ::: "memory");
}

__device__ __forceinline__ float wave_sum(float v) {
#pragma unroll
    for (int o = 1; o < 64; o <<= 1) v += __shfl_xor(v, o);
    return v;
}

__global__ void __launch_bounds__(NWAVES * 64, 2) mega_fwd(Args a) {
    extern __shared__ __attribute__((aligned(16))) unsigned char lds_raw[];
    LAS unsigned char* lds = (LAS unsigned char*)lds_raw;
    cg::grid_group grid = cg::this_grid();
    typedef const __attribute__((address_space(4))) Args* ArgP;
    ArgP ap = (ArgP)__builtin_amdgcn_kernarg_segment_ptr();
    const int G = gridDim.x, bx = blockIdx.x;
    const int wave0 = __builtin_amdgcn_readfirstlane((int)threadIdx.x >> 6);
    const int lo = ap->ph_lo, hi = ap->ph_hi;
#define PHASE_VARS \
    asm volatile("" : "+s"(ap)); \
    int lane_ = (int)__builtin_amdgcn_mbcnt_hi(~0u, __builtin_amdgcn_mbcnt_lo(~0u, 0u)); asm volatile("" : "+v"(lane_)); \
    int wave_ = wave0; asm volatile("" : "+s"(wave_)); \
    const int lane = lane_, wave = wave_, tid = wave * 64 + lane; \
    const int vcu = (G % 8 == 0) ? (bx % 8) * (G / 8) + bx / 8 : bx; \
    const int gw = vcu * NWAVES + wave, NGW = G * NWAVES; \
    const int gt = gw * 64 + lane, NGT = NGW * 64; \
    unsigned char* ws = ap->ws; \
    bf16_t* WT = (bf16_t*)(ws + WS_WT); bf16_t* XB = (bf16_t*)(ws + WS_XB); float* SSQ = (float*)(ws + WS_SSQ); \
    bf16_t* CK = (bf16_t*)(ws + WS_CK); bf16_t* CV = (bf16_t*)(ws + WS_CV); bf16_t* Z = (bf16_t*)(ws + WS_Z); bf16_t* HB = Z; \
    float* X = ap->out; \
    (void)tid; (void)lane; (void)wave; (void)gw; (void)NGW; (void)gt; (void)NGT; (void)WT; (void)XB; (void)SSQ; (void)CK; (void)CV; (void)Z; (void)HB; (void)X;
#define IN(k) (lo <= (k) && (k) < hi)
#define SEAM(k) do { if (IN(k) && IN((k) + 1)) grid.sync(); } while (0)

#pragma unroll 1
    for (int l = 0; l < DEPTH; ++l) {
        const int pb = 9 * l;
        if (IN(pb + 0)) { PHASE_VARS
            LAS float* scr = (LAS float*)(lds + wave * 16384);
            constexpr int I_GU = 16 * 176, I_D = 44 * 32, I_IN = 16 * 160, I_C = 8 * 32, I_O = 16 * 32;
            constexpr int NITEMS = 2 * I_GU + 2 * I_D + I_IN + 2 * I_C + I_O;
            for (int it = gw; it < NITEMS; it += NGW) {
                int r = it;
                if (r < I_GU) { transpose_item(ap->w_ffn1_gu + (size_t)l * DM * 2 * DFF, 2 * DFF, ap->norm_ffn1 + l * DM, WT + W_GU1, DM, 0, 1, r / 176, r % 176, 0, scr, lane); continue; } r -= I_GU;
                if (r < I_GU) { transpose_item(ap->w_ffn2_gu + (size_t)l * DM * 2 * DFF, 2 * DFF, ap->norm_ffn2 + l * DM, WT + W_GU2, DM, 0, 1, r / 176, r % 176, 0, scr, lane); continue; } r -= I_GU;
                if (r < I_D) { transpose_item(ap->w_ffn1_down + (size_t)l * DFF * DM, DM, nullptr, WT + W_D1, DFF, 0, 0, r / 32, r % 32, 32 * (r % 32), scr, lane); continue; } r -= I_D;
                if (r < I_D) { transpose_item(ap->w_ffn2_down + (size_t)l * DFF * DM, DM, nullptr, WT + W_D2, DFF, 0, 0, r / 32, r % 32, 32 * (r % 32), scr, lane); continue; } r -= I_D;
                if (r < I_IN) { const int nb = r % 160, kb = r / 160, blk = nb >> 4;
                    const int ob = (blk == 1) ? 3 : (blk == 2) ? 1 : (blk == 3) ? 2 : blk;
                    transpose_item(ap->w_in + (size_t)l * DM * INC, INC, ap->norm_mix + l * DM, WT + W_IN, DM, 0, 0, kb, nb, ob * 512 + 32 * (nb & 15), scr, lane); continue; } r -= I_IN;
                if (r < I_C) { transpose_item(ap->w_conv_out + (size_t)l * 512 * DM, DM, nullptr, WT + W_CAT, DM, 0, 0, r / 32, r % 32, 32 * (r % 32), scr, lane); continue; } r -= I_C;
                if (r < I_C) { transpose_item(ap->w_attn_out + (size_t)l * 512 * DM, DM, nullptr, WT + W_CAT, DM, 512, 0, r / 32, r % 32, 32 * (r % 32), scr, lane); continue; } r -= I_C;
                transpose_item(ap->w_o + (size_t)l * DM * DM, DM, nullptr, WT + W_O, DM, 0, 0, r / 32, r % 32, 32 * (r % 32), scr, lane);
            }
            for (int i = gt; i < 2 * (NBATCH * 512 * 512 / 8); i += NGT) {
                const int which = i / (NBATCH * 512 * 512 / 8), e = (i % (NBATCH * 512 * 512 / 8)) * 8;
                const float* src = (which ? ap->cache_v : ap->cache_k) + (size_t)l * NBATCH * 512 * 512 + e;
                const f32x4 v0 = *(const f32x4*)src, v1 = *(const f32x4*)(src + 4);
                u32x4 w; w.x = pk2(v0[0], v0[1]); w.y = pk2(v0[2], v0[3]); w.z = pk2(v1[0], v1[1]); w.w = pk2(v1[2], v1[3]);
                *(u32x4*)((which ? CV : CK) + e) = w;
            }
            if (l == 0) {
                for (int m = gw; m < MPAD; m += NGW) {
                    bf16_t* xb = XB + (size_t)m * DM; float* sq = SSQ + (size_t)m * 16;
                    if (m < MR) {
                        const float* src = (m < MP) ? ap->x_prompt + (size_t)m * DM : ap->x_sample + (size_t)(m - MP) * DM;
                        float* dst = X + (size_t)m * DM; float s = 0.f;
#pragma unroll
                        for (int j = 0; j < 4; ++j) { const f32x4 v = *(const f32x4*)(src + 256 * j + 4 * lane); *(f32x4*)(dst + 256 * j + 4 * lane) = v;
                            u32x2 w; w.x = pk2(v[0], v[1]); w.y = pk2(v[2], v[3]); *(u32x2*)(xb + 256 * j + 4 * lane) = w; s += (v[0] * v[0] + v[1] * v[1]) + (v[2] * v[2] + v[3] * v[3]); }
                        s = wave_sum(s);
                        if (lane < 16) sq[lane] = (lane == 0) ? s : 0.f;
                    } else {
#pragma unroll
                        for (int j = 0; j < 4; ++j) *(u32x2*)(xb + 256 * j + 4 * lane) = (u32x2){0u, 0u};
                        if (lane < 16) sq[lane] = 0.f;
                    }
                }
            }
        }
        SEAM(pb + 0);
        if (IN(pb + 1)) { PHASE_VARS
            pg8::Gemm g{XB, WT + W_GU1, DM, DM, DM, 0, 0}; pg8::StaticOrder S; S.init(NTM, 2 * DFF / 256, G, bx, 1);
            EpiUp E{HB, SSQ};
            small_gemm<1, 4, EpiUp>(lds, XB, XB, DM, WT + W_GU1, WT + W_GU1, DM, 2 * DFF / 64, E, bx, G, wave, lane);
            pg8::gemm_phase<EpiUp>(lds, g, S, E, tid);
        }
        SEAM(pb + 1);
        if (IN(pb + 2)) { PHASE_VARS
            pg8::Gemm g{HB, WT + W_D1, DFF, DFF, DFF, 0, 0}; pg8::StaticOrder S; S.init(NTM, DM / 256, G, bx, 1);
            EpiRes E{X, XB, SSQ, 0.5f};
            small_gemm<1, 11, EpiRes>(lds, HB, HB, DFF, WT + W_D1, WT + W_D1, DFF, DM / 64, E, bx, G, wave, lane);
            pg8::gemm_phase<EpiRes>(lds, g, S, E, tid);
        }
        SEAM(pb + 2);
        if (IN(pb + 3)) { PHASE_VARS
            pg8::Gemm g{XB, WT + W_IN, DM, DM, DM, 0, 0}; pg8::StaticOrder S; S.init(NTM, INC / 256, G, bx, 1);
            EpiIn E{Z, SSQ, ap->b_gate + (size_t)l * 2 * DM, ap->out + O_KP + (size_t)l * NBATCH * 512 * 512, ap->out + O_VP + (size_t)l * NBATCH * 512 * 512,
                    ap->out + O_KS + (size_t)l * MS * 512, ap->out + O_VS + (size_t)l * MS * 512};
            small_gemm<1, 4, EpiIn>(lds, XB, XB, DM, WT + W_IN, WT + W_IN, DM, INC / 64, E, bx, G, wave, lane);
            pg8::gemm_phase<EpiIn>(lds, g, S, E, tid);
        }
        SEAM(pb + 3);
        if (IN(pb + 4)) { PHASE_VARS
            LAS float* rbl = (LAS float*)(lds + RB_OFF);
            for (int i = tid; i < NH * NREL; i += NWAVES * 64) { const int h = i / NREL, j = i - h * NREL; rbl[h * 264 + j] = ap->rel_bias[(size_t)l * NH * NREL + i] * LOG2E; }
            __syncthreads();
            LAS unsigned char* vbuf = lds + wave * 16384;
#pragma unroll 1
            for (int u = gw; u < 4096; u += NGW) {
                const int c = u & 63, h = (u >> 6) & 7, b = u >> 9;
                const int jlo = (c > 8) ? c - 8 : 0;
                const bf16_t* base = Z + (size_t)(b * SEQ) * INC + h * 64;
                auto tf = [&](int j) { TileD td; const size_t ro = (size_t)(64 * (jlo + j)) * INC; td.K = base + ro + ZC_K; td.V = base + ro + ZC_V; td.pitch = INC; td.nkeys = 64; td.delta0 = 64 * (c - jlo - j); return td; };
                bf16_t* qp = Z + (size_t)(b * SEQ + 64 * c) * INC + ZC_Q + h * 64;
                attn_wave<4>(qp, qp, INC, c - jlo + 1, tf, vbuf, rbl + h * 264, lane);
            }
            { int l2 = lane; asm volatile("" : "+v"(l2)); asm volatile("" : "+s"(Z), "+s"(CK), "+s"(CV));
#pragma unroll 1
            for (int us = gw; us < 64; us += NGW) {
                const int h = us & 7, b = us >> 3;
                const bf16_t* zrow = Z + (size_t)(MP + 16 * b) * INC + h * 64;
                auto tf = [&](int j) { TileD td;
                    if (j < 8) { const size_t ro = (size_t)(b * 512 + 64 * j) * 512 + h * 64; td.K = CK + ro; td.V = CV + ro; td.pitch = 512; td.nkeys = 64; td.delta0 = 512 - 64 * j; }
                    else { td.K = zrow + ZC_K; td.V = zrow + ZC_V; td.pitch = INC; td.nkeys = 16; td.delta0 = 0; }
                    return td; };
                bf16_t* qp = Z + (size_t)(MP + 16 * b) * INC + ZC_Q + h * 64;
                attn_wave<1>(qp, qp, INC, 9, tf, vbuf, rbl + h * 264, l2);
            } }
            for (int cu = (NGW - 1 - gw); cu < MR / 16; cu += NGW) {
                const int row0 = cu * 16, ch = 8 * lane;
                const bool samp = (row0 >= MP);
                const int bb = samp ? (row0 - MP) / 16 : (row0 >> 12), t0 = samp ? 0 : (row0 & 4095);
                float w0[8], w1[8], w2[8], um2[8], um1[8];
                { const float* wc = ap->w_conv + (size_t)l * 3 * 512 + ch;
#pragma unroll
                  for (int i = 0; i < 8; ++i) { w0[i] = wc[i]; w1[i] = wc[512 + i]; w2[i] = wc[1024 + i]; } }
                if (samp) { const float* sc = ap->state_conv + ((size_t)(l * NBATCH + bb) * 2) * 512 + ch;
#pragma unroll
                    for (int i = 0; i < 8; ++i) { um2[i] = sc[i]; um1[i] = sc[512 + i]; }
                } else if (t0 == 0) {
#pragma unroll
                    for (int i = 0; i < 8; ++i) { um2[i] = 0.f; um1[i] = 0.f; }
                } else {
                    const bf16_t* z2 = Z + (size_t)(row0 - 2) * INC + ch; const bf16_t* z1 = Z + (size_t)(row0 - 1) * INC + ch;
                    const u32x4 c2 = *(const u32x4*)(z2 + ZC_CC), v2 = *(const u32x4*)(z2 + ZC_CV), c1 = *(const u32x4*)(z1 + ZC_CC), v1 = *(const u32x4*)(z1 + ZC_CV);
#pragma unroll
                    for (int i = 0; i < 4; ++i) { um2[2 * i] = bf_lo(c2[i]) * bf_lo(v2[i]); um2[2 * i + 1] = bf_hi(c2[i]) * bf_hi(v2[i]); um1[2 * i] = bf_lo(c1[i]) * bf_lo(v1[i]); um1[2 * i + 1] = bf_hi(c1[i]) * bf_hi(v1[i]); }
                }
#pragma unroll 4
                for (int r = 0; r < 16; ++r) {
                    bf16_t* zr = Z + (size_t)(row0 + r) * INC + ch;
                    const u32x4 cbw = *(const u32x4*)(zr + ZC_CB), ccw = *(const u32x4*)(zr + ZC_CC), cvw = *(const u32x4*)(zr + ZC_CV);
                    float y[8];
#pragma unroll
                    for (int i = 0; i < 4; ++i) {
                        const float u0 = bf_lo(ccw[i]) * bf_lo(cvw[i]), u1 = bf_hi(ccw[i]) * bf_hi(cvw[i]);
                        y[2 * i] = bf_lo(cbw[i]) * (w0[2 * i] * um2[2 * i] + w1[2 * i] * um1[2 * i] + w2[2 * i] * u0);
                        y[2 * i + 1] = bf_hi(cbw[i]) * (w0[2 * i + 1] * um2[2 * i + 1] + w1[2 * i + 1] * um1[2 * i + 1] + w2[2 * i + 1] * u1);
                        um2[2 * i] = um1[2 * i]; um1[2 * i] = u0; um2[2 * i + 1] = um1[2 * i + 1]; um1[2 * i + 1] = u1;
                    }
                    u32x4 w; w.x = cvt_pk_bf16(y[0], y[1]); w.y = cvt_pk_bf16(y[2], y[3]); w.z = cvt_pk_bf16(y[4], y[5]); w.w = cvt_pk_bf16(y[6], y[7]);
                    *(u32x4*)(zr + ZC_CB) = w;
                }
                if (samp || t0 == SEQ - 16) {
                    float* dst = ap->out + (samp ? O_CS : O_CP) + ((size_t)(l * NBATCH + bb) * 2) * 512 + ch;
                    *(f32x4*)dst = (f32x4){um2[0], um2[1], um2[2], um2[3]}; *(f32x4*)(dst + 4) = (f32x4){um2[4], um2[5], um2[6], um2[7]};
                    *(f32x4*)(dst + 512) = (f32x4){um1[0], um1[1], um1[2], um1[3]}; *(f32x4*)(dst + 516) = (f32x4){um1[4], um1[5], um1[6], um1[7]};
                }
            }
            asm volatile("s_waitcnt vmcnt(0) lgkmcnt(0)" ::: "memory");
            __syncthreads();
        }
        SEAM(pb + 4);
        if (IN(pb + 5)) { PHASE_VARS
            pg8::Gemm g{Z, WT + W_CAT, INC, DM, 512, 512 * 2, 512 * 2}; pg8::StaticOrder S; S.init(NTM, DM / 256, G, bx, 2);
            EpiMix E{Z};
            small_gemm<2, 2, EpiMix>(lds, Z + ZC_CB, Z + ZC_Q, INC, WT + W_CAT, WT + W_CAT + 512, DM, DM / 64, E, bx, G, wave, lane);
            pg8::gemm_phase<EpiMix>(lds, g, S, E, tid);
        }
        SEAM(pb + 5);
        if (IN(pb + 6)) { PHASE_VARS
            pg8::Gemm g{Z + ZC_MB, WT + W_O, INC, DM, DM, 0, 0}; pg8::StaticOrder S; S.init(NTM, DM / 256, G, bx, 1);
            EpiRes E{X, XB, SSQ, 1.0f};
            small_gemm<1, 4, EpiRes>(lds, Z + ZC_MB, Z + ZC_MB, INC, WT + W_O, WT + W_O, DM, DM / 64, E, bx, G, wave, lane);
            pg8::gemm_phase<EpiRes>(lds, g, S, E, tid);
        }
        SEAM(pb + 6);
        if (IN(pb + 7)) { PHASE_VARS
            pg8::Gemm g{XB, WT + W_GU2, DM, DM, DM, 0, 0}; pg8::StaticOrder S; S.init(NTM, 2 * DFF / 256, G, bx, 1);
            EpiUp E{HB, SSQ};
            small_gemm<1, 4, EpiUp>(lds, XB, XB, DM, WT + W_GU2, WT + W_GU2, DM, 2 * DFF / 64, E, bx, G, wave, lane);
            pg8::gemm_phase<EpiUp>(lds, g, S, E, tid);
        }
        SEAM(pb + 7);
        if (IN(pb + 8)) { PHASE_VARS
            pg8::Gemm g{HB, WT + W_D2, DFF, DFF, DFF, 0, 0}; pg8::StaticOrder S; S.init(NTM, DM / 256, G, bx, 1);
            EpiRes E{X, XB, SSQ, 0.5f};
            small_gemm<1, 11, EpiRes>(lds, HB, HB, DFF, WT + W_D2, WT + W_D2, DFF, DM / 64, E, bx, G, wave, lane);
            pg8::gemm_phase<EpiRes>(lds, g, S, E, tid);
        }
        SEAM(pb + 8);
    }
    if (IN(36)) { PHASE_VARS
        for (int m = gw; m < MR; m += NGW) {
            float* xr = X + (size_t)m * DM;
            const float sv = (lane < 16) ? SSQ[(size_t)m * 16 + lane] : 0.f;
            const float rs = __builtin_amdgcn_rsqf(wave_sum(sv) * (1.0f / 1024.0f) + EPS);
#pragma unroll
            for (int j = 0; j < 4; ++j) { const f32x4 v = *(const f32x4*)(xr + 256 * j + 4 * lane), gn = *(const f32x4*)(ap->norm_final + 256 * j + 4 * lane); *(f32x4*)(xr + 256 * j + 4 * lane) = v * rs * gn; }
        }
    }
#undef IN
#undef SEAM
}

extern "C" void kernel_launch(void* const* d_in, const int* in_sizes, int n_in, void* d_out, int out_size, void* d_ws, size_t ws_size, hipStream_t stream) {
    static int grid = 0;
    if (grid == 0) {
        if (n_in != 20 || (size_t)out_size != O_END || ws_size < WS_END) { fprintf(stderr, "kernel_launch: unexpected shapes: n_in %d out %d (want %zu) ws %zu (need %zu)\n", n_in, out_size, (size_t)O_END, ws_size, (size_t)WS_END); grid = -1; return; }
        int dev = 0, cus = 0, per_cu = 0;
        hipGetDevice(&dev); hipDeviceGetAttribute(&cus, hipDeviceAttributeMultiprocessorCount, dev);
        if (hipFuncSetAttribute((const void*)mega_fwd, hipFuncAttributeMaxDynamicSharedMemorySize, LDS_BYTES) != hipSuccess) { fprintf(stderr, "kernel_launch: hipFuncSetAttribute failed\n"); grid = -1; return; }
        if (hipOccupancyMaxActiveBlocksPerMultiprocessor(&per_cu, (const void*)mega_fwd, NWAVES * 64, LDS_BYTES) != hipSuccess || per_cu < 1) { fprintf(stderr, "kernel_launch: occupancy query says %d\n", per_cu); per_cu = 1; }
        (void)hipGetLastError();
        grid = cus;
    }
    if (grid < 0) return;
    Args a{};
    const float** ap = (const float**)&a;
    for (int i = 0; i < 20; ++i) ap[i] = (const float*)d_in[i];
    a.out = (float*)d_out; a.ws = (unsigned char*)d_ws; a.ph_lo = 0; a.ph_hi = 37;
    void* args[] = {&a};
    hipError_t e = hipLaunchCooperativeKernel((const void*)mega_fwd, dim3(grid), dim3(NWAVES * 64), args, LDS_BYTES, stream);
    if (e != hipSuccess) fprintf(stderr, "kernel_launch: cooperative launch failed: %s (grid %d)\n", hipGetErrorString(e), grid);
}
```

```cpp
#include <hip/hip_runtime.h>
#include <hip/hip_cooperative_groups.h>
#include <cstdio>
#include <cstdint>
namespace cg = cooperative_groups;
#ifndef PROBE_REP
#define PROBE_REP (-1)
#endif

#define LAS __attribute__((address_space(3)))
typedef unsigned short bf16_t;
typedef short bf16x8 __attribute__((ext_vector_type(8)));
typedef short s16x4 __attribute__((ext_vector_type(4)));
typedef float f32x4 __attribute__((ext_vector_type(4)));
typedef unsigned u32x4 __attribute__((ext_vector_type(4)));
typedef unsigned u32x2 __attribute__((ext_vector_type(2)));

constexpr int DM = 1024, NBATCH = 8, SEQ = 4096, DEPTH = 4, DSEQ = 16;
constexpr int NH = 8, DFF = 2816, INC = 5120, NREL = 257;
constexpr int MP = NBATCH * SEQ;
constexpr int MS = NBATCH * DSEQ;
constexpr int MR = MP + MS;
constexpr int MPAD = 33024;
constexpr int NTM = MP / 256;
constexpr float EPS = 1e-6f;
constexpr float LOG2E = 1.4426950408889634f;
constexpr float QSCALE = 0.125f * LOG2E;
constexpr int ZC_CB = 0, ZC_Q = 512, ZC_CC = 1024, ZC_CV = 1536, ZC_K = 2048, ZC_V = 2560, ZC_GC = 3072, ZC_GA = 4096, ZC_MB = 1024;

constexpr size_t O_Y = 0;
constexpr size_t O_KP = (size_t)MR * DM;
constexpr size_t O_VP = O_KP + (size_t)DEPTH * NBATCH * 512 * 512;
constexpr size_t O_CP = O_VP + (size_t)DEPTH * NBATCH * 512 * 512;
constexpr size_t O_KS = O_CP + (size_t)DEPTH * NBATCH * 2 * 512;
constexpr size_t O_VS = O_KS + (size_t)DEPTH * NBATCH * DSEQ * 512;
constexpr size_t O_CS = O_VS + (size_t)DEPTH * NBATCH * DSEQ * 512;
constexpr size_t O_END = O_CS + (size_t)DEPTH * NBATCH * 2 * 512;

constexpr size_t W_GU1 = 0;
constexpr size_t W_D1 = W_GU1 + (size_t)2 * DFF * DM;
constexpr size_t W_IN = W_D1 + (size_t)DM * DFF;
constexpr size_t W_CAT = W_IN + (size_t)INC * DM;
constexpr size_t W_O = W_CAT + (size_t)DM * DM;
constexpr size_t W_GU2 = W_O + (size_t)DM * DM;
constexpr size_t W_D2 = W_GU2 + (size_t)2 * DFF * DM;
constexpr size_t W_TOTAL = W_D2 + (size_t)DM * DFF;

constexpr size_t WS_WT = 0;
constexpr size_t WS_XB = WS_WT + ((W_TOTAL * 2 + 4095) / 4096) * 4096;
constexpr size_t WS_SSQ = WS_XB + (size_t)MPAD * DM * 2;
constexpr size_t WS_CK = WS_SSQ + (size_t)MPAD * 16 * 4;
constexpr size_t WS_CV = WS_CK + (size_t)NBATCH * 512 * 512 * 2;
constexpr size_t WS_Z = WS_CV + (size_t)NBATCH * 512 * 512 * 2;
constexpr size_t WS_WT2 = WS_Z + (size_t)MPAD * INC * 2;
constexpr size_t WS_BAR = WS_WT2 + ((W_TOTAL * 2 + 4095) / 4096) * 4096;
constexpr size_t WS_CK2 = WS_BAR + 16384;
constexpr size_t WS_CV2 = WS_CK2 + (size_t)NBATCH * 512 * 512 * 2;
constexpr size_t WS_END = WS_CV2 + (size_t)NBATCH * 512 * 512 * 2;

constexpr int NWAVES = 8;
constexpr int RING_BYTES = 131072;
constexpr int RB_OFF = RING_BYTES + 1024;
constexpr int LDS_BYTES = 147456;
constexpr int BARST_OFF = LDS_BYTES - 64;

__device__ __forceinline__ unsigned cvt_pk_bf16(float lo, float hi) { unsigned r; asm volatile("v_cvt_pk_bf16_f32 %0, %1, %2" : "=v"(r) : "v"(lo), "v"(hi)); return r; }
__device__ __forceinline__ float bf_lo(unsigned w) { return __uint_as_float(w << 16); }
__device__ __forceinline__ float bf_hi(unsigned w) { return __uint_as_float(w & 0xffff0000u); }
__device__ __forceinline__ unsigned f2bf(float f) { unsigned u = __float_as_uint(f); return (u + 0x7fffu + ((u >> 16) & 1u)) >> 16; }
__device__ __forceinline__ unsigned pk2(float lo, float hi) { return f2bf(lo) | (f2bf(hi) << 16); }
__device__ __forceinline__ float fast_sigmoid(float x) { return __builtin_amdgcn_rcpf(1.0f + __builtin_amdgcn_exp2f(-x * LOG2E)); }

namespace pg8 {
constexpr int BM = 256, BK = 64, HALF = 128, HTB = HALF * BK * 2, STAGE_BYTES = 8 * HTB, NXCD = 8, WGM = 8;
__host__ __device__ __forceinline__ int lds_byte(int r, int c) { const int st = (r >> 4) * 2 + (c >> 5), rr = r & 15, cc = c & 31, ob = rr * 64 + cc * 2; return st * 1024 + (ob ^ (((ob >> 9) & 1) << 5)); }
__host__ __device__ __forceinline__ void stage_rc(int b, int& R, int& C) { const int st = b / 1024, sb = b % 1024, swz = sb ^ (((sb >> 9) & 1) << 5); R = (st >> 1) * 16 + swz / 64; C = (st & 1) * 32 + (swz % 64) / 2; }
__host__ __device__ __forceinline__ int perm32(int rho) { const int n = rho >> 4, i = rho & 15; return 8 * (i >> 2) + 4 * n + (i & 3); }

struct Unit { int pm, pn, z; };
struct Gemm { const bf16_t* A; const bf16_t* Bt; int lda, ldb, K; long zA, zB; };

struct StaticOrder {
    int nM, nN, nwg, G, c, nz;
    __device__ void init(int nM_, int nN_, int G_, int c_, int nz_) { nM = nM_; nN = nN_; nwg = nM * nN; G = G_; c = c_; nz = nz_; }
    __device__ bool next(int i, Unit& u) const {
        const int it = i / nz; u.z = i - it * nz;
        const long L = (long)it * G + c; if (L >= nwg) return false;
        int wgid = (int)L; { const int q = nwg / NXCD, r = nwg % NXCD, xcd = wgid % NXCD, off = wgid / NXCD; wgid = (xcd < r ? xcd * (q + 1) : r * (q + 1) + (xcd - r) * q) + off; }
        const int nig = WGM * nN, gid = wgid / nig, fm = gid * WGM, gsz = (nM - fm) < WGM ? (nM - fm) : WGM;
        u.pm = fm + ((wgid % nig) % gsz); u.pn = (wgid % nig) / gsz; return true;
    }
};

template <class Epi>
__device__ __forceinline__ void gemm_phase(LAS unsigned char* lds, const Gemm g, const StaticOrder& S, const Epi& E, const int tid) {
    const int wid = __builtin_amdgcn_readfirstlane(tid >> 6), lane = tid & 63, wr = wid >> 2, wc = wid & 3, fr = lane & 15, fq = lane >> 4;
    const int K = g.K, nt = K / BK;
    unsigned voffA[2], voffB[2];
#pragma unroll
    for (int i = 0; i < 2; ++i) { int R, C; stage_rc(tid * 16 + i * 8192, R, C); const int Rb = (R & ~31) + perm32(R & 31);
        voffA[i] = (unsigned)(R * g.lda + C) * 2u; voffB[i] = (unsigned)(Rb * g.ldb + C) * 2u; }
    const size_t kstep = (size_t)(BK * 2);
    const size_t hstepA = (size_t)HALF * g.lda * 2, hstepB = (size_t)HALF * g.ldb * 2;
    const size_t tstepA = 2 * hstepA, tstepB = 2 * hstepB;
    const unsigned ldsw = (unsigned)wid * 1024u;
    const int aoff = lds_byte(wr * 64 + fr, fq * 8), boff = lds_byte(wc * 32 + fr, fq * 8);
#define PG8_SA(b, h) (((b) * 2 + (h)) * HTB)
#define PG8_SB(b, h) ((4 + (b) * 2 + (h)) * HTB)
#define PG8_STAGE(bufoff, gbase, voff) do { _Pragma("unroll") for (int _i = 0; _i < 2; ++_i) \
        __builtin_amdgcn_global_load_lds((const unsigned*)((const char*)(gbase) + (voff)[_i]), (LAS unsigned*)(lds + (bufoff) + ldsw + _i * 8192), 16, 0, 0); } while (0)
#define PG8_LDA(dst, b, h) do { _Pragma("unroll") for (int m = 0; m < 4; ++m) _Pragma("unroll") for (int k = 0; k < 2; ++k) dst[m][k] = *(const LAS bf16x8*)(lds + PG8_SA(b, h) + aoff + m * 2048 + k * 1024); } while (0)
#define PG8_LDB(dst, b, h) do { _Pragma("unroll") for (int n = 0; n < 2; ++n) _Pragma("unroll") for (int k = 0; k < 2; ++k) dst[n][k] = *(const LAS bf16x8*)(lds + PG8_SB(b, h) + boff + n * 2048 + k * 1024); } while (0)
#define PG8_MMA(ai, bj, At, Bt) do { __builtin_amdgcn_s_setprio(1); _Pragma("unroll") for (int m = 0; m < 4; ++m) _Pragma("unroll") for (int n = 0; n < 2; ++n) _Pragma("unroll") for (int k = 0; k < 2; ++k) \
        acc[ai][bj][m][n] = __builtin_amdgcn_mfma_f32_16x16x32_bf16(Bt[n][k], At[m][k], acc[ai][bj][m][n], 0, 0, 0); __builtin_amdgcn_s_setprio(0); } while (0)
#define PG8_WAIT_V(n) asm volatile("s_waitcnt vmcnt(" #n ")" ::: "memory")
#define PG8_WAIT_L(n) asm volatile("s_waitcnt lgkmcnt(" #n ")" ::: "memory")
#define PG8_BAR __builtin_amdgcn_s_barrier()
#define PG8_SCHED __builtin_amdgcn_sched_barrier(0)
    Unit cur, nxt; int ui = 0;
    if (!S.next(0, cur)) return;
    f32x4 acc[2][2][4][2];
#pragma unroll
    for (int a = 0; a < 2; ++a)
#pragma unroll
        for (int b = 0; b < 2; ++b)
#pragma unroll
            for (int m = 0; m < 4; ++m)
#pragma unroll
                for (int n = 0; n < 2; ++n) acc[a][b][m][n] = (f32x4){0.f, 0.f, 0.f, 0.f};
    bf16x8 At[4][2], B0[2][2], B1[2][2];
    const char* cA = (const char*)g.A + (size_t)cur.pm * tstepA + (size_t)cur.z * g.zA; const char* cB = (const char*)g.Bt + (size_t)cur.pn * tstepB + (size_t)cur.z * g.zB;
    PG8_STAGE(PG8_SB(0, 0), cB, voffB); PG8_STAGE(PG8_SB(0, 1), cB + hstepB, voffB); PG8_STAGE(PG8_SA(0, 0), cA, voffA); PG8_STAGE(PG8_SA(0, 1), cA + hstepA, voffA);
    if (wr == 1) PG8_BAR;
    PG8_WAIT_V(2); PG8_BAR;
    PG8_STAGE(PG8_SB(1, 0), cB + kstep, voffB); PG8_STAGE(PG8_SA(1, 0), cA + kstep, voffA); PG8_STAGE(PG8_SB(1, 1), cB + hstepB + kstep, voffB);
    PG8_WAIT_V(6); PG8_BAR;
    for (;;) {
        const bool has_next = S.next(ui + 1, nxt);
        const char* nA = has_next ? (const char*)g.A + (size_t)nxt.pm * tstepA + (size_t)nxt.z * g.zA : cA; const char* nB = has_next ? (const char*)g.Bt + (size_t)nxt.pn * tstepB + (size_t)nxt.z * g.zB : cB;
        for (int t = 0; t < nt; t += 2) {
            const bool last = (t == nt - 2);
            const char* a1 = cA + (size_t)(t + 1) * kstep;
            const char* a2 = last ? nA : cA + (size_t)(t + 2) * kstep; const char* b2 = last ? nB : cB + (size_t)(t + 2) * kstep;
            const char* a3 = a2 + kstep; const char* b3 = b2 + kstep;
            PG8_LDB(B0, 0, 0); PG8_LDB(B1, 0, 1); PG8_SCHED; PG8_LDA(At, 0, 0); PG8_STAGE(PG8_SA(1, 1), a1 + hstepA, voffA);
            PG8_WAIT_V(8); PG8_WAIT_L(0); PG8_BAR; PG8_MMA(0, 0, At, B0); PG8_MMA(0, 1, At, B1); PG8_BAR; PG8_SCHED;
            PG8_LDA(At, 0, 1); PG8_STAGE(PG8_SB(0, 0), b2, voffB); PG8_STAGE(PG8_SB(0, 1), b2 + hstepB, voffB); PG8_STAGE(PG8_SA(0, 0), a2, voffA);
            PG8_WAIT_V(8); PG8_WAIT_L(0); PG8_BAR; PG8_MMA(1, 0, At, B0); PG8_MMA(1, 1, At, B1); PG8_BAR; PG8_SCHED;
            PG8_LDB(B0, 1, 0); PG8_LDB(B1, 1, 1); PG8_SCHED; PG8_LDA(At, 1, 0); PG8_STAGE(PG8_SA(0, 1), a2 + hstepA, voffA);
            PG8_WAIT_V(8); PG8_WAIT_L(0); PG8_BAR; PG8_MMA(0, 0, At, B0); PG8_MMA(0, 1, At, B1); PG8_BAR; PG8_SCHED;
            PG8_LDA(At, 1, 1); PG8_STAGE(PG8_SB(1, 0), b3, voffB); PG8_STAGE(PG8_SB(1, 1), b3 + hstepB, voffB); PG8_STAGE(PG8_SA(1, 0), a3, voffA);
            PG8_WAIT_V(8); PG8_WAIT_L(0); PG8_BAR; PG8_MMA(1, 0, At, B0); PG8_MMA(1, 1, At, B1); PG8_BAR; PG8_SCHED;
        }
        if (wr == 0) PG8_BAR;
        E(acc, cur, wr, wc, fr, fq);
        if (!has_next) break;
#pragma unroll
        for (int a = 0; a < 2; ++a)
#pragma unroll
            for (int b = 0; b < 2; ++b)
#pragma unroll
                for (int m = 0; m < 4; ++m)
#pragma unroll
                    for (int n = 0; n < 2; ++n) acc[a][b][m][n] = (f32x4){0.f, 0.f, 0.f, 0.f};
        cur = nxt; cA = nA; cB = nB; ++ui;
        if (wr == 1) PG8_BAR;
    }
    PG8_WAIT_V(0);
    PG8_BAR;
#undef PG8_SA
#undef PG8_SB
#undef PG8_STAGE
#undef PG8_LDA
#undef PG8_LDB
#undef PG8_MMA
#undef PG8_WAIT_V
#undef PG8_WAIT_L
#undef PG8_BAR
#undef PG8_SCHED
}
}

__device__ __forceinline__ float row_rs(const float* ssq, int row, int fq) {
    const f32x4 v = *(const f32x4*)(ssq + (size_t)row * 16 + 4 * fq);
    float s = (v[0] + v[1]) + (v[2] + v[3]);
    s += __shfl_xor(s, 16); s += __shfl_xor(s, 32);
    return __builtin_amdgcn_rsqf(s * (1.0f / 1024.0f) + EPS);
}

struct EpiUp {
    bf16_t* H; const float* ssq;
    __device__ __forceinline__ void operator()(const f32x4 (&acc)[2][2][4][2], const pg8::Unit& u, int wr, int wc, int fr, int fq) const {
        const int row0 = u.pm * 256 + wr * 64 + fr, hc0 = u.pn * 128 + wc * 16 + 4 * fq;
#pragma unroll
        for (int ai = 0; ai < 2; ++ai)
#pragma unroll
            for (int m = 0; m < 4; ++m) {
                const int row = row0 + ai * 128 + m * 16; const float rs = row_rs(ssq, row, fq);
#pragma unroll
                for (int bj = 0; bj < 2; ++bj) {
                    const f32x4 gg = acc[ai][bj][m][0] * rs, uu = acc[ai][bj][m][1] * rs; float h[4];
#pragma unroll
                    for (int i = 0; i < 4; ++i) h[i] = gg[i] * fast_sigmoid(gg[i]) * uu[i];
                    u32x2 w; w.x = cvt_pk_bf16(h[0], h[1]); w.y = cvt_pk_bf16(h[2], h[3]);
                    *(u32x2*)(H + (size_t)row * DFF + hc0 + bj * 64) = w;
                }
            }
    }
    __device__ __forceinline__ void small(const f32x4 (&acc)[1][2][2], int row, int c0, int fr, int fq) const {
        const float rs = row_rs(ssq, row, fq);
#pragma unroll
        for (int j = 0; j < 2; ++j) {
            const f32x4 gg = acc[0][j][0] * rs, uu = acc[0][j][1] * rs; float h[4];
#pragma unroll
            for (int i = 0; i < 4; ++i) h[i] = gg[i] * fast_sigmoid(gg[i]) * uu[i];
            u32x2 w; w.x = cvt_pk_bf16(h[0], h[1]); w.y = cvt_pk_bf16(h[2], h[3]);
            *(u32x2*)(H + (size_t)row * DFF + (c0 >> 1) + 16 * j + 4 * fq) = w;
        }
    }
};

struct EpiRes {
    float* X; bf16_t* XB; float* ssq; float scale;
    __device__ __forceinline__ void operator()(const f32x4 (&acc)[2][2][4][2], const pg8::Unit& u, int wr, int wc, int fr, int fq) const {
        const int row0 = u.pm * 256 + wr * 64 + fr, col0 = u.pn * 256 + wc * 32 + 8 * fq;
#pragma unroll
        for (int ai = 0; ai < 2; ++ai)
#pragma unroll
            for (int m = 0; m < 4; ++m) {
                const int row = row0 + ai * 128 + m * 16;
                {
                    float s = 0.f;
#pragma unroll
                    for (int bj = 0; bj < 2; ++bj) {
                        float* xp = X + (size_t)row * DM + col0 + bj * 128;
                        f32x4 x0 = *(const f32x4*)xp, x1 = *(const f32x4*)(xp + 4);
                        x0 += acc[ai][bj][m][0] * scale; x1 += acc[ai][bj][m][1] * scale;
                        *(f32x4*)xp = x0; *(f32x4*)(xp + 4) = x1;
                        u32x4 w; w.x = cvt_pk_bf16(x0[0], x0[1]); w.y = cvt_pk_bf16(x0[2], x0[3]); w.z = cvt_pk_bf16(x1[0], x1[1]); w.w = cvt_pk_bf16(x1[2], x1[3]);
                        *(u32x4*)(XB + (size_t)row * DM + col0 + bj * 128) = w;
                        s += (x0[0] * x0[0] + x0[1] * x0[1]) + (x0[2] * x0[2] + x0[3] * x0[3]) + (x1[0] * x1[0] + x1[1] * x1[1]) + (x1[2] * x1[2] + x1[3] * x1[3]);
                    }
                    s += __shfl_xor(s, 16); s += __shfl_xor(s, 32);
                    if (fq == 0) ssq[(size_t)row * 16 + u.pn * 4 + wc] = s;
                }
                if (m & 1) asm volatile("" ::: "memory");
            }
    }
    __device__ __forceinline__ void small(const f32x4 (&acc)[1][2][2], int row, int c0, int fr, int fq) const {
        float s = 0.f;
#pragma unroll
        for (int j = 0; j < 2; ++j) {
            float* xp = X + (size_t)row * DM + c0 + 32 * j + 8 * fq;
            f32x4 x0 = *(const f32x4*)xp, x1 = *(const f32x4*)(xp + 4);
            x0 += acc[0][j][0] * scale; x1 += acc[0][j][1] * scale;
            *(f32x4*)xp = x0; *(f32x4*)(xp + 4) = x1;
            u32x4 w; w.x = cvt_pk_bf16(x0[0], x0[1]); w.y = cvt_pk_bf16(x0[2], x0[3]); w.z = cvt_pk_bf16(x1[0], x1[1]); w.w = cvt_pk_bf16(x1[2], x1[3]);
            *(u32x4*)(XB + (size_t)row * DM + c0 + 32 * j + 8 * fq) = w;
            s += (x0[0] * x0[0] + x0[1] * x0[1]) + (x0[2] * x0[2] + x0[3] * x0[3]) + (x1[0] * x1[0] + x1[1] * x1[1]) + (x1[2] * x1[2] + x1[3] * x1[3]);
        }
        s += __shfl_xor(s, 16); s += __shfl_xor(s, 32);
        if (fq == 0) ssq[(size_t)row * 16 + (c0 >> 6)] = s;
    }
};

struct EpiIn {
    bf16_t* Z; const float* ssq; const float* bgate; float* okp; float* ovp; float* oks; float* ovs;
    __device__ __forceinline__ void operator()(const f32x4 (&acc)[2][2][4][2], const pg8::Unit& u, int wr, int wc, int fr, int fq) const {
        const int row0 = u.pm * 256 + wr * 64 + fr, col0 = u.pn * 256 + wc * 32 + 8 * fq;
        const int pn = u.pn;
        const bool isq = (pn == 2 || pn == 3), iskv = (pn >= 8 && pn < 12), isg = (pn >= 12);
        const bool kvp = iskv && ((u.pm & 15) >= 14);
        f32x4 bg[2][2];
#pragma unroll
        for (int bj = 0; bj < 2; ++bj) { if (isg) { bg[bj][0] = *(const f32x4*)(bgate + col0 - ZC_GC + bj * 128); bg[bj][1] = *(const f32x4*)(bgate + col0 - ZC_GC + bj * 128 + 4); } else { bg[bj][0] = (f32x4){0.f, 0.f, 0.f, 0.f}; bg[bj][1] = bg[bj][0]; } }
#pragma unroll
        for (int ai = 0; ai < 2; ++ai)
#pragma unroll
            for (int m = 0; m < 4; ++m) {
                const int row = row0 + ai * 128 + m * 16; float rs = row_rs(ssq, row, fq);
                if (isq) rs *= QSCALE;
#pragma unroll
                for (int bj = 0; bj < 2; ++bj) {
                    f32x4 v0 = acc[ai][bj][m][0] * rs, v1 = acc[ai][bj][m][1] * rs;
                    const int c = col0 + bj * 128;
                    if (isg) {
                        v0 += bg[bj][0]; v1 += bg[bj][1];
#pragma unroll
                        for (int i = 0; i < 4; ++i) { v0[i] = fast_sigmoid(v0[i]); v1[i] = fast_sigmoid(v1[i]); }
                    }
                    u32x4 w; w.x = cvt_pk_bf16(v0[0], v0[1]); w.y = cvt_pk_bf16(v0[2], v0[3]); w.z = cvt_pk_bf16(v1[0], v1[1]); w.w = cvt_pk_bf16(v1[2], v1[3]);
                    *(u32x4*)(Z + (size_t)row * INC + c) = w;
                    if (kvp) {
                        const int b = row >> 12, t = row & 4095;
                        float* dst = ((pn < 10) ? okp : ovp) + ((size_t)(b * 512 + (t - 3584)) * 512 + (c - ((pn < 10) ? ZC_K : ZC_V)));
                        *(f32x4*)dst = v0; *(f32x4*)(dst + 4) = v1;
                    }
                }
            }
    }
    __device__ __forceinline__ void small(const f32x4 (&acc)[1][2][2], int row, int c0, int fr, int fq) const {
        const int pn = c0 >> 8;
        const bool isq = (pn == 2 || pn == 3), iskv = (pn >= 8 && pn < 12), isg = (pn >= 12);
        float rs = row_rs(ssq, row, fq);
        if (isq) rs *= QSCALE;
#pragma unroll
        for (int j = 0; j < 2; ++j) {
            f32x4 v0 = acc[0][j][0] * rs, v1 = acc[0][j][1] * rs;
            const int c = c0 + 32 * j + 8 * fq;
            if (isg) {
                v0 += *(const f32x4*)(bgate + c - ZC_GC); v1 += *(const f32x4*)(bgate + c - ZC_GC + 4);
#pragma unroll
                for (int i = 0; i < 4; ++i) { v0[i] = fast_sigmoid(v0[i]); v1[i] = fast_sigmoid(v1[i]); }
            }
            u32x4 w; w.x = cvt_pk_bf16(v0[0], v0[1]); w.y = cvt_pk_bf16(v0[2], v0[3]); w.z = cvt_pk_bf16(v1[0], v1[1]); w.w = cvt_pk_bf16(v1[2], v1[3]);
            *(u32x4*)(Z + (size_t)row * INC + c) = w;
            if (iskv) {
                float* dst = ((pn < 10) ? oks : ovs) + ((size_t)(row - MP) * 512 + (c - ((pn < 10) ? ZC_K : ZC_V)));
                *(f32x4*)dst = v0; *(f32x4*)(dst + 4) = v1;
            }
        }
    }
};

struct EpiMix {
    bf16_t* Z;
    __device__ __forceinline__ void operator()(const f32x4 (&acc)[2][2][4][2], const pg8::Unit& u, int wr, int wc, int fr, int fq) const {
        const int row0 = u.pm * 256 + wr * 64 + fr, col0 = u.pn * 256 + wc * 32 + 8 * fq;
        const int gcol = (u.z == 0) ? ZC_GC : ZC_GA;
#pragma unroll
        for (int ai = 0; ai < 2; ++ai)
#pragma unroll
            for (int m = 0; m < 4; ++m) {
                const int row = row0 + ai * 128 + m * 16;
#pragma unroll
                for (int bj = 0; bj < 2; ++bj) {
                    const int c = col0 + bj * 128;
                    const u32x4 gw = *(const u32x4*)(Z + (size_t)row * INC + gcol + c);
                    f32x4 v0 = acc[ai][bj][m][0], v1 = acc[ai][bj][m][1];
                    v0[0] *= bf_lo(gw.x); v0[1] *= bf_hi(gw.x); v0[2] *= bf_lo(gw.y); v0[3] *= bf_hi(gw.y);
                    v1[0] *= bf_lo(gw.z); v1[1] *= bf_hi(gw.z); v1[2] *= bf_lo(gw.w); v1[3] *= bf_hi(gw.w);
                    bf16_t* mp = Z + (size_t)row * INC + ZC_MB + c;
                    if (u.z != 0) {
                        const u32x4 pw = *(const u32x4*)mp;
                        v0[0] += bf_lo(pw.x); v0[1] += bf_hi(pw.x); v0[2] += bf_lo(pw.y); v0[3] += bf_hi(pw.y);
                        v1[0] += bf_lo(pw.z); v1[1] += bf_hi(pw.z); v1[2] += bf_lo(pw.w); v1[3] += bf_hi(pw.w);
                    }
                    u32x4 w; w.x = cvt_pk_bf16(v0[0], v0[1]); w.y = cvt_pk_bf16(v0[2], v0[3]); w.z = cvt_pk_bf16(v1[0], v1[1]); w.w = cvt_pk_bf16(v1[2], v1[3]);
                    *(u32x4*)mp = w;
                }
            }
    }
    __device__ __forceinline__ void small(const f32x4 (&acc)[2][2][2], int row, int c0, int fr, int fq) const {
#pragma unroll
        for (int j = 0; j < 2; ++j) {
            const int c = c0 + 32 * j + 8 * fq;
            const u32x4 gc = *(const u32x4*)(Z + (size_t)row * INC + ZC_GC + c), ga = *(const u32x4*)(Z + (size_t)row * INC + ZC_GA + c);
            const f32x4 a0 = acc[0][j][0], a1 = acc[0][j][1], b0 = acc[1][j][0], b1 = acc[1][j][1];
            float m[8];
            m[0] = a0[0] * bf_lo(gc.x) + b0[0] * bf_lo(ga.x); m[1] = a0[1] * bf_hi(gc.x) + b0[1] * bf_hi(ga.x);
            m[2] = a0[2] * bf_lo(gc.y) + b0[2] * bf_lo(ga.y); m[3] = a0[3] * bf_hi(gc.y) + b0[3] * bf_hi(ga.y);
            m[4] = a1[0] * bf_lo(gc.z) + b1[0] * bf_lo(ga.z); m[5] = a1[1] * bf_hi(gc.z) + b1[1] * bf_hi(ga.z);
            m[6] = a1[2] * bf_lo(gc.w) + b1[2] * bf_lo(ga.w); m[7] = a1[3] * bf_hi(gc.w) + b1[3] * bf_hi(ga.w);
            u32x4 w; w.x = cvt_pk_bf16(m[0], m[1]); w.y = cvt_pk_bf16(m[2], m[3]); w.z = cvt_pk_bf16(m[4], m[5]); w.w = cvt_pk_bf16(m[6], m[7]);
            *(u32x4*)(Z + (size_t)row * INC + ZC_MB + c) = w;
        }
    }
};

template <int NSET, int NSTEP  , class Epi>
__device__ __forceinline__ void small_gemm(LAS unsigned char* lds, const bf16_t* A0, const bf16_t* A1, int lda, const bf16_t* W0, const bf16_t* W1, int ldb, int ncg, const Epi& E, int bx, int G, int wave, int lane) {
    const int fr = lane & 15, fq = lane >> 4;
    LAS f32x4* part = (LAS f32x4*)lds;
#pragma unroll 1
    for (int u = bx; u < 8 * ncg; u += G) {
        const int rb = u & 7, cg = u >> 3;
        const int row = MP + 16 * rb + fr;
        f32x4 acc[NSET][2][2];
#pragma unroll
        for (int st = 0; st < NSET; ++st) {
            const bf16_t* Ap = (st ? A1 : A0) + (size_t)row * lda + wave * (NSTEP * 32) + 8 * fq;
            const bf16_t* Wp = (st ? W1 : W0) + (size_t)(64 * cg + 8 * (fr >> 2) + (fr & 3)) * ldb + wave * (NSTEP * 32) + 8 * fq;
#pragma unroll
            for (int j = 0; j < 2; ++j)
#pragma unroll
                for (int n = 0; n < 2; ++n) acc[st][j][n] = (f32x4){0.f, 0.f, 0.f, 0.f};
#pragma unroll 4
            for (int k = 0; k < NSTEP; ++k) {
                const bf16x8 av = *(const bf16x8*)(Ap + 32 * k);
#pragma unroll
                for (int j = 0; j < 2; ++j)
#pragma unroll
                    for (int n = 0; n < 2; ++n) {
                        const bf16x8 bv = *(const bf16x8*)(Wp + (size_t)(32 * j + 4 * n) * ldb + 32 * k);
                        acc[st][j][n] = __builtin_amdgcn_mfma_f32_16x16x32_bf16(bv, av, acc[st][j][n], 0, 0, 0);
                    }
            }
        }
#pragma unroll
        for (int st = 0; st < NSET; ++st)
#pragma unroll
            for (int j = 0; j < 2; ++j)
#pragma unroll
                for (int n = 0; n < 2; ++n) part[((wave * NSET + st) * 4 + j * 2 + n) * 64 + lane] = acc[st][j][n];
        __syncthreads();
        if (wave == 0) {
#pragma unroll
            for (int w = 1; w < 8; ++w)
#pragma unroll
                for (int st = 0; st < NSET; ++st)
#pragma unroll
                    for (int j = 0; j < 2; ++j)
#pragma unroll
                        for (int n = 0; n < 2; ++n) acc[st][j][n] += part[((w * NSET + st) * 4 + j * 2 + n) * 64 + lane];
            E.small(acc, row, 64 * cg, fr, fq);
        }
        __syncthreads();
    }
}

struct TileD { const bf16_t* K; const bf16_t* V; int pitch; int nkeys; int delta0; };

__device__ __forceinline__ void attn_dma_v(const TileD& td, LAS unsigned char* vb, int lane) {
#pragma unroll
    for (int i = 0; i < 8; ++i) {
        const int row = 8 * i + (lane >> 3), chs = lane & 7, ch = chs ^ (((row >> 1) & 3) << 1);
        __builtin_amdgcn_global_load_lds((const unsigned*)(td.V + (size_t)row * td.pitch + ch * 8), (LAS unsigned*)(vb + i * 1024), 16, 0, 0);
    }
}
template <int NQB, class TF>
__device__ __forceinline__ void attn_wave(const bf16_t* Qp, bf16_t* Op, int qpitch, int opitch, int nt, const TF& tilef, LAS unsigned char* vbuf, const LAS float* rb, int lane) {
    const int fr = lane & 15, fq = lane >> 4;
    bf16x8 qf[NQB][2];
#pragma unroll
    for (int qb = 0; qb < NQB; ++qb)
#pragma unroll
        for (int dh = 0; dh < 2; ++dh) qf[qb][dh] = *(const bf16x8*)(Qp + (size_t)(16 * qb + fr) * qpitch + dh * 32 + 8 * fq);
    f32x4 O[NQB][4]; float mrow[NQB], lrow[NQB];
#pragma unroll
    for (int qb = 0; qb < NQB; ++qb) { mrow[qb] = -1e30f; lrow[qb] = 0.f;
#pragma unroll
        for (int db = 0; db < 4; ++db) O[qb][db] = (f32x4){0.f, 0.f, 0.f, 0.f}; }
    const int qp = fr >> 2, pp = fr & 3, rowl = 4 * fq + qp, sw = ((rowl >> 1) & 3) << 1;
    const int vrow = rowl * 128 + (pp & 1) * 8, vch = (pp >> 1) ^ sw;
    bf16x8 kf[2][2];
    { const TileD td = tilef(0); attn_dma_v(td, vbuf, lane);
#pragma unroll
      for (int kb = 0; kb < 2; ++kb)
#pragma unroll
          for (int dh = 0; dh < 2; ++dh) kf[kb][dh] = *(const bf16x8*)(td.K + (size_t)(16 * kb + fr) * td.pitch + dh * 32 + 8 * fq); }
    const int nht = 2 * nt;
#pragma unroll 1
    for (int ht = 0; ht < nht; ++ht) {
        const int t = ht >> 1, half = ht & 1;
        asm volatile("s_waitcnt vmcnt(0)" ::: "memory");
        const TileD td = tilef(t);
        if (half == 0 && t + 1 < nt) { const TileD tn = tilef(t + 1); attn_dma_v(tn, vbuf + ((t + 1) & 1) * 8192, lane); }
        f32x4 S[2][NQB];
#pragma unroll
        for (int kb = 0; kb < 2; ++kb)
#pragma unroll
            for (int qb = 0; qb < NQB; ++qb) {
                f32x4 s = __builtin_amdgcn_mfma_f32_16x16x32_bf16(kf[kb][0], qf[qb][0], (f32x4){0.f, 0.f, 0.f, 0.f}, 0, 0, 0);
                S[kb][qb] = __builtin_amdgcn_mfma_f32_16x16x32_bf16(kf[kb][1], qf[qb][1], s, 0, 0, 0);
            }
        if (ht + 1 < nht) {
            const TileD tk = tilef((ht + 1) >> 1); const int r0 = 32 * ((ht + 1) & 1);
#pragma unroll
            for (int kb = 0; kb < 2; ++kb)
#pragma unroll
                for (int dh = 0; dh < 2; ++dh) kf[kb][dh] = *(const bf16x8*)(tk.K + (size_t)(r0 + 16 * kb + fr) * tk.pitch + dh * 32 + 8 * fq);
        }
        const int delta0 = td.delta0 - 32 * half, nkeys = td.nkeys - 32 * half;
        if (delta0 >= 160) {
            const float bc = rb[256];
#pragma unroll
            for (int kb = 0; kb < 2; ++kb)
#pragma unroll
                for (int qb = 0; qb < NQB; ++qb) S[kb][qb] += bc;
        } else {
#pragma unroll
            for (int kb = 0; kb < 2; ++kb)
#pragma unroll
                for (int qb = 0; qb < NQB; ++qb)
#pragma unroll
                    for (int i = 0; i < 4; ++i) {
                        int d = delta0 + (16 * qb + fr) - (16 * kb + 4 * fq + i);
                        d = d < -128 ? -128 : (d > 128 ? 128 : d);
                        S[kb][qb][i] += rb[d + 128];
                    }
        }
        if (nkeys < 32) {
#pragma unroll
            for (int kb = 0; kb < 2; ++kb)
#pragma unroll
                for (int qb = 0; qb < NQB; ++qb)
#pragma unroll
                    for (int i = 0; i < 4; ++i) if (16 * kb + 4 * fq + i >= nkeys) S[kb][qb][i] = -INFINITY;
        }
        bf16x8 pf[NQB];
#pragma unroll
        for (int qb = 0; qb < NQB; ++qb) {
            float mx = fmaxf(fmaxf(fmaxf(S[0][qb][0], S[0][qb][1]), fmaxf(S[0][qb][2], S[0][qb][3])), fmaxf(fmaxf(S[1][qb][0], S[1][qb][1]), fmaxf(S[1][qb][2], S[1][qb][3])));
            mx = fmaxf(mx, __shfl_xor(mx, 16)); mx = fmaxf(mx, __shfl_xor(mx, 32));
            const float mn = fmaxf(mrow[qb], mx), alpha = __builtin_amdgcn_exp2f(mrow[qb] - mn);
            mrow[qb] = mn; float ps = 0.f; float p[2][4];
#pragma unroll
            for (int kb = 0; kb < 2; ++kb)
#pragma unroll
                for (int i = 0; i < 4; ++i) { p[kb][i] = __builtin_amdgcn_exp2f(S[kb][qb][i] - mn); ps += p[kb][i]; }
            lrow[qb] = lrow[qb] * alpha + ps;
#pragma unroll
            for (int db = 0; db < 4; ++db) O[qb][db] *= alpha;
            u32x4 w; w.x = cvt_pk_bf16(p[0][0], p[0][1]); w.y = cvt_pk_bf16(p[0][2], p[0][3]); w.z = cvt_pk_bf16(p[1][0], p[1][1]); w.w = cvt_pk_bf16(p[1][2], p[1][3]);
            pf[qb] = __builtin_bit_cast(bf16x8, w);
        }
        const LAS unsigned char* vb = vbuf + (t & 1) * 8192 + half * 4096 + vrow;
#pragma unroll
        for (int db = 0; db < 4; ++db) {
            const int off = ((2 * db) ^ vch) << 4;
            const s16x4 lo = __builtin_amdgcn_ds_read_tr16_b64_v4i16((LAS s16x4*)(vb + off));
            const s16x4 hi = __builtin_amdgcn_ds_read_tr16_b64_v4i16((LAS s16x4*)(vb + off + 2048));
            const bf16x8 vf = (bf16x8){lo[0], lo[1], lo[2], lo[3], hi[0], hi[1], hi[2], hi[3]};
#pragma unroll
            for (int qb = 0; qb < NQB; ++qb) O[qb][db] = __builtin_amdgcn_mfma_f32_16x16x32_bf16(vf, pf[qb], O[qb][db], 0, 0, 0);
        }
    }
    asm volatile("s_waitcnt lgkmcnt(0)" ::: "memory");
#pragma unroll
    for (int qb = 0; qb < NQB; ++qb) {
        float l = lrow[qb]; l += __shfl_xor(l, 16); l += __shfl_xor(l, 32);
        const float inv = 1.0f / l;
#pragma unroll
        for (int db = 0; db < 4; ++db) {
            const f32x4 o = O[qb][db] * inv; u32x2 w; w.x = cvt_pk_bf16(o[0], o[1]); w.y = cvt_pk_bf16(o[2], o[3]);
            *(u32x2*)(Op + (size_t)(16 * qb + fr) * opitch + 16 * db + 4 * fq) = w;
        }
    }
}


#define XB_TMO      128
#define XB_XCNT(j)  (256  + 64 * (j))
#define XB_XSUB(j)  (1280 + 64 * (j))
#define XB_XGEN(j)  (2304 + 64 * (j))
#define XB_TOP      3328
#define XB_TOPGEN   3392
#define XCD_BAR_WORDS 3456
#define XB_SPIN_CAP (1u << 20)
__device__ __forceinline__ unsigned xb_ld(unsigned* p)              { return __hip_atomic_load(p, __ATOMIC_RELAXED, __HIP_MEMORY_SCOPE_AGENT); }
__device__ __forceinline__ unsigned xb_add(unsigned* p, unsigned v) { return __hip_atomic_fetch_add(p, v, __ATOMIC_RELAXED, __HIP_MEMORY_SCOPE_AGENT); }
__device__ __forceinline__ unsigned xb_xcc_id() { return (unsigned)__builtin_amdgcn_s_getreg((3 << 11) | 20) & 0xFu; }
#define XB_SPIN(cond, bar) do { unsigned _sp = 0; while (cond) { __builtin_amdgcn_s_sleep(1); \
    if ((++_sp & 255u) == 0u) { if (xb_ld(&(bar)[XB_TMO])) break; if (_sp > XB_SPIN_CAP) { atomicAdd(&(bar)[XB_TMO], 1u); break; } } } } while (0)
struct XcdBarrier { unsigned* bar; unsigned x; volatile LAS unsigned* st; };
__device__ __forceinline__ XcdBarrier xcd_barrier_post(unsigned* bar, volatile LAS unsigned* st) {
    XcdBarrier b; b.bar = bar; b.x = xb_xcc_id(); b.st = st;
    if (threadIdx.x == 0) (void)xb_add(&bar[XB_XCNT(b.x)], 1u);
    return b;
}
__device__ __forceinline__ void xcd_barrier_complete(unsigned* bar, unsigned x, unsigned& nloc, unsigned& nx) {
    const unsigned G = gridDim.x * gridDim.y * gridDim.z;
    unsigned sum, cnt, mine, sp = 0u;
    for (;;) {
        sum = 0u; cnt = 0u; mine = 0u;
#pragma unroll
        for (unsigned j = 0; j < 16; ++j) { const unsigned c = xb_ld(&bar[XB_XCNT(j)]); sum += c; cnt += (c > 0u) ? 1u : 0u; mine = (j == x) ? c : mine; }
        if (sum == G) break;
        __builtin_amdgcn_s_sleep(1);
        if ((++sp & 255u) == 0u) { if (xb_ld(&bar[XB_TMO])) break; if (sp > XB_SPIN_CAP) { atomicAdd(&bar[XB_TMO], 1u); break; } }
    }
    nloc = mine > 0u ? mine : 1u; nx = cnt > 0u ? cnt : 1u;
}
__device__ __forceinline__ void xcd_barrier(const XcdBarrier& b) {
    asm volatile("s_waitcnt vmcnt(0)" ::: "memory");
    __syncthreads();
    if (threadIdx.x == 0) {
        unsigned* bar = b.bar;
        __builtin_amdgcn_s_waitcnt(0);
        unsigned nloc = b.st[0], nx = b.st[1];
        if (nloc == 0u) { xcd_barrier_complete(bar, b.x, nloc, nx); b.st[0] = nloc; b.st[1] = nx; }
        const unsigned old = xb_add(&bar[XB_XSUB(b.x)], 1u);
        const unsigned gen = old / nloc;
        if (old + 1u == (gen + 1u) * nloc) {
            __builtin_amdgcn_fence(__ATOMIC_RELEASE, "agent");
            asm volatile("s_waitcnt vmcnt(0)" ::: "memory");
            const unsigned og = xb_add(&bar[XB_TOP], 1u);
            const unsigned tg = og / nx;
            if (og + 1u == (tg + 1u) * nx) xb_add(&bar[XB_TOPGEN], 1u);
            else XB_SPIN(xb_ld(&bar[XB_TOPGEN]) == tg, bar);
            __builtin_amdgcn_fence(__ATOMIC_ACQUIRE, "agent");
            xb_add(&bar[XB_XGEN(b.x)], 1u);
            asm volatile("s_waitcnt vmcnt(0)" ::: "memory");
        } else {
            XB_SPIN(xb_ld(&bar[XB_XGEN(b.x)]) == gen, bar);
            __builtin_amdgcn_fence(__ATOMIC_ACQUIRE, "agent");
            asm volatile("s_waitcnt vmcnt(0)" ::: "memory");
        }
    }
    __syncthreads();
}

struct Args {
    const float* x_prompt; const float* x_sample; const float* cache_k; const float* cache_v; const float* state_conv;
    const float* norm_ffn1; const float* w_ffn1_gu; const float* w_ffn1_down; const float* norm_mix; const float* w_in; const float* b_gate; const float* w_conv;
    const float* rel_bias; const float* w_conv_out; const float* w_attn_out; const float* w_o; const float* norm_ffn2; const float* w_ffn2_gu; const float* w_ffn2_down; const float* norm_final;
    float* out; unsigned char* ws; int ph_lo, ph_hi;
};

__device__ __forceinline__ void transpose_item(const float* W, int N, const float* gain, bf16_t* WT, int dpitch, int dkoff, int mode, int kb, int nb, int scol0, LAS float* scr, int lane) {
    const int k0 = 64 * kb, n0 = 32 * nb, c = lane & 31;
    const int scol = (mode == 1) ? ((c < 16) ? 16 * nb + c : DFF + 16 * nb + (c - 16)) : scol0 + c;
#pragma unroll 8
    for (int i = 0; i < 32; ++i) { const int kk = 2 * i + (lane >> 5); float v = W[(size_t)(k0 + kk) * N + scol]; if (gain) v *= gain[k0 + kk]; scr[kk * 33 + c] = v; }
    asm volatile("s_waitcnt lgkmcnt(0)" ::: "memory");
    const int c8 = lane & 7;
#pragma unroll
    for (int j = 0; j < 4; ++j) { const int n = (lane >> 3) + 8 * j; const LAS float* s = scr + (8 * c8) * 33 + n;
        u32x4 o; o.x = pk2(s[0 * 33], s[1 * 33]); o.y = pk2(s[2 * 33], s[3 * 33]); o.z = pk2(s[4 * 33], s[5 * 33]); o.w = pk2(s[6 * 33], s[7 * 33]);
        int drow;
        if (mode == 1) { const int jj = n & 15, isu = n >> 4; drow = n0 + 8 * (jj >> 2) + 4 * isu + (jj & 3); } else drow = n0 + n;
        *(u32x4*)(WT + (size_t)drow * dpitch + dkoff + k0 + 8 * c8) = o; }
    asm volatile("s_waitcnt lgkmcnt(0)" ::: "memory");
}

__device__ __forceinline__ float wave_sum(float v) {
#pragma unroll
    for (int o = 1; o < 64; o <<= 1) v += __shfl_xor(v, o);
    return v;
}

__global__ void __launch_bounds__(NWAVES * 64, 2) mega_fwd(Args a) {
    extern __shared__ __attribute__((aligned(16))) unsigned char lds_raw[];
    LAS unsigned char* lds = (LAS unsigned char*)lds_raw;
    cg::grid_group grid = cg::this_grid();
    typedef const __attribute__((address_space(4))) Args* ArgP;
    ArgP ap = (ArgP)__builtin_amdgcn_kernarg_segment_ptr();
    const int G = gridDim.x, bx = blockIdx.x;
    const int wave0 = __builtin_amdgcn_readfirstlane((int)threadIdx.x >> 6);
    unsigned* barw = (unsigned*)(ap->ws + WS_BAR);
    if (bx == 0) for (int i = threadIdx.x; i < XCD_BAR_WORDS; i += NWAVES * 64) barw[i] = 0u;
    if (threadIdx.x < 16) ((LAS unsigned*)(lds + BARST_OFF))[threadIdx.x] = 0u;
    XcdBarrier xbar; xbar.bar = barw; xbar.x = 0; xbar.st = (volatile LAS unsigned*)(lds + BARST_OFF);
    bool xposted = false;
    const int lo = ap->ph_lo, hi = ap->ph_hi;
#define PHASE_VARS \
    asm volatile("" : "+s"(ap)); \
    int lane_ = (int)__builtin_amdgcn_mbcnt_hi(~0u, __builtin_amdgcn_mbcnt_lo(~0u, 0u)); asm volatile("" : "+v"(lane_)); \
    int wave_ = wave0; asm volatile("" : "+s"(wave_)); \
    const int lane = lane_, wave = wave_, tid = wave * 64 + lane; \
    const int vcu = (G % 8 == 0) ? (bx % 8) * (G / 8) + bx / 8 : bx; \
    const int gw = vcu * NWAVES + wave, NGW = G * NWAVES; \
    const int gt = gw * 64 + lane, NGT = NGW * 64; \
    unsigned char* ws = ap->ws; \
    bf16_t* WT = (bf16_t*)(ws + ((l & 1) ? WS_WT2 : WS_WT)); bf16_t* WTN = (bf16_t*)(ws + ((l & 1) ? WS_WT : WS_WT2)); bf16_t* XB = (bf16_t*)(ws + WS_XB); float* SSQ = (float*)(ws + WS_SSQ); \
    bf16_t* CK = (bf16_t*)(ws + ((l & 1) ? WS_CK2 : WS_CK)); bf16_t* CV = (bf16_t*)(ws + ((l & 1) ? WS_CV2 : WS_CV)); \
    bf16_t* CKN = (bf16_t*)(ws + ((l & 1) ? WS_CK : WS_CK2)); bf16_t* CVN = (bf16_t*)(ws + ((l & 1) ? WS_CV : WS_CV2)); bf16_t* Z = (bf16_t*)(ws + WS_Z); bf16_t* HB = Z; \
    float* X = ap->out; \
    (void)WTN; (void)CKN; (void)CVN; (void)tid; (void)lane; (void)wave; (void)gw; (void)NGW; (void)gt; (void)NGT; (void)WT; (void)XB; (void)SSQ; (void)CK; (void)CV; (void)Z; (void)HB; (void)X;
#define IN(k) (lo <= (k) && (k) < hi)
#define GSYNC() do { if (!xposted) { grid.sync(); xbar = xcd_barrier_post(barw, (volatile LAS unsigned*)(lds + BARST_OFF)); xposted = true; } else xcd_barrier(xbar); } while (0)
#define SEAM(k) do { if (IN(k) && IN((k) + 1)) { GSYNC(); if (PROBE_REP == 9) GSYNC(); } } while (0)
#define REPS(k) for (int rep = (PROBE_REP == (k)) ? 0 : 1; rep < 2; ++rep)
#define REPSYNC() do { if (rep == 0) GSYNC(); } while (0)

#define CONVERT_LAYER(LC, WTD, CKD, CVD) do { \
            LAS float* scr = (LAS float*)(lds + wave * 16384); \
            constexpr int I_GU = 16 * 176, I_D = 44 * 32, I_IN = 16 * 160, I_C = 8 * 32, I_O = 16 * 32; \
            constexpr int NITEMS = 2 * I_GU + 2 * I_D + I_IN + 2 * I_C + I_O; \
            for (int it = gw; it < NITEMS; it += NGW) { \
                int r = it; \
                if (r < I_GU) { transpose_item(ap->w_ffn1_gu + (size_t)(LC) * DM * 2 * DFF, 2 * DFF, ap->norm_ffn1 + (LC) * DM, (WTD) + W_GU1, DM, 0, 1, r / 176, r % 176, 0, scr, lane); continue; } r -= I_GU; \
                if (r < I_GU) { transpose_item(ap->w_ffn2_gu + (size_t)(LC) * DM * 2 * DFF, 2 * DFF, ap->norm_ffn2 + (LC) * DM, (WTD) + W_GU2, DM, 0, 1, r / 176, r % 176, 0, scr, lane); continue; } r -= I_GU; \
                if (r < I_D) { transpose_item(ap->w_ffn1_down + (size_t)(LC) * DFF * DM, DM, nullptr, (WTD) + W_D1, DFF, 0, 0, r / 32, r % 32, 32 * (r % 32), scr, lane); continue; } r -= I_D; \
                if (r < I_D) { transpose_item(ap->w_ffn2_down + (size_t)(LC) * DFF * DM, DM, nullptr, (WTD) + W_D2, DFF, 0, 0, r / 32, r % 32, 32 * (r % 32), scr, lane); continue; } r -= I_D; \
                if (r < I_IN) { const int nb = r % 160, kb = r / 160, blk = nb >> 4; \
                    const int ob = (blk == 1) ? 3 : (blk == 2) ? 1 : (blk == 3) ? 2 : blk; \
                    transpose_item(ap->w_in + (size_t)(LC) * DM * INC, INC, ap->norm_mix + (LC) * DM, (WTD) + W_IN, DM, 0, 0, kb, nb, ob * 512 + 32 * (nb & 15), scr, lane); continue; } r -= I_IN; \
                if (r < I_C) { transpose_item(ap->w_conv_out + (size_t)(LC) * 512 * DM, DM, nullptr, (WTD) + W_CAT, DM, 0, 0, r / 32, r % 32, 32 * (r % 32), scr, lane); continue; } r -= I_C; \
                if (r < I_C) { transpose_item(ap->w_attn_out + (size_t)(LC) * 512 * DM, DM, nullptr, (WTD) + W_CAT, DM, 512, 0, r / 32, r % 32, 32 * (r % 32), scr, lane); continue; } r -= I_C; \
                transpose_item(ap->w_o + (size_t)(LC) * DM * DM, DM, nullptr, (WTD) + W_O, DM, 0, 0, r / 32, r % 32, 32 * (r % 32), scr, lane); \
            } \
 \
            for (int i = gt; i < 2 * (NBATCH * 512 * 512 / 8); i += NGT) { \
                const int which = i / (NBATCH * 512 * 512 / 8), e = (i % (NBATCH * 512 * 512 / 8)) * 8; \
                const float* src = (which ? ap->cache_v : ap->cache_k) + (size_t)(LC) * NBATCH * 512 * 512 + e; \
                const f32x4 v0 = *(const f32x4*)src, v1 = *(const f32x4*)(src + 4); \
                u32x4 w; w.x = pk2(v0[0], v0[1]); w.y = pk2(v0[2], v0[3]); w.z = pk2(v1[0], v1[1]); w.w = pk2(v1[2], v1[3]); \
                *(u32x4*)((which ? (CVD) : (CKD)) + e) = w; \
            } \
} while (0)

#pragma unroll 1
    for (int l = 0; l < DEPTH; ++l) {
        const int pb = 9 * l;
        if (l == 0 && IN(pb + 0)) REPS(0) { PHASE_VARS
            CONVERT_LAYER(0, WT, CK, CV);
            if (l == 0) {
                for (int m = gw; m < MPAD; m += NGW) {
                    bf16_t* xb = XB + (size_t)m * DM; float* sq = SSQ + (size_t)m * 16;
                    if (m < MR) {
                        const float* src = (m < MP) ? ap->x_prompt + (size_t)m * DM : ap->x_sample + (size_t)(m - MP) * DM;
                        float* dst = X + (size_t)m * DM; float s = 0.f;
#pragma unroll
                        for (int j = 0; j < 4; ++j) { const f32x4 v = *(const f32x4*)(src + 256 * j + 4 * lane); *(f32x4*)(dst + 256 * j + 4 * lane) = v;
                            u32x2 w; w.x = pk2(v[0], v[1]); w.y = pk2(v[2], v[3]); *(u32x2*)(xb + 256 * j + 4 * lane) = w; s += (v[0] * v[0] + v[1] * v[1]) + (v[2] * v[2] + v[3] * v[3]); }
                        s = wave_sum(s);
                        if (lane < 16) sq[lane] = (lane == 0) ? s : 0.f;
                    } else {
#pragma unroll
                        for (int j = 0; j < 4; ++j) *(u32x2*)(xb + 256 * j + 4 * lane) = (u32x2){0u, 0u};
                        if (lane < 16) sq[lane] = 0.f;
                    }
                }
            }
        REPSYNC(); }
        if (l == 0) SEAM(pb + 0);
        if (IN(pb + 1)) REPS(1) { PHASE_VARS
            pg8::Gemm g{XB, WT + W_GU1, DM, DM, DM, 0, 0}; pg8::StaticOrder S; S.init(NTM, 2 * DFF / 256, G, bx, 1);
            EpiUp E{HB, SSQ};
            small_gemm<1, 4, EpiUp>(lds, XB, XB, DM, WT + W_GU1, WT + W_GU1, DM, 2 * DFF / 64, E, bx, G, wave, lane);
            pg8::gemm_phase<EpiUp>(lds, g, S, E, tid);
        REPSYNC(); }
        SEAM(pb + 1);
        if (IN(pb + 2)) REPS(2) { PHASE_VARS
            pg8::Gemm g{HB, WT + W_D1, DFF, DFF, DFF, 0, 0}; pg8::StaticOrder S; S.init(NTM, DM / 256, G, bx, 1);
            EpiRes E{X, XB, SSQ, rep ? 0.5f : 0.0f};
            small_gemm<1, 11, EpiRes>(lds, HB, HB, DFF, WT + W_D1, WT + W_D1, DFF, DM / 64, E, bx, G, wave, lane);
            pg8::gemm_phase<EpiRes>(lds, g, S, E, tid);
        REPSYNC(); }
        SEAM(pb + 2);
        if (IN(pb + 3)) REPS(3) { PHASE_VARS
            pg8::Gemm g{XB, WT + W_IN, DM, DM, DM, 0, 0}; pg8::StaticOrder S; S.init(NTM, INC / 256, G, bx, 1);
            EpiIn E{Z, SSQ, ap->b_gate + (size_t)l * 2 * DM, ap->out + O_KP + (size_t)l * NBATCH * 512 * 512, ap->out + O_VP + (size_t)l * NBATCH * 512 * 512,
                    ap->out + O_KS + (size_t)l * MS * 512, ap->out + O_VS + (size_t)l * MS * 512};
            small_gemm<1, 4, EpiIn>(lds, XB, XB, DM, WT + W_IN, WT + W_IN, DM, INC / 64, E, bx, G, wave, lane);
            pg8::gemm_phase<EpiIn>(lds, g, S, E, tid);
        REPSYNC(); }
        SEAM(pb + 3);
        if (IN(pb + 4)) REPS(4) { PHASE_VARS
            LAS float* rbl = (LAS float*)(lds + RB_OFF);
            for (int i = tid; i < NH * NREL; i += NWAVES * 64) { const int h = i / NREL, j = i - h * NREL; rbl[h * 264 + j] = ap->rel_bias[(size_t)l * NH * NREL + i] * LOG2E; }
            __syncthreads();
            LAS unsigned char* vbuf = lds + wave * 16384;
#pragma unroll 1
            for (int u = gw; u < 4096; u += NGW) {
                const int c = u & 63, h = (u >> 6) & 7, b = u >> 9;
                const int jlo = (c > 8) ? c - 8 : 0;
                const bf16_t* base = Z + (size_t)(b * SEQ) * INC + h * 64;
                auto tf = [&](int j) { TileD td; const size_t ro = (size_t)(64 * (jlo + j)) * INC; td.K = base + ro + ZC_K; td.V = base + ro + ZC_V; td.pitch = INC; td.nkeys = 64; td.delta0 = 64 * (c - jlo - j); return td; };
                bf16_t* qp = Z + (size_t)(b * SEQ + 64 * c) * INC + ZC_Q + h * 64;
                bf16_t* op = rep ? qp : XB + (size_t)(b * SEQ + 64 * c) * DM + h * 64;
                attn_wave<4>(qp, op, INC, rep ? INC : DM, c - jlo + 1, tf, vbuf, rbl + h * 264, lane);
            }
            { int l2 = lane; asm volatile("" : "+v"(l2)); asm volatile("" : "+s"(Z), "+s"(CK), "+s"(CV));
#pragma unroll 1
            for (int us = gw; us < 64; us += NGW) {
                const int h = us & 7, b = us >> 3;
                const bf16_t* zrow = Z + (size_t)(MP + 16 * b) * INC + h * 64;
                auto tf = [&](int j) { TileD td;
                    if (j < 8) { const size_t ro = (size_t)(b * 512 + 64 * j) * 512 + h * 64; td.K = CK + ro; td.V = CV + ro; td.pitch = 512; td.nkeys = 64; td.delta0 = 512 - 64 * j; }
                    else { td.K = zrow + ZC_K; td.V = zrow + ZC_V; td.pitch = INC; td.nkeys = 16; td.delta0 = 0; }
                    return td; };
                bf16_t* qp = Z + (size_t)(MP + 16 * b) * INC + ZC_Q + h * 64;
                bf16_t* op = rep ? qp : XB + (size_t)(16 * b) * DM + h * 64;
                attn_wave<1>(qp, op, INC, rep ? INC : DM, 9, tf, vbuf, rbl + h * 264, l2);
            } }
            for (int cu = (NGW - 1 - gw); cu < MR / 16; cu += NGW) {
                const int row0 = cu * 16, ch = 8 * lane;
                const bool samp = (row0 >= MP);
                const int bb = samp ? (row0 - MP) / 16 : (row0 >> 12), t0 = samp ? 0 : (row0 & 4095);
                float w0[8], w1[8], w2[8], um2[8], um1[8];
                { const float* wc = ap->w_conv + (size_t)l * 3 * 512 + ch;
#pragma unroll
                  for (int i = 0; i < 8; ++i) { w0[i] = wc[i]; w1[i] = wc[512 + i]; w2[i] = wc[1024 + i]; } }
                if (samp) { const float* sc = ap->state_conv + ((size_t)(l * NBATCH + bb) * 2) * 512 + ch;
#pragma unroll
                    for (int i = 0; i < 8; ++i) { um2[i] = sc[i]; um1[i] = sc[512 + i]; }
                } else if (t0 == 0) {
#pragma unroll
                    for (int i = 0; i < 8; ++i) { um2[i] = 0.f; um1[i] = 0.f; }
                } else {
                    const bf16_t* z2 = Z + (size_t)(row0 - 2) * INC + ch; const bf16_t* z1 = Z + (size_t)(row0 - 1) * INC + ch;
                    const u32x4 c2 = *(const u32x4*)(z2 + ZC_CC), v2 = *(const u32x4*)(z2 + ZC_CV), c1 = *(const u32x4*)(z1 + ZC_CC), v1 = *(const u32x4*)(z1 + ZC_CV);
#pragma unroll
                    for (int i = 0; i < 4; ++i) { um2[2 * i] = bf_lo(c2[i]) * bf_lo(v2[i]); um2[2 * i + 1] = bf_hi(c2[i]) * bf_hi(v2[i]); um1[2 * i] = bf_lo(c1[i]) * bf_lo(v1[i]); um1[2 * i + 1] = bf_hi(c1[i]) * bf_hi(v1[i]); }
                }
#pragma unroll 4
                for (int r = 0; r < 16; ++r) {
                    bf16_t* zr = Z + (size_t)(row0 + r) * INC + ch;
                    const u32x4 cbw = *(const u32x4*)(zr + ZC_CB), ccw = *(const u32x4*)(zr + ZC_CC), cvw = *(const u32x4*)(zr + ZC_CV);
                    float y[8];
#pragma unroll
                    for (int i = 0; i < 4; ++i) {
                        const float u0 = bf_lo(ccw[i]) * bf_lo(cvw[i]), u1 = bf_hi(ccw[i]) * bf_hi(cvw[i]);
                        y[2 * i] = bf_lo(cbw[i]) * (w0[2 * i] * um2[2 * i] + w1[2 * i] * um1[2 * i] + w2[2 * i] * u0);
                        y[2 * i + 1] = bf_hi(cbw[i]) * (w0[2 * i + 1] * um2[2 * i + 1] + w1[2 * i + 1] * um1[2 * i + 1] + w2[2 * i + 1] * u1);
                        um2[2 * i] = um1[2 * i]; um1[2 * i] = u0; um2[2 * i + 1] = um1[2 * i + 1]; um1[2 * i + 1] = u1;
                    }
                    u32x4 w; w.x = cvt_pk_bf16(y[0], y[1]); w.y = cvt_pk_bf16(y[2], y[3]); w.z = cvt_pk_bf16(y[4], y[5]); w.w = cvt_pk_bf16(y[6], y[7]);
                    *(u32x4*)(rep ? zr + ZC_CB : XB + (size_t)(row0 + r) * DM + 512 + ch) = w;
                }
                if (samp || t0 == SEQ - 16) {
                    float* dst = ap->out + (samp ? O_CS : O_CP) + ((size_t)(l * NBATCH + bb) * 2) * 512 + ch;
                    *(f32x4*)dst = (f32x4){um2[0], um2[1], um2[2], um2[3]}; *(f32x4*)(dst + 4) = (f32x4){um2[4], um2[5], um2[6], um2[7]};
                    *(f32x4*)(dst + 512) = (f32x4){um1[0], um1[1], um1[2], um1[3]}; *(f32x4*)(dst + 516) = (f32x4){um1[4], um1[5], um1[6], um1[7]};
                }
            }
            if (rep && l + 1 < DEPTH) { asm volatile("s_waitcnt vmcnt(0) lgkmcnt(0)" ::: "memory"); asm volatile("" : "+s"(ap)); CONVERT_LAYER(l + 1, WTN, CKN, CVN); }
            asm volatile("s_waitcnt vmcnt(0) lgkmcnt(0)" ::: "memory");
            __syncthreads();
        REPSYNC(); }
        SEAM(pb + 4);
        if (IN(pb + 5)) REPS(5) { PHASE_VARS
            pg8::Gemm g{Z, WT + W_CAT, INC, DM, 512, 512 * 2, 512 * 2}; pg8::StaticOrder S; S.init(NTM, DM / 256, G, bx, 2);
            EpiMix E{Z};
            small_gemm<2, 2, EpiMix>(lds, Z + ZC_CB, Z + ZC_Q, INC, WT + W_CAT, WT + W_CAT + 512, DM, DM / 64, E, bx, G, wave, lane);
            pg8::gemm_phase<EpiMix>(lds, g, S, E, tid);
        REPSYNC(); }
        SEAM(pb + 5);
        if (IN(pb + 6)) REPS(6) { PHASE_VARS
            pg8::Gemm g{Z + ZC_MB, WT + W_O, INC, DM, DM, 0, 0}; pg8::StaticOrder S; S.init(NTM, DM / 256, G, bx, 1);
            EpiRes E{X, XB, SSQ, rep ? 1.0f : 0.0f};
            small_gemm<1, 4, EpiRes>(lds, Z + ZC_MB, Z + ZC_MB, INC, WT + W_O, WT + W_O, DM, DM / 64, E, bx, G, wave, lane);
            pg8::gemm_phase<EpiRes>(lds, g, S, E, tid);
        REPSYNC(); }
        SEAM(pb + 6);
        if (IN(pb + 7)) REPS(7) { PHASE_VARS
            pg8::Gemm g{XB, WT + W_GU2, DM, DM, DM, 0, 0}; pg8::StaticOrder S; S.init(NTM, 2 * DFF / 256, G, bx, 1);
            EpiUp E{HB, SSQ};
            small_gemm<1, 4, EpiUp>(lds, XB, XB, DM, WT + W_GU2, WT + W_GU2, DM, 2 * DFF / 64, E, bx, G, wave, lane);
            pg8::gemm_phase<EpiUp>(lds, g, S, E, tid);
        REPSYNC(); }
        SEAM(pb + 7);
        if (IN(pb + 8)) REPS(8) { PHASE_VARS
            pg8::Gemm g{HB, WT + W_D2, DFF, DFF, DFF, 0, 0}; pg8::StaticOrder S; S.init(NTM, DM / 256, G, bx, 1);
            EpiRes E{X, XB, SSQ, rep ? 0.5f : 0.0f};
            small_gemm<1, 11, EpiRes>(lds, HB, HB, DFF, WT + W_D2, WT + W_D2, DFF, DM / 64, E, bx, G, wave, lane);
            pg8::gemm_phase<EpiRes>(lds, g, S, E, tid);
        REPSYNC(); }
        SEAM(pb + 8);
    }
    if (IN(36)) { const int l = 0; PHASE_VARS
        for (int m = gw; m < MR; m += NGW) {
            float* xr = X + (size_t)m * DM;
            const float sv = (lane < 16) ? SSQ[(size_t)m * 16 + lane] : 0.f;
            const float rs = __builtin_amdgcn_rsqf(wave_sum(sv) * (1.0f / 1024.0f) + EPS);
#pragma unroll
            for (int j = 0; j < 4; ++j) { const f32x4 v = *(const f32x4*)(xr + 256 * j + 4 * lane), gn = *(const f32x4*)(ap->norm_final + 256 * j + 4 * lane); *(f32x4*)(xr + 256 * j + 4 * lane) = v * rs * gn; }
        }
    }
#undef IN
#undef SEAM
}

extern "C" void kernel_launch(void* const* d_in, const int* in_sizes, int n_in, void* d_out, int out_size, void* d_ws, size_t ws_size, hipStream_t stream) {
    static int grid = 0;
    if (grid == 0) {
        if (n_in != 20 || (size_t)out_size != O_END || ws_size < WS_END) { fprintf(stderr, "kernel_launch: unexpected shapes: n_in %d out %d (want %zu) ws %zu (need %zu)\n", n_in, out_size, (size_t)O_END, ws_size, (size_t)WS_END); grid = -1; return; }
        int dev = 0, cus = 0, per_cu = 0;
        hipGetDevice(&dev); hipDeviceGetAttribute(&cus, hipDeviceAttributeMultiprocessorCount, dev);
        if (hipFuncSetAttribute((const void*)mega_fwd, hipFuncAttributeMaxDynamicSharedMemorySize, LDS_BYTES) != hipSuccess) { fprintf(stderr, "kernel_launch: hipFuncSetAttribute failed\n"); grid = -1; return; }
        if (hipOccupancyMaxActiveBlocksPerMultiprocessor(&per_cu, (const void*)mega_fwd, NWAVES * 64, LDS_BYTES) != hipSuccess || per_cu < 1) { fprintf(stderr, "kernel_launch: occupancy query says %d\n", per_cu); per_cu = 1; }
        (void)hipGetLastError();
        grid = cus;
    }
    if (grid < 0) return;
    Args a{};
    const float** ap = (const float**)&a;
    for (int i = 0; i < 20; ++i) ap[i] = (const float*)d_in[i];
    a.out = (float*)d_out; a.ws = (unsigned char*)d_ws; a.ph_lo = 0; a.ph_hi = 37;
    void* args[] = {&a};
    hipError_t e = hipLaunchCooperativeKernel((const void*)mega_fwd, dim3(grid), dim3(NWAVES * 64), args, LDS_BYTES, stream);
    if (e != hipSuccess) fprintf(stderr, "kernel_launch: cooperative launch failed: %s (grid %d)\n", hipGetErrorString(e), grid);
}
```

```cpp
#include <hip/hip_runtime.h>
#include <hip/hip_cooperative_groups.h>
#include <cstdio>
#include <cstdint>
namespace cg = cooperative_groups;
#ifndef PROBE_REP
#define PROBE_REP (-1)
#endif

#define LAS __attribute__((address_space(3)))
typedef unsigned short bf16_t;
typedef short bf16x8 __attribute__((ext_vector_type(8)));
typedef short s16x4 __attribute__((ext_vector_type(4)));
typedef float f32x4 __attribute__((ext_vector_type(4)));
typedef unsigned u32x4 __attribute__((ext_vector_type(4)));
typedef unsigned u32x2 __attribute__((ext_vector_type(2)));

constexpr int DM = 1024, NBATCH = 8, SEQ = 4096, DEPTH = 4, DSEQ = 16;
constexpr int NH = 8, DFF = 2816, INC = 5120, NREL = 257;
constexpr int MP = NBATCH * SEQ;
constexpr int MS = NBATCH * DSEQ;
constexpr int MR = MP + MS;
constexpr int MPAD = 33024;
constexpr int NTM = MP / 256;
constexpr float EPS = 1e-6f;
constexpr float LOG2E = 1.4426950408889634f;
constexpr float QSCALE = 0.125f * LOG2E;
constexpr int ZC_CB = 0, ZC_Q = 512, ZC_CC = 1024, ZC_CV = 1536, ZC_K = 2048, ZC_V = 2560, ZC_GC = 3072, ZC_GA = 4096, ZC_MB = 1024;

constexpr size_t O_Y = 0;
constexpr size_t O_KP = (size_t)MR * DM;
constexpr size_t O_VP = O_KP + (size_t)DEPTH * NBATCH * 512 * 512;
constexpr size_t O_CP = O_VP + (size_t)DEPTH * NBATCH * 512 * 512;
constexpr size_t O_KS = O_CP + (size_t)DEPTH * NBATCH * 2 * 512;
constexpr size_t O_VS = O_KS + (size_t)DEPTH * NBATCH * DSEQ * 512;
constexpr size_t O_CS = O_VS + (size_t)DEPTH * NBATCH * DSEQ * 512;
constexpr size_t O_END = O_CS + (size_t)DEPTH * NBATCH * 2 * 512;

constexpr size_t W_GU1 = 0;
constexpr size_t W_D1 = W_GU1 + (size_t)2 * DFF * DM;
constexpr size_t W_IN = W_D1 + (size_t)DM * DFF;
constexpr size_t W_CAT = W_IN + (size_t)INC * DM;
constexpr size_t W_O = W_CAT + (size_t)DM * DM;
constexpr size_t W_GU2 = W_O + (size_t)DM * DM;
constexpr size_t W_D2 = W_GU2 + (size_t)2 * DFF * DM;
constexpr size_t W_TOTAL = W_D2 + (size_t)DM * DFF;

constexpr size_t WS_WT = 0;
constexpr size_t WS_XB = WS_WT + ((W_TOTAL * 2 + 4095) / 4096) * 4096;
constexpr size_t WS_SSQ = WS_XB + (size_t)MPAD * DM * 2;
constexpr size_t WS_CK = WS_SSQ + (size_t)MPAD * 16 * 4;
constexpr size_t WS_CV = WS_CK + (size_t)NBATCH * 512 * 512 * 2;
constexpr size_t WS_Z = WS_CV + (size_t)NBATCH * 512 * 512 * 2;
constexpr size_t WS_WT2 = WS_Z + (size_t)MPAD * INC * 2;
constexpr size_t WS_BAR = WS_WT2 + ((W_TOTAL * 2 + 4095) / 4096) * 4096;
constexpr size_t WS_CK2 = WS_BAR + 16384;
constexpr size_t WS_CV2 = WS_CK2 + (size_t)NBATCH * 512 * 512 * 2;
constexpr size_t WS_END = WS_CV2 + (size_t)NBATCH * 512 * 512 * 2;

constexpr int NWAVES = 8;
constexpr int RING_BYTES = 131072;
constexpr int RB_OFF = RING_BYTES + 1024;
constexpr int LDS_BYTES = 147456;
constexpr int BARST_OFF = LDS_BYTES - 64;

__device__ __forceinline__ unsigned cvt_pk_bf16(float lo, float hi) { unsigned r; asm volatile("v_cvt_pk_bf16_f32 %0, %1, %2" : "=v"(r) : "v"(lo), "v"(hi)); return r; }
__device__ __forceinline__ float bf_lo(unsigned w) { return __uint_as_float(w << 16); }
__device__ __forceinline__ float bf_hi(unsigned w) { return __uint_as_float(w & 0xffff0000u); }
__device__ __forceinline__ unsigned f2bf(float f) { unsigned u = __float_as_uint(f); return (u + 0x7fffu + ((u >> 16) & 1u)) >> 16; }
__device__ __forceinline__ unsigned pk2(float lo, float hi) { return f2bf(lo) | (f2bf(hi) << 16); }
__device__ __forceinline__ float fast_sigmoid(float x) { return __builtin_amdgcn_rcpf(1.0f + __builtin_amdgcn_exp2f(-x * LOG2E)); }

namespace pg8 {
constexpr int BM = 256, BK = 64, HALF = 128, HTB = HALF * BK * 2, STAGE_BYTES = 8 * HTB, NXCD = 8, WGM = 8;
__host__ __device__ __forceinline__ int lds_byte(int r, int c) { const int st = (r >> 4) * 2 + (c >> 5), rr = r & 15, cc = c & 31, ob = rr * 64 + cc * 2; return st * 1024 + (ob ^ (((ob >> 9) & 1) << 5)); }
__host__ __device__ __forceinline__ void stage_rc(int b, int& R, int& C) { const int st = b / 1024, sb = b % 1024, swz = sb ^ (((sb >> 9) & 1) << 5); R = (st >> 1) * 16 + swz / 64; C = (st & 1) * 32 + (swz % 64) / 2; }
__host__ __device__ __forceinline__ int perm32(int rho) { const int n = rho >> 4, i = rho & 15; return 8 * (i >> 2) + 4 * n + (i & 3); }

struct Unit { int pm, pn, z; };
struct Gemm { const bf16_t* A; const bf16_t* Bt; int lda, ldb, K; long zA, zB; };

struct StaticOrder {
    int nM, nN, nwg, G, c, nz;
    __device__ void init(int nM_, int nN_, int G_, int c_, int nz_) { nM = nM_; nN = nN_; nwg = nM * nN; G = G_; c = c_; nz = nz_; }
    __device__ bool next(int i, Unit& u) const {
        const int it = i / nz; u.z = i - it * nz;
        const long L = (long)it * G + c; if (L >= nwg) return false;
        int wgid = (int)L; { const int q = nwg / NXCD, r = nwg % NXCD, xcd = wgid % NXCD, off = wgid / NXCD; wgid = (xcd < r ? xcd * (q + 1) : r * (q + 1) + (xcd - r) * q) + off; }
        const int nig = WGM * nN, gid = wgid / nig, fm = gid * WGM, gsz = (nM - fm) < WGM ? (nM - fm) : WGM;
        u.pm = fm + ((wgid % nig) % gsz); u.pn = (wgid % nig) / gsz; return true;
    }
};

template <class Epi>
__device__ __forceinline__ void gemm_phase(LAS unsigned char* lds, const Gemm g, const StaticOrder& S, const Epi& E, const int tid) {
    const int wid = __builtin_amdgcn_readfirstlane(tid >> 6), lane = tid & 63, wr = wid >> 2, wc = wid & 3, fr = lane & 15, fq = lane >> 4;
    const int K = g.K, nt = K / BK;
    unsigned voffA[2], voffB[2];
#pragma unroll
    for (int i = 0; i < 2; ++i) { int R, C; stage_rc(tid * 16 + i * 8192, R, C); const int Rb = (R & ~31) + perm32(R & 31);
        voffA[i] = (unsigned)(R * g.lda + C) * 2u; voffB[i] = (unsigned)(Rb * g.ldb + C) * 2u; }
    const size_t kstep = (size_t)(BK * 2);
    const size_t hstepA = (size_t)HALF * g.lda * 2, hstepB = (size_t)HALF * g.ldb * 2;
    const size_t tstepA = 2 * hstepA, tstepB = 2 * hstepB;
    const unsigned ldsw = (unsigned)wid * 1024u;
    const int aoff = lds_byte(wr * 64 + fr, fq * 8), boff = lds_byte(wc * 32 + fr, fq * 8);
#define PG8_SA(b, h) (((b) * 2 + (h)) * HTB)
#define PG8_SB(b, h) ((4 + (b) * 2 + (h)) * HTB)
#define PG8_STAGE(bufoff, gbase, voff) do { _Pragma("unroll") for (int _i = 0; _i < 2; ++_i) \
        __builtin_amdgcn_global_load_lds((const unsigned*)((const char*)(gbase) + (voff)[_i]), (LAS unsigned*)(lds + (bufoff) + ldsw + _i * 8192), 16, 0, 0); } while (0)
#define PG8_LDA(dst, b, h) do { _Pragma("unroll") for (int m = 0; m < 4; ++m) _Pragma("unroll") for (int k = 0; k < 2; ++k) dst[m][k] = *(const LAS bf16x8*)(lds + PG8_SA(b, h) + aoff + m * 2048 + k * 1024); } while (0)
#define PG8_LDB(dst, b, h) do { _Pragma("unroll") for (int n = 0; n < 2; ++n) _Pragma("unroll") for (int k = 0; k < 2; ++k) dst[n][k] = *(const LAS bf16x8*)(lds + PG8_SB(b, h) + boff + n * 2048 + k * 1024); } while (0)
#define PG8_MMA(ai, bj, At, Bt) do { __builtin_amdgcn_s_setprio(1); _Pragma("unroll") for (int m = 0; m < 4; ++m) _Pragma("unroll") for (int n = 0; n < 2; ++n) _Pragma("unroll") for (int k = 0; k < 2; ++k) \
        acc[ai][bj][m][n] = __builtin_amdgcn_mfma_f32_16x16x32_bf16(Bt[n][k], At[m][k], acc[ai][bj][m][n], 0, 0, 0); __builtin_amdgcn_s_setprio(0); } while (0)
#define PG8_WAIT_V(n) asm volatile("s_waitcnt vmcnt(" #n ")" ::: "memory")
#define PG8_WAIT_L(n) asm volatile("s_waitcnt lgkmcnt(" #n ")" ::: "memory")
#define PG8_BAR __builtin_amdgcn_s_barrier()
#define PG8_SCHED __builtin_amdgcn_sched_barrier(0)
    Unit cur, nxt; int ui = 0;
    if (!S.next(0, cur)) return;
    f32x4 acc[2][2][4][2];
#pragma unroll
    for (int a = 0; a < 2; ++a)
#pragma unroll
        for (int b = 0; b < 2; ++b)
#pragma unroll
            for (int m = 0; m < 4; ++m)
#pragma unroll
                for (int n = 0; n < 2; ++n) acc[a][b][m][n] = (f32x4){0.f, 0.f, 0.f, 0.f};
    bf16x8 At[4][2], B0[2][2], B1[2][2];
    const char* cA = (const char*)g.A + (size_t)cur.pm * tstepA + (size_t)cur.z * g.zA; const char* cB = (const char*)g.Bt + (size_t)cur.pn * tstepB + (size_t)cur.z * g.zB;
    PG8_STAGE(PG8_SB(0, 0), cB, voffB); PG8_STAGE(PG8_SB(0, 1), cB + hstepB, voffB); PG8_STAGE(PG8_SA(0, 0), cA, voffA); PG8_STAGE(PG8_SA(0, 1), cA + hstepA, voffA);
    if (wr == 1) PG8_BAR;
    PG8_WAIT_V(2); PG8_BAR;
    PG8_STAGE(PG8_SB(1, 0), cB + kstep, voffB); PG8_STAGE(PG8_SA(1, 0), cA + kstep, voffA); PG8_STAGE(PG8_SB(1, 1), cB + hstepB + kstep, voffB);
    PG8_WAIT_V(6); PG8_BAR;
    for (;;) {
        const bool has_next = S.next(ui + 1, nxt);
        const char* nA = has_next ? (const char*)g.A + (size_t)nxt.pm * tstepA + (size_t)nxt.z * g.zA : cA; const char* nB = has_next ? (const char*)g.Bt + (size_t)nxt.pn * tstepB + (size_t)nxt.z * g.zB : cB;
        for (int t = 0; t < nt; t += 2) {
            const bool last = (t == nt - 2);
            const char* a1 = cA + (size_t)(t + 1) * kstep;
            const char* a2 = last ? nA : cA + (size_t)(t + 2) * kstep; const char* b2 = last ? nB : cB + (size_t)(t + 2) * kstep;
            const char* a3 = a2 + kstep; const char* b3 = b2 + kstep;
            PG8_LDB(B0, 0, 0); PG8_LDB(B1, 0, 1); PG8_SCHED; PG8_LDA(At, 0, 0); PG8_STAGE(PG8_SA(1, 1), a1 + hstepA, voffA);
            PG8_WAIT_V(8); PG8_WAIT_L(0); PG8_BAR; PG8_MMA(0, 0, At, B0); PG8_MMA(0, 1, At, B1); PG8_BAR; PG8_SCHED;
            PG8_LDA(At, 0, 1); PG8_STAGE(PG8_SB(0, 0), b2, voffB); PG8_STAGE(PG8_SB(0, 1), b2 + hstepB, voffB); PG8_STAGE(PG8_SA(0, 0), a2, voffA);
            PG8_WAIT_V(8); PG8_WAIT_L(0); PG8_BAR; PG8_MMA(1, 0, At, B0); PG8_MMA(1, 1, At, B1); PG8_BAR; PG8_SCHED;
            PG8_LDB(B0, 1, 0); PG8_LDB(B1, 1, 1); PG8_SCHED; PG8_LDA(At, 1, 0); PG8_STAGE(PG8_SA(0, 1), a2 + hstepA, voffA);
            PG8_WAIT_V(8); PG8_WAIT_L(0); PG8_BAR; PG8_MMA(0, 0, At, B0); PG8_MMA(0, 1, At, B1); PG8_BAR; PG8_SCHED;
            PG8_LDA(At, 1, 1); PG8_STAGE(PG8_SB(1, 0), b3, voffB); PG8_STAGE(PG8_SB(1, 1), b3 + hstepB, voffB); PG8_STAGE(PG8_SA(1, 0), a3, voffA);
            PG8_WAIT_V(8); PG8_WAIT_L(0); PG8_BAR; PG8_MMA(1, 0, At, B0); PG8_MMA(1, 1, At, B1); PG8_BAR; PG8_SCHED;
        }
        if (wr == 0) PG8_BAR;
        E(acc, cur, wr, wc, fr, fq);
        if (!has_next) break;
#pragma unroll
        for (int a = 0; a < 2; ++a)
#pragma unroll
            for (int b = 0; b < 2; ++b)
#pragma unroll
                for (int m = 0; m < 4; ++m)
#pragma unroll
                    for (int n = 0; n < 2; ++n) acc[a][b][m][n] = (f32x4){0.f, 0.f, 0.f, 0.f};
        cur = nxt; cA = nA; cB = nB; ++ui;
        if (wr == 1) PG8_BAR;
    }
    PG8_WAIT_V(0);
    PG8_BAR;
#undef PG8_SA
#undef PG8_SB
#undef PG8_STAGE
#undef PG8_LDA
#undef PG8_LDB
#undef PG8_MMA
#undef PG8_WAIT_V
#undef PG8_WAIT_L
#undef PG8_BAR
#undef PG8_SCHED
}
}

__device__ __forceinline__ float row_rs(const float* ssq, int row, int fq) {
    const f32x4 v = *(const f32x4*)(ssq + (size_t)row * 16 + 4 * fq);
    float s = (v[0] + v[1]) + (v[2] + v[3]);
    s += __shfl_xor(s, 16); s += __shfl_xor(s, 32);
    return __builtin_amdgcn_rsqf(s * (1.0f / 1024.0f) + EPS);
}

struct EpiUp {
    bf16_t* H; const float* ssq;
    __device__ __forceinline__ void operator()(const f32x4 (&acc)[2][2][4][2], const pg8::Unit& u, int wr, int wc, int fr, int fq) const {
        const int row0 = u.pm * 256 + wr * 64 + fr, hc0 = u.pn * 128 + wc * 16 + 4 * fq;
#pragma unroll
        for (int ai = 0; ai < 2; ++ai)
#pragma unroll
            for (int m = 0; m < 4; ++m) {
                const int row = row0 + ai * 128 + m * 16; const float rs = row_rs(ssq, row, fq);
#pragma unroll
                for (int bj = 0; bj < 2; ++bj) {
                    const f32x4 gg = acc[ai][bj][m][0] * rs, uu = acc[ai][bj][m][1] * rs; float h[4];
#pragma unroll
                    for (int i = 0; i < 4; ++i) h[i] = gg[i] * fast_sigmoid(gg[i]) * uu[i];
                    u32x2 w; w.x = cvt_pk_bf16(h[0], h[1]); w.y = cvt_pk_bf16(h[2], h[3]);
                    *(u32x2*)(H + (size_t)row * DFF + hc0 + bj * 64) = w;
                }
            }
    }
    __device__ __forceinline__ void small(const f32x4 (&acc)[1][2][2], int row, int c0, int fr, int fq) const {
        const float rs = row_rs(ssq, row, fq);
#pragma unroll
        for (int j = 0; j < 2; ++j) {
            const f32x4 gg = acc[0][j][0] * rs, uu = acc[0][j][1] * rs; float h[4];
#pragma unroll
            for (int i = 0; i < 4; ++i) h[i] = gg[i] * fast_sigmoid(gg[i]) * uu[i];
            u32x2 w; w.x = cvt_pk_bf16(h[0], h[1]); w.y = cvt_pk_bf16(h[2], h[3]);
            *(u32x2*)(H + (size_t)row * DFF + (c0 >> 1) + 16 * j + 4 * fq) = w;
        }
    }
};

struct EpiRes {
    float* X; bf16_t* XB; float* ssq; float scale;
    __device__ __forceinline__ void operator()(const f32x4 (&acc)[2][2][4][2], const pg8::Unit& u, int wr, int wc, int fr, int fq) const {
        const int row0 = u.pm * 256 + wr * 64 + fr, col0 = u.pn * 256 + wc * 32 + 8 * fq;
#pragma unroll
        for (int ai = 0; ai < 2; ++ai)
#pragma unroll
            for (int m = 0; m < 4; ++m) {
                const int row = row0 + ai * 128 + m * 16;
                {
                    float s = 0.f;
#pragma unroll
                    for (int bj = 0; bj < 2; ++bj) {
                        float* xp = X + (size_t)row * DM + col0 + bj * 128;
                        f32x4 x0 = *(const f32x4*)xp, x1 = *(const f32x4*)(xp + 4);
                        x0 += acc[ai][bj][m][0] * scale; x1 += acc[ai][bj][m][1] * scale;
                        *(f32x4*)xp = x0; *(f32x4*)(xp + 4) = x1;
                        u32x4 w; w.x = cvt_pk_bf16(x0[0], x0[1]); w.y = cvt_pk_bf16(x0[2], x0[3]); w.z = cvt_pk_bf16(x1[0], x1[1]); w.w = cvt_pk_bf16(x1[2], x1[3]);
                        *(u32x4*)(XB + (size_t)row * DM + col0 + bj * 128) = w;
                        s += (x0[0] * x0[0] + x0[1] * x0[1]) + (x0[2] * x0[2] + x0[3] * x0[3]) + (x1[0] * x1[0] + x1[1] * x1[1]) + (x1[2] * x1[2] + x1[3] * x1[3]);
                    }
                    s += __shfl_xor(s, 16); s += __shfl_xor(s, 32);
                    if (fq == 0) ssq[(size_t)row * 16 + u.pn * 4 + wc] = s;
                }
                if (m == 3) asm volatile("" ::: "memory");
            }
    }
    __device__ __forceinline__ void small(const f32x4 (&acc)[1][2][2], int row, int c0, int fr, int fq) const {
        float s = 0.f;
#pragma unroll
        for (int j = 0; j < 2; ++j) {
            float* xp = X + (size_t)row * DM + c0 + 32 * j + 8 * fq;
            f32x4 x0 = *(const f32x4*)xp, x1 = *(const f32x4*)(xp + 4);
            x0 += acc[0][j][0] * scale; x1 += acc[0][j][1] * scale;
            *(f32x4*)xp = x0; *(f32x4*)(xp + 4) = x1;
            u32x4 w; w.x = cvt_pk_bf16(x0[0], x0[1]); w.y = cvt_pk_bf16(x0[2], x0[3]); w.z = cvt_pk_bf16(x1[0], x1[1]); w.w = cvt_pk_bf16(x1[2], x1[3]);
            *(u32x4*)(XB + (size_t)row * DM + c0 + 32 * j + 8 * fq) = w;
            s += (x0[0] * x0[0] + x0[1] * x0[1]) + (x0[2] * x0[2] + x0[3] * x0[3]) + (x1[0] * x1[0] + x1[1] * x1[1]) + (x1[2] * x1[2] + x1[3] * x1[3]);
        }
        s += __shfl_xor(s, 16); s += __shfl_xor(s, 32);
        if (fq == 0) ssq[(size_t)row * 16 + (c0 >> 6)] = s;
    }
};

struct EpiIn {
    bf16_t* Z; const float* ssq; const float* bgate; float* okp; float* ovp; float* oks; float* ovs;
    __device__ __forceinline__ void operator()(const f32x4 (&acc)[2][2][4][2], const pg8::Unit& u, int wr, int wc, int fr, int fq) const {
        const int row0 = u.pm * 256 + wr * 64 + fr, col0 = u.pn * 256 + wc * 32 + 8 * fq;
        const int pn = u.pn;
        const bool isq = (pn == 2 || pn == 3), iskv = (pn >= 8 && pn < 12), isg = (pn >= 12);
        const bool kvp = iskv && ((u.pm & 15) >= 14);
        f32x4 bg[2][2];
#pragma unroll
        for (int bj = 0; bj < 2; ++bj) { if (isg) { bg[bj][0] = *(const f32x4*)(bgate + col0 - ZC_GC + bj * 128); bg[bj][1] = *(const f32x4*)(bgate + col0 - ZC_GC + bj * 128 + 4); } else { bg[bj][0] = (f32x4){0.f, 0.f, 0.f, 0.f}; bg[bj][1] = bg[bj][0]; } }
#pragma unroll
        for (int ai = 0; ai < 2; ++ai)
#pragma unroll
            for (int m = 0; m < 4; ++m) {
                const int row = row0 + ai * 128 + m * 16; float rs = row_rs(ssq, row, fq);
                if (isq) rs *= QSCALE;
#pragma unroll
                for (int bj = 0; bj < 2; ++bj) {
                    f32x4 v0 = acc[ai][bj][m][0] * rs, v1 = acc[ai][bj][m][1] * rs;
                    const int c = col0 + bj * 128;
                    if (isg) {
                        v0 += bg[bj][0]; v1 += bg[bj][1];
#pragma unroll
                        for (int i = 0; i < 4; ++i) { v0[i] = fast_sigmoid(v0[i]); v1[i] = fast_sigmoid(v1[i]); }
                    }
                    u32x4 w; w.x = cvt_pk_bf16(v0[0], v0[1]); w.y = cvt_pk_bf16(v0[2], v0[3]); w.z = cvt_pk_bf16(v1[0], v1[1]); w.w = cvt_pk_bf16(v1[2], v1[3]);
                    *(u32x4*)(Z + (size_t)row * INC + c) = w;
                    if (kvp) {
                        const int b = row >> 12, t = row & 4095;
                        float* dst = ((pn < 10) ? okp : ovp) + ((size_t)(b * 512 + (t - 3584)) * 512 + (c - ((pn < 10) ? ZC_K : ZC_V)));
                        *(f32x4*)dst = v0; *(f32x4*)(dst + 4) = v1;
                    }
                }
            }
    }
    __device__ __forceinline__ void small(const f32x4 (&acc)[1][2][2], int row, int c0, int fr, int fq) const {
        const int pn = c0 >> 8;
        const bool isq = (pn == 2 || pn == 3), iskv = (pn >= 8 && pn < 12), isg = (pn >= 12);
        float rs = row_rs(ssq, row, fq);
        if (isq) rs *= QSCALE;
#pragma unroll
        for (int j = 0; j < 2; ++j) {
            f32x4 v0 = acc[0][j][0] * rs, v1 = acc[0][j][1] * rs;
            const int c = c0 + 32 * j + 8 * fq;
            if (isg) {
                v0 += *(const f32x4*)(bgate + c - ZC_GC); v1 += *(const f32x4*)(bgate + c - ZC_GC + 4);
#pragma unroll
                for (int i = 0; i < 4; ++i) { v0[i] = fast_sigmoid(v0[i]); v1[i] = fast_sigmoid(v1[i]); }
            }
            u32x4 w; w.x = cvt_pk_bf16(v0[0], v0[1]); w.y = cvt_pk_bf16(v0[2], v0[3]); w.z = cvt_pk_bf16(v1[0], v1[1]); w.w = cvt_pk_bf16(v1[2], v1[3]);
            *(u32x4*)(Z + (size_t)row * INC + c) = w;
            if (iskv) {
                float* dst = ((pn < 10) ? oks : ovs) + ((size_t)(row - MP) * 512 + (c - ((pn < 10) ? ZC_K : ZC_V)));
                *(f32x4*)dst = v0; *(f32x4*)(dst + 4) = v1;
            }
        }
    }
};

struct EpiMix {
    bf16_t* Z;
    __device__ __forceinline__ void operator()(const f32x4 (&acc)[2][2][4][2], const pg8::Unit& u, int wr, int wc, int fr, int fq) const {
        const int row0 = u.pm * 256 + wr * 64 + fr, col0 = u.pn * 256 + wc * 32 + 8 * fq;
        const int gcol = (u.z == 0) ? ZC_GC : ZC_GA;
#pragma unroll
        for (int ai = 0; ai < 2; ++ai)
#pragma unroll
            for (int m = 0; m < 4; ++m) {
                const int row = row0 + ai * 128 + m * 16;
#pragma unroll
                for (int bj = 0; bj < 2; ++bj) {
                    const int c = col0 + bj * 128;
                    const u32x4 gw = *(const u32x4*)(Z + (size_t)row * INC + gcol + c);
                    f32x4 v0 = acc[ai][bj][m][0], v1 = acc[ai][bj][m][1];
                    v0[0] *= bf_lo(gw.x); v0[1] *= bf_hi(gw.x); v0[2] *= bf_lo(gw.y); v0[3] *= bf_hi(gw.y);
                    v1[0] *= bf_lo(gw.z); v1[1] *= bf_hi(gw.z); v1[2] *= bf_lo(gw.w); v1[3] *= bf_hi(gw.w);
                    bf16_t* mp = Z + (size_t)row * INC + ZC_MB + c;
                    if (u.z != 0) {
                        const u32x4 pw = *(const u32x4*)mp;
                        v0[0] += bf_lo(pw.x); v0[1] += bf_hi(pw.x); v0[2] += bf_lo(pw.y); v0[3] += bf_hi(pw.y);
                        v1[0] += bf_lo(pw.z); v1[1] += bf_hi(pw.z); v1[2] += bf_lo(pw.w); v1[3] += bf_hi(pw.w);
                    }
                    u32x4 w; w.x = cvt_pk_bf16(v0[0], v0[1]); w.y = cvt_pk_bf16(v0[2], v0[3]); w.z = cvt_pk_bf16(v1[0], v1[1]); w.w = cvt_pk_bf16(v1[2], v1[3]);
                    *(u32x4*)mp = w;
                }
            }
    }
    __device__ __forceinline__ void small(const f32x4 (&acc)[2][2][2], int row, int c0, int fr, int fq) const {
#pragma unroll
        for (int j = 0; j < 2; ++j) {
            const int c = c0 + 32 * j + 8 * fq;
            const u32x4 gc = *(const u32x4*)(Z + (size_t)row * INC + ZC_GC + c), ga = *(const u32x4*)(Z + (size_t)row * INC + ZC_GA + c);
            const f32x4 a0 = acc[0][j][0], a1 = acc[0][j][1], b0 = acc[1][j][0], b1 = acc[1][j][1];
            float m[8];
            m[0] = a0[0] * bf_lo(gc.x) + b0[0] * bf_lo(ga.x); m[1] = a0[1] * bf_hi(gc.x) + b0[1] * bf_hi(ga.x);
            m[2] = a0[2] * bf_lo(gc.y) + b0[2] * bf_lo(ga.y); m[3] = a0[3] * bf_hi(gc.y) + b0[3] * bf_hi(ga.y);
            m[4] = a1[0] * bf_lo(gc.z) + b1[0] * bf_lo(ga.z); m[5] = a1[1] * bf_hi(gc.z) + b1[1] * bf_hi(ga.z);
            m[6] = a1[2] * bf_lo(gc.w) + b1[2] * bf_lo(ga.w); m[7] = a1[3] * bf_hi(gc.w) + b1[3] * bf_hi(ga.w);
            u32x4 w; w.x = cvt_pk_bf16(m[0], m[1]); w.y = cvt_pk_bf16(m[2], m[3]); w.z = cvt_pk_bf16(m[4], m[5]); w.w = cvt_pk_bf16(m[6], m[7]);
            *(u32x4*)(Z + (size_t)row * INC + ZC_MB + c) = w;
        }
    }
};

template <int NSET, int NSTEP  , class Epi>
__device__ __forceinline__ void small_gemm(LAS unsigned char* lds, const bf16_t* A0, const bf16_t* A1, int lda, const bf16_t* W0, const bf16_t* W1, int ldb, int ncg, const Epi& E, int bx, int G, int wave, int lane) {
    const int fr = lane & 15, fq = lane >> 4;
    LAS f32x4* part = (LAS f32x4*)lds;
#pragma unroll 1
    for (int u = bx; u < 8 * ncg; u += G) {
        const int rb = u & 7, cg = u >> 3;
        const int row = MP + 16 * rb + fr;
        f32x4 acc[NSET][2][2];
#pragma unroll
        for (int st = 0; st < NSET; ++st) {
            const bf16_t* Ap = (st ? A1 : A0) + (size_t)row * lda + wave * (NSTEP * 32) + 8 * fq;
            const bf16_t* Wp = (st ? W1 : W0) + (size_t)(64 * cg + 8 * (fr >> 2) + (fr & 3)) * ldb + wave * (NSTEP * 32) + 8 * fq;
#pragma unroll
            for (int j = 0; j < 2; ++j)
#pragma unroll
                for (int n = 0; n < 2; ++n) acc[st][j][n] = (f32x4){0.f, 0.f, 0.f, 0.f};
#pragma unroll 4
            for (int k = 0; k < NSTEP; ++k) {
                const bf16x8 av = *(const bf16x8*)(Ap + 32 * k);
#pragma unroll
                for (int j = 0; j < 2; ++j)
#pragma unroll
                    for (int n = 0; n < 2; ++n) {
                        const bf16x8 bv = *(const bf16x8*)(Wp + (size_t)(32 * j + 4 * n) * ldb + 32 * k);
                        acc[st][j][n] = __builtin_amdgcn_mfma_f32_16x16x32_bf16(bv, av, acc[st][j][n], 0, 0, 0);
                    }
            }
        }
#pragma unroll
        for (int st = 0; st < NSET; ++st)
#pragma unroll
            for (int j = 0; j < 2; ++j)
#pragma unroll
                for (int n = 0; n < 2; ++n) part[((wave * NSET + st) * 4 + j * 2 + n) * 64 + lane] = acc[st][j][n];
        __syncthreads();
        if (wave == 0) {
#pragma unroll
            for (int w = 1; w < 8; ++w)
#pragma unroll
                for (int st = 0; st < NSET; ++st)
#pragma unroll
                    for (int j = 0; j < 2; ++j)
#pragma unroll
                        for (int n = 0; n < 2; ++n) acc[st][j][n] += part[((w * NSET + st) * 4 + j * 2 + n) * 64 + lane];
            E.small(acc, row, 64 * cg, fr, fq);
        }
        __syncthreads();
    }
}

struct TileD { const bf16_t* K; const bf16_t* V; int pitch; int nkeys; int delta0; };

__device__ __forceinline__ void attn_dma_v(const TileD& td, LAS unsigned char* vb, int lane) {
#pragma unroll
    for (int i = 0; i < 8; ++i) {
        const int row = 8 * i + (lane >> 3), chs = lane & 7, ch = chs ^ (((row >> 1) & 3) << 1);
        __builtin_amdgcn_global_load_lds((const unsigned*)(td.V + (size_t)row * td.pitch + ch * 8), (LAS unsigned*)(vb + i * 1024), 16, 0, 0);
    }
}
template <int NQB, class TF>
__device__ __forceinline__ void attn_wave(const bf16_t* Qp, bf16_t* Op, int qpitch, int opitch, int nt, const TF& tilef, LAS unsigned char* vbuf, const LAS float* rb, int lane) {
    const int fr = lane & 15, fq = lane >> 4;
    bf16x8 qf[NQB][2];
#pragma unroll
    for (int qb = 0; qb < NQB; ++qb)
#pragma unroll
        for (int dh = 0; dh < 2; ++dh) qf[qb][dh] = *(const bf16x8*)(Qp + (size_t)(16 * qb + fr) * qpitch + dh * 32 + 8 * fq);
    f32x4 O[NQB][4]; float mrow[NQB], lrow[NQB];
#pragma unroll
    for (int qb = 0; qb < NQB; ++qb) { mrow[qb] = -1e30f; lrow[qb] = 0.f;
#pragma unroll
        for (int db = 0; db < 4; ++db) O[qb][db] = (f32x4){0.f, 0.f, 0.f, 0.f}; }
    const int qp = fr >> 2, pp = fr & 3, rowl = 4 * fq + qp, sw = ((rowl >> 1) & 3) << 1;
    const int vrow = rowl * 128 + (pp & 1) * 8, vch = (pp >> 1) ^ sw;
    bf16x8 kf[2][2];
    { const TileD td = tilef(0); attn_dma_v(td, vbuf, lane);
#pragma unroll
      for (int kb = 0; kb < 2; ++kb)
#pragma unroll
          for (int dh = 0; dh < 2; ++dh) kf[kb][dh] = *(const bf16x8*)(td.K + (size_t)(16 * kb + fr) * td.pitch + dh * 32 + 8 * fq); }
    const int nht = 2 * nt;
#pragma unroll 1
    for (int ht = 0; ht < nht; ++ht) {
        const int t = ht >> 1, half = ht & 1;
        asm volatile("s_waitcnt vmcnt(0)" ::: "memory");
        const TileD td = tilef(t);
        if (half == 0 && t + 1 < nt) { const TileD tn = tilef(t + 1); attn_dma_v(tn, vbuf + ((t + 1) & 1) * 8192, lane); }
        f32x4 S[2][NQB];
#pragma unroll
        for (int kb = 0; kb < 2; ++kb)
#pragma unroll
            for (int qb = 0; qb < NQB; ++qb) {
                f32x4 s = __builtin_amdgcn_mfma_f32_16x16x32_bf16(kf[kb][0], qf[qb][0], (f32x4){0.f, 0.f, 0.f, 0.f}, 0, 0, 0);
                S[kb][qb] = __builtin_amdgcn_mfma_f32_16x16x32_bf16(kf[kb][1], qf[qb][1], s, 0, 0, 0);
            }
        if (ht + 1 < nht) {
            const TileD tk = tilef((ht + 1) >> 1); const int r0 = 32 * ((ht + 1) & 1);
#pragma unroll
            for (int kb = 0; kb < 2; ++kb)
#pragma unroll
                for (int dh = 0; dh < 2; ++dh) kf[kb][dh] = *(const bf16x8*)(tk.K + (size_t)(r0 + 16 * kb + fr) * tk.pitch + dh * 32 + 8 * fq);
        }
        const int delta0 = td.delta0 - 32 * half, nkeys = td.nkeys - 32 * half;
        if (delta0 >= 160) {
            const float bc = rb[256];
#pragma unroll
            for (int kb = 0; kb < 2; ++kb)
#pragma unroll
                for (int qb = 0; qb < NQB; ++qb) S[kb][qb] += bc;
        } else {
#pragma unroll
            for (int kb = 0; kb < 2; ++kb)
#pragma unroll
                for (int qb = 0; qb < NQB; ++qb)
#pragma unroll
                    for (int i = 0; i < 4; ++i) {
                        int d = delta0 + (16 * qb + fr) - (16 * kb + 4 * fq + i);
                        d = d < -128 ? -128 : (d > 128 ? 128 : d);
                        S[kb][qb][i] += rb[d + 128];
                    }
        }
        if (nkeys < 32) {
#pragma unroll
            for (int kb = 0; kb < 2; ++kb)
#pragma unroll
                for (int qb = 0; qb < NQB; ++qb)
#pragma unroll
                    for (int i = 0; i < 4; ++i) if (16 * kb + 4 * fq + i >= nkeys) S[kb][qb][i] = -INFINITY;
        }
        bf16x8 pf[NQB];
#pragma unroll
        for (int qb = 0; qb < NQB; ++qb) {
            float mx = fmaxf(fmaxf(fmaxf(S[0][qb][0], S[0][qb][1]), fmaxf(S[0][qb][2], S[0][qb][3])), fmaxf(fmaxf(S[1][qb][0], S[1][qb][1]), fmaxf(S[1][qb][2], S[1][qb][3])));
            mx = fmaxf(mx, __shfl_xor(mx, 16)); mx = fmaxf(mx, __shfl_xor(mx, 32));
            const float mn = fmaxf(mrow[qb], mx), alpha = __builtin_amdgcn_exp2f(mrow[qb] - mn);
            mrow[qb] = mn; float ps = 0.f; float p[2][4];
#pragma unroll
            for (int kb = 0; kb < 2; ++kb)
#pragma unroll
                for (int i = 0; i < 4; ++i) { p[kb][i] = __builtin_amdgcn_exp2f(S[kb][qb][i] - mn); ps += p[kb][i]; }
            lrow[qb] = lrow[qb] * alpha + ps;
#pragma unroll
            for (int db = 0; db < 4; ++db) O[qb][db] *= alpha;
            u32x4 w; w.x = cvt_pk_bf16(p[0][0], p[0][1]); w.y = cvt_pk_bf16(p[0][2], p[0][3]); w.z = cvt_pk_bf16(p[1][0], p[1][1]); w.w = cvt_pk_bf16(p[1][2], p[1][3]);
            pf[qb] = __builtin_bit_cast(bf16x8, w);
        }
        const LAS unsigned char* vb = vbuf + (t & 1) * 8192 + half * 4096 + vrow;
#pragma unroll
        for (int db = 0; db < 4; ++db) {
            const int off = ((2 * db) ^ vch) << 4;
            const s16x4 lo = __builtin_amdgcn_ds_read_tr16_b64_v4i16((LAS s16x4*)(vb + off));
            const s16x4 hi = __builtin_amdgcn_ds_read_tr16_b64_v4i16((LAS s16x4*)(vb + off + 2048));
            const bf16x8 vf = (bf16x8){lo[0], lo[1], lo[2], lo[3], hi[0], hi[1], hi[2], hi[3]};
#pragma unroll
            for (int qb = 0; qb < NQB; ++qb) O[qb][db] = __builtin_amdgcn_mfma_f32_16x16x32_bf16(vf, pf[qb], O[qb][db], 0, 0, 0);
        }
    }
    asm volatile("s_waitcnt lgkmcnt(0)" ::: "memory");
#pragma unroll
    for (int qb = 0; qb < NQB; ++qb) {
        float l = lrow[qb]; l += __shfl_xor(l, 16); l += __shfl_xor(l, 32);
        const float inv = 1.0f / l;
#pragma unroll
        for (int db = 0; db < 4; ++db) {
            const f32x4 o = O[qb][db] * inv; u32x2 w; w.x = cvt_pk_bf16(o[0], o[1]); w.y = cvt_pk_bf16(o[2], o[3]);
            *(u32x2*)(Op + (size_t)(16 * qb + fr) * opitch + 16 * db + 4 * fq) = w;
        }
    }
}


#define XB_TMO      128
#define XB_XCNT(j)  (256  + 64 * (j))
#define XB_XSUB(j)  (1280 + 64 * (j))
#define XB_XGEN(j)  (2304 + 64 * (j))
#define XB_TOP      3328
#define XB_TOPGEN   3392
#define XCD_BAR_WORDS 3456
#define XB_SPIN_CAP (1u << 20)
__device__ __forceinline__ unsigned xb_ld(unsigned* p)              { return __hip_atomic_load(p, __ATOMIC_RELAXED, __HIP_MEMORY_SCOPE_AGENT); }
__device__ __forceinline__ unsigned xb_add(unsigned* p, unsigned v) { return __hip_atomic_fetch_add(p, v, __ATOMIC_RELAXED, __HIP_MEMORY_SCOPE_AGENT); }
__device__ __forceinline__ unsigned xb_xcc_id() { return (unsigned)__builtin_amdgcn_s_getreg((3 << 11) | 20) & 0xFu; }
#define XB_SPIN(cond, bar) do { unsigned _sp = 0; while (cond) { __builtin_amdgcn_s_sleep(1); \
    if ((++_sp & 255u) == 0u) { if (xb_ld(&(bar)[XB_TMO])) break; if (_sp > XB_SPIN_CAP) { atomicAdd(&(bar)[XB_TMO], 1u); break; } } } } while (0)
struct XcdBarrier { unsigned* bar; unsigned x; volatile LAS unsigned* st; };
__device__ __forceinline__ XcdBarrier xcd_barrier_post(unsigned* bar, volatile LAS unsigned* st) {
    XcdBarrier b; b.bar = bar; b.x = xb_xcc_id(); b.st = st;
    if (threadIdx.x == 0) (void)xb_add(&bar[XB_XCNT(b.x)], 1u);
    return b;
}
__device__ __forceinline__ void xcd_barrier_complete(unsigned* bar, unsigned x, unsigned& nloc, unsigned& nx) {
    const unsigned G = gridDim.x * gridDim.y * gridDim.z;
    unsigned sum, cnt, mine, sp = 0u;
    for (;;) {
        sum = 0u; cnt = 0u; mine = 0u;
#pragma unroll
        for (unsigned j = 0; j < 16; ++j) { const unsigned c = xb_ld(&bar[XB_XCNT(j)]); sum += c; cnt += (c > 0u) ? 1u : 0u; mine = (j == x) ? c : mine; }
        if (sum == G) break;
        __builtin_amdgcn_s_sleep(1);
        if ((++sp & 255u) == 0u) { if (xb_ld(&bar[XB_TMO])) break; if (sp > XB_SPIN_CAP) { atomicAdd(&bar[XB_TMO], 1u); break; } }
    }
    nloc = mine > 0u ? mine : 1u; nx = cnt > 0u ? cnt : 1u;
}
__device__ __forceinline__ void xcd_barrier(const XcdBarrier& b) {
    asm volatile("s_waitcnt vmcnt(0)" ::: "memory");
    __syncthreads();
    if (threadIdx.x == 0) {
        unsigned* bar = b.bar;
        __builtin_amdgcn_s_waitcnt(0);
        unsigned nloc = b.st[0], nx = b.st[1];
        if (nloc == 0u) { xcd_barrier_complete(bar, b.x, nloc, nx); b.st[0] = nloc; b.st[1] = nx; }
        const unsigned old = xb_add(&bar[XB_XSUB(b.x)], 1u);
        const unsigned gen = old / nloc;
        if (old + 1u == (gen + 1u) * nloc) {
            __builtin_amdgcn_fence(__ATOMIC_RELEASE, "agent");
            asm volatile("s_waitcnt vmcnt(0)" ::: "memory");
            const unsigned og = xb_add(&bar[XB_TOP], 1u);
            const unsigned tg = og / nx;
            if (og + 1u == (tg + 1u) * nx) xb_add(&bar[XB_TOPGEN], 1u);
            else XB_SPIN(xb_ld(&bar[XB_TOPGEN]) == tg, bar);
            __builtin_amdgcn_fence(__ATOMIC_ACQUIRE, "agent");
            xb_add(&bar[XB_XGEN(b.x)], 1u);
            asm volatile("s_waitcnt vmcnt(0)" ::: "memory");
        } else {
            XB_SPIN(xb_ld(&bar[XB_XGEN(b.x)]) == gen, bar);
            __builtin_amdgcn_fence(__ATOMIC_ACQUIRE, "agent");
            asm volatile("s_waitcnt vmcnt(0)" ::: "memory");
        }
    }
    __syncthreads();
}

struct Args {
    const float* x_prompt; const float* x_sample; const float* cache_k; const float* cache_v; const float* state_conv;
    const float* norm_ffn1; const float* w_ffn1_gu; const float* w_ffn1_down; const float* norm_mix; const float* w_in; const float* b_gate; const float* w_conv;
    const float* rel_bias; const float* w_conv_out; const float* w_attn_out; const float* w_o; const float* norm_ffn2; const float* w_ffn2_gu; const float* w_ffn2_down; const float* norm_final;
    float* out; unsigned char* ws; int ph_lo, ph_hi;
};

__device__ __forceinline__ void transpose_item(const float* W, int N, const float* gain, bf16_t* WT, int dpitch, int dkoff, int mode, int kb, int nb, int scol0, LAS float* scr, int lane) {
    const int k0 = 64 * kb, n0 = 32 * nb, c = lane & 31;
    const int scol = (mode == 1) ? ((c < 16) ? 16 * nb + c : DFF + 16 * nb + (c - 16)) : scol0 + c;
    float wv[32];
#pragma unroll
    for (int i = 0; i < 32; ++i) wv[i] = W[(size_t)(k0 + 2 * i + (lane >> 5)) * N + scol];
    if (gain) {
#pragma unroll
        for (int i = 0; i < 32; ++i) wv[i] *= gain[k0 + 2 * i + (lane >> 5)];
    }
#pragma unroll
    for (int i = 0; i < 32; ++i) scr[(2 * i + (lane >> 5)) * 33 + c] = wv[i];
    asm volatile("s_waitcnt lgkmcnt(0)" ::: "memory");
    const int c8 = lane & 7;
#pragma unroll
    for (int j = 0; j < 4; ++j) { const int n = (lane >> 3) + 8 * j; const LAS float* s = scr + (8 * c8) * 33 + n;
        u32x4 o; o.x = pk2(s[0 * 33], s[1 * 33]); o.y = pk2(s[2 * 33], s[3 * 33]); o.z = pk2(s[4 * 33], s[5 * 33]); o.w = pk2(s[6 * 33], s[7 * 33]);
        int drow;
        if (mode == 1) { const int jj = n & 15, isu = n >> 4; drow = n0 + 8 * (jj >> 2) + 4 * isu + (jj & 3); } else drow = n0 + n;
        *(u32x4*)(WT + (size_t)drow * dpitch + dkoff + k0 + 8 * c8) = o; }
    asm volatile("s_waitcnt lgkmcnt(0)" ::: "memory");
}

__device__ __forceinline__ float wave_sum(float v) {
#pragma unroll
    for (int o = 1; o < 64; o <<= 1) v += __shfl_xor(v, o);
    return v;
}

__global__ void __launch_bounds__(NWAVES * 64, 2) mega_fwd(Args a) {
    extern __shared__ __attribute__((aligned(16))) unsigned char lds_raw[];
    LAS unsigned char* lds = (LAS unsigned char*)lds_raw;
    cg::grid_group grid = cg::this_grid();
    typedef const __attribute__((address_space(4))) Args* ArgP;
    ArgP ap = (ArgP)__builtin_amdgcn_kernarg_segment_ptr();
    const int G = gridDim.x, bx = blockIdx.x;
    const int wave0 = __builtin_amdgcn_readfirstlane((int)threadIdx.x >> 6);
    unsigned* barw = (unsigned*)(ap->ws + WS_BAR);
    if (bx == 0) for (int i = threadIdx.x; i < XCD_BAR_WORDS; i += NWAVES * 64) barw[i] = 0u;
    if (threadIdx.x < 16) ((LAS unsigned*)(lds + BARST_OFF))[threadIdx.x] = 0u;
    XcdBarrier xbar; xbar.bar = barw; xbar.x = 0; xbar.st = (volatile LAS unsigned*)(lds + BARST_OFF);
    bool xposted = false;
    const int lo = ap->ph_lo, hi = ap->ph_hi;
#define PHASE_VARS \
    asm volatile("" : "+s"(ap)); \
    int lane_ = (int)__builtin_amdgcn_mbcnt_hi(~0u, __builtin_amdgcn_mbcnt_lo(~0u, 0u)); asm volatile("" : "+v"(lane_)); \
    int wave_ = wave0; asm volatile("" : "+s"(wave_)); \
    const int lane = lane_, wave = wave_, tid = wave * 64 + lane; \
    const int vcu = (G % 8 == 0) ? (bx % 8) * (G / 8) + bx / 8 : bx; \
    const int gw = vcu * NWAVES + wave, NGW = G * NWAVES; \
    const int gt = gw * 64 + lane, NGT = NGW * 64; \
    unsigned char* ws = ap->ws; \
    bf16_t* WT = (bf16_t*)(ws + ((l & 1) ? WS_WT2 : WS_WT)); bf16_t* WTN = (bf16_t*)(ws + ((l & 1) ? WS_WT : WS_WT2)); bf16_t* XB = (bf16_t*)(ws + WS_XB); float* SSQ = (float*)(ws + WS_SSQ); \
    bf16_t* CK = (bf16_t*)(ws + ((l & 1) ? WS_CK2 : WS_CK)); bf16_t* CV = (bf16_t*)(ws + ((l & 1) ? WS_CV2 : WS_CV)); \
    bf16_t* CKN = (bf16_t*)(ws + ((l & 1) ? WS_CK : WS_CK2)); bf16_t* CVN = (bf16_t*)(ws + ((l & 1) ? WS_CV : WS_CV2)); bf16_t* Z = (bf16_t*)(ws + WS_Z); bf16_t* HB = Z; \
    float* X = ap->out; \
    (void)WTN; (void)CKN; (void)CVN; (void)tid; (void)lane; (void)wave; (void)gw; (void)NGW; (void)gt; (void)NGT; (void)WT; (void)XB; (void)SSQ; (void)CK; (void)CV; (void)Z; (void)HB; (void)X;
#define IN(k) (lo <= (k) && (k) < hi)
#define GSYNC() do { if (!xposted) { grid.sync(); xbar = xcd_barrier_post(barw, (volatile LAS unsigned*)(lds + BARST_OFF)); xposted = true; } else xcd_barrier(xbar); } while (0)
#define SEAM(k) do { if (IN(k) && IN((k) + 1)) { GSYNC(); if (PROBE_REP == 9) GSYNC(); } } while (0)
#define REPS(k) for (int rep = (PROBE_REP == (k)) ? 0 : 1; rep < 2; ++rep)
#define REPSYNC() do { if (rep == 0) GSYNC(); } while (0)

#define CONVERT_LAYER(LC, WTD, CKD, CVD) do { \
            LAS float* scr = (LAS float*)(lds + wave * 16384); \
            constexpr int I_GU = 16 * 176, I_D = 44 * 32, I_IN = 16 * 160, I_C = 8 * 32, I_O = 16 * 32; \
            constexpr int NITEMS = 2 * I_GU + 2 * I_D + I_IN + 2 * I_C + I_O; \
            for (int it = gw; it < NITEMS; it += NGW) { \
                int r = it; \
                if (r < I_GU) { transpose_item(ap->w_ffn1_gu + (size_t)(LC) * DM * 2 * DFF, 2 * DFF, ap->norm_ffn1 + (LC) * DM, (WTD) + W_GU1, DM, 0, 1, r / 176, r % 176, 0, scr, lane); continue; } r -= I_GU; \
                if (r < I_GU) { transpose_item(ap->w_ffn2_gu + (size_t)(LC) * DM * 2 * DFF, 2 * DFF, ap->norm_ffn2 + (LC) * DM, (WTD) + W_GU2, DM, 0, 1, r / 176, r % 176, 0, scr, lane); continue; } r -= I_GU; \
                if (r < I_D) { transpose_item(ap->w_ffn1_down + (size_t)(LC) * DFF * DM, DM, nullptr, (WTD) + W_D1, DFF, 0, 0, r / 32, r % 32, 32 * (r % 32), scr, lane); continue; } r -= I_D; \
                if (r < I_D) { transpose_item(ap->w_ffn2_down + (size_t)(LC) * DFF * DM, DM, nullptr, (WTD) + W_D2, DFF, 0, 0, r / 32, r % 32, 32 * (r % 32), scr, lane); continue; } r -= I_D; \
                if (r < I_IN) { const int nb = r % 160, kb = r / 160, blk = nb >> 4; \
                    const int ob = (blk == 1) ? 3 : (blk == 2) ? 1 : (blk == 3) ? 2 : blk; \
                    transpose_item(ap->w_in + (size_t)(LC) * DM * INC, INC, ap->norm_mix + (LC) * DM, (WTD) + W_IN, DM, 0, 0, kb, nb, ob * 512 + 32 * (nb & 15), scr, lane); continue; } r -= I_IN; \
                if (r < I_C) { transpose_item(ap->w_conv_out + (size_t)(LC) * 512 * DM, DM, nullptr, (WTD) + W_CAT, DM, 0, 0, r / 32, r % 32, 32 * (r % 32), scr, lane); continue; } r -= I_C; \
                if (r < I_C) { transpose_item(ap->w_attn_out + (size_t)(LC) * 512 * DM, DM, nullptr, (WTD) + W_CAT, DM, 512, 0, r / 32, r % 32, 32 * (r % 32), scr, lane); continue; } r -= I_C; \
                transpose_item(ap->w_o + (size_t)(LC) * DM * DM, DM, nullptr, (WTD) + W_O, DM, 0, 0, r / 32, r % 32, 32 * (r % 32), scr, lane); \
            } \
 \
            for (int i = gt; i < 2 * (NBATCH * 512 * 512 / 8); i += NGT) { \
                const int which = i / (NBATCH * 512 * 512 / 8), e = (i % (NBATCH * 512 * 512 / 8)) * 8; \
                const float* src = (which ? ap->cache_v : ap->cache_k) + (size_t)(LC) * NBATCH * 512 * 512 + e; \
                const f32x4 v0 = *(const f32x4*)src, v1 = *(const f32x4*)(src + 4); \
                u32x4 w; w.x = pk2(v0[0], v0[1]); w.y = pk2(v0[2], v0[3]); w.z = pk2(v1[0], v1[1]); w.w = pk2(v1[2], v1[3]); \
                *(u32x4*)((which ? (CVD) : (CKD)) + e) = w; \
            } \
} while (0)

#pragma unroll 1
    for (int l = 0; l < DEPTH; ++l) {
        const int pb = 9 * l;
        if (l == 0 && IN(pb + 0)) REPS(0) { PHASE_VARS
            CONVERT_LAYER(0, WT, CK, CV);
            if (l == 0) {
                for (int m = gw; m < MPAD; m += NGW) {
                    bf16_t* xb = XB + (size_t)m * DM; float* sq = SSQ + (size_t)m * 16;
                    if (m < MR) {
                        const float* src = (m < MP) ? ap->x_prompt + (size_t)m * DM : ap->x_sample + (size_t)(m - MP) * DM;
                        float* dst = X + (size_t)m * DM; float s = 0.f;
#pragma unroll
                        for (int j = 0; j < 4; ++j) { const f32x4 v = *(const f32x4*)(src + 256 * j + 4 * lane); *(f32x4*)(dst + 256 * j + 4 * lane) = v;
                            u32x2 w; w.x = pk2(v[0], v[1]); w.y = pk2(v[2], v[3]); *(u32x2*)(xb + 256 * j + 4 * lane) = w; s += (v[0] * v[0] + v[1] * v[1]) + (v[2] * v[2] + v[3] * v[3]); }
                        s = wave_sum(s);
                        if (lane < 16) sq[lane] = (lane == 0) ? s : 0.f;
                    } else {
#pragma unroll
                        for (int j = 0; j < 4; ++j) *(u32x2*)(xb + 256 * j + 4 * lane) = (u32x2){0u, 0u};
                        if (lane < 16) sq[lane] = 0.f;
                    }
                }
            }
        REPSYNC(); }
        if (l == 0) SEAM(pb + 0);
        if (IN(pb + 1)) REPS(1) { PHASE_VARS
            pg8::Gemm g{XB, WT + W_GU1, DM, DM, DM, 0, 0}; pg8::StaticOrder S; S.init(NTM, 2 * DFF / 256, G, bx, 1);
            EpiUp E{HB, SSQ};
            small_gemm<1, 4, EpiUp>(lds, XB, XB, DM, WT + W_GU1, WT + W_GU1, DM, 2 * DFF / 64, E, bx, G, wave, lane);
            pg8::gemm_phase<EpiUp>(lds, g, S, E, tid);
        REPSYNC(); }
        SEAM(pb + 1);
        if (IN(pb + 2)) REPS(2) { PHASE_VARS
            pg8::Gemm g{HB, WT + W_D1, DFF, DFF, DFF, 0, 0}; pg8::StaticOrder S; S.init(NTM, DM / 256, G, bx, 1);
            EpiRes E{X, XB, SSQ, rep ? 0.5f : 0.0f};
            small_gemm<1, 11, EpiRes>(lds, HB, HB, DFF, WT + W_D1, WT + W_D1, DFF, DM / 64, E, bx, G, wave, lane);
            pg8::gemm_phase<EpiRes>(lds, g, S, E, tid);
        REPSYNC(); }
        SEAM(pb + 2);
        if (IN(pb + 3)) REPS(3) { PHASE_VARS
            pg8::Gemm g{XB, WT + W_IN, DM, DM, DM, 0, 0}; pg8::StaticOrder S; S.init(NTM, INC / 256, G, bx, 1);
            EpiIn E{Z, SSQ, ap->b_gate + (size_t)l * 2 * DM, ap->out + O_KP + (size_t)l * NBATCH * 512 * 512, ap->out + O_VP + (size_t)l * NBATCH * 512 * 512,
                    ap->out + O_KS + (size_t)l * MS * 512, ap->out + O_VS + (size_t)l * MS * 512};
            small_gemm<1, 4, EpiIn>(lds, XB, XB, DM, WT + W_IN, WT + W_IN, DM, INC / 64, E, bx, G, wave, lane);
            pg8::gemm_phase<EpiIn>(lds, g, S, E, tid);
        REPSYNC(); }
        SEAM(pb + 3);
        if (IN(pb + 4)) REPS(4) { PHASE_VARS
            LAS float* rbl = (LAS float*)(lds + RB_OFF);
            for (int i = tid; i < NH * NREL; i += NWAVES * 64) { const int h = i / NREL, j = i - h * NREL; rbl[h * 264 + j] = ap->rel_bias[(size_t)l * NH * NREL + i] * LOG2E; }
            __syncthreads();
            LAS unsigned char* vbuf = lds + wave * 16384;
#pragma unroll 1
            for (int u = gw; u < 4096; u += NGW) {
                const int c = u & 63, h = (u >> 6) & 7, b = u >> 9;
                const int jlo = (c > 8) ? c - 8 : 0;
                const bf16_t* base = Z + (size_t)(b * SEQ) * INC + h * 64;
                auto tf = [&](int j) { TileD td; const size_t ro = (size_t)(64 * (jlo + j)) * INC; td.K = base + ro + ZC_K; td.V = base + ro + ZC_V; td.pitch = INC; td.nkeys = 64; td.delta0 = 64 * (c - jlo - j); return td; };
                bf16_t* qp = Z + (size_t)(b * SEQ + 64 * c) * INC + ZC_Q + h * 64;
                bf16_t* op = rep ? qp : XB + (size_t)(b * SEQ + 64 * c) * DM + h * 64;
                attn_wave<4>(qp, op, INC, rep ? INC : DM, c - jlo + 1, tf, vbuf, rbl + h * 264, lane);
            }
            { int l2 = lane; asm volatile("" : "+v"(l2)); asm volatile("" : "+s"(Z), "+s"(CK), "+s"(CV));
#pragma unroll 1
            for (int us = ((gw & 31) == 31) ? (gw >> 5) : 64; us < 64; us += 64) {
                const int h = us & 7, b = us >> 3;
                const bf16_t* zrow = Z + (size_t)(MP + 16 * b) * INC + h * 64;
                auto tf = [&](int j) { TileD td;
                    if (j < 8) { const size_t ro = (size_t)(b * 512 + 64 * j) * 512 + h * 64; td.K = CK + ro; td.V = CV + ro; td.pitch = 512; td.nkeys = 64; td.delta0 = 512 - 64 * j; }
                    else { td.K = zrow + ZC_K; td.V = zrow + ZC_V; td.pitch = INC; td.nkeys = 16; td.delta0 = 0; }
                    return td; };
                bf16_t* qp = Z + (size_t)(MP + 16 * b) * INC + ZC_Q + h * 64;
                bf16_t* op = rep ? qp : XB + (size_t)(16 * b) * DM + h * 64;
                attn_wave<1>(qp, op, INC, rep ? INC : DM, 9, tf, vbuf, rbl + h * 264, l2);
            } }
            for (int cu = (NGW - 1 - gw); cu < MR / 16; cu += NGW) {
                const int row0 = cu * 16, ch = 8 * lane;
                const bool samp = (row0 >= MP);
                const int bb = samp ? (row0 - MP) / 16 : (row0 >> 12), t0 = samp ? 0 : (row0 & 4095);
                float w0[8], w1[8], w2[8], um2[8], um1[8];
                { const float* wc = ap->w_conv + (size_t)l * 3 * 512 + ch;
#pragma unroll
                  for (int i = 0; i < 8; ++i) { w0[i] = wc[i]; w1[i] = wc[512 + i]; w2[i] = wc[1024 + i]; } }
                if (samp) { const float* sc = ap->state_conv + ((size_t)(l * NBATCH + bb) * 2) * 512 + ch;
#pragma unroll
                    for (int i = 0; i < 8; ++i) { um2[i] = sc[i]; um1[i] = sc[512 + i]; }
                } else if (t0 == 0) {
#pragma unroll
                    for (int i = 0; i < 8; ++i) { um2[i] = 0.f; um1[i] = 0.f; }
                } else {
                    const bf16_t* z2 = Z + (size_t)(row0 - 2) * INC + ch; const bf16_t* z1 = Z + (size_t)(row0 - 1) * INC + ch;
                    const u32x4 c2 = *(const u32x4*)(z2 + ZC_CC), v2 = *(const u32x4*)(z2 + ZC_CV), c1 = *(const u32x4*)(z1 + ZC_CC), v1 = *(const u32x4*)(z1 + ZC_CV);
#pragma unroll
                    for (int i = 0; i < 4; ++i) { um2[2 * i] = bf_lo(c2[i]) * bf_lo(v2[i]); um2[2 * i + 1] = bf_hi(c2[i]) * bf_hi(v2[i]); um1[2 * i] = bf_lo(c1[i]) * bf_lo(v1[i]); um1[2 * i + 1] = bf_hi(c1[i]) * bf_hi(v1[i]); }
                }
#pragma unroll 8
                for (int r = 0; r < 16; ++r) {
                    bf16_t* zr = Z + (size_t)(row0 + r) * INC + ch;
                    const u32x4 cbw = *(const u32x4*)(zr + ZC_CB), ccw = *(const u32x4*)(zr + ZC_CC), cvw = *(const u32x4*)(zr + ZC_CV);
                    float y[8];
#pragma unroll
                    for (int i = 0; i < 4; ++i) {
                        const float u0 = bf_lo(ccw[i]) * bf_lo(cvw[i]), u1 = bf_hi(ccw[i]) * bf_hi(cvw[i]);
                        y[2 * i] = bf_lo(cbw[i]) * (w0[2 * i] * um2[2 * i] + w1[2 * i] * um1[2 * i] + w2[2 * i] * u0);
                        y[2 * i + 1] = bf_hi(cbw[i]) * (w0[2 * i + 1] * um2[2 * i + 1] + w1[2 * i + 1] * um1[2 * i + 1] + w2[2 * i + 1] * u1);
                        um2[2 * i] = um1[2 * i]; um1[2 * i] = u0; um2[2 * i + 1] = um1[2 * i + 1]; um1[2 * i + 1] = u1;
                    }
                    u32x4 w; w.x = cvt_pk_bf16(y[0], y[1]); w.y = cvt_pk_bf16(y[2], y[3]); w.z = cvt_pk_bf16(y[4], y[5]); w.w = cvt_pk_bf16(y[6], y[7]);
                    *(u32x4*)(rep ? zr + ZC_CB : XB + (size_t)(row0 + r) * DM + 512 + ch) = w;
                }
                if (samp || t0 == SEQ - 16) {
                    float* dst = ap->out + (samp ? O_CS : O_CP) + ((size_t)(l * NBATCH + bb) * 2) * 512 + ch;
                    *(f32x4*)dst = (f32x4){um2[0], um2[1], um2[2], um2[3]}; *(f32x4*)(dst + 4) = (f32x4){um2[4], um2[5], um2[6], um2[7]};
                    *(f32x4*)(dst + 512) = (f32x4){um1[0], um1[1], um1[2], um1[3]}; *(f32x4*)(dst + 516) = (f32x4){um1[4], um1[5], um1[6], um1[7]};
                }
            }
            if (rep && l + 1 < DEPTH) { asm volatile("s_waitcnt vmcnt(0) lgkmcnt(0)" ::: "memory"); asm volatile("" : "+s"(ap)); CONVERT_LAYER(l + 1, WTN, CKN, CVN); }
            asm volatile("s_waitcnt vmcnt(0) lgkmcnt(0)" ::: "memory");
            __syncthreads();
        REPSYNC(); }
        SEAM(pb + 4);
        if (IN(pb + 5)) REPS(5) { PHASE_VARS
            pg8::Gemm g{Z, WT + W_CAT, INC, DM, 512, 512 * 2, 512 * 2}; pg8::StaticOrder S; S.init(NTM, DM / 256, G, bx, 2);
            EpiMix E{Z};
            small_gemm<2, 2, EpiMix>(lds, Z + ZC_CB, Z + ZC_Q, INC, WT + W_CAT, WT + W_CAT + 512, DM, DM / 64, E, bx, G, wave, lane);
            pg8::gemm_phase<EpiMix>(lds, g, S, E, tid);
        REPSYNC(); }
        SEAM(pb + 5);
        if (IN(pb + 6)) REPS(6) { PHASE_VARS
            pg8::Gemm g{Z + ZC_MB, WT + W_O, INC, DM, DM, 0, 0}; pg8::StaticOrder S; S.init(NTM, DM / 256, G, bx, 1);
            EpiRes E{X, XB, SSQ, rep ? 1.0f : 0.0f};
            small_gemm<1, 4, EpiRes>(lds, Z + ZC_MB, Z + ZC_MB, INC, WT + W_O, WT + W_O, DM, DM / 64, E, bx, G, wave, lane);
            pg8::gemm_phase<EpiRes>(lds, g, S, E, tid);
        REPSYNC(); }
        SEAM(pb + 6);
        if (IN(pb + 7)) REPS(7) { PHASE_VARS
            pg8::Gemm g{XB, WT + W_GU2, DM, DM, DM, 0, 0}; pg8::StaticOrder S; S.init(NTM, 2 * DFF / 256, G, bx, 1);
            EpiUp E{HB, SSQ};
            small_gemm<1, 4, EpiUp>(lds, XB, XB, DM, WT + W_GU2, WT + W_GU2, DM, 2 * DFF / 64, E, bx, G, wave, lane);
            pg8::gemm_phase<EpiUp>(lds, g, S, E, tid);
        REPSYNC(); }
        SEAM(pb + 7);
        if (IN(pb + 8)) REPS(8) { PHASE_VARS
            pg8::Gemm g{HB, WT + W_D2, DFF, DFF, DFF, 0, 0}; pg8::StaticOrder S; S.init(NTM, DM / 256, G, bx, 1);
            EpiRes E{X, XB, SSQ, rep ? 0.5f : 0.0f};
            small_gemm<1, 11, EpiRes>(lds, HB, HB, DFF, WT + W_D2, WT + W_D2, DFF, DM / 64, E, bx, G, wave, lane);
            pg8::gemm_phase<EpiRes>(lds, g, S, E, tid);
        REPSYNC(); }
        SEAM(pb + 8);
    }
    if (IN(36)) { const int l = 0; PHASE_VARS
        for (int m = gw; m < MR; m += NGW) {
            float* xr = X + (size_t)m * DM;
            const float sv = (lane < 16) ? SSQ[(size_t)m * 16 + lane] : 0.f;
            const float rs = __builtin_amdgcn_rsqf(wave_sum(sv) * (1.0f / 1024.0f) + EPS);
#pragma unroll
            for (int j = 0; j < 4; ++j) { const f32x4 v = *(const f32x4*)(xr + 256 * j + 4 * lane), gn = *(const f32x4*)(ap->norm_final + 256 * j + 4 * lane); *(f32x4*)(xr + 256 * j + 4 * lane) = v * rs * gn; }
        }
    }
#undef IN
#undef SEAM
}

extern "C" void kernel_launch(void* const* d_in, const int* in_sizes, int n_in, void* d_out, int out_size, void* d_ws, size_t ws_size, hipStream_t stream) {
    static int grid = 0;
    if (grid == 0) {
        if (n_in != 20 || (size_t)out_size != O_END || ws_size < WS_END) { fprintf(stderr, "kernel_launch: unexpected shapes: n_in %d out %d (want %zu) ws %zu (need %zu)\n", n_in, out_size, (size_t)O_END, ws_size, (size_t)WS_END); grid = -1; return; }
        int dev = 0, cus = 0, per_cu = 0;
        hipGetDevice(&dev); hipDeviceGetAttribute(&cus, hipDeviceAttributeMultiprocessorCount, dev);
        if (hipFuncSetAttribute((const void*)mega_fwd, hipFuncAttributeMaxDynamicSharedMemorySize, LDS_BYTES) != hipSuccess) { fprintf(stderr, "kernel_launch: hipFuncSetAttribute failed\n"); grid = -1; return; }
        if (hipOccupancyMaxActiveBlocksPerMultiprocessor(&per_cu, (const void*)mega_fwd, NWAVES * 64, LDS_BYTES) != hipSuccess || per_cu < 1) { fprintf(stderr, "kernel_launch: occupancy query says %d\n", per_cu); per_cu = 1; }
        (void)hipGetLastError();
        grid = cus;
    }
    if (grid < 0) return;
    Args a{};
    const float** ap = (const float**)&a;
    for (int i = 0; i < 20; ++i) ap[i] = (const float*)d_in[i];
    a.out = (float*)d_out; a.ws = (unsigned char*)d_ws; a.ph_lo = 0; a.ph_hi = 37;
    void* args[] = {&a};
    hipError_t e = hipLaunchCooperativeKernel((const void*)mega_fwd, dim3(grid), dim3(NWAVES * 64), args, LDS_BYTES, stream);
    if (e != hipSuccess) fprintf(stderr, "kernel_launch: cooperative launch failed: %s (grid %d)\n", hipGetErrorString(e), grid);
}
```

```cpp
#include <hip/hip_runtime.h>
#include <hip/hip_cooperative_groups.h>
#include <cstdio>
#include <cstdint>
namespace cg = cooperative_groups;
#ifndef PROBE_REP
#define PROBE_REP (-1)
#endif
#ifndef PROBE_EPI
#define PROBE_EPI 0
#endif

#define LAS __attribute__((address_space(3)))
typedef unsigned short bf16_t;
typedef short bf16x8 __attribute__((ext_vector_type(8)));
typedef short s16x4 __attribute__((ext_vector_type(4)));
typedef float f32x4 __attribute__((ext_vector_type(4)));
typedef unsigned u32x4 __attribute__((ext_vector_type(4)));
typedef unsigned u32x2 __attribute__((ext_vector_type(2)));

constexpr int DM = 1024, NBATCH = 8, SEQ = 4096, DEPTH = 4, DSEQ = 16;
constexpr int NH = 8, DFF = 2816, INC = 5120, NREL = 257;
constexpr int MP = NBATCH * SEQ;
constexpr int MS = NBATCH * DSEQ;
constexpr int MR = MP + MS;
constexpr int MPAD = 33024;
constexpr int NTM = MP / 256;
constexpr float EPS = 1e-6f;
constexpr float LOG2E = 1.4426950408889634f;
constexpr float QSCALE = 0.125f * LOG2E;
constexpr int ZC_CB = 0, ZC_Q = 512, ZC_CC = 1024, ZC_CV = 1536, ZC_K = 2048, ZC_V = 2560, ZC_GC = 3072, ZC_GA = 4096, ZC_MB = 1024;

constexpr size_t O_Y = 0;
constexpr size_t O_KP = (size_t)MR * DM;
constexpr size_t O_VP = O_KP + (size_t)DEPTH * NBATCH * 512 * 512;
constexpr size_t O_CP = O_VP + (size_t)DEPTH * NBATCH * 512 * 512;
constexpr size_t O_KS = O_CP + (size_t)DEPTH * NBATCH * 2 * 512;
constexpr size_t O_VS = O_KS + (size_t)DEPTH * NBATCH * DSEQ * 512;
constexpr size_t O_CS = O_VS + (size_t)DEPTH * NBATCH * DSEQ * 512;
constexpr size_t O_END = O_CS + (size_t)DEPTH * NBATCH * 2 * 512;

constexpr size_t W_GU1 = 0;
constexpr size_t W_D1 = W_GU1 + (size_t)2 * DFF * DM;
constexpr size_t W_IN = W_D1 + (size_t)DM * DFF;
constexpr size_t W_CAT = W_IN + (size_t)INC * DM;
constexpr size_t W_O = W_CAT + (size_t)DM * DM;
constexpr size_t W_GU2 = W_O + (size_t)DM * DM;
constexpr size_t W_D2 = W_GU2 + (size_t)2 * DFF * DM;
constexpr size_t W_TOTAL = W_D2 + (size_t)DM * DFF;

constexpr size_t WS_WT = 0;
constexpr size_t WS_XB = WS_WT + ((W_TOTAL * 2 + 4095) / 4096) * 4096;
constexpr size_t WS_SSQ = WS_XB + (size_t)MPAD * DM * 2;
constexpr size_t WS_CK = WS_SSQ + (size_t)MPAD * 16 * 4;
constexpr size_t WS_CV = WS_CK + (size_t)NBATCH * 512 * 512 * 2;
constexpr size_t WS_Z = WS_CV + (size_t)NBATCH * 512 * 512 * 2;
constexpr size_t WS_WT2 = WS_Z + (size_t)MPAD * INC * 2;
constexpr size_t WS_BAR = WS_WT2 + ((W_TOTAL * 2 + 4095) / 4096) * 4096;
constexpr size_t WS_CK2 = WS_BAR + 16384;
constexpr size_t WS_CV2 = WS_CK2 + (size_t)NBATCH * 512 * 512 * 2;
constexpr size_t WS_END = WS_CV2 + (size_t)NBATCH * 512 * 512 * 2;

constexpr int NWAVES = 8;
constexpr int RING_BYTES = 131072;
constexpr int RB_OFF = RING_BYTES + 1024;
constexpr int LDS_BYTES = 147456;
constexpr int BARST_OFF = LDS_BYTES - 64;

__device__ __forceinline__ unsigned cvt_pk_bf16(float lo, float hi) { unsigned r; asm volatile("v_cvt_pk_bf16_f32 %0, %1, %2" : "=v"(r) : "v"(lo), "v"(hi)); return r; }
__device__ __forceinline__ float bf_lo(unsigned w) { return __uint_as_float(w << 16); }
__device__ __forceinline__ float bf_hi(unsigned w) { return __uint_as_float(w & 0xffff0000u); }
__device__ __forceinline__ unsigned f2bf(float f) { unsigned u = __float_as_uint(f); return (u + 0x7fffu + ((u >> 16) & 1u)) >> 16; }
__device__ __forceinline__ unsigned pk2(float lo, float hi) { return f2bf(lo) | (f2bf(hi) << 16); }
__device__ __forceinline__ float fast_sigmoid(float x) { return __builtin_amdgcn_rcpf(1.0f + __builtin_amdgcn_exp2f(-x * LOG2E)); }

namespace pg8 {
constexpr int BM = 256, BK = 64, HALF = 128, HTB = HALF * BK * 2, STAGE_BYTES = 8 * HTB, NXCD = 8, WGM = 8;
__host__ __device__ __forceinline__ int lds_byte(int r, int c) { const int st = (r >> 4) * 2 + (c >> 5), rr = r & 15, cc = c & 31, ob = rr * 64 + cc * 2; return st * 1024 + (ob ^ (((ob >> 9) & 1) << 5)); }
__host__ __device__ __forceinline__ void stage_rc(int b, int& R, int& C) { const int st = b / 1024, sb = b % 1024, swz = sb ^ (((sb >> 9) & 1) << 5); R = (st >> 1) * 16 + swz / 64; C = (st & 1) * 32 + (swz % 64) / 2; }
__host__ __device__ __forceinline__ int perm32(int rho) { const int n = rho >> 4, i = rho & 15; return 8 * (i >> 2) + 4 * n + (i & 3); }

struct Unit { int pm, pn, z; };
struct Gemm { const bf16_t* A; const bf16_t* Bt; int lda, ldb, K; long zA, zB; };

struct StaticOrder {
    int nM, nN, nwg, G, c, nz;
    __device__ void init(int nM_, int nN_, int G_, int c_, int nz_) { nM = nM_; nN = nN_; nwg = nM * nN; G = G_; c = c_; nz = nz_; }
    __device__ bool next(int i, Unit& u) const {
        const int it = i / nz; u.z = i - it * nz;
        const long L = (long)it * G + c; if (L >= nwg) return false;
        int wgid = (int)L; { const int q = nwg / NXCD, r = nwg % NXCD, xcd = wgid % NXCD, off = wgid / NXCD; wgid = (xcd < r ? xcd * (q + 1) : r * (q + 1) + (xcd - r) * q) + off; }
        const int nig = WGM * nN, gid = wgid / nig, fm = gid * WGM, gsz = (nM - fm) < WGM ? (nM - fm) : WGM;
        u.pm = fm + ((wgid % nig) % gsz); u.pn = (wgid % nig) / gsz; return true;
    }
};

template <class Epi>
__device__ __forceinline__ void gemm_phase(LAS unsigned char* lds, const Gemm g, const StaticOrder& S, const Epi& E, const int tid) {
    const int wid = __builtin_amdgcn_readfirstlane(tid >> 6), lane = tid & 63, wr = wid >> 2, wc = wid & 3, fr = lane & 15, fq = lane >> 4;
    const int K = g.K, nt = K / BK;
    unsigned voffA[2], voffB[2];
#pragma unroll
    for (int i = 0; i < 2; ++i) { int R, C; stage_rc(tid * 16 + i * 8192, R, C); const int Rb = (R & ~31) + perm32(R & 31);
        voffA[i] = (unsigned)(R * g.lda + C) * 2u; voffB[i] = (unsigned)(Rb * g.ldb + C) * 2u; }
    const size_t kstep = (size_t)(BK * 2);
    const size_t hstepA = (size_t)HALF * g.lda * 2, hstepB = (size_t)HALF * g.ldb * 2;
    const size_t tstepA = 2 * hstepA, tstepB = 2 * hstepB;
    const unsigned ldsw = (unsigned)wid * 1024u;
    const int aoff = lds_byte(wr * 64 + fr, fq * 8), boff = lds_byte(wc * 32 + fr, fq * 8);
#define PG8_SA(b, h) (((b) * 2 + (h)) * HTB)
#define PG8_SB(b, h) ((4 + (b) * 2 + (h)) * HTB)
#define PG8_STAGE(bufoff, gbase, voff) do { _Pragma("unroll") for (int _i = 0; _i < 2; ++_i) \
        __builtin_amdgcn_global_load_lds((const unsigned*)((const char*)(gbase) + (voff)[_i]), (LAS unsigned*)(lds + (bufoff) + ldsw + _i * 8192), 16, 0, 0); } while (0)
#define PG8_LDA(dst, b, h) do { _Pragma("unroll") for (int m = 0; m < 4; ++m) _Pragma("unroll") for (int k = 0; k < 2; ++k) dst[m][k] = *(const LAS bf16x8*)(lds + PG8_SA(b, h) + aoff + m * 2048 + k * 1024); } while (0)
#define PG8_LDB(dst, b, h) do { _Pragma("unroll") for (int n = 0; n < 2; ++n) _Pragma("unroll") for (int k = 0; k < 2; ++k) dst[n][k] = *(const LAS bf16x8*)(lds + PG8_SB(b, h) + boff + n * 2048 + k * 1024); } while (0)
#define PG8_MMA(ai, bj, At, Bt) do { __builtin_amdgcn_s_setprio(1); _Pragma("unroll") for (int m = 0; m < 4; ++m) _Pragma("unroll") for (int n = 0; n < 2; ++n) _Pragma("unroll") for (int k = 0; k < 2; ++k) \
        acc[ai][bj][m][n] = __builtin_amdgcn_mfma_f32_16x16x32_bf16(Bt[n][k], At[m][k], acc[ai][bj][m][n], 0, 0, 0); __builtin_amdgcn_s_setprio(0); } while (0)
#define PG8_WAIT_V(n) asm volatile("s_waitcnt vmcnt(" #n ")" ::: "memory")
#define PG8_WAIT_L(n) asm volatile("s_waitcnt lgkmcnt(" #n ")" ::: "memory")
#define PG8_BAR __builtin_amdgcn_s_barrier()
#define PG8_SCHED __builtin_amdgcn_sched_barrier(0)
    Unit cur, nxt; int ui = 0;
    if (!S.next(0, cur)) return;
    f32x4 acc[2][2][4][2];
#pragma unroll
    for (int a = 0; a < 2; ++a)
#pragma unroll
        for (int b = 0; b < 2; ++b)
#pragma unroll
            for (int m = 0; m < 4; ++m)
#pragma unroll
                for (int n = 0; n < 2; ++n) acc[a][b][m][n] = (f32x4){0.f, 0.f, 0.f, 0.f};
    bf16x8 At[4][2], B0[2][2], B1[2][2];
    const char* cA = (const char*)g.A + (size_t)cur.pm * tstepA + (size_t)cur.z * g.zA; const char* cB = (const char*)g.Bt + (size_t)cur.pn * tstepB + (size_t)cur.z * g.zB;
    PG8_STAGE(PG8_SB(0, 0), cB, voffB); PG8_STAGE(PG8_SB(0, 1), cB + hstepB, voffB); PG8_STAGE(PG8_SA(0, 0), cA, voffA); PG8_STAGE(PG8_SA(0, 1), cA + hstepA, voffA);
    if (wr == 1) PG8_BAR;
    PG8_WAIT_V(2); PG8_BAR;
    PG8_STAGE(PG8_SB(1, 0), cB + kstep, voffB); PG8_STAGE(PG8_SA(1, 0), cA + kstep, voffA); PG8_STAGE(PG8_SB(1, 1), cB + hstepB + kstep, voffB);
    PG8_WAIT_V(6); PG8_BAR;
    for (;;) {
        const bool has_next = S.next(ui + 1, nxt);
        const char* nA = has_next ? (const char*)g.A + (size_t)nxt.pm * tstepA + (size_t)nxt.z * g.zA : cA; const char* nB = has_next ? (const char*)g.Bt + (size_t)nxt.pn * tstepB + (size_t)nxt.z * g.zB : cB;
        for (int t = 0; t < nt; t += 2) {
            const bool last = (t == nt - 2);
            const char* a1 = cA + (size_t)(t + 1) * kstep;
            const char* a2 = last ? nA : cA + (size_t)(t + 2) * kstep; const char* b2 = last ? nB : cB + (size_t)(t + 2) * kstep;
            const char* a3 = a2 + kstep; const char* b3 = b2 + kstep;
            PG8_LDB(B0, 0, 0); PG8_LDB(B1, 0, 1); PG8_SCHED; PG8_LDA(At, 0, 0); PG8_STAGE(PG8_SA(1, 1), a1 + hstepA, voffA);
            PG8_WAIT_V(8); PG8_WAIT_L(0); PG8_BAR; PG8_MMA(0, 0, At, B0); PG8_MMA(0, 1, At, B1); PG8_BAR; PG8_SCHED;
            PG8_LDA(At, 0, 1); PG8_STAGE(PG8_SB(0, 0), b2, voffB); PG8_STAGE(PG8_SB(0, 1), b2 + hstepB, voffB); PG8_STAGE(PG8_SA(0, 0), a2, voffA);
            PG8_WAIT_V(8); PG8_WAIT_L(0); PG8_BAR; PG8_MMA(1, 0, At, B0); PG8_MMA(1, 1, At, B1); PG8_BAR; PG8_SCHED;
            PG8_LDB(B0, 1, 0); PG8_LDB(B1, 1, 1); PG8_SCHED; PG8_LDA(At, 1, 0); PG8_STAGE(PG8_SA(0, 1), a2 + hstepA, voffA);
            PG8_WAIT_V(8); PG8_WAIT_L(0); PG8_BAR; PG8_MMA(0, 0, At, B0); PG8_MMA(0, 1, At, B1); PG8_BAR; PG8_SCHED;
            PG8_LDA(At, 1, 1); PG8_STAGE(PG8_SB(1, 0), b3, voffB); PG8_STAGE(PG8_SB(1, 1), b3 + hstepB, voffB); PG8_STAGE(PG8_SA(1, 0), a3, voffA);
            PG8_WAIT_V(8); PG8_WAIT_L(0); PG8_BAR; PG8_MMA(1, 0, At, B0); PG8_MMA(1, 1, At, B1); PG8_BAR; PG8_SCHED;
        }
        if (wr == 0) PG8_BAR;
        E(acc, cur, wr, wc, fr, fq);
        if (PROBE_EPI == Epi::PROBE_ID) { const Epi E2 = E.probe_copy(); E2(acc, cur, wr, wc, fr, fq); }
        if (!has_next) break;
#pragma unroll
        for (int a = 0; a < 2; ++a)
#pragma unroll
            for (int b = 0; b < 2; ++b)
#pragma unroll
                for (int m = 0; m < 4; ++m)
#pragma unroll
                    for (int n = 0; n < 2; ++n) acc[a][b][m][n] = (f32x4){0.f, 0.f, 0.f, 0.f};
        cur = nxt; cA = nA; cB = nB; ++ui;
        if (wr == 1) PG8_BAR;
    }
    PG8_WAIT_V(0);
    PG8_BAR;
#undef PG8_SA
#undef PG8_SB
#undef PG8_STAGE
#undef PG8_LDA
#undef PG8_LDB
#undef PG8_MMA
#undef PG8_WAIT_V
#undef PG8_WAIT_L
#undef PG8_BAR
#undef PG8_SCHED
}
}

__device__ __forceinline__ float row_rs(const float* ssq, int row, int fq) {
    const f32x4 v = *(const f32x4*)(ssq + (size_t)row * 16 + 4 * fq);
    float s = (v[0] + v[1]) + (v[2] + v[3]);
    s += __shfl_xor(s, 16); s += __shfl_xor(s, 32);
    return __builtin_amdgcn_rsqf(s * (1.0f / 1024.0f) + EPS);
}

struct EpiUp {
    static constexpr int PROBE_ID = 1; __device__ __forceinline__ EpiUp probe_copy() const { return *this; }
    bf16_t* H; const float* ssq;
    __device__ __forceinline__ void operator()(const f32x4 (&acc)[2][2][4][2], const pg8::Unit& u, int wr, int wc, int fr, int fq) const {
        const int row0 = u.pm * 256 + wr * 64 + fr, hc0 = u.pn * 128 + wc * 32 + 8 * fq;
#pragma unroll
        for (int ai = 0; ai < 2; ++ai)
#pragma unroll
            for (int m = 0; m < 4; ++m) {
                const int row = row0 + ai * 128 + m * 16; const float rs = row_rs(ssq, row, fq);
                float h[8];
#pragma unroll
                for (int n = 0; n < 2; ++n) {
                    const f32x4 gg = acc[ai][0][m][n] * rs, uu = acc[ai][1][m][n] * rs;
#pragma unroll
                    for (int i = 0; i < 4; ++i) h[4 * n + i] = gg[i] * fast_sigmoid(gg[i]) * uu[i];
                }
                u32x4 w; w.x = cvt_pk_bf16(h[0], h[1]); w.y = cvt_pk_bf16(h[2], h[3]); w.z = cvt_pk_bf16(h[4], h[5]); w.w = cvt_pk_bf16(h[6], h[7]);
                *(u32x4*)(H + (size_t)row * DFF + hc0) = w;
            }
    }
    __device__ __forceinline__ void small(const f32x4 (&acc)[1][2][2], int row, int h0, int fr, int fq) const {
        const float rs = row_rs(ssq, row, fq); float h[8];
#pragma unroll
        for (int n = 0; n < 2; ++n) {
            const f32x4 gg = acc[0][0][n] * rs, uu = acc[0][1][n] * rs;
#pragma unroll
            for (int i = 0; i < 4; ++i) h[4 * n + i] = gg[i] * fast_sigmoid(gg[i]) * uu[i];
        }
        u32x4 w; w.x = cvt_pk_bf16(h[0], h[1]); w.y = cvt_pk_bf16(h[2], h[3]); w.z = cvt_pk_bf16(h[4], h[5]); w.w = cvt_pk_bf16(h[6], h[7]);
        *(u32x4*)(H + (size_t)row * DFF + h0 + 8 * fq) = w;
    }
};

struct EpiRes {
    static constexpr int PROBE_ID = 2; __device__ __forceinline__ EpiRes probe_copy() const { EpiRes e = *this; e.scale = 0.f; return e; }
    bf16_t* XB; float* ssq; float scale;
    __device__ __forceinline__ void operator()(const f32x4 (&acc)[2][2][4][2], const pg8::Unit& u, int wr, int wc, int fr, int fq) const {
        const int row0 = u.pm * 256 + wr * 64 + fr, col0 = u.pn * 256 + wc * 32 + 8 * fq;
#pragma unroll
        for (int ai = 0; ai < 2; ++ai) {
            u32x4 xw[4][2];
#pragma unroll
            for (int m = 0; m < 4; ++m)
#pragma unroll
                for (int bj = 0; bj < 2; ++bj) xw[m][bj] = *(const u32x4*)(XB + (size_t)(row0 + ai * 128 + m * 16) * DM + col0 + bj * 128);
#pragma unroll
            for (int m = 0; m < 4; ++m) {
                const int row = row0 + ai * 128 + m * 16; float s = 0.f;
#pragma unroll
                for (int bj = 0; bj < 2; ++bj) {
                    const u32x4 o = xw[m][bj];
                    f32x4 x0 = (f32x4){bf_lo(o.x), bf_hi(o.x), bf_lo(o.y), bf_hi(o.y)}, x1 = (f32x4){bf_lo(o.z), bf_hi(o.z), bf_lo(o.w), bf_hi(o.w)};
                    x0 += acc[ai][bj][m][0] * scale; x1 += acc[ai][bj][m][1] * scale;
                    u32x4 w; w.x = cvt_pk_bf16(x0[0], x0[1]); w.y = cvt_pk_bf16(x0[2], x0[3]); w.z = cvt_pk_bf16(x1[0], x1[1]); w.w = cvt_pk_bf16(x1[2], x1[3]);
                    *(u32x4*)(XB + (size_t)row * DM + col0 + bj * 128) = w;
                    s += (x0[0] * x0[0] + x0[1] * x0[1]) + (x0[2] * x0[2] + x0[3] * x0[3]) + (x1[0] * x1[0] + x1[1] * x1[1]) + (x1[2] * x1[2] + x1[3] * x1[3]);
                }
                s += __shfl_xor(s, 16); s += __shfl_xor(s, 32);
                if (fq == 0) ssq[(size_t)row * 16 + u.pn * 4 + wc] = s;
            }
        }
    }
    __device__ __forceinline__ void small(const f32x4 (&acc)[1][2][2], int row, int c0, int fr, int fq) const {
        float s = 0.f;
#pragma unroll
        for (int j = 0; j < 2; ++j) {
            bf16_t* xp = XB + (size_t)row * DM + c0 + 32 * j + 8 * fq;
            const u32x4 o = *(const u32x4*)xp;
            f32x4 x0 = (f32x4){bf_lo(o.x), bf_hi(o.x), bf_lo(o.y), bf_hi(o.y)}, x1 = (f32x4){bf_lo(o.z), bf_hi(o.z), bf_lo(o.w), bf_hi(o.w)};
            x0 += acc[0][j][0] * scale; x1 += acc[0][j][1] * scale;
            u32x4 w; w.x = cvt_pk_bf16(x0[0], x0[1]); w.y = cvt_pk_bf16(x0[2], x0[3]); w.z = cvt_pk_bf16(x1[0], x1[1]); w.w = cvt_pk_bf16(x1[2], x1[3]);
            *(u32x4*)xp = w;
            s += (x0[0] * x0[0] + x0[1] * x0[1]) + (x0[2] * x0[2] + x0[3] * x0[3]) + (x1[0] * x1[0] + x1[1] * x1[1]) + (x1[2] * x1[2] + x1[3] * x1[3]);
        }
        s += __shfl_xor(s, 16); s += __shfl_xor(s, 32);
        if (fq == 0) ssq[(size_t)row * 16 + (c0 >> 6)] = s;
    }
};

struct EpiIn {
    static constexpr int PROBE_ID = 3; __device__ __forceinline__ EpiIn probe_copy() const { return *this; }
    bf16_t* Z; const float* ssq; const float* bgate; float* okp; float* ovp; float* oks; float* ovs;
    __device__ __forceinline__ void operator()(const f32x4 (&acc)[2][2][4][2], const pg8::Unit& u, int wr, int wc, int fr, int fq) const {
        const int row0 = u.pm * 256 + wr * 64 + fr, col0 = u.pn * 256 + wc * 32 + 8 * fq;
        const int pn = u.pn;
        const bool isq = (pn == 2 || pn == 3), iskv = (pn >= 8 && pn < 12), isg = (pn >= 12);
        const bool kvp = iskv && ((u.pm & 15) >= 14);
        f32x4 bg[2][2];
#pragma unroll
        for (int bj = 0; bj < 2; ++bj) { if (isg) { bg[bj][0] = *(const f32x4*)(bgate + col0 - ZC_GC + bj * 128); bg[bj][1] = *(const f32x4*)(bgate + col0 - ZC_GC + bj * 128 + 4); } else { bg[bj][0] = (f32x4){0.f, 0.f, 0.f, 0.f}; bg[bj][1] = bg[bj][0]; } }
#pragma unroll
        for (int ai = 0; ai < 2; ++ai)
#pragma unroll
            for (int m = 0; m < 4; ++m) {
                const int row = row0 + ai * 128 + m * 16; float rs = row_rs(ssq, row, fq);
                if (isq) rs *= QSCALE;
#pragma unroll
                for (int bj = 0; bj < 2; ++bj) {
                    f32x4 v0 = acc[ai][bj][m][0] * rs, v1 = acc[ai][bj][m][1] * rs;
                    const int c = col0 + bj * 128;
                    if (isg) {
                        v0 += bg[bj][0]; v1 += bg[bj][1];
#pragma unroll
                        for (int i = 0; i < 4; ++i) { v0[i] = fast_sigmoid(v0[i]); v1[i] = fast_sigmoid(v1[i]); }
                    }
                    u32x4 w; w.x = cvt_pk_bf16(v0[0], v0[1]); w.y = cvt_pk_bf16(v0[2], v0[3]); w.z = cvt_pk_bf16(v1[0], v1[1]); w.w = cvt_pk_bf16(v1[2], v1[3]);
                    *(u32x4*)(Z + (size_t)row * INC + c) = w;
                    if (kvp) {
                        const int b = row >> 12, t = row & 4095;
                        float* dst = ((pn < 10) ? okp : ovp) + ((size_t)(b * 512 + (t - 3584)) * 512 + (c - ((pn < 10) ? ZC_K : ZC_V)));
                        *(f32x4*)dst = v0; *(f32x4*)(dst + 4) = v1;
                    }
                }
            }
    }
    __device__ __forceinline__ void small(const f32x4 (&acc)[1][2][2], int row, int c0, int fr, int fq) const {
        const int pn = c0 >> 8;
        const bool isq = (pn == 2 || pn == 3), iskv = (pn >= 8 && pn < 12), isg = (pn >= 12);
        float rs = row_rs(ssq, row, fq);
        if (isq) rs *= QSCALE;
#pragma unroll
        for (int j = 0; j < 2; ++j) {
            f32x4 v0 = acc[0][j][0] * rs, v1 = acc[0][j][1] * rs;
            const int c = c0 + 32 * j + 8 * fq;
            if (isg) {
                v0 += *(const f32x4*)(bgate + c - ZC_GC); v1 += *(const f32x4*)(bgate + c - ZC_GC + 4);
#pragma unroll
                for (int i = 0; i < 4; ++i) { v0[i] = fast_sigmoid(v0[i]); v1[i] = fast_sigmoid(v1[i]); }
            }
            u32x4 w; w.x = cvt_pk_bf16(v0[0], v0[1]); w.y = cvt_pk_bf16(v0[2], v0[3]); w.z = cvt_pk_bf16(v1[0], v1[1]); w.w = cvt_pk_bf16(v1[2], v1[3]);
            *(u32x4*)(Z + (size_t)row * INC + c) = w;
            if (iskv) {
                float* dst = ((pn < 10) ? oks : ovs) + ((size_t)(row - MP) * 512 + (c - ((pn < 10) ? ZC_K : ZC_V)));
                *(f32x4*)dst = v0; *(f32x4*)(dst + 4) = v1;
            }
        }
    }
};

struct EpiMix {
    static constexpr int PROBE_ID = 4; __device__ __forceinline__ EpiMix probe_copy() const { return *this; }
    bf16_t* Z;
    __device__ __forceinline__ void operator()(const f32x4 (&acc)[2][2][4][2], const pg8::Unit& u, int wr, int wc, int fr, int fq) const {
        const int row0 = u.pm * 256 + wr * 64 + fr, col0 = u.pn * 256 + wc * 32 + 8 * fq;
        const int gcol = (u.z == 0) ? ZC_GC : ZC_GA;
#pragma unroll
        for (int ai = 0; ai < 2; ++ai)
#pragma unroll
            for (int m = 0; m < 4; ++m) {
                const int row = row0 + ai * 128 + m * 16;
#pragma unroll
                for (int bj = 0; bj < 2; ++bj) {
                    const int c = col0 + bj * 128;
                    const u32x4 gw = *(const u32x4*)(Z + (size_t)row * INC + gcol + c);
                    f32x4 v0 = acc[ai][bj][m][0], v1 = acc[ai][bj][m][1];
                    v0[0] *= bf_lo(gw.x); v0[1] *= bf_hi(gw.x); v0[2] *= bf_lo(gw.y); v0[3] *= bf_hi(gw.y);
                    v1[0] *= bf_lo(gw.z); v1[1] *= bf_hi(gw.z); v1[2] *= bf_lo(gw.w); v1[3] *= bf_hi(gw.w);
                    bf16_t* mp = Z + (size_t)row * INC + ZC_MB + c;
                    if (u.z != 0) {
                        const u32x4 pw = *(const u32x4*)mp;
                        v0[0] += bf_lo(pw.x); v0[1] += bf_hi(pw.x); v0[2] += bf_lo(pw.y); v0[3] += bf_hi(pw.y);
                        v1[0] += bf_lo(pw.z); v1[1] += bf_hi(pw.z); v1[2] += bf_lo(pw.w); v1[3] += bf_hi(pw.w);
                    }
                    u32x4 w; w.x = cvt_pk_bf16(v0[0], v0[1]); w.y = cvt_pk_bf16(v0[2], v0[3]); w.z = cvt_pk_bf16(v1[0], v1[1]); w.w = cvt_pk_bf16(v1[2], v1[3]);
                    *(u32x4*)mp = w;
                }
            }
    }
    __device__ __forceinline__ void small(const f32x4 (&acc)[2][2][2], int row, int c0, int fr, int fq) const {
#pragma unroll
        for (int j = 0; j < 2; ++j) {
            const int c = c0 + 32 * j + 8 * fq;
            const u32x4 gc = *(const u32x4*)(Z + (size_t)row * INC + ZC_GC + c), ga = *(const u32x4*)(Z + (size_t)row * INC + ZC_GA + c);
            const f32x4 a0 = acc[0][j][0], a1 = acc[0][j][1], b0 = acc[1][j][0], b1 = acc[1][j][1];
            float m[8];
            m[0] = a0[0] * bf_lo(gc.x) + b0[0] * bf_lo(ga.x); m[1] = a0[1] * bf_hi(gc.x) + b0[1] * bf_hi(ga.x);
            m[2] = a0[2] * bf_lo(gc.y) + b0[2] * bf_lo(ga.y); m[3] = a0[3] * bf_hi(gc.y) + b0[3] * bf_hi(ga.y);
            m[4] = a1[0] * bf_lo(gc.z) + b1[0] * bf_lo(ga.z); m[5] = a1[1] * bf_hi(gc.z) + b1[1] * bf_hi(ga.z);
            m[6] = a1[2] * bf_lo(gc.w) + b1[2] * bf_lo(ga.w); m[7] = a1[3] * bf_hi(gc.w) + b1[3] * bf_hi(ga.w);
            u32x4 w; w.x = cvt_pk_bf16(m[0], m[1]); w.y = cvt_pk_bf16(m[2], m[3]); w.z = cvt_pk_bf16(m[4], m[5]); w.w = cvt_pk_bf16(m[6], m[7]);
            *(u32x4*)(Z + (size_t)row * INC + ZC_MB + c) = w;
        }
    }
};

template <int NSET, int NSTEP  , class Epi, bool UPMODE = false>
__device__ __forceinline__ void small_gemm(LAS unsigned char* lds, const bf16_t* A0, const bf16_t* A1, int lda, const bf16_t* W0, const bf16_t* W1, int ldb, int ncg, const Epi& E, int bx, int G, int wave, int lane) {
    const int fr = lane & 15, fq = lane >> 4;
    LAS f32x4* part = (LAS f32x4*)lds;
#pragma unroll 1
    for (int u = bx; u < 8 * ncg; u += G) {
        const int rb = u & 7, cg = u >> 3;
        const int row = MP + 16 * rb + fr;
        f32x4 acc[NSET][2][2];
#pragma unroll
        for (int st = 0; st < NSET; ++st) {
            const bf16_t* Ap = (st ? A1 : A0) + (size_t)row * lda + wave * (NSTEP * 32) + 8 * fq;
            const int cb0 = UPMODE ? 256 * (cg >> 2) + 32 * (cg & 3) : 64 * cg;
            const bf16_t* Wp = (st ? W1 : W0) + (size_t)(cb0 + 8 * (fr >> 2) + (fr & 3)) * ldb + wave * (NSTEP * 32) + 8 * fq;
#pragma unroll
            for (int j = 0; j < 2; ++j)
#pragma unroll
                for (int n = 0; n < 2; ++n) acc[st][j][n] = (f32x4){0.f, 0.f, 0.f, 0.f};
#pragma unroll 4
            for (int k = 0; k < NSTEP; ++k) {
                const bf16x8 av = *(const bf16x8*)(Ap + 32 * k);
#pragma unroll
                for (int j = 0; j < 2; ++j)
#pragma unroll
                    for (int n = 0; n < 2; ++n) {
                        const bf16x8 bv = *(const bf16x8*)(Wp + (size_t)((UPMODE ? 128 : 32) * j + 4 * n) * ldb + 32 * k);
                        acc[st][j][n] = __builtin_amdgcn_mfma_f32_16x16x32_bf16(bv, av, acc[st][j][n], 0, 0, 0);
                    }
            }
        }
#pragma unroll
        for (int st = 0; st < NSET; ++st)
#pragma unroll
            for (int j = 0; j < 2; ++j)
#pragma unroll
                for (int n = 0; n < 2; ++n) part[((wave * NSET + st) * 4 + j * 2 + n) * 64 + lane] = acc[st][j][n];
        __syncthreads();
        if (wave == 0) {
#pragma unroll
            for (int w = 1; w < 8; ++w)
#pragma unroll
                for (int st = 0; st < NSET; ++st)
#pragma unroll
                    for (int j = 0; j < 2; ++j)
#pragma unroll
                        for (int n = 0; n < 2; ++n) acc[st][j][n] += part[((w * NSET + st) * 4 + j * 2 + n) * 64 + lane];
            E.small(acc, row, UPMODE ? 128 * (cg >> 2) + 32 * (cg & 3) : 64 * cg, fr, fq);
        }
        __syncthreads();
    }
}

struct TileD { const bf16_t* K; const bf16_t* V; int pitch; int nkeys; int delta0; };

__device__ __forceinline__ void attn_dma_v(const TileD& td, LAS unsigned char* vb, int lane) {
#pragma unroll
    for (int i = 0; i < 8; ++i) {
        const int row = 8 * i + (lane >> 3), chs = lane & 7, ch = chs ^ (((row >> 1) & 3) << 1);
        __builtin_amdgcn_global_load_lds((const unsigned*)(td.V + (size_t)row * td.pitch + ch * 8), (LAS unsigned*)(vb + i * 1024), 16, 0, 0);
    }
}
template <int NQB, class TF>
__device__ __forceinline__ void attn_wave(const bf16_t* Qp, bf16_t* Op, int qpitch, int opitch, int nt, const TF& tilef, LAS unsigned char* vbuf, const LAS float* rb, int lane) {
    const int fr = lane & 15, fq = lane >> 4;
    bf16x8 qf[NQB][2];
#pragma unroll
    for (int qb = 0; qb < NQB; ++qb)
#pragma unroll
        for (int dh = 0; dh < 2; ++dh) qf[qb][dh] = *(const bf16x8*)(Qp + (size_t)(16 * qb + fr) * qpitch + dh * 32 + 8 * fq);
    f32x4 O[NQB][4]; float mrow[NQB], lrow[NQB];
#pragma unroll
    for (int qb = 0; qb < NQB; ++qb) { mrow[qb] = -1e30f; lrow[qb] = 0.f;
#pragma unroll
        for (int db = 0; db < 4; ++db) O[qb][db] = (f32x4){0.f, 0.f, 0.f, 0.f}; }
    const int qp = fr >> 2, pp = fr & 3, rowl = 4 * fq + qp, sw = ((rowl >> 1) & 3) << 1;
    const int vrow = rowl * 128 + (pp & 1) * 8, vch = (pp >> 1) ^ sw;
    bf16x8 kf[2][2];
    { const TileD td = tilef(0); attn_dma_v(td, vbuf, lane);
#pragma unroll
      for (int kb = 0; kb < 2; ++kb)
#pragma unroll
          for (int dh = 0; dh < 2; ++dh) kf[kb][dh] = *(const bf16x8*)(td.K + (size_t)(16 * kb + fr) * td.pitch + dh * 32 + 8 * fq); }
    const int nht = 2 * nt;
#pragma unroll 1
    for (int ht = 0; ht < nht; ++ht) {
        const int t = ht >> 1, half = ht & 1;
        asm volatile("s_waitcnt vmcnt(0)" ::: "memory");
        const TileD td = tilef(t);
        if (half == 0 && t + 1 < nt) { const TileD tn = tilef(t + 1); attn_dma_v(tn, vbuf + ((t + 1) & 1) * 8192, lane); }
        f32x4 S[2][NQB];
#pragma unroll
        for (int kb = 0; kb < 2; ++kb)
#pragma unroll
            for (int qb = 0; qb < NQB; ++qb) {
                f32x4 s = __builtin_amdgcn_mfma_f32_16x16x32_bf16(kf[kb][0], qf[qb][0], (f32x4){0.f, 0.f, 0.f, 0.f}, 0, 0, 0);
                S[kb][qb] = __builtin_amdgcn_mfma_f32_16x16x32_bf16(kf[kb][1], qf[qb][1], s, 0, 0, 0);
            }
        if (ht + 1 < nht) {
            const TileD tk = tilef((ht + 1) >> 1); const int r0 = 32 * ((ht + 1) & 1);
#pragma unroll
            for (int kb = 0; kb < 2; ++kb)
#pragma unroll
                for (int dh = 0; dh < 2; ++dh) kf[kb][dh] = *(const bf16x8*)(tk.K + (size_t)(r0 + 16 * kb + fr) * tk.pitch + dh * 32 + 8 * fq);
        }
        const int delta0 = td.delta0 - 32 * half, nkeys = td.nkeys - 32 * half;
        if (delta0 >= 160) {
            const float bc = rb[256];
#pragma unroll
            for (int kb = 0; kb < 2; ++kb)
#pragma unroll
                for (int qb = 0; qb < NQB; ++qb) S[kb][qb] += bc;
        } else {
#pragma unroll
            for (int kb = 0; kb < 2; ++kb)
#pragma unroll
                for (int qb = 0; qb < NQB; ++qb)
#pragma unroll
                    for (int i = 0; i < 4; ++i) {
                        int d = delta0 + (16 * qb + fr) - (16 * kb + 4 * fq + i);
                        d = d < -128 ? -128 : (d > 128 ? 128 : d);
                        S[kb][qb][i] += rb[d + 128];
                    }
        }
        if (nkeys < 32) {
#pragma unroll
            for (int kb = 0; kb < 2; ++kb)
#pragma unroll
                for (int qb = 0; qb < NQB; ++qb)
#pragma unroll
                    for (int i = 0; i < 4; ++i) if (16 * kb + 4 * fq + i >= nkeys) S[kb][qb][i] = -INFINITY;
        }
        bf16x8 pf[NQB];
#pragma unroll
        for (int qb = 0; qb < NQB; ++qb) {
            float mx = fmaxf(fmaxf(fmaxf(S[0][qb][0], S[0][qb][1]), fmaxf(S[0][qb][2], S[0][qb][3])), fmaxf(fmaxf(S[1][qb][0], S[1][qb][1]), fmaxf(S[1][qb][2], S[1][qb][3])));
            mx = fmaxf(mx, __shfl_xor(mx, 16)); mx = fmaxf(mx, __shfl_xor(mx, 32));
            const float mn = fmaxf(mrow[qb], mx), alpha = __builtin_amdgcn_exp2f(mrow[qb] - mn);
            mrow[qb] = mn; float ps = 0.f; float p[2][4];
#pragma unroll
            for (int kb = 0; kb < 2; ++kb)
#pragma unroll
                for (int i = 0; i < 4; ++i) { p[kb][i] = __builtin_amdgcn_exp2f(S[kb][qb][i] - mn); ps += p[kb][i]; }
            lrow[qb] = lrow[qb] * alpha + ps;
#pragma unroll
            for (int db = 0; db < 4; ++db) O[qb][db] *= alpha;
            u32x4 w; w.x = cvt_pk_bf16(p[0][0], p[0][1]); w.y = cvt_pk_bf16(p[0][2], p[0][3]); w.z = cvt_pk_bf16(p[1][0], p[1][1]); w.w = cvt_pk_bf16(p[1][2], p[1][3]);
            pf[qb] = __builtin_bit_cast(bf16x8, w);
        }
        const LAS unsigned char* vb = vbuf + (t & 1) * 8192 + half * 4096 + vrow;
#pragma unroll
        for (int db = 0; db < 4; ++db) {
            const int off = ((2 * db) ^ vch) << 4;
            const s16x4 lo = __builtin_amdgcn_ds_read_tr16_b64_v4i16((LAS s16x4*)(vb + off));
            const s16x4 hi = __builtin_amdgcn_ds_read_tr16_b64_v4i16((LAS s16x4*)(vb + off + 2048));
            const bf16x8 vf = (bf16x8){lo[0], lo[1], lo[2], lo[3], hi[0], hi[1], hi[2], hi[3]};
#pragma unroll
            for (int qb = 0; qb < NQB; ++qb) O[qb][db] = __builtin_amdgcn_mfma_f32_16x16x32_bf16(vf, pf[qb], O[qb][db], 0, 0, 0);
        }
    }
    asm volatile("s_waitcnt lgkmcnt(0)" ::: "memory");
#pragma unroll
    for (int qb = 0; qb < NQB; ++qb) {
        float l = lrow[qb]; l += __shfl_xor(l, 16); l += __shfl_xor(l, 32);
        const float inv = 1.0f / l;
#pragma unroll
        for (int db = 0; db < 4; ++db) {
            const f32x4 o = O[qb][db] * inv; u32x2 w; w.x = cvt_pk_bf16(o[0], o[1]); w.y = cvt_pk_bf16(o[2], o[3]);
            *(u32x2*)(Op + (size_t)(16 * qb + fr) * opitch + 16 * db + 4 * fq) = w;
        }
    }
}


#define XB_TMO      128
#define XB_XCNT(j)  (256  + 64 * (j))
#define XB_XSUB(j)  (1280 + 64 * (j))
#define XB_XGEN(j)  (2304 + 64 * (j))
#define XB_TOP      3328
#define XB_TOPGEN   3392
#define XCD_BAR_WORDS 3456
#define XB_SPIN_CAP (1u << 20)
__device__ __forceinline__ unsigned xb_ld(unsigned* p)              { return __hip_atomic_load(p, __ATOMIC_RELAXED, __HIP_MEMORY_SCOPE_AGENT); }
__device__ __forceinline__ unsigned xb_add(unsigned* p, unsigned v) { return __hip_atomic_fetch_add(p, v, __ATOMIC_RELAXED, __HIP_MEMORY_SCOPE_AGENT); }
__device__ __forceinline__ unsigned xb_xcc_id() { return (unsigned)__builtin_amdgcn_s_getreg((3 << 11) | 20) & 0xFu; }
#define XB_SPIN(cond, bar) do { unsigned _sp = 0; while (cond) { __builtin_amdgcn_s_sleep(1); \
    if ((++_sp & 255u) == 0u) { if (xb_ld(&(bar)[XB_TMO])) break; if (_sp > XB_SPIN_CAP) { atomicAdd(&(bar)[XB_TMO], 1u); break; } } } } while (0)
struct XcdBarrier { unsigned* bar; unsigned x; volatile LAS unsigned* st; };
__device__ __forceinline__ XcdBarrier xcd_barrier_post(unsigned* bar, volatile LAS unsigned* st) {
    XcdBarrier b; b.bar = bar; b.x = xb_xcc_id(); b.st = st;
    if (threadIdx.x == 0) (void)xb_add(&bar[XB_XCNT(b.x)], 1u);
    return b;
}
__device__ __forceinline__ void xcd_barrier_complete(unsigned* bar, unsigned x, unsigned& nloc, unsigned& nx) {
    const unsigned G = gridDim.x * gridDim.y * gridDim.z;
    unsigned sum, cnt, mine, sp = 0u;
    for (;;) {
        sum = 0u; cnt = 0u; mine = 0u;
#pragma unroll
        for (unsigned j = 0; j < 16; ++j) { const unsigned c = xb_ld(&bar[XB_XCNT(j)]); sum += c; cnt += (c > 0u) ? 1u : 0u; mine = (j == x) ? c : mine; }
        if (sum == G) break;
        __builtin_amdgcn_s_sleep(1);
        if ((++sp & 255u) == 0u) { if (xb_ld(&bar[XB_TMO])) break; if (sp > XB_SPIN_CAP) { atomicAdd(&bar[XB_TMO], 1u); break; } }
    }
    nloc = mine > 0u ? mine : 1u; nx = cnt > 0u ? cnt : 1u;
}
__device__ __forceinline__ void xcd_barrier(const XcdBarrier& b) {
    asm volatile("s_waitcnt vmcnt(0)" ::: "memory");
    __syncthreads();
    if (threadIdx.x == 0) {
        unsigned* bar = b.bar;
        __builtin_amdgcn_s_waitcnt(0);
        unsigned nloc = b.st[0], nx = b.st[1];
        if (nloc == 0u) { xcd_barrier_complete(bar, b.x, nloc, nx); b.st[0] = nloc; b.st[1] = nx; }
        const unsigned old = xb_add(&bar[XB_XSUB(b.x)], 1u);
        const unsigned gen = old / nloc;
        if (old + 1u == (gen + 1u) * nloc) {
            __builtin_amdgcn_fence(__ATOMIC_RELEASE, "agent");
            asm volatile("s_waitcnt vmcnt(0)" ::: "memory");
            const unsigned og = xb_add(&bar[XB_TOP], 1u);
            const unsigned tg = og / nx;
            if (og + 1u == (tg + 1u) * nx) xb_add(&bar[XB_TOPGEN], 1u);
            else XB_SPIN(xb_ld(&bar[XB_TOPGEN]) == tg, bar);
            __builtin_amdgcn_fence(__ATOMIC_ACQUIRE, "agent");
            xb_add(&bar[XB_XGEN(b.x)], 1u);
            asm volatile("s_waitcnt vmcnt(0)" ::: "memory");
        } else {
            XB_SPIN(xb_ld(&bar[XB_XGEN(b.x)]) == gen, bar);
            __builtin_amdgcn_fence(__ATOMIC_ACQUIRE, "agent");
            asm volatile("s_waitcnt vmcnt(0)" ::: "memory");
        }
    }
    __syncthreads();
}

struct Args {
    const float* x_prompt; const float* x_sample; const float* cache_k; const float* cache_v; const float* state_conv;
    const float* norm_ffn1; const float* w_ffn1_gu; const float* w_ffn1_down; const float* norm_mix; const float* w_in; const float* b_gate; const float* w_conv;
    const float* rel_bias; const float* w_conv_out; const float* w_attn_out; const float* w_o; const float* norm_ffn2; const float* w_ffn2_gu; const float* w_ffn2_down; const float* norm_final;
    float* out; unsigned char* ws; int ph_lo, ph_hi;
};

__device__ __forceinline__ void transpose_item(const float* W, int N, const float* gain, bf16_t* WT, int dpitch, int dkoff, int mode, int kb, int nb, int scol0, LAS float* scr, int lane) {
    const int k0 = 64 * kb, n0 = 32 * nb, c = lane & 31;
    const int scol = (mode == 1) ? ((c < 16) ? 16 * nb + c : DFF + 16 * nb + (c - 16)) : scol0 + c;
    float wv[32];
#pragma unroll
    for (int i = 0; i < 32; ++i) wv[i] = W[(size_t)(k0 + 2 * i + (lane >> 5)) * N + scol];
    if (gain) {
#pragma unroll
        for (int i = 0; i < 32; ++i) wv[i] *= gain[k0 + 2 * i + (lane >> 5)];
    }
#pragma unroll
    for (int i = 0; i < 32; ++i) scr[(2 * i + (lane >> 5)) * 33 + c] = wv[i];
    asm volatile("s_waitcnt lgkmcnt(0)" ::: "memory");
    const int c8 = lane & 7;
#pragma unroll
    for (int j = 0; j < 4; ++j) { const int n = (lane >> 3) + 8 * j; const LAS float* s = scr + (8 * c8) * 33 + n;
        u32x4 o; o.x = pk2(s[0 * 33], s[1 * 33]); o.y = pk2(s[2 * 33], s[3 * 33]); o.z = pk2(s[4 * 33], s[5 * 33]); o.w = pk2(s[6 * 33], s[7 * 33]);
        int drow;
        if (mode == 1) { const int jj = n & 15, isu = n >> 4; drow = n0 + 8 * (jj >> 2) + 4 * isu + (jj & 3); } else drow = n0 + n;
        *(u32x4*)(WT + (size_t)drow * dpitch + dkoff + k0 + 8 * c8) = o; }
    asm volatile("s_waitcnt lgkmcnt(0)" ::: "memory");
}

__device__ __forceinline__ float wave_sum(float v) {
#pragma unroll
    for (int o = 1; o < 64; o <<= 1) v += __shfl_xor(v, o);
    return v;
}

__global__ void __launch_bounds__(NWAVES * 64, 2) mega_fwd(Args a) {
    extern __shared__ __attribute__((aligned(16))) unsigned char lds_raw[];
    LAS unsigned char* lds = (LAS unsigned char*)lds_raw;
    cg::grid_group grid = cg::this_grid();
    typedef const __attribute__((address_space(4))) Args* ArgP;
    ArgP ap = (ArgP)__builtin_amdgcn_kernarg_segment_ptr();
    const int G = gridDim.x, bx = blockIdx.x;
    const int wave0 = __builtin_amdgcn_readfirstlane((int)threadIdx.x >> 6);
    unsigned* barw = (unsigned*)(ap->ws + WS_BAR);
    if (bx == 0) for (int i = threadIdx.x; i < XCD_BAR_WORDS; i += NWAVES * 64) barw[i] = 0u;
    if (threadIdx.x < 16) ((LAS unsigned*)(lds + BARST_OFF))[threadIdx.x] = 0u;
    XcdBarrier xbar; xbar.bar = barw; xbar.x = 0; xbar.st = (volatile LAS unsigned*)(lds + BARST_OFF);
    bool xposted = false;
    const int lo = ap->ph_lo, hi = ap->ph_hi;
#define PHASE_VARS \
    asm volatile("" : "+s"(ap)); \
    int lane_ = (int)__builtin_amdgcn_mbcnt_hi(~0u, __builtin_amdgcn_mbcnt_lo(~0u, 0u)); asm volatile("" : "+v"(lane_)); \
    int wave_ = wave0; asm volatile("" : "+s"(wave_)); \
    const int lane = lane_, wave = wave_, tid = wave * 64 + lane; \
    const int vcu = (G % 8 == 0) ? (bx % 8) * (G / 8) + bx / 8 : bx; \
    const int gw = vcu * NWAVES + wave, NGW = G * NWAVES; \
    const int gt = gw * 64 + lane, NGT = NGW * 64; \
    unsigned char* ws = ap->ws; \
    bf16_t* WT = (bf16_t*)(ws + ((l & 1) ? WS_WT2 : WS_WT)); bf16_t* WTN = (bf16_t*)(ws + ((l & 1) ? WS_WT : WS_WT2)); bf16_t* XB = (bf16_t*)(ws + WS_XB); float* SSQ = (float*)(ws + WS_SSQ); \
    bf16_t* CK = (bf16_t*)(ws + ((l & 1) ? WS_CK2 : WS_CK)); bf16_t* CV = (bf16_t*)(ws + ((l & 1) ? WS_CV2 : WS_CV)); \
    bf16_t* CKN = (bf16_t*)(ws + ((l & 1) ? WS_CK : WS_CK2)); bf16_t* CVN = (bf16_t*)(ws + ((l & 1) ? WS_CV : WS_CV2)); bf16_t* Z = (bf16_t*)(ws + WS_Z); bf16_t* HB = Z; \
    float* X = ap->out; \
    (void)WTN; (void)CKN; (void)CVN; (void)tid; (void)lane; (void)wave; (void)gw; (void)NGW; (void)gt; (void)NGT; (void)WT; (void)XB; (void)SSQ; (void)CK; (void)CV; (void)Z; (void)HB; (void)X;
#define IN(k) (lo <= (k) && (k) < hi)
#define GSYNC() do { if (!xposted) { grid.sync(); xbar = xcd_barrier_post(barw, (volatile LAS unsigned*)(lds + BARST_OFF)); xposted = true; } else xcd_barrier(xbar); } while (0)
#define SEAM(k) do { if (IN(k) && IN((k) + 1)) { GSYNC(); if (PROBE_REP == 9) GSYNC(); } } while (0)
#define REPS(k) for (int rep = (PROBE_REP == (k)) ? 0 : 1; rep < 2; ++rep)
#define REPSYNC() do { if (rep == 0) GSYNC(); } while (0)

#define CONVERT_LAYER(LC, WTD, CKD, CVD) do { \
            LAS float* scr = (LAS float*)(lds + wave * 16384); \
            constexpr int I_GU = 16 * 176, I_D = 44 * 32, I_IN = 16 * 160, I_C = 8 * 32, I_O = 16 * 32; \
            constexpr int NITEMS = 2 * I_GU + 2 * I_D + I_IN + 2 * I_C + I_O; \
            for (int it = gw; it < NITEMS; it += NGW) { \
                int r = it; \
                if (r < I_GU) { transpose_item(ap->w_ffn1_gu + (size_t)(LC) * DM * 2 * DFF, 2 * DFF, ap->norm_ffn1 + (LC) * DM, (WTD) + W_GU1, DM, 0, 0, r / 176, r % 176, (((r % 176) >> 2) & 1) * DFF + 128 * ((r % 176) >> 3) + 32 * ((r % 176) & 3), scr, lane); continue; } r -= I_GU; \
                if (r < I_GU) { transpose_item(ap->w_ffn2_gu + (size_t)(LC) * DM * 2 * DFF, 2 * DFF, ap->norm_ffn2 + (LC) * DM, (WTD) + W_GU2, DM, 0, 0, r / 176, r % 176, (((r % 176) >> 2) & 1) * DFF + 128 * ((r % 176) >> 3) + 32 * ((r % 176) & 3), scr, lane); continue; } r -= I_GU; \
                if (r < I_D) { transpose_item(ap->w_ffn1_down + (size_t)(LC) * DFF * DM, DM, nullptr, (WTD) + W_D1, DFF, 0, 0, r / 32, r % 32, 32 * (r % 32), scr, lane); continue; } r -= I_D; \
                if (r < I_D) { transpose_item(ap->w_ffn2_down + (size_t)(LC) * DFF * DM, DM, nullptr, (WTD) + W_D2, DFF, 0, 0, r / 32, r % 32, 32 * (r % 32), scr, lane); continue; } r -= I_D; \
                if (r < I_IN) { const int nb = r % 160, kb = r / 160, blk = nb >> 4; \
                    const int ob = (blk == 1) ? 3 : (blk == 2) ? 1 : (blk == 3) ? 2 : blk; \
                    transpose_item(ap->w_in + (size_t)(LC) * DM * INC, INC, ap->norm_mix + (LC) * DM, (WTD) + W_IN, DM, 0, 0, kb, nb, ob * 512 + 32 * (nb & 15), scr, lane); continue; } r -= I_IN; \
                if (r < I_C) { transpose_item(ap->w_conv_out + (size_t)(LC) * 512 * DM, DM, nullptr, (WTD) + W_CAT, DM, 0, 0, r / 32, r % 32, 32 * (r % 32), scr, lane); continue; } r -= I_C; \
                if (r < I_C) { transpose_item(ap->w_attn_out + (size_t)(LC) * 512 * DM, DM, nullptr, (WTD) + W_CAT, DM, 512, 0, r / 32, r % 32, 32 * (r % 32), scr, lane); continue; } r -= I_C; \
                transpose_item(ap->w_o + (size_t)(LC) * DM * DM, DM, nullptr, (WTD) + W_O, DM, 0, 0, r / 32, r % 32, 32 * (r % 32), scr, lane); \
            } \
 \
            for (int i = gt; i < 2 * (NBATCH * 512 * 512 / 8); i += NGT) { \
                const int which = i / (NBATCH * 512 * 512 / 8), e = (i % (NBATCH * 512 * 512 / 8)) * 8; \
                const float* src = (which ? ap->cache_v : ap->cache_k) + (size_t)(LC) * NBATCH * 512 * 512 + e; \
                const f32x4 v0 = *(const f32x4*)src, v1 = *(const f32x4*)(src + 4); \
                u32x4 w; w.x = pk2(v0[0], v0[1]); w.y = pk2(v0[2], v0[3]); w.z = pk2(v1[0], v1[1]); w.w = pk2(v1[2], v1[3]); \
                *(u32x4*)((which ? (CVD) : (CKD)) + e) = w; \
            } \
} while (0)

#pragma unroll 1
    for (int l = 0; l < DEPTH; ++l) {
        const int pb = 9 * l;
        if (l == 0 && IN(pb + 0)) REPS(0) { PHASE_VARS
            CONVERT_LAYER(0, WT, CK, CV);
            if (l == 0) {
                for (int m = gw; m < MPAD; m += NGW) {
                    bf16_t* xb = XB + (size_t)m * DM; float* sq = SSQ + (size_t)m * 16;
                    if (m < MR) {
                        const float* src = (m < MP) ? ap->x_prompt + (size_t)m * DM : ap->x_sample + (size_t)(m - MP) * DM;
                        float s = 0.f;
#pragma unroll
                        for (int j = 0; j < 4; ++j) { const f32x4 v = *(const f32x4*)(src + 256 * j + 4 * lane);
                            u32x2 w; w.x = pk2(v[0], v[1]); w.y = pk2(v[2], v[3]); *(u32x2*)(xb + 256 * j + 4 * lane) = w; s += (v[0] * v[0] + v[1] * v[1]) + (v[2] * v[2] + v[3] * v[3]); }
                        s = wave_sum(s);
                        if (lane < 16) sq[lane] = (lane == 0) ? s : 0.f;
                    } else {
#pragma unroll
                        for (int j = 0; j < 4; ++j) *(u32x2*)(xb + 256 * j + 4 * lane) = (u32x2){0u, 0u};
                        if (lane < 16) sq[lane] = 0.f;
                    }
                }
            }
        REPSYNC(); }
        if (l == 0) SEAM(pb + 0);
        if (IN(pb + 1)) REPS(1) { PHASE_VARS
            pg8::Gemm g{XB, WT + W_GU1, DM, DM, DM, 0, 0}; pg8::StaticOrder S; S.init(NTM, 2 * DFF / 256, G, bx, 1);
            EpiUp E{HB, SSQ};
            small_gemm<1, 4, EpiUp, true>(lds, XB, XB, DM, WT + W_GU1, WT + W_GU1, DM, 2 * DFF / 64, E, bx, G, wave, lane);
            pg8::gemm_phase<EpiUp>(lds, g, S, E, tid);
        REPSYNC(); }
        SEAM(pb + 1);
        if (IN(pb + 2)) REPS(2) { PHASE_VARS
            pg8::Gemm g{HB, WT + W_D1, DFF, DFF, DFF, 0, 0}; pg8::StaticOrder S; S.init(NTM, DM / 256, G, bx, 1);
            EpiRes E{XB, SSQ, rep ? 0.5f : 0.0f};
            small_gemm<1, 11, EpiRes>(lds, HB, HB, DFF, WT + W_D1, WT + W_D1, DFF, DM / 64, E, bx, G, wave, lane);
            pg8::gemm_phase<EpiRes>(lds, g, S, E, tid);
        REPSYNC(); }
        SEAM(pb + 2);
        if (IN(pb + 3)) REPS(3) { PHASE_VARS
            pg8::Gemm g{XB, WT + W_IN, DM, DM, DM, 0, 0}; pg8::StaticOrder S; S.init(NTM, INC / 256, G, bx, 1);
            EpiIn E{Z, SSQ, ap->b_gate + (size_t)l * 2 * DM, ap->out + O_KP + (size_t)l * NBATCH * 512 * 512, ap->out + O_VP + (size_t)l * NBATCH * 512 * 512,
                    ap->out + O_KS + (size_t)l * MS * 512, ap->out + O_VS + (size_t)l * MS * 512};
            small_gemm<1, 4, EpiIn>(lds, XB, XB, DM, WT + W_IN, WT + W_IN, DM, INC / 64, E, bx, G, wave, lane);
            pg8::gemm_phase<EpiIn>(lds, g, S, E, tid);
        REPSYNC(); }
        SEAM(pb + 3);
        if (IN(pb + 4)) REPS(4) { PHASE_VARS
            LAS float* rbl = (LAS float*)(lds + RB_OFF);
            for (int i = tid; i < NH * NREL; i += NWAVES * 64) { const int h = i / NREL, j = i - h * NREL; rbl[h * 264 + j] = ap->rel_bias[(size_t)l * NH * NREL + i] * LOG2E; }
            __syncthreads();
            LAS unsigned char* vbuf = lds + wave * 16384;
#pragma unroll 1
            for (int u = gw; u < 4096; u += NGW) {
                const int c = u & 63, h = (u >> 6) & 7, b = u >> 9;
                const int jlo = (c > 8) ? c - 8 : 0;
                const bf16_t* base = Z + (size_t)(b * SEQ) * INC + h * 64;
                auto tf = [&](int j) { TileD td; const size_t ro = (size_t)(64 * (jlo + j)) * INC; td.K = base + ro + ZC_K; td.V = base + ro + ZC_V; td.pitch = INC; td.nkeys = 64; td.delta0 = 64 * (c - jlo - j); return td; };
                bf16_t* qp = Z + (size_t)(b * SEQ + 64 * c) * INC + ZC_Q + h * 64;
                bf16_t* op = rep ? qp : XB + (size_t)(b * SEQ + 64 * c) * DM + h * 64;
                attn_wave<4>(qp, op, INC, rep ? INC : DM, c - jlo + 1, tf, vbuf, rbl + h * 264, lane);
            }
            { int l2 = lane; asm volatile("" : "+v"(l2)); asm volatile("" : "+s"(Z), "+s"(CK), "+s"(CV));
#pragma unroll 1
            for (int us = ((gw & 31) == 31) ? (gw >> 5) : 64; us < 64; us += 64) {
                const int h = us & 7, b = us >> 3;
                const bf16_t* zrow = Z + (size_t)(MP + 16 * b) * INC + h * 64;
                auto tf = [&](int j) { TileD td;
                    if (j < 8) { const size_t ro = (size_t)(b * 512 + 64 * j) * 512 + h * 64; td.K = CK + ro; td.V = CV + ro; td.pitch = 512; td.nkeys = 64; td.delta0 = 512 - 64 * j; }
                    else { td.K = zrow + ZC_K; td.V = zrow + ZC_V; td.pitch = INC; td.nkeys = 16; td.delta0 = 0; }
                    return td; };
                bf16_t* qp = Z + (size_t)(MP + 16 * b) * INC + ZC_Q + h * 64;
                bf16_t* op = rep ? qp : XB + (size_t)(16 * b) * DM + h * 64;
                attn_wave<1>(qp, op, INC, rep ? INC : DM, 9, tf, vbuf, rbl + h * 264, l2);
            } }
            for (int cu = (NGW - 1 - gw); cu < MR / 16; cu += NGW) {
                const int row0 = cu * 16, ch = 8 * lane;
                const bool samp = (row0 >= MP);
                const int bb = samp ? (row0 - MP) / 16 : (row0 >> 12), t0 = samp ? 0 : (row0 & 4095);
                float w0[8], w1[8], w2[8], um2[8], um1[8];
                { const float* wc = ap->w_conv + (size_t)l * 3 * 512 + ch;
#pragma unroll
                  for (int i = 0; i < 8; ++i) { w0[i] = wc[i]; w1[i] = wc[512 + i]; w2[i] = wc[1024 + i]; } }
                if (samp) { const float* sc = ap->state_conv + ((size_t)(l * NBATCH + bb) * 2) * 512 + ch;
#pragma unroll
                    for (int i = 0; i < 8; ++i) { um2[i] = sc[i]; um1[i] = sc[512 + i]; }
                } else if (t0 == 0) {
#pragma unroll
                    for (int i = 0; i < 8; ++i) { um2[i] = 0.f; um1[i] = 0.f; }
                } else {
                    const bf16_t* z2 = Z + (size_t)(row0 - 2) * INC + ch; const bf16_t* z1 = Z + (size_t)(row0 - 1) * INC + ch;
                    const u32x4 c2 = *(const u32x4*)(z2 + ZC_CC), v2 = *(const u32x4*)(z2 + ZC_CV), c1 = *(const u32x4*)(z1 + ZC_CC), v1 = *(const u32x4*)(z1 + ZC_CV);
#pragma unroll
                    for (int i = 0; i < 4; ++i) { um2[2 * i] = bf_lo(c2[i]) * bf_lo(v2[i]); um2[2 * i + 1] = bf_hi(c2[i]) * bf_hi(v2[i]); um1[2 * i] = bf_lo(c1[i]) * bf_lo(v1[i]); um1[2 * i + 1] = bf_hi(c1[i]) * bf_hi(v1[i]); }
                }
#pragma unroll 8
                for (int r = 0; r < 16; ++r) {
                    bf16_t* zr = Z + (size_t)(row0 + r) * INC + ch;
                    const u32x4 cbw = *(const u32x4*)(zr + ZC_CB), ccw = *(const u32x4*)(zr + ZC_CC), cvw = *(const u32x4*)(zr + ZC_CV);
                    float y[8];
#pragma unroll
                    for (int i = 0; i < 4; ++i) {
                        const float u0 = bf_lo(ccw[i]) * bf_lo(cvw[i]), u1 = bf_hi(ccw[i]) * bf_hi(cvw[i]);
                        y[2 * i] = bf_lo(cbw[i]) * (w0[2 * i] * um2[2 * i] + w1[2 * i] * um1[2 * i] + w2[2 * i] * u0);
                        y[2 * i + 1] = bf_hi(cbw[i]) * (w0[2 * i + 1] * um2[2 * i + 1] + w1[2 * i + 1] * um1[2 * i + 1] + w2[2 * i + 1] * u1);
                        um2[2 * i] = um1[2 * i]; um1[2 * i] = u0; um2[2 * i + 1] = um1[2 * i + 1]; um1[2 * i + 1] = u1;
                    }
                    u32x4 w; w.x = cvt_pk_bf16(y[0], y[1]); w.y = cvt_pk_bf16(y[2], y[3]); w.z = cvt_pk_bf16(y[4], y[5]); w.w = cvt_pk_bf16(y[6], y[7]);
                    *(u32x4*)(rep ? zr + ZC_CB : XB + (size_t)(row0 + r) * DM + 512 + ch) = w;
                }
                if (samp || t0 == SEQ - 16) {
                    float* dst = ap->out + (samp ? O_CS : O_CP) + ((size_t)(l * NBATCH + bb) * 2) * 512 + ch;
                    *(f32x4*)dst = (f32x4){um2[0], um2[1], um2[2], um2[3]}; *(f32x4*)(dst + 4) = (f32x4){um2[4], um2[5], um2[6], um2[7]};
                    *(f32x4*)(dst + 512) = (f32x4){um1[0], um1[1], um1[2], um1[3]}; *(f32x4*)(dst + 516) = (f32x4){um1[4], um1[5], um1[6], um1[7]};
                }
            }
            if (rep && l + 1 < DEPTH) { asm volatile("s_waitcnt vmcnt(0) lgkmcnt(0)" ::: "memory"); asm volatile("" : "+s"(ap)); CONVERT_LAYER(l + 1, WTN, CKN, CVN); }
            asm volatile("s_waitcnt vmcnt(0) lgkmcnt(0)" ::: "memory");
            __syncthreads();
        REPSYNC(); }
        SEAM(pb + 4);
        if (IN(pb + 5)) REPS(5) { PHASE_VARS
            pg8::Gemm g{Z, WT + W_CAT, INC, DM, 512, 512 * 2, 512 * 2}; pg8::StaticOrder S; S.init(NTM, DM / 256, G, bx, 2);
            EpiMix E{Z};
            small_gemm<2, 2, EpiMix>(lds, Z + ZC_CB, Z + ZC_Q, INC, WT + W_CAT, WT + W_CAT + 512, DM, DM / 64, E, bx, G, wave, lane);
            pg8::gemm_phase<EpiMix>(lds, g, S, E, tid);
        REPSYNC(); }
        SEAM(pb + 5);
        if (IN(pb + 6)) REPS(6) { PHASE_VARS
            pg8::Gemm g{Z + ZC_MB, WT + W_O, INC, DM, DM, 0, 0}; pg8::StaticOrder S; S.init(NTM, DM / 256, G, bx, 1);
            EpiRes E{XB, SSQ, rep ? 1.0f : 0.0f};
            small_gemm<1, 4, EpiRes>(lds, Z + ZC_MB, Z + ZC_MB, INC, WT + W_O, WT + W_O, DM, DM / 64, E, bx, G, wave, lane);
            pg8::gemm_phase<EpiRes>(lds, g, S, E, tid);
        REPSYNC(); }
        SEAM(pb + 6);
        if (IN(pb + 7)) REPS(7) { PHASE_VARS
            pg8::Gemm g{XB, WT + W_GU2, DM, DM, DM, 0, 0}; pg8::StaticOrder S; S.init(NTM, 2 * DFF / 256, G, bx, 1);
            EpiUp E{HB, SSQ};
            small_gemm<1, 4, EpiUp, true>(lds, XB, XB, DM, WT + W_GU2, WT + W_GU2, DM, 2 * DFF / 64, E, bx, G, wave, lane);
            pg8::gemm_phase<EpiUp>(lds, g, S, E, tid);
        REPSYNC(); }
        SEAM(pb + 7);
        if (IN(pb + 8)) REPS(8) { PHASE_VARS
            pg8::Gemm g{HB, WT + W_D2, DFF, DFF, DFF, 0, 0}; pg8::StaticOrder S; S.init(NTM, DM / 256, G, bx, 1);
            EpiRes E{XB, SSQ, rep ? 0.5f : 0.0f};
            small_gemm<1, 11, EpiRes>(lds, HB, HB, DFF, WT + W_D2, WT + W_D2, DFF, DM / 64, E, bx, G, wave, lane);
            pg8::gemm_phase<EpiRes>(lds, g, S, E, tid);
        REPSYNC(); }
        SEAM(pb + 8);
    }
    if (IN(36)) { const int l = 0; PHASE_VARS
        for (int m = gw; m < MR; m += NGW) {
            float* yr = X + (size_t)m * DM; const bf16_t* xb = XB + (size_t)m * DM;
            const float sv = (lane < 16) ? SSQ[(size_t)m * 16 + lane] : 0.f;
            const float rs = __builtin_amdgcn_rsqf(wave_sum(sv) * (1.0f / 1024.0f) + EPS);
#pragma unroll
            for (int j = 0; j < 4; ++j) { const u32x2 o = *(const u32x2*)(xb + 256 * j + 4 * lane); const f32x4 v = (f32x4){bf_lo(o.x), bf_hi(o.x), bf_lo(o.y), bf_hi(o.y)}, gn = *(const f32x4*)(ap->norm_final + 256 * j + 4 * lane); *(f32x4*)(yr + 256 * j + 4 * lane) = v * rs * gn; }
        }
    }
#undef IN
#undef SEAM
}

extern "C" void kernel_launch(void* const* d_in, const int* in_sizes, int n_in, void* d_out, int out_size, void* d_ws, size_t ws_size, hipStream_t stream) {
    static int grid = 0;
    if (grid == 0) {
        if (n_in != 20 || (size_t)out_size != O_END || ws_size < WS_END) { fprintf(stderr, "kernel_launch: unexpected shapes: n_in %d out %d (want %zu) ws %zu (need %zu)\n", n_in, out_size, (size_t)O_END, ws_size, (size_t)WS_END); grid = -1; return; }
        int dev = 0, cus = 0, per_cu = 0;
        hipGetDevice(&dev); hipDeviceGetAttribute(&cus, hipDeviceAttributeMultiprocessorCount, dev);
        if (hipFuncSetAttribute((const void*)mega_fwd, hipFuncAttributeMaxDynamicSharedMemorySize, LDS_BYTES) != hipSuccess) { fprintf(stderr, "kernel_launch: hipFuncSetAttribute failed\n"); grid = -1; return; }
        if (hipOccupancyMaxActiveBlocksPerMultiprocessor(&per_cu, (const void*)mega_fwd, NWAVES * 64, LDS_BYTES) != hipSuccess || per_cu < 1) { fprintf(stderr, "kernel_launch: occupancy query says %d\n", per_cu); per_cu = 1; }
        (void)hipGetLastError();
        grid = cus;
    }
    if (grid < 0) return;
    Args a{};
    const float** ap = (const float**)&a;
    for (int i = 0; i < 20; ++i) ap[i] = (const float*)d_in[i];
    a.out = (float*)d_out; a.ws = (unsigned char*)d_ws; a.ph_lo = 0; a.ph_hi = 37;
    void* args[] = {&a};
    hipError_t e = hipLaunchCooperativeKernel((const void*)mega_fwd, dim3(grid), dim3(NWAVES * 64), args, LDS_BYTES, stream);
    if (e != hipSuccess) fprintf(stderr, "kernel_launch: cooperative launch failed: %s (grid %d)\n", hipGetErrorString(e), grid);
}
```

```cpp
#include <hip/hip_runtime.h>
#include <hip/hip_cooperative_groups.h>
#include <cstdio>
#include <cstdint>
namespace cg = cooperative_groups;
#ifndef PROBE_REP
#define PROBE_REP (-1)
#endif
#ifndef PROBE_EPI
#define PROBE_EPI 0
#endif

#define LAS __attribute__((address_space(3)))
typedef unsigned short bf16_t;
typedef short bf16x8 __attribute__((ext_vector_type(8)));
typedef short s16x4 __attribute__((ext_vector_type(4)));
typedef float f32x4 __attribute__((ext_vector_type(4)));
typedef unsigned u32x4 __attribute__((ext_vector_type(4)));
typedef unsigned u32x2 __attribute__((ext_vector_type(2)));

constexpr int DM = 1024, NBATCH = 8, SEQ = 4096, DEPTH = 4, DSEQ = 16;
constexpr int NH = 8, DFF = 2816, INC = 5120, NREL = 257;
constexpr int MP = NBATCH * SEQ;
constexpr int MS = NBATCH * DSEQ;
constexpr int MR = MP + MS;
constexpr int MPAD = 33024;
constexpr int NTM = MP / 256;
constexpr float EPS = 1e-6f;
constexpr float LOG2E = 1.4426950408889634f;
constexpr float QSCALE = 0.125f * LOG2E;
constexpr int ZC_CB = 0, ZC_Q = 512, ZC_CC = 1024, ZC_CV = 1536, ZC_K = 2048, ZC_V = 2560, ZC_GC = 3072, ZC_GA = 4096, ZC_MB = 1024;

constexpr size_t O_Y = 0;
constexpr size_t O_KP = (size_t)MR * DM;
constexpr size_t O_VP = O_KP + (size_t)DEPTH * NBATCH * 512 * 512;
constexpr size_t O_CP = O_VP + (size_t)DEPTH * NBATCH * 512 * 512;
constexpr size_t O_KS = O_CP + (size_t)DEPTH * NBATCH * 2 * 512;
constexpr size_t O_VS = O_KS + (size_t)DEPTH * NBATCH * DSEQ * 512;
constexpr size_t O_CS = O_VS + (size_t)DEPTH * NBATCH * DSEQ * 512;
constexpr size_t O_END = O_CS + (size_t)DEPTH * NBATCH * 2 * 512;

constexpr size_t W_GU1 = 0;
constexpr size_t W_D1 = W_GU1 + (size_t)2 * DFF * DM;
constexpr size_t W_IN = W_D1 + (size_t)DM * DFF;
constexpr size_t W_CAT = W_IN + (size_t)INC * DM;
constexpr size_t W_O = W_CAT + (size_t)DM * DM;
constexpr size_t W_GU2 = W_O + (size_t)DM * DM;
constexpr size_t W_D2 = W_GU2 + (size_t)2 * DFF * DM;
constexpr size_t W_TOTAL = W_D2 + (size_t)DM * DFF;

constexpr size_t WS_WT = 0;
constexpr size_t WS_XB = WS_WT + ((W_TOTAL * 2 + 4095) / 4096) * 4096;
constexpr size_t WS_SSQ = WS_XB + (size_t)MPAD * DM * 2;
constexpr size_t WS_CK = WS_SSQ + (size_t)MPAD * 16 * 4;
constexpr size_t WS_CV = WS_CK + (size_t)NBATCH * 512 * 512 * 2;
constexpr size_t WS_Z = WS_CV + (size_t)NBATCH * 512 * 512 * 2;
constexpr size_t WS_WT2 = WS_Z + (size_t)MPAD * INC * 2;
constexpr size_t WS_BAR = WS_WT2 + ((W_TOTAL * 2 + 4095) / 4096) * 4096;
constexpr size_t WS_CK2 = WS_BAR + 16384;
constexpr size_t WS_CV2 = WS_CK2 + (size_t)NBATCH * 512 * 512 * 2;
constexpr size_t WS_END = WS_CV2 + (size_t)NBATCH * 512 * 512 * 2;

constexpr int NWAVES = 8;
constexpr int RING_BYTES = 131072;
constexpr int RB_OFF = RING_BYTES + 1024;
constexpr int LDS_BYTES = 147456;
constexpr int BARST_OFF = LDS_BYTES - 64;

__device__ __forceinline__ unsigned cvt_pk_bf16(float lo, float hi) { unsigned r; asm volatile("v_cvt_pk_bf16_f32 %0, %1, %2" : "=v"(r) : "v"(lo), "v"(hi)); return r; }
__device__ __forceinline__ float bf_lo(unsigned w) { return __uint_as_float(w << 16); }
__device__ __forceinline__ float bf_hi(unsigned w) { return __uint_as_float(w & 0xffff0000u); }
__device__ __forceinline__ unsigned f2bf(float f) { unsigned u = __float_as_uint(f); return (u + 0x7fffu + ((u >> 16) & 1u)) >> 16; }
__device__ __forceinline__ unsigned pk2(float lo, float hi) { return f2bf(lo) | (f2bf(hi) << 16); }
__device__ __forceinline__ float fast_sigmoid(float x) { return __builtin_amdgcn_rcpf(1.0f + __builtin_amdgcn_exp2f(-x * LOG2E)); }

namespace pg8 {
constexpr int BM = 256, BK = 64, HALF = 128, HTB = HALF * BK * 2, STAGE_BYTES = 8 * HTB, NXCD = 8, WGM = 8;
__host__ __device__ __forceinline__ int lds_byte(int r, int c) { const int st = (r >> 4) * 2 + (c >> 5), rr = r & 15, cc = c & 31, ob = rr * 64 + cc * 2; return st * 1024 + (ob ^ (((ob >> 9) & 1) << 5)); }
__host__ __device__ __forceinline__ void stage_rc(int b, int& R, int& C) { const int st = b / 1024, sb = b % 1024, swz = sb ^ (((sb >> 9) & 1) << 5); R = (st >> 1) * 16 + swz / 64; C = (st & 1) * 32 + (swz % 64) / 2; }
__host__ __device__ __forceinline__ int perm32(int rho) { const int n = rho >> 4, i = rho & 15; return 8 * (i >> 2) + 4 * n + (i & 3); }

struct Unit { int pm, pn, z; };
struct Gemm { const bf16_t* A; const bf16_t* Bt; int lda, ldb, K; long zA, zB; };

struct StaticOrder {
    int nM, nN, nwg, G, c, nz;
    __device__ void init(int nM_, int nN_, int G_, int c_, int nz_) { nM = nM_; nN = nN_; nwg = nM * nN; G = G_; c = c_; nz = nz_; }
    __device__ bool next(int i, Unit& u) const {
        const int it = i / nz; u.z = i - it * nz;
        const long L = (long)it * G + c; if (L >= nwg) return false;
        int wgid = (int)L; { const int q = nwg / NXCD, r = nwg % NXCD, xcd = wgid % NXCD, off = wgid / NXCD; wgid = (xcd < r ? xcd * (q + 1) : r * (q + 1) + (xcd - r) * q) + off; }
        const int nig = WGM * nN, gid = wgid / nig, fm = gid * WGM, gsz = (nM - fm) < WGM ? (nM - fm) : WGM;
        u.pm = fm + ((wgid % nig) % gsz); u.pn = (wgid % nig) / gsz; return true;
    }
};

template <class Epi>
__device__ __forceinline__ void gemm_phase(LAS unsigned char* lds, const Gemm g, const StaticOrder& S, const Epi& E, const int tid) {
    const int wid = __builtin_amdgcn_readfirstlane(tid >> 6), lane = tid & 63, wr = wid >> 2, wc = wid & 3, fr = lane & 15, fq = lane >> 4;
    const int K = g.K, nt = K / BK;
    unsigned voffA[2], voffB[2];
#pragma unroll
    for (int i = 0; i < 2; ++i) { int R, C; stage_rc(tid * 16 + i * 8192, R, C); const int Rb = (R & ~31) + perm32(R & 31);
        voffA[i] = (unsigned)(R * g.lda + C) * 2u; voffB[i] = (unsigned)(Rb * g.ldb + C) * 2u; }
    const size_t kstep = (size_t)(BK * 2);
    const size_t hstepA = (size_t)HALF * g.lda * 2, hstepB = (size_t)HALF * g.ldb * 2;
    const size_t tstepA = 2 * hstepA, tstepB = 2 * hstepB;
    const unsigned ldsw = (unsigned)wid * 1024u;
    const int aoff = lds_byte(wr * 64 + fr, fq * 8), boff = lds_byte(wc * 32 + fr, fq * 8);
#define PG8_SA(b, h) (((b) * 2 + (h)) * HTB)
#define PG8_SB(b, h) ((4 + (b) * 2 + (h)) * HTB)
#define PG8_STAGE(bufoff, gbase, voff) do { _Pragma("unroll") for (int _i = 0; _i < 2; ++_i) \
        __builtin_amdgcn_global_load_lds((const unsigned*)((const char*)(gbase) + (voff)[_i]), (LAS unsigned*)(lds + (bufoff) + ldsw + _i * 8192), 16, 0, 0); } while (0)
#define PG8_LDA(dst, b, h) do { _Pragma("unroll") for (int m = 0; m < 4; ++m) _Pragma("unroll") for (int k = 0; k < 2; ++k) dst[m][k] = *(const LAS bf16x8*)(lds + PG8_SA(b, h) + aoff + m * 2048 + k * 1024); } while (0)
#define PG8_LDB(dst, b, h) do { _Pragma("unroll") for (int n = 0; n < 2; ++n) _Pragma("unroll") for (int k = 0; k < 2; ++k) dst[n][k] = *(const LAS bf16x8*)(lds + PG8_SB(b, h) + boff + n * 2048 + k * 1024); } while (0)
#define PG8_MMA(ai, bj, At, Bt) do { __builtin_amdgcn_s_setprio(1); _Pragma("unroll") for (int m = 0; m < 4; ++m) _Pragma("unroll") for (int n = 0; n < 2; ++n) _Pragma("unroll") for (int k = 0; k < 2; ++k) \
        acc[ai][bj][m][n] = __builtin_amdgcn_mfma_f32_16x16x32_bf16(Bt[n][k], At[m][k], acc[ai][bj][m][n], 0, 0, 0); __builtin_amdgcn_s_setprio(0); } while (0)
#define PG8_WAIT_V(n) asm volatile("s_waitcnt vmcnt(" #n ")" ::: "memory")
#define PG8_WAIT_L(n) asm volatile("s_waitcnt lgkmcnt(" #n ")" ::: "memory")
#define PG8_BAR __builtin_amdgcn_s_barrier()
#define PG8_SCHED __builtin_amdgcn_sched_barrier(0)
    Unit cur, nxt; int ui = 0;
    if (!S.next(0, cur)) return;
    f32x4 acc[2][2][4][2];
#pragma unroll
    for (int a = 0; a < 2; ++a)
#pragma unroll
        for (int b = 0; b < 2; ++b)
#pragma unroll
            for (int m = 0; m < 4; ++m)
#pragma unroll
                for (int n = 0; n < 2; ++n) acc[a][b][m][n] = (f32x4){0.f, 0.f, 0.f, 0.f};
    bf16x8 At[4][2], B0[2][2], B1[2][2];
    const char* cA = (const char*)g.A + (size_t)cur.pm * tstepA + (size_t)cur.z * g.zA; const char* cB = (const char*)g.Bt + (size_t)cur.pn * tstepB + (size_t)cur.z * g.zB;
    PG8_STAGE(PG8_SB(0, 0), cB, voffB); PG8_STAGE(PG8_SB(0, 1), cB + hstepB, voffB); PG8_STAGE(PG8_SA(0, 0), cA, voffA); PG8_STAGE(PG8_SA(0, 1), cA + hstepA, voffA);
    if (wr == 1) PG8_BAR;
    PG8_WAIT_V(2); PG8_BAR;
    PG8_STAGE(PG8_SB(1, 0), cB + kstep, voffB); PG8_STAGE(PG8_SA(1, 0), cA + kstep, voffA); PG8_STAGE(PG8_SB(1, 1), cB + hstepB + kstep, voffB);
    PG8_WAIT_V(6); PG8_BAR;
    for (;;) {
        const bool has_next = S.next(ui + 1, nxt);
        const char* nA = has_next ? (const char*)g.A + (size_t)nxt.pm * tstepA + (size_t)nxt.z * g.zA : cA; const char* nB = has_next ? (const char*)g.Bt + (size_t)nxt.pn * tstepB + (size_t)nxt.z * g.zB : cB;
        for (int t = 0; t < nt; t += 2) {
            const bool last = (t == nt - 2);
            const char* a1 = cA + (size_t)(t + 1) * kstep;
            const char* a2 = last ? nA : cA + (size_t)(t + 2) * kstep; const char* b2 = last ? nB : cB + (size_t)(t + 2) * kstep;
            const char* a3 = a2 + kstep; const char* b3 = b2 + kstep;
            PG8_LDB(B0, 0, 0); PG8_LDB(B1, 0, 1); PG8_SCHED; PG8_LDA(At, 0, 0); PG8_STAGE(PG8_SA(1, 1), a1 + hstepA, voffA);
            PG8_WAIT_V(8); PG8_WAIT_L(0); PG8_BAR; PG8_MMA(0, 0, At, B0); PG8_MMA(0, 1, At, B1); PG8_BAR; PG8_SCHED;
            PG8_LDA(At, 0, 1); PG8_STAGE(PG8_SB(0, 0), b2, voffB); PG8_STAGE(PG8_SB(0, 1), b2 + hstepB, voffB); PG8_STAGE(PG8_SA(0, 0), a2, voffA);
            PG8_WAIT_V(8); PG8_WAIT_L(0); PG8_BAR; PG8_MMA(1, 0, At, B0); PG8_MMA(1, 1, At, B1); PG8_BAR; PG8_SCHED;
            PG8_LDB(B0, 1, 0); PG8_LDB(B1, 1, 1); PG8_SCHED; PG8_LDA(At, 1, 0); PG8_STAGE(PG8_SA(0, 1), a2 + hstepA, voffA);
            PG8_WAIT_V(8); PG8_WAIT_L(0); PG8_BAR; PG8_MMA(0, 0, At, B0); PG8_MMA(0, 1, At, B1); PG8_BAR; PG8_SCHED;
            PG8_LDA(At, 1, 1); PG8_STAGE(PG8_SB(1, 0), b3, voffB); PG8_STAGE(PG8_SB(1, 1), b3 + hstepB, voffB); PG8_STAGE(PG8_SA(1, 0), a3, voffA);
            PG8_WAIT_V(8); PG8_WAIT_L(0); PG8_BAR; PG8_MMA(1, 0, At, B0); PG8_MMA(1, 1, At, B1); PG8_BAR; PG8_SCHED;
        }
        if (wr == 0) PG8_BAR;
        E(acc, cur, wr, wc, fr, fq);
        if (PROBE_EPI == Epi::PROBE_ID) { const Epi E2 = E.probe_copy(); E2(acc, cur, wr, wc, fr, fq); }
        if (!has_next) break;
#pragma unroll
        for (int a = 0; a < 2; ++a)
#pragma unroll
            for (int b = 0; b < 2; ++b)
#pragma unroll
                for (int m = 0; m < 4; ++m)
#pragma unroll
                    for (int n = 0; n < 2; ++n) acc[a][b][m][n] = (f32x4){0.f, 0.f, 0.f, 0.f};
        cur = nxt; cA = nA; cB = nB; ++ui;
        if (wr == 1) PG8_BAR;
    }
    PG8_WAIT_V(0);
    PG8_BAR;
#undef PG8_SA
#undef PG8_SB
#undef PG8_STAGE
#undef PG8_LDA
#undef PG8_LDB
#undef PG8_MMA
#undef PG8_WAIT_V
#undef PG8_WAIT_L
#undef PG8_BAR
#undef PG8_SCHED
}
}

__device__ __forceinline__ float row_rs(const float* ssq, int row, int fq) {
    const f32x4 v = *(const f32x4*)(ssq + (size_t)row * 16 + 4 * fq);
    float s = (v[0] + v[1]) + (v[2] + v[3]);
    s += __shfl_xor(s, 16); s += __shfl_xor(s, 32);
    return __builtin_amdgcn_rsqf(s * (1.0f / 1024.0f) + EPS);
}

struct EpiUp {
    static constexpr int PROBE_ID = 1; __device__ __forceinline__ EpiUp probe_copy() const { return *this; }
    bf16_t* H; const float* ssq;
    __device__ __forceinline__ void operator()(const f32x4 (&acc)[2][2][4][2], const pg8::Unit& u, int wr, int wc, int fr, int fq) const {
        const int row0 = u.pm * 256 + wr * 64 + fr, hc0 = u.pn * 128 + wc * 32 + 8 * fq;
#pragma unroll
        for (int ai = 0; ai < 2; ++ai)
#pragma unroll
            for (int m = 0; m < 4; ++m) {
                const int row = row0 + ai * 128 + m * 16; const float rs = row_rs(ssq, row, fq);
                float h[8];
#pragma unroll
                for (int n = 0; n < 2; ++n) {
                    const f32x4 gg = acc[ai][0][m][n] * rs, uu = acc[ai][1][m][n] * rs;
#pragma unroll
                    for (int i = 0; i < 4; ++i) h[4 * n + i] = gg[i] * fast_sigmoid(gg[i]) * uu[i];
                }
                u32x4 w; w.x = cvt_pk_bf16(h[0], h[1]); w.y = cvt_pk_bf16(h[2], h[3]); w.z = cvt_pk_bf16(h[4], h[5]); w.w = cvt_pk_bf16(h[6], h[7]);
                *(u32x4*)(H + (size_t)row * DFF + hc0) = w;
            }
    }
    __device__ __forceinline__ void small(const f32x4 (&acc)[1][2][2], int row, int h0, int fr, int fq) const {
        const float rs = row_rs(ssq, row, fq); float h[8];
#pragma unroll
        for (int n = 0; n < 2; ++n) {
            const f32x4 gg = acc[0][0][n] * rs, uu = acc[0][1][n] * rs;
#pragma unroll
            for (int i = 0; i < 4; ++i) h[4 * n + i] = gg[i] * fast_sigmoid(gg[i]) * uu[i];
        }
        u32x4 w; w.x = cvt_pk_bf16(h[0], h[1]); w.y = cvt_pk_bf16(h[2], h[3]); w.z = cvt_pk_bf16(h[4], h[5]); w.w = cvt_pk_bf16(h[6], h[7]);
        *(u32x4*)(H + (size_t)row * DFF + h0 + 8 * fq) = w;
    }
};

struct EpiRes {
    static constexpr int PROBE_ID = 2; __device__ __forceinline__ EpiRes probe_copy() const { EpiRes e = *this; e.scale = 0.f; return e; }
    bf16_t* XB; float* ssq; float scale;
    __device__ __forceinline__ void operator()(const f32x4 (&acc)[2][2][4][2], const pg8::Unit& u, int wr, int wc, int fr, int fq) const {
        const int row0 = u.pm * 256 + wr * 64 + fr, col0 = u.pn * 256 + wc * 32 + 8 * fq;
#pragma unroll
        for (int ai = 0; ai < 2; ++ai) {
            u32x4 xw[4][2];
#pragma unroll
            for (int m = 0; m < 4; ++m)
#pragma unroll
                for (int bj = 0; bj < 2; ++bj) xw[m][bj] = *(const u32x4*)(XB + (size_t)(row0 + ai * 128 + m * 16) * DM + col0 + bj * 128);
#pragma unroll
            for (int m = 0; m < 4; ++m) {
                const int row = row0 + ai * 128 + m * 16; float s = 0.f;
#pragma unroll
                for (int bj = 0; bj < 2; ++bj) {
                    const u32x4 o = xw[m][bj];
                    f32x4 x0 = (f32x4){bf_lo(o.x), bf_hi(o.x), bf_lo(o.y), bf_hi(o.y)}, x1 = (f32x4){bf_lo(o.z), bf_hi(o.z), bf_lo(o.w), bf_hi(o.w)};
                    x0 += acc[ai][bj][m][0] * scale; x1 += acc[ai][bj][m][1] * scale;
                    u32x4 w; w.x = cvt_pk_bf16(x0[0], x0[1]); w.y = cvt_pk_bf16(x0[2], x0[3]); w.z = cvt_pk_bf16(x1[0], x1[1]); w.w = cvt_pk_bf16(x1[2], x1[3]);
                    *(u32x4*)(XB + (size_t)row * DM + col0 + bj * 128) = w;
                    s += (x0[0] * x0[0] + x0[1] * x0[1]) + (x0[2] * x0[2] + x0[3] * x0[3]) + (x1[0] * x1[0] + x1[1] * x1[1]) + (x1[2] * x1[2] + x1[3] * x1[3]);
                }
                s += __shfl_xor(s, 16); s += __shfl_xor(s, 32);
                if (fq == 0) ssq[(size_t)row * 16 + u.pn * 4 + wc] = s;
            }
        }
    }
    __device__ __forceinline__ void small(const f32x4 (&acc)[1][2][2], int row, int c0, int fr, int fq) const {
        float s = 0.f;
#pragma unroll
        for (int j = 0; j < 2; ++j) {
            bf16_t* xp = XB + (size_t)row * DM + c0 + 32 * j + 8 * fq;
            const u32x4 o = *(const u32x4*)xp;
            f32x4 x0 = (f32x4){bf_lo(o.x), bf_hi(o.x), bf_lo(o.y), bf_hi(o.y)}, x1 = (f32x4){bf_lo(o.z), bf_hi(o.z), bf_lo(o.w), bf_hi(o.w)};
            x0 += acc[0][j][0] * scale; x1 += acc[0][j][1] * scale;
            u32x4 w; w.x = cvt_pk_bf16(x0[0], x0[1]); w.y = cvt_pk_bf16(x0[2], x0[3]); w.z = cvt_pk_bf16(x1[0], x1[1]); w.w = cvt_pk_bf16(x1[2], x1[3]);
            *(u32x4*)xp = w;
            s += (x0[0] * x0[0] + x0[1] * x0[1]) + (x0[2] * x0[2] + x0[3] * x0[3]) + (x1[0] * x1[0] + x1[1] * x1[1]) + (x1[2] * x1[2] + x1[3] * x1[3]);
        }
        s += __shfl_xor(s, 16); s += __shfl_xor(s, 32);
        if (fq == 0) ssq[(size_t)row * 16 + (c0 >> 6)] = s;
    }
};

struct EpiIn {
    static constexpr int PROBE_ID = 3; __device__ __forceinline__ EpiIn probe_copy() const { return *this; }
    bf16_t* Z; const float* ssq; const float* bgate; float* okp; float* ovp; float* oks; float* ovs;
    __device__ __forceinline__ void operator()(const f32x4 (&acc)[2][2][4][2], const pg8::Unit& u, int wr, int wc, int fr, int fq) const {
        const int row0 = u.pm * 256 + wr * 64 + fr, col0 = u.pn * 256 + wc * 32 + 8 * fq;
        const int pn = u.pn;
        const bool isq = (pn == 2 || pn == 3), iskv = (pn >= 8 && pn < 12), isg = (pn >= 12);
        const bool kvp = iskv && ((u.pm & 15) >= 14);
        f32x4 bg[2][2];
#pragma unroll
        for (int bj = 0; bj < 2; ++bj) { if (isg) { bg[bj][0] = *(const f32x4*)(bgate + col0 - ZC_GC + bj * 128); bg[bj][1] = *(const f32x4*)(bgate + col0 - ZC_GC + bj * 128 + 4); } else { bg[bj][0] = (f32x4){0.f, 0.f, 0.f, 0.f}; bg[bj][1] = bg[bj][0]; } }
#pragma unroll
        for (int ai = 0; ai < 2; ++ai)
#pragma unroll
            for (int m = 0; m < 4; ++m) {
                const int row = row0 + ai * 128 + m * 16; float rs = row_rs(ssq, row, fq);
                if (isq) rs *= QSCALE;
#pragma unroll
                for (int bj = 0; bj < 2; ++bj) {
                    f32x4 v0 = acc[ai][bj][m][0] * rs, v1 = acc[ai][bj][m][1] * rs;
                    const int c = col0 + bj * 128;
                    if (isg) {
                        v0 += bg[bj][0]; v1 += bg[bj][1];
#pragma unroll
                        for (int i = 0; i < 4; ++i) { v0[i] = fast_sigmoid(v0[i]); v1[i] = fast_sigmoid(v1[i]); }
                    }
                    u32x4 w; w.x = cvt_pk_bf16(v0[0], v0[1]); w.y = cvt_pk_bf16(v0[2], v0[3]); w.z = cvt_pk_bf16(v1[0], v1[1]); w.w = cvt_pk_bf16(v1[2], v1[3]);
                    *(u32x4*)(Z + (size_t)row * INC + c) = w;
                    if (kvp) {
                        const int b = row >> 12, t = row & 4095;
                        float* dst = ((pn < 10) ? okp : ovp) + ((size_t)(b * 512 + (t - 3584)) * 512 + (c - ((pn < 10) ? ZC_K : ZC_V)));
                        *(f32x4*)dst = v0; *(f32x4*)(dst + 4) = v1;
                    }
                }
            }
    }
    __device__ __forceinline__ void small(const f32x4 (&acc)[1][2][2], int row, int c0, int fr, int fq) const {
        const int pn = c0 >> 8;
        const bool isq = (pn == 2 || pn == 3), iskv = (pn >= 8 && pn < 12), isg = (pn >= 12);
        float rs = row_rs(ssq, row, fq);
        if (isq) rs *= QSCALE;
#pragma unroll
        for (int j = 0; j < 2; ++j) {
            f32x4 v0 = acc[0][j][0] * rs, v1 = acc[0][j][1] * rs;
            const int c = c0 + 32 * j + 8 * fq;
            if (isg) {
                v0 += *(const f32x4*)(bgate + c - ZC_GC); v1 += *(const f32x4*)(bgate + c - ZC_GC + 4);
#pragma unroll
                for (int i = 0; i < 4; ++i) { v0[i] = fast_sigmoid(v0[i]); v1[i] = fast_sigmoid(v1[i]); }
            }
            u32x4 w; w.x = cvt_pk_bf16(v0[0], v0[1]); w.y = cvt_pk_bf16(v0[2], v0[3]); w.z = cvt_pk_bf16(v1[0], v1[1]); w.w = cvt_pk_bf16(v1[2], v1[3]);
            *(u32x4*)(Z + (size_t)row * INC + c) = w;
            if (iskv) {
                float* dst = ((pn < 10) ? oks : ovs) + ((size_t)(row - MP) * 512 + (c - ((pn < 10) ? ZC_K : ZC_V)));
                *(f32x4*)dst = v0; *(f32x4*)(dst + 4) = v1;
            }
        }
    }
};

struct EpiMix {
    static constexpr int PROBE_ID = 4; __device__ __forceinline__ EpiMix probe_copy() const { return *this; }
    bf16_t* Z;
    __device__ __forceinline__ void operator()(const f32x4 (&acc)[2][2][4][2], const pg8::Unit& u, int wr, int wc, int fr, int fq) const {
        const int row0 = u.pm * 256 + wr * 64 + fr, col0 = u.pn * 256 + wc * 32 + 8 * fq;
        const int gcol = (u.z == 0) ? ZC_GC : ZC_GA;
#pragma unroll
        for (int ai = 0; ai < 2; ++ai)
#pragma unroll
            for (int m = 0; m < 4; ++m) {
                const int row = row0 + ai * 128 + m * 16;
#pragma unroll
                for (int bj = 0; bj < 2; ++bj) {
                    const int c = col0 + bj * 128;
                    const u32x4 gw = *(const u32x4*)(Z + (size_t)row * INC + gcol + c);
                    f32x4 v0 = acc[ai][bj][m][0], v1 = acc[ai][bj][m][1];
                    v0[0] *= bf_lo(gw.x); v0[1] *= bf_hi(gw.x); v0[2] *= bf_lo(gw.y); v0[3] *= bf_hi(gw.y);
                    v1[0] *= bf_lo(gw.z); v1[1] *= bf_hi(gw.z); v1[2] *= bf_lo(gw.w); v1[3] *= bf_hi(gw.w);
                    bf16_t* mp = Z + (size_t)row * INC + ZC_MB + c;
                    if (u.z != 0) {
                        const u32x4 pw = *(const u32x4*)mp;
                        v0[0] += bf_lo(pw.x); v0[1] += bf_hi(pw.x); v0[2] += bf_lo(pw.y); v0[3] += bf_hi(pw.y);
                        v1[0] += bf_lo(pw.z); v1[1] += bf_hi(pw.z); v1[2] += bf_lo(pw.w); v1[3] += bf_hi(pw.w);
                    }
                    u32x4 w; w.x = cvt_pk_bf16(v0[0], v0[1]); w.y = cvt_pk_bf16(v0[2], v0[3]); w.z = cvt_pk_bf16(v1[0], v1[1]); w.w = cvt_pk_bf16(v1[2], v1[3]);
                    *(u32x4*)mp = w;
                }
            }
    }
    __device__ __forceinline__ void small(const f32x4 (&acc)[2][2][2], int row, int c0, int fr, int fq) const {
#pragma unroll
        for (int j = 0; j < 2; ++j) {
            const int c = c0 + 32 * j + 8 * fq;
            const u32x4 gc = *(const u32x4*)(Z + (size_t)row * INC + ZC_GC + c), ga = *(const u32x4*)(Z + (size_t)row * INC + ZC_GA + c);
            const f32x4 a0 = acc[0][j][0], a1 = acc[0][j][1], b0 = acc[1][j][0], b1 = acc[1][j][1];
            float m[8];
            m[0] = a0[0] * bf_lo(gc.x) + b0[0] * bf_lo(ga.x); m[1] = a0[1] * bf_hi(gc.x) + b0[1] * bf_hi(ga.x);
            m[2] = a0[2] * bf_lo(gc.y) + b0[2] * bf_lo(ga.y); m[3] = a0[3] * bf_hi(gc.y) + b0[3] * bf_hi(ga.y);
            m[4] = a1[0] * bf_lo(gc.z) + b1[0] * bf_lo(ga.z); m[5] = a1[1] * bf_hi(gc.z) + b1[1] * bf_hi(ga.z);
            m[6] = a1[2] * bf_lo(gc.w) + b1[2] * bf_lo(ga.w); m[7] = a1[3] * bf_hi(gc.w) + b1[3] * bf_hi(ga.w);
            u32x4 w; w.x = cvt_pk_bf16(m[0], m[1]); w.y = cvt_pk_bf16(m[2], m[3]); w.z = cvt_pk_bf16(m[4], m[5]); w.w = cvt_pk_bf16(m[6], m[7]);
            *(u32x4*)(Z + (size_t)row * INC + ZC_MB + c) = w;
        }
    }
};

template <int NSET, int NSTEP  , class Epi, bool UPMODE = false, int KSPLIT = 8  >
__device__ __forceinline__ void small_gemm(LAS unsigned char* lds, const bf16_t* A0, const bf16_t* A1, int lda, const bf16_t* W0, const bf16_t* W1, int ldb, int ncg, const Epi& E, int bx, int G, int wave, int lane) {
    constexpr int UPR = 8 / KSPLIT;
    const int fr = lane & 15, fq = lane >> 4, us = wave / KSPLIT, kp = wave % KSPLIT;
    LAS f32x4* part = (LAS f32x4*)lds;
#pragma unroll 1
    for (int u0 = bx * UPR; u0 < 8 * ncg; u0 += G * UPR) {
        const int u = u0 + us; const bool valid = (u < 8 * ncg);
        const int uc = valid ? u : 0;
        const int rb = uc & 7, cg = uc >> 3;
        const int row = MP + 16 * rb + fr;
        f32x4 acc[NSET][2][2];
#pragma unroll
        for (int st = 0; st < NSET; ++st) {
            const bf16_t* Ap = (st ? A1 : A0) + (size_t)row * lda + kp * (NSTEP * 32) + 8 * fq;
            const int cb0 = UPMODE ? 256 * (cg >> 2) + 32 * (cg & 3) : 64 * cg;
            const bf16_t* Wp = (st ? W1 : W0) + (size_t)(cb0 + 8 * (fr >> 2) + (fr & 3)) * ldb + kp * (NSTEP * 32) + 8 * fq;
#pragma unroll
            for (int j = 0; j < 2; ++j)
#pragma unroll
                for (int n = 0; n < 2; ++n) acc[st][j][n] = (f32x4){0.f, 0.f, 0.f, 0.f};
#pragma unroll 4
            for (int k = 0; k < NSTEP; ++k) {
                const bf16x8 av = *(const bf16x8*)(Ap + 32 * k);
#pragma unroll
                for (int j = 0; j < 2; ++j)
#pragma unroll
                    for (int n = 0; n < 2; ++n) {
                        const bf16x8 bv = *(const bf16x8*)(Wp + (size_t)((UPMODE ? 128 : 32) * j + 4 * n) * ldb + 32 * k);
                        acc[st][j][n] = __builtin_amdgcn_mfma_f32_16x16x32_bf16(bv, av, acc[st][j][n], 0, 0, 0);
                    }
            }
        }
        if (kp != 0) {
#pragma unroll
            for (int st = 0; st < NSET; ++st)
#pragma unroll
                for (int j = 0; j < 2; ++j)
#pragma unroll
                    for (int n = 0; n < 2; ++n) part[((wave * NSET + st) * 4 + j * 2 + n) * 64 + lane] = acc[st][j][n];
        }
        __syncthreads();
        if (kp == 0 && valid) {
#pragma unroll
            for (int w = 1; w < KSPLIT; ++w)
#pragma unroll
                for (int st = 0; st < NSET; ++st)
#pragma unroll
                    for (int j = 0; j < 2; ++j)
#pragma unroll
                        for (int n = 0; n < 2; ++n) acc[st][j][n] += part[(((wave + w) * NSET + st) * 4 + j * 2 + n) * 64 + lane];
            E.small(acc, row, UPMODE ? 128 * (cg >> 2) + 32 * (cg & 3) : 64 * cg, fr, fq);
        }
        __syncthreads();
    }
}

struct TileD { const bf16_t* K; const bf16_t* V; int pitch; int nkeys; int delta0; };

__device__ __forceinline__ void attn_dma_v(const TileD& td, LAS unsigned char* vb, int lane) {
#pragma unroll
    for (int i = 0; i < 8; ++i) {
        const int row = 8 * i + (lane >> 3), chs = lane & 7, ch = chs ^ (((row >> 1) & 3) << 1);
        __builtin_amdgcn_global_load_lds((const unsigned*)(td.V + (size_t)row * td.pitch + ch * 8), (LAS unsigned*)(vb + i * 1024), 16, 0, 0);
    }
}
template <int NQB, class TF>
__device__ __forceinline__ void attn_wave(const bf16_t* Qp, bf16_t* Op, int qpitch, int opitch, int nt, const TF& tilef, LAS unsigned char* vbuf, const LAS float* rb, int lane) {
    const int fr = lane & 15, fq = lane >> 4;
    bf16x8 qf[NQB][2];
#pragma unroll
    for (int qb = 0; qb < NQB; ++qb)
#pragma unroll
        for (int dh = 0; dh < 2; ++dh) qf[qb][dh] = *(const bf16x8*)(Qp + (size_t)(16 * qb + fr) * qpitch + dh * 32 + 8 * fq);
    f32x4 O[NQB][4]; float mrow[NQB], lrow[NQB];
#pragma unroll
    for (int qb = 0; qb < NQB; ++qb) { mrow[qb] = -1e30f; lrow[qb] = 0.f;
#pragma unroll
        for (int db = 0; db < 4; ++db) O[qb][db] = (f32x4){0.f, 0.f, 0.f, 0.f}; }
    const int qp = fr >> 2, pp = fr & 3, rowl = 4 * fq + qp, sw = ((rowl >> 1) & 3) << 1;
    const int vrow = rowl * 128 + (pp & 1) * 8, vch = (pp >> 1) ^ sw;
    bf16x8 kf[2][2];
    { const TileD td = tilef(0); attn_dma_v(td, vbuf, lane);
#pragma unroll
      for (int kb = 0; kb < 2; ++kb)
#pragma unroll
          for (int dh = 0; dh < 2; ++dh) kf[kb][dh] = *(const bf16x8*)(td.K + (size_t)(16 * kb + fr) * td.pitch + dh * 32 + 8 * fq); }
    const int nht = 2 * nt;
#pragma unroll 1
    for (int ht = 0; ht < nht; ++ht) {
        const int t = ht >> 1, half = ht & 1;
        asm volatile("s_waitcnt vmcnt(0)" ::: "memory");
        const TileD td = tilef(t);
        if (half == 0 && t + 1 < nt) { const TileD tn = tilef(t + 1); attn_dma_v(tn, vbuf + ((t + 1) & 1) * 8192, lane); }
        f32x4 S[2][NQB];
#pragma unroll
        for (int kb = 0; kb < 2; ++kb)
#pragma unroll
            for (int qb = 0; qb < NQB; ++qb) {
                f32x4 s = __builtin_amdgcn_mfma_f32_16x16x32_bf16(kf[kb][0], qf[qb][0], (f32x4){0.f, 0.f, 0.f, 0.f}, 0, 0, 0);
                S[kb][qb] = __builtin_amdgcn_mfma_f32_16x16x32_bf16(kf[kb][1], qf[qb][1], s, 0, 0, 0);
            }
        if (ht + 1 < nht) {
            const TileD tk = tilef((ht + 1) >> 1); const int r0 = 32 * ((ht + 1) & 1);
#pragma unroll
            for (int kb = 0; kb < 2; ++kb)
#pragma unroll
                for (int dh = 0; dh < 2; ++dh) kf[kb][dh] = *(const bf16x8*)(tk.K + (size_t)(r0 + 16 * kb + fr) * tk.pitch + dh * 32 + 8 * fq);
        }
        const int delta0 = td.delta0 - 32 * half, nkeys = td.nkeys - 32 * half;
        if (delta0 < 160) {
#pragma unroll
            for (int kb = 0; kb < 2; ++kb)
#pragma unroll
                for (int qb = 0; qb < NQB; ++qb)
#pragma unroll
                    for (int i = 0; i < 4; ++i) {
                        int d = delta0 + (16 * qb + fr) - (16 * kb + 4 * fq + i);
                        d = d < -128 ? -128 : (d > 128 ? 128 : d);
                        S[kb][qb][i] += rb[d + 128];
                    }
        }
        if (nkeys < 32) {
#pragma unroll
            for (int kb = 0; kb < 2; ++kb)
#pragma unroll
                for (int qb = 0; qb < NQB; ++qb)
#pragma unroll
                    for (int i = 0; i < 4; ++i) if (16 * kb + 4 * fq + i >= nkeys) S[kb][qb][i] = -INFINITY;
        }
        float mxq[NQB]; bool grow = false;
#pragma unroll
        for (int qb = 0; qb < NQB; ++qb) {
            float mx = fmaxf(fmaxf(fmaxf(S[0][qb][0], S[0][qb][1]), fmaxf(S[0][qb][2], S[0][qb][3])), fmaxf(fmaxf(S[1][qb][0], S[1][qb][1]), fmaxf(S[1][qb][2], S[1][qb][3])));
            mx = fmaxf(mx, __shfl_xor(mx, 16)); mx = fmaxf(mx, __shfl_xor(mx, 32));
            mxq[qb] = mx; grow = grow || (mx > mrow[qb]);
        }
        if (__any(grow)) {
#pragma unroll
            for (int qb = 0; qb < NQB; ++qb) {
                const float mn = fmaxf(mrow[qb], mxq[qb]), alpha = __builtin_amdgcn_exp2f(mrow[qb] - mn);
                mrow[qb] = mn; lrow[qb] *= alpha;
#pragma unroll
                for (int db = 0; db < 4; ++db) O[qb][db] *= alpha;
            }
        }
        bf16x8 pf[NQB];
#pragma unroll
        for (int qb = 0; qb < NQB; ++qb) {
            const float mn = mrow[qb]; float ps = 0.f; float p[2][4];
#pragma unroll
            for (int kb = 0; kb < 2; ++kb)
#pragma unroll
                for (int i = 0; i < 4; ++i) { p[kb][i] = __builtin_amdgcn_exp2f(S[kb][qb][i] - mn); ps += p[kb][i]; }
            lrow[qb] += ps;
            u32x4 w; w.x = cvt_pk_bf16(p[0][0], p[0][1]); w.y = cvt_pk_bf16(p[0][2], p[0][3]); w.z = cvt_pk_bf16(p[1][0], p[1][1]); w.w = cvt_pk_bf16(p[1][2], p[1][3]);
            pf[qb] = __builtin_bit_cast(bf16x8, w);
        }
        const LAS unsigned char* vb = vbuf + (t & 1) * 8192 + half * 4096 + vrow;
#pragma unroll
        for (int db = 0; db < 4; ++db) {
            const int off = ((2 * db) ^ vch) << 4;
            const s16x4 lo = __builtin_amdgcn_ds_read_tr16_b64_v4i16((LAS s16x4*)(vb + off));
            const s16x4 hi = __builtin_amdgcn_ds_read_tr16_b64_v4i16((LAS s16x4*)(vb + off + 2048));
            const bf16x8 vf = (bf16x8){lo[0], lo[1], lo[2], lo[3], hi[0], hi[1], hi[2], hi[3]};
#pragma unroll
            for (int qb = 0; qb < NQB; ++qb) O[qb][db] = __builtin_amdgcn_mfma_f32_16x16x32_bf16(vf, pf[qb], O[qb][db], 0, 0, 0);
        }
    }
    asm volatile("s_waitcnt lgkmcnt(0)" ::: "memory");
#pragma unroll
    for (int qb = 0; qb < NQB; ++qb) {
        float l = lrow[qb]; l += __shfl_xor(l, 16); l += __shfl_xor(l, 32);
        const float inv = 1.0f / l;
#pragma unroll
        for (int db = 0; db < 4; ++db) {
            const f32x4 o = O[qb][db] * inv; u32x2 w; w.x = cvt_pk_bf16(o[0], o[1]); w.y = cvt_pk_bf16(o[2], o[3]);
            *(u32x2*)(Op + (size_t)(16 * qb + fr) * opitch + 16 * db + 4 * fq) = w;
        }
    }
}


#define XB_TMO      128
#define XB_XCNT(j)  (256  + 64 * (j))
#define XB_XSUB(j)  (1280 + 64 * (j))
#define XB_XGEN(j)  (2304 + 64 * (j))
#define XB_TOP      3328
#define XB_TOPGEN   3392
#define XCD_BAR_WORDS 3456
#define XB_SPIN_CAP (1u << 20)
__device__ __forceinline__ unsigned xb_ld(unsigned* p)              { return __hip_atomic_load(p, __ATOMIC_RELAXED, __HIP_MEMORY_SCOPE_AGENT); }
__device__ __forceinline__ unsigned xb_add(unsigned* p, unsigned v) { return __hip_atomic_fetch_add(p, v, __ATOMIC_RELAXED, __HIP_MEMORY_SCOPE_AGENT); }
__device__ __forceinline__ unsigned xb_xcc_id() { return (unsigned)__builtin_amdgcn_s_getreg((3 << 11) | 20) & 0xFu; }
#define XB_SPIN(cond, bar) do { unsigned _sp = 0; while (cond) { __builtin_amdgcn_s_sleep(1); \
    if ((++_sp & 255u) == 0u) { if (xb_ld(&(bar)[XB_TMO])) break; if (_sp > XB_SPIN_CAP) { atomicAdd(&(bar)[XB_TMO], 1u); break; } } } } while (0)
struct XcdBarrier { unsigned* bar; unsigned x; volatile LAS unsigned* st; };
__device__ __forceinline__ XcdBarrier xcd_barrier_post(unsigned* bar, volatile LAS unsigned* st) {
    XcdBarrier b; b.bar = bar; b.x = xb_xcc_id(); b.st = st;
    if (threadIdx.x == 0) (void)xb_add(&bar[XB_XCNT(b.x)], 1u);
    return b;
}
__device__ __forceinline__ void xcd_barrier_complete(unsigned* bar, unsigned x, unsigned& nloc, unsigned& nx) {
    const unsigned G = gridDim.x * gridDim.y * gridDim.z;
    unsigned sum, cnt, mine, sp = 0u;
    for (;;) {
        sum = 0u; cnt = 0u; mine = 0u;
#pragma unroll
        for (unsigned j = 0; j < 16; ++j) { const unsigned c = xb_ld(&bar[XB_XCNT(j)]); sum += c; cnt += (c > 0u) ? 1u : 0u; mine = (j == x) ? c : mine; }
        if (sum == G) break;
        __builtin_amdgcn_s_sleep(1);
        if ((++sp & 255u) == 0u) { if (xb_ld(&bar[XB_TMO])) break; if (sp > XB_SPIN_CAP) { atomicAdd(&bar[XB_TMO], 1u); break; } }
    }
    nloc = mine > 0u ? mine : 1u; nx = cnt > 0u ? cnt : 1u;
}
__device__ __forceinline__ void xcd_barrier(const XcdBarrier& b) {
    asm volatile("s_waitcnt vmcnt(0)" ::: "memory");
    __syncthreads();
    if (threadIdx.x == 0) {
        unsigned* bar = b.bar;
        __builtin_amdgcn_s_waitcnt(0);
        unsigned nloc = b.st[0], nx = b.st[1];
        if (nloc == 0u) { xcd_barrier_complete(bar, b.x, nloc, nx); b.st[0] = nloc; b.st[1] = nx; }
        const unsigned old = xb_add(&bar[XB_XSUB(b.x)], 1u);
        const unsigned gen = old / nloc;
        if (old + 1u == (gen + 1u) * nloc) {
            __builtin_amdgcn_fence(__ATOMIC_RELEASE, "agent");
            asm volatile("s_waitcnt vmcnt(0)" ::: "memory");
            const unsigned og = xb_add(&bar[XB_TOP], 1u);
            const unsigned tg = og / nx;
            if (og + 1u == (tg + 1u) * nx) xb_add(&bar[XB_TOPGEN], 1u);
            else XB_SPIN(xb_ld(&bar[XB_TOPGEN]) == tg, bar);
            __builtin_amdgcn_fence(__ATOMIC_ACQUIRE, "agent");
            xb_add(&bar[XB_XGEN(b.x)], 1u);
            asm volatile("s_waitcnt vmcnt(0)" ::: "memory");
        } else {
            XB_SPIN(xb_ld(&bar[XB_XGEN(b.x)]) == gen, bar);
            __builtin_amdgcn_fence(__ATOMIC_ACQUIRE, "agent");
            asm volatile("s_waitcnt vmcnt(0)" ::: "memory");
        }
    }
    __syncthreads();
}

struct Args {
    const float* x_prompt; const float* x_sample; const float* cache_k; const float* cache_v; const float* state_conv;
    const float* norm_ffn1; const float* w_ffn1_gu; const float* w_ffn1_down; const float* norm_mix; const float* w_in; const float* b_gate; const float* w_conv;
    const float* rel_bias; const float* w_conv_out; const float* w_attn_out; const float* w_o; const float* norm_ffn2; const float* w_ffn2_gu; const float* w_ffn2_down; const float* norm_final;
    float* out; unsigned char* ws; int ph_lo, ph_hi;
};

__device__ __forceinline__ void transpose_item(const float* W, int N, const float* gain, bf16_t* WT, int dpitch, int dkoff, int mode, int kb, int nb, int scol0, LAS float* scr, int lane) {
    const int k0 = 64 * kb, n0 = 32 * nb, c = lane & 31;
    const int scol = (mode == 1) ? ((c < 16) ? 16 * nb + c : DFF + 16 * nb + (c - 16)) : scol0 + c;
    float wv[32];
#pragma unroll
    for (int i = 0; i < 32; ++i) wv[i] = W[(size_t)(k0 + 2 * i + (lane >> 5)) * N + scol];
    if (gain) {
#pragma unroll
        for (int i = 0; i < 32; ++i) wv[i] *= gain[k0 + 2 * i + (lane >> 5)];
    }
#pragma unroll
    for (int i = 0; i < 32; ++i) scr[(2 * i + (lane >> 5)) * 33 + c] = wv[i];
    asm volatile("s_waitcnt lgkmcnt(0)" ::: "memory");
    const int c8 = lane & 7;
#pragma unroll
    for (int j = 0; j < 4; ++j) { const int n = (lane >> 3) + 8 * j; const LAS float* s = scr + (8 * c8) * 33 + n;
        u32x4 o; o.x = pk2(s[0 * 33], s[1 * 33]); o.y = pk2(s[2 * 33], s[3 * 33]); o.z = pk2(s[4 * 33], s[5 * 33]); o.w = pk2(s[6 * 33], s[7 * 33]);
        int drow;
        if (mode == 1) { const int jj = n & 15, isu = n >> 4; drow = n0 + 8 * (jj >> 2) + 4 * isu + (jj & 3); } else drow = n0 + n;
        *(u32x4*)(WT + (size_t)drow * dpitch + dkoff + k0 + 8 * c8) = o; }
    asm volatile("s_waitcnt lgkmcnt(0)" ::: "memory");
}

__device__ __forceinline__ float wave_sum(float v) {
#pragma unroll
    for (int o = 1; o < 64; o <<= 1) v += __shfl_xor(v, o);
    return v;
}

__global__ void __launch_bounds__(NWAVES * 64, 2) mega_fwd(Args a) {
    extern __shared__ __attribute__((aligned(16))) unsigned char lds_raw[];
    LAS unsigned char* lds = (LAS unsigned char*)lds_raw;
    cg::grid_group grid = cg::this_grid();
    typedef const __attribute__((address_space(4))) Args* ArgP;
    ArgP ap = (ArgP)__builtin_amdgcn_kernarg_segment_ptr();
    const int G = gridDim.x, bx = blockIdx.x;
    const int wave0 = __builtin_amdgcn_readfirstlane((int)threadIdx.x >> 6);
    unsigned* barw = (unsigned*)(ap->ws + WS_BAR);
    if (bx == 0) for (int i = threadIdx.x; i < XCD_BAR_WORDS; i += NWAVES * 64) barw[i] = 0u;
    if (threadIdx.x < 16) ((LAS unsigned*)(lds + BARST_OFF))[threadIdx.x] = 0u;
    XcdBarrier xbar; xbar.bar = barw; xbar.x = 0; xbar.st = (volatile LAS unsigned*)(lds + BARST_OFF);
    bool xposted = false;
    const int lo = ap->ph_lo, hi = ap->ph_hi;
#define PHASE_VARS \
    asm volatile("" : "+s"(ap)); \
    int lane_ = (int)__builtin_amdgcn_mbcnt_hi(~0u, __builtin_amdgcn_mbcnt_lo(~0u, 0u)); asm volatile("" : "+v"(lane_)); \
    int wave_ = wave0; asm volatile("" : "+s"(wave_)); \
    const int lane = lane_, wave = wave_, tid = wave * 64 + lane; \
    const int vcu = (G % 8 == 0) ? (bx % 8) * (G / 8) + bx / 8 : bx; \
    const int gw = vcu * NWAVES + wave, NGW = G * NWAVES; \
    const int gt = gw * 64 + lane, NGT = NGW * 64; \
    unsigned char* ws = ap->ws; \
    bf16_t* WT = (bf16_t*)(ws + ((l & 1) ? WS_WT2 : WS_WT)); bf16_t* WTN = (bf16_t*)(ws + ((l & 1) ? WS_WT : WS_WT2)); bf16_t* XB = (bf16_t*)(ws + WS_XB); float* SSQ = (float*)(ws + WS_SSQ); \
    bf16_t* CK = (bf16_t*)(ws + ((l & 1) ? WS_CK2 : WS_CK)); bf16_t* CV = (bf16_t*)(ws + ((l & 1) ? WS_CV2 : WS_CV)); \
    bf16_t* CKN = (bf16_t*)(ws + ((l & 1) ? WS_CK : WS_CK2)); bf16_t* CVN = (bf16_t*)(ws + ((l & 1) ? WS_CV : WS_CV2)); bf16_t* Z = (bf16_t*)(ws + WS_Z); bf16_t* HB = Z; \
    float* X = ap->out; \
    (void)WTN; (void)CKN; (void)CVN; (void)tid; (void)lane; (void)wave; (void)gw; (void)NGW; (void)gt; (void)NGT; (void)WT; (void)XB; (void)SSQ; (void)CK; (void)CV; (void)Z; (void)HB; (void)X;
#define IN(k) (lo <= (k) && (k) < hi)
#define GSYNC() do { if (!xposted) { grid.sync(); xbar = xcd_barrier_post(barw, (volatile LAS unsigned*)(lds + BARST_OFF)); xposted = true; } else xcd_barrier(xbar); } while (0)
#define SEAM(k) do { if (IN(k) && IN((k) + 1)) { GSYNC(); if (PROBE_REP == 9) GSYNC(); } } while (0)
#define REPS(k) for (int rep = (PROBE_REP == (k)) ? 0 : 1; rep < 2; ++rep)
#define REPSYNC() do { if (rep == 0) GSYNC(); } while (0)

#define CONVERT_LAYER(LC, WTD, CKD, CVD) do { \
            LAS float* scr = (LAS float*)(lds + wave * 16384); \
            constexpr int I_GU = 16 * 176, I_D = 44 * 32, I_IN = 16 * 160, I_C = 8 * 32, I_O = 16 * 32; \
            constexpr int NITEMS = 2 * I_GU + 2 * I_D + I_IN + 2 * I_C + I_O; \
            for (int it = gw; it < NITEMS; it += NGW) { \
                int r = it; \
                if (r < I_GU) { transpose_item(ap->w_ffn1_gu + (size_t)(LC) * DM * 2 * DFF, 2 * DFF, ap->norm_ffn1 + (LC) * DM, (WTD) + W_GU1, DM, 0, 0, r / 176, r % 176, (((r % 176) >> 2) & 1) * DFF + 128 * ((r % 176) >> 3) + 32 * ((r % 176) & 3), scr, lane); continue; } r -= I_GU; \
                if (r < I_GU) { transpose_item(ap->w_ffn2_gu + (size_t)(LC) * DM * 2 * DFF, 2 * DFF, ap->norm_ffn2 + (LC) * DM, (WTD) + W_GU2, DM, 0, 0, r / 176, r % 176, (((r % 176) >> 2) & 1) * DFF + 128 * ((r % 176) >> 3) + 32 * ((r % 176) & 3), scr, lane); continue; } r -= I_GU; \
                if (r < I_D) { transpose_item(ap->w_ffn1_down + (size_t)(LC) * DFF * DM, DM, nullptr, (WTD) + W_D1, DFF, 0, 0, r / 32, r % 32, 32 * (r % 32), scr, lane); continue; } r -= I_D; \
                if (r < I_D) { transpose_item(ap->w_ffn2_down + (size_t)(LC) * DFF * DM, DM, nullptr, (WTD) + W_D2, DFF, 0, 0, r / 32, r % 32, 32 * (r % 32), scr, lane); continue; } r -= I_D; \
                if (r < I_IN) { const int nb = r % 160, kb = r / 160, blk = nb >> 4; \
                    const int ob = (blk == 1) ? 3 : (blk == 2) ? 1 : (blk == 3) ? 2 : blk; \
                    transpose_item(ap->w_in + (size_t)(LC) * DM * INC, INC, ap->norm_mix + (LC) * DM, (WTD) + W_IN, DM, 0, 0, kb, nb, ob * 512 + 32 * (nb & 15), scr, lane); continue; } r -= I_IN; \
                if (r < I_C) { transpose_item(ap->w_conv_out + (size_t)(LC) * 512 * DM, DM, nullptr, (WTD) + W_CAT, DM, 0, 0, r / 32, r % 32, 32 * (r % 32), scr, lane); continue; } r -= I_C; \
                if (r < I_C) { transpose_item(ap->w_attn_out + (size_t)(LC) * 512 * DM, DM, nullptr, (WTD) + W_CAT, DM, 512, 0, r / 32, r % 32, 32 * (r % 32), scr, lane); continue; } r -= I_C; \
                transpose_item(ap->w_o + (size_t)(LC) * DM * DM, DM, nullptr, (WTD) + W_O, DM, 0, 0, r / 32, r % 32, 32 * (r % 32), scr, lane); \
            } \
 \
            for (int i = gt; i < 2 * (NBATCH * 512 * 512 / 8); i += NGT) { \
                const int which = i / (NBATCH * 512 * 512 / 8), e = (i % (NBATCH * 512 * 512 / 8)) * 8; \
                const float* src = (which ? ap->cache_v : ap->cache_k) + (size_t)(LC) * NBATCH * 512 * 512 + e; \
                const f32x4 v0 = *(const f32x4*)src, v1 = *(const f32x4*)(src + 4); \
                u32x4 w; w.x = pk2(v0[0], v0[1]); w.y = pk2(v0[2], v0[3]); w.z = pk2(v1[0], v1[1]); w.w = pk2(v1[2], v1[3]); \
                *(u32x4*)((which ? (CVD) : (CKD)) + e) = w; \
            } \
} while (0)

#pragma unroll 1
    for (int l = 0; l < DEPTH; ++l) {
        const int pb = 9 * l;
        if (l == 0 && IN(pb + 0)) REPS(0) { PHASE_VARS
            CONVERT_LAYER(0, WT, CK, CV);
            if (l == 0) {
                for (int m = gw; m < MPAD; m += NGW) {
                    bf16_t* xb = XB + (size_t)m * DM; float* sq = SSQ + (size_t)m * 16;
                    if (m < MR) {
                        const float* src = (m < MP) ? ap->x_prompt + (size_t)m * DM : ap->x_sample + (size_t)(m - MP) * DM;
                        float s = 0.f;
#pragma unroll
                        for (int j = 0; j < 4; ++j) { const f32x4 v = *(const f32x4*)(src + 256 * j + 4 * lane);
                            u32x2 w; w.x = pk2(v[0], v[1]); w.y = pk2(v[2], v[3]); *(u32x2*)(xb + 256 * j + 4 * lane) = w; s += (v[0] * v[0] + v[1] * v[1]) + (v[2] * v[2] + v[3] * v[3]); }
                        s = wave_sum(s);
                        if (lane < 16) sq[lane] = (lane == 0) ? s : 0.f;
                    } else {
#pragma unroll
                        for (int j = 0; j < 4; ++j) *(u32x2*)(xb + 256 * j + 4 * lane) = (u32x2){0u, 0u};
                        if (lane < 16) sq[lane] = 0.f;
                    }
                }
            }
        REPSYNC(); }
        if (l == 0) SEAM(pb + 0);
        if (IN(pb + 1)) REPS(1) { PHASE_VARS
            pg8::Gemm g{XB, WT + W_GU1, DM, DM, DM, 0, 0}; pg8::StaticOrder S; S.init(NTM, 2 * DFF / 256, G, bx, 1);
            EpiUp E{HB, SSQ};
            small_gemm<1, 16, EpiUp, true, 2>(lds, XB, XB, DM, WT + W_GU1, WT + W_GU1, DM, 2 * DFF / 64, E, bx, G, wave, lane);
            pg8::gemm_phase<EpiUp>(lds, g, S, E, tid);
        REPSYNC(); }
        SEAM(pb + 1);
        if (IN(pb + 2)) REPS(2) { PHASE_VARS
            pg8::Gemm g{HB, WT + W_D1, DFF, DFF, DFF, 0, 0}; pg8::StaticOrder S; S.init(NTM, DM / 256, G, bx, 1);
            EpiRes E{XB, SSQ, rep ? 0.5f : 0.0f};
            small_gemm<1, 11, EpiRes>(lds, HB, HB, DFF, WT + W_D1, WT + W_D1, DFF, DM / 64, E, bx, G, wave, lane);
            pg8::gemm_phase<EpiRes>(lds, g, S, E, tid);
        REPSYNC(); }
        SEAM(pb + 2);
        if (IN(pb + 3)) REPS(3) { PHASE_VARS
            pg8::Gemm g{XB, WT + W_IN, DM, DM, DM, 0, 0}; pg8::StaticOrder S; S.init(NTM, INC / 256, G, bx, 1);
            EpiIn E{Z, SSQ, ap->b_gate + (size_t)l * 2 * DM, ap->out + O_KP + (size_t)l * NBATCH * 512 * 512, ap->out + O_VP + (size_t)l * NBATCH * 512 * 512,
                    ap->out + O_KS + (size_t)l * MS * 512, ap->out + O_VS + (size_t)l * MS * 512};
            small_gemm<1, 16, EpiIn, false, 2>(lds, XB, XB, DM, WT + W_IN, WT + W_IN, DM, INC / 64, E, bx, G, wave, lane);
            pg8::gemm_phase<EpiIn>(lds, g, S, E, tid);
        REPSYNC(); }
        SEAM(pb + 3);
        if (IN(pb + 4)) REPS(4) { PHASE_VARS
            LAS float* rbl = (LAS float*)(lds + RB_OFF);
            for (int i = tid; i < NH * NREL; i += NWAVES * 64) { const int h = i / NREL, j = i - h * NREL; rbl[h * 264 + j] = (ap->rel_bias[(size_t)l * NH * NREL + i] - ap->rel_bias[(size_t)l * NH * NREL + h * NREL + 256]) * LOG2E; }
            __syncthreads();
            LAS unsigned char* vbuf = lds + wave * 16384;
#pragma unroll 1
            for (int u = gw; u < 4096; u += NGW) {
                const int c = u & 63, h = (u >> 6) & 7, b = u >> 9;
                const int jlo = (c > 8) ? c - 8 : 0;
                const bf16_t* base = Z + (size_t)(b * SEQ) * INC + h * 64;
                auto tf = [&](int j) { TileD td; const size_t ro = (size_t)(64 * (jlo + j)) * INC; td.K = base + ro + ZC_K; td.V = base + ro + ZC_V; td.pitch = INC; td.nkeys = 64; td.delta0 = 64 * (c - jlo - j); return td; };
                bf16_t* qp = Z + (size_t)(b * SEQ + 64 * c) * INC + ZC_Q + h * 64;
                bf16_t* op = rep ? qp : XB + (size_t)(b * SEQ + 64 * c) * DM + h * 64;
                attn_wave<4>(qp, op, INC, rep ? INC : DM, c - jlo + 1, tf, vbuf, rbl + h * 264, lane);
            }
            { int l2 = lane; asm volatile("" : "+v"(l2)); asm volatile("" : "+s"(Z), "+s"(CK), "+s"(CV));
#pragma unroll 1
            for (int us = ((gw & 31) == 31) ? (gw >> 5) : 64; us < 64; us += 64) {
                const int h = us & 7, b = us >> 3;
                const bf16_t* zrow = Z + (size_t)(MP + 16 * b) * INC + h * 64;
                auto tf = [&](int j) { TileD td;
                    if (j < 8) { const size_t ro = (size_t)(b * 512 + 64 * j) * 512 + h * 64; td.K = CK + ro; td.V = CV + ro; td.pitch = 512; td.nkeys = 64; td.delta0 = 512 - 64 * j; }
                    else { td.K = zrow + ZC_K; td.V = zrow + ZC_V; td.pitch = INC; td.nkeys = 16; td.delta0 = 0; }
                    return td; };
                bf16_t* qp = Z + (size_t)(MP + 16 * b) * INC + ZC_Q + h * 64;
                bf16_t* op = rep ? qp : XB + (size_t)(16 * b) * DM + h * 64;
                attn_wave<1>(qp, op, INC, rep ? INC : DM, 9, tf, vbuf, rbl + h * 264, l2);
            } }
            for (int cu = (NGW - 1 - gw); cu < MR / 16; cu += NGW) {
                const int row0 = cu * 16, ch = 8 * lane;
                const bool samp = (row0 >= MP);
                const int bb = samp ? (row0 - MP) / 16 : (row0 >> 12), t0 = samp ? 0 : (row0 & 4095);
                float w0[8], w1[8], w2[8], um2[8], um1[8];
                { const float* wc = ap->w_conv + (size_t)l * 3 * 512 + ch;
#pragma unroll
                  for (int i = 0; i < 8; ++i) { w0[i] = wc[i]; w1[i] = wc[512 + i]; w2[i] = wc[1024 + i]; } }
                if (samp) { const float* sc = ap->state_conv + ((size_t)(l * NBATCH + bb) * 2) * 512 + ch;
#pragma unroll
                    for (int i = 0; i < 8; ++i) { um2[i] = sc[i]; um1[i] = sc[512 + i]; }
                } else if (t0 == 0) {
#pragma unroll
                    for (int i = 0; i < 8; ++i) { um2[i] = 0.f; um1[i] = 0.f; }
                } else {
                    const bf16_t* z2 = Z + (size_t)(row0 - 2) * INC + ch; const bf16_t* z1 = Z + (size_t)(row0 - 1) * INC + ch;
                    const u32x4 c2 = *(const u32x4*)(z2 + ZC_CC), v2 = *(const u32x4*)(z2 + ZC_CV), c1 = *(const u32x4*)(z1 + ZC_CC), v1 = *(const u32x4*)(z1 + ZC_CV);
#pragma unroll
                    for (int i = 0; i < 4; ++i) { um2[2 * i] = bf_lo(c2[i]) * bf_lo(v2[i]); um2[2 * i + 1] = bf_hi(c2[i]) * bf_hi(v2[i]); um1[2 * i] = bf_lo(c1[i]) * bf_lo(v1[i]); um1[2 * i + 1] = bf_hi(c1[i]) * bf_hi(v1[i]); }
                }
#pragma unroll 8
                for (int r = 0; r < 16; ++r) {
                    bf16_t* zr = Z + (size_t)(row0 + r) * INC + ch;
                    const u32x4 cbw = *(const u32x4*)(zr + ZC_CB), ccw = *(const u32x4*)(zr + ZC_CC), cvw = *(const u32x4*)(zr + ZC_CV);
                    float y[8];
#pragma unroll
                    for (int i = 0; i < 4; ++i) {
                        const float u0 = bf_lo(ccw[i]) * bf_lo(cvw[i]), u1 = bf_hi(ccw[i]) * bf_hi(cvw[i]);
                        y[2 * i] = bf_lo(cbw[i]) * (w0[2 * i] * um2[2 * i] + w1[2 * i] * um1[2 * i] + w2[2 * i] * u0);
                        y[2 * i + 1] = bf_hi(cbw[i]) * (w0[2 * i + 1] * um2[2 * i + 1] + w1[2 * i + 1] * um1[2 * i + 1] + w2[2 * i + 1] * u1);
                        um2[2 * i] = um1[2 * i]; um1[2 * i] = u0; um2[2 * i + 1] = um1[2 * i + 1]; um1[2 * i + 1] = u1;
                    }
                    u32x4 w; w.x = cvt_pk_bf16(y[0], y[1]); w.y = cvt_pk_bf16(y[2], y[3]); w.z = cvt_pk_bf16(y[4], y[5]); w.w = cvt_pk_bf16(y[6], y[7]);
                    *(u32x4*)(rep ? zr + ZC_CB : XB + (size_t)(row0 + r) * DM + 512 + ch) = w;
                }
                if (samp || t0 == SEQ - 16) {
                    float* dst = ap->out + (samp ? O_CS : O_CP) + ((size_t)(l * NBATCH + bb) * 2) * 512 + ch;
                    *(f32x4*)dst = (f32x4){um2[0], um2[1], um2[2], um2[3]}; *(f32x4*)(dst + 4) = (f32x4){um2[4], um2[5], um2[6], um2[7]};
                    *(f32x4*)(dst + 512) = (f32x4){um1[0], um1[1], um1[2], um1[3]}; *(f32x4*)(dst + 516) = (f32x4){um1[4], um1[5], um1[6], um1[7]};
                }
            }
            if (rep && l + 1 < DEPTH) { asm volatile("s_waitcnt vmcnt(0) lgkmcnt(0)" ::: "memory"); asm volatile("" : "+s"(ap)); CONVERT_LAYER(l + 1, WTN, CKN, CVN); }
            asm volatile("s_waitcnt vmcnt(0) lgkmcnt(0)" ::: "memory");
            __syncthreads();
        REPSYNC(); }
        SEAM(pb + 4);
        if (IN(pb + 5)) REPS(5) { PHASE_VARS
            pg8::Gemm g{Z, WT + W_CAT, INC, DM, 512, 512 * 2, 512 * 2}; pg8::StaticOrder S; S.init(NTM, DM / 256, G, bx, 2);
            EpiMix E{Z};
            small_gemm<2, 2, EpiMix>(lds, Z + ZC_CB, Z + ZC_Q, INC, WT + W_CAT, WT + W_CAT + 512, DM, DM / 64, E, bx, G, wave, lane);
            pg8::gemm_phase<EpiMix>(lds, g, S, E, tid);
        REPSYNC(); }
        SEAM(pb + 5);
        if (IN(pb + 6)) REPS(6) { PHASE_VARS
            pg8::Gemm g{Z + ZC_MB, WT + W_O, INC, DM, DM, 0, 0}; pg8::StaticOrder S; S.init(NTM, DM / 256, G, bx, 1);
            EpiRes E{XB, SSQ, rep ? 1.0f : 0.0f};
            small_gemm<1, 4, EpiRes>(lds, Z + ZC_MB, Z + ZC_MB, INC, WT + W_O, WT + W_O, DM, DM / 64, E, bx, G, wave, lane);
            pg8::gemm_phase<EpiRes>(lds, g, S, E, tid);
        REPSYNC(); }
        SEAM(pb + 6);
        if (IN(pb + 7)) REPS(7) { PHASE_VARS
            pg8::Gemm g{XB, WT + W_GU2, DM, DM, DM, 0, 0}; pg8::StaticOrder S; S.init(NTM, 2 * DFF / 256, G, bx, 1);
            EpiUp E{HB, SSQ};
            small_gemm<1, 16, EpiUp, true, 2>(lds, XB, XB, DM, WT + W_GU2, WT + W_GU2, DM, 2 * DFF / 64, E, bx, G, wave, lane);
            pg8::gemm_phase<EpiUp>(lds, g, S, E, tid);
        REPSYNC(); }
        SEAM(pb + 7);
        if (IN(pb + 8)) REPS(8) { PHASE_VARS
            pg8::Gemm g{HB, WT + W_D2, DFF, DFF, DFF, 0, 0}; pg8::StaticOrder S; S.init(NTM, DM / 256, G, bx, 1);
            EpiRes E{XB, SSQ, rep ? 0.5f : 0.0f};
            small_gemm<1, 11, EpiRes>(lds, HB, HB, DFF, WT + W_D2, WT + W_D2, DFF, DM / 64, E, bx, G, wave, lane);
            pg8::gemm_phase<EpiRes>(lds, g, S, E, tid);
        REPSYNC(); }
        SEAM(pb + 8);
    }
    if (IN(36)) { const int l = 0; PHASE_VARS
        for (int m = gw; m < MR; m += NGW) {
            float* yr = X + (size_t)m * DM; const bf16_t* xb = XB + (size_t)m * DM;
            const float sv = (lane < 16) ? SSQ[(size_t)m * 16 + lane] : 0.f;
            const float rs = __builtin_amdgcn_rsqf(wave_sum(sv) * (1.0f / 1024.0f) + EPS);
#pragma unroll
            for (int j = 0; j < 4; ++j) { const u32x2 o = *(const u32x2*)(xb + 256 * j + 4 * lane); const f32x4 v = (f32x4){bf_lo(o.x), bf_hi(o.x), bf_lo(o.y), bf_hi(o.y)}, gn = *(const f32x4*)(ap->norm_final + 256 * j + 4 * lane); *(f32x4*)(yr + 256 * j + 4 * lane) = v * rs * gn; }
        }
    }
#undef IN
#undef SEAM
}

extern "C" void kernel_launch(void* const* d_in, const int* in_sizes, int n_in, void* d_out, int out_size, void* d_ws, size_t ws_size, hipStream_t stream) {
    static int grid = 0;
    if (grid == 0) {
        if (n_in != 20 || (size_t)out_size != O_END || ws_size < WS_END) { fprintf(stderr, "kernel_launch: unexpected shapes: n_in %d out %d (want %zu) ws %zu (need %zu)\n", n_in, out_size, (size_t)O_END, ws_size, (size_t)WS_END); grid = -1; return; }
        int dev = 0, cus = 0, per_cu = 0;
        hipGetDevice(&dev); hipDeviceGetAttribute(&cus, hipDeviceAttributeMultiprocessorCount, dev);
        if (hipFuncSetAttribute((const void*)mega_fwd, hipFuncAttributeMaxDynamicSharedMemorySize, LDS_BYTES) != hipSuccess) { fprintf(stderr, "kernel_launch: hipFuncSetAttribute failed\n"); grid = -1; return; }
        if (hipOccupancyMaxActiveBlocksPerMultiprocessor(&per_cu, (const void*)mega_fwd, NWAVES * 64, LDS_BYTES) != hipSuccess || per_cu < 1) { fprintf(stderr, "kernel_launch: occupancy query says %d\n", per_cu); per_cu = 1; }
        (void)hipGetLastError();
        grid = cus;
    }
    if (grid < 0) return;
    Args a{};
    const float** ap = (const float**)&a;
    for (int i = 0; i < 20; ++i) ap[i] = (const float*)d_in[i];
    a.out = (float*)d_out; a.ws = (unsigned char*)d_ws; a.ph_lo = 0; a.ph_hi = 37;
    void* args[] = {&a};
    hipError_t e = hipLaunchCooperativeKernel((const void*)mega_fwd, dim3(grid), dim3(NWAVES * 64), args, LDS_BYTES, stream);
    if (e != hipSuccess) fprintf(stderr, "kernel_launch: cooperative launch failed: %s (grid %d)\n", hipGetErrorString(e), grid);
}
```

```cpp
#include <hip/hip_runtime.h>
#include <hip/hip_cooperative_groups.h>
#include <cstdio>
#include <cstdint>
namespace cg = cooperative_groups;
#ifndef PROBE_REP
#define PROBE_REP (-1)
#endif
#ifndef PROBE_EPI
#define PROBE_EPI 0
#endif
#ifndef PROBE_WAIT
#define PROBE_WAIT 0
#endif

#define LAS __attribute__((address_space(3)))
typedef unsigned short bf16_t;
typedef short bf16x8 __attribute__((ext_vector_type(8)));
typedef short s16x4 __attribute__((ext_vector_type(4)));
typedef float f32x4 __attribute__((ext_vector_type(4)));
typedef unsigned u32x4 __attribute__((ext_vector_type(4)));
typedef unsigned u32x2 __attribute__((ext_vector_type(2)));

constexpr int DM = 1024, NBATCH = 8, SEQ = 4096, DEPTH = 4, DSEQ = 16;
constexpr int NH = 8, DFF = 2816, INC = 5120, NREL = 257;
constexpr int MP = NBATCH * SEQ;
constexpr int MS = NBATCH * DSEQ;
constexpr int MR = MP + MS;
constexpr int MPAD = 33024;
constexpr int NTM = MP / 256;
constexpr float EPS = 1e-6f;
constexpr float LOG2E = 1.4426950408889634f;
constexpr float QSCALE = 0.125f * LOG2E;
constexpr int ZC_CB = 0, ZC_Q = 512, ZC_CC = 1024, ZC_CV = 1536, ZC_K = 2048, ZC_V = 2560, ZC_GC = 3072, ZC_GA = 4096, ZC_MB = 1024;

constexpr size_t O_Y = 0;
constexpr size_t O_KP = (size_t)MR * DM;
constexpr size_t O_VP = O_KP + (size_t)DEPTH * NBATCH * 512 * 512;
constexpr size_t O_CP = O_VP + (size_t)DEPTH * NBATCH * 512 * 512;
constexpr size_t O_KS = O_CP + (size_t)DEPTH * NBATCH * 2 * 512;
constexpr size_t O_VS = O_KS + (size_t)DEPTH * NBATCH * DSEQ * 512;
constexpr size_t O_CS = O_VS + (size_t)DEPTH * NBATCH * DSEQ * 512;
constexpr size_t O_END = O_CS + (size_t)DEPTH * NBATCH * 2 * 512;

constexpr size_t W_GU1 = 0;
constexpr size_t W_D1 = W_GU1 + (size_t)2 * DFF * DM;
constexpr size_t W_IN = W_D1 + (size_t)DM * DFF;
constexpr size_t W_CAT = W_IN + (size_t)INC * DM;
constexpr size_t W_O = W_CAT + (size_t)DM * DM;
constexpr size_t W_GU2 = W_O + (size_t)DM * DM;
constexpr size_t W_D2 = W_GU2 + (size_t)2 * DFF * DM;
constexpr size_t W_TOTAL = W_D2 + (size_t)DM * DFF;

constexpr size_t WS_WT = 0;
constexpr size_t WS_XB = WS_WT + ((W_TOTAL * 2 + 4095) / 4096) * 4096;
constexpr size_t WS_SSQ = WS_XB + (size_t)MPAD * DM * 2;
constexpr size_t WS_CK = WS_SSQ + (size_t)MPAD * 16 * 4;
constexpr size_t WS_CV = WS_CK + (size_t)NBATCH * 512 * 512 * 2;
constexpr size_t WS_Z = WS_CV + (size_t)NBATCH * 512 * 512 * 2;
constexpr size_t WS_WT2 = WS_Z + (size_t)MPAD * INC * 2;
constexpr size_t WS_BAR = WS_WT2 + ((W_TOTAL * 2 + 4095) / 4096) * 4096;
constexpr size_t WS_CK2 = WS_BAR + 16384;
constexpr size_t WS_CV2 = WS_CK2 + (size_t)NBATCH * 512 * 512 * 2;
constexpr size_t WS_END = WS_CV2 + (size_t)NBATCH * 512 * 512 * 2;

constexpr int NWAVES = 8;
constexpr int RING_BYTES = 131072;
constexpr int RB_OFF = RING_BYTES + 1024;
constexpr int LDS_BYTES = 147456;
constexpr int BARST_OFF = LDS_BYTES - 64;

__device__ __forceinline__ unsigned cvt_pk_bf16(float lo, float hi) { unsigned r; asm volatile("v_cvt_pk_bf16_f32 %0, %1, %2" : "=v"(r) : "v"(lo), "v"(hi)); return r; }
__device__ __forceinline__ float bf_lo(unsigned w) { return __uint_as_float(w << 16); }
__device__ __forceinline__ float bf_hi(unsigned w) { return __uint_as_float(w & 0xffff0000u); }
__device__ __forceinline__ unsigned f2bf(float f) { unsigned u = __float_as_uint(f); return (u + 0x7fffu + ((u >> 16) & 1u)) >> 16; }
__device__ __forceinline__ unsigned pk2(float lo, float hi) { return f2bf(lo) | (f2bf(hi) << 16); }
#define GAS __attribute__((address_space(1)))
__device__ __forceinline__ u32x4 ldg16(const void* p) { return *(const GAS u32x4*)p; }
__device__ __forceinline__ bf16x8 ldg16b(const void* p) { return *(const GAS bf16x8*)p; }
__device__ __forceinline__ void stg16(void* p, u32x4 v) { *(GAS u32x4*)p = v; }
__device__ __forceinline__ float xsum_16_32(float s) {
    auto r = __builtin_amdgcn_permlane16_swap(__float_as_uint(s), __float_as_uint(s), false, false);
    s = __uint_as_float(r[0]) + __uint_as_float(r[1]);
    auto q = __builtin_amdgcn_permlane32_swap(__float_as_uint(s), __float_as_uint(s), false, false);
    return __uint_as_float(q[0]) + __uint_as_float(q[1]);
}
__device__ __forceinline__ float xmax_16_32(float s) {
    auto r = __builtin_amdgcn_permlane16_swap(__float_as_uint(s), __float_as_uint(s), false, false);
    s = fmaxf(__uint_as_float(r[0]), __uint_as_float(r[1]));
    auto q = __builtin_amdgcn_permlane32_swap(__float_as_uint(s), __float_as_uint(s), false, false);
    return fmaxf(__uint_as_float(q[0]), __uint_as_float(q[1]));
}
__device__ __forceinline__ float fast_sigmoid(float x) { return __builtin_amdgcn_rcpf(1.0f + __builtin_amdgcn_exp2f(-x * LOG2E)); }

namespace pg8 {
constexpr int BM = 256, BK = 64, HALF = 128, HTB = HALF * BK * 2, STAGE_BYTES = 8 * HTB, NXCD = 8, WGM = 8;
__host__ __device__ __forceinline__ int lds_byte(int r, int c) { const int st = (r >> 4) * 2 + (c >> 5), rr = r & 15, cc = c & 31, ob = rr * 64 + cc * 2; return st * 1024 + (ob ^ (((ob >> 9) & 1) << 5)); }
__host__ __device__ __forceinline__ void stage_rc(int b, int& R, int& C) { const int st = b / 1024, sb = b % 1024, swz = sb ^ (((sb >> 9) & 1) << 5); R = (st >> 1) * 16 + swz / 64; C = (st & 1) * 32 + (swz % 64) / 2; }
__host__ __device__ __forceinline__ int perm32(int rho) { const int n = rho >> 4, i = rho & 15; return 8 * (i >> 2) + 4 * n + (i & 3); }

struct Unit { int pm, pn, z; };
struct Gemm { const bf16_t* A; const bf16_t* Bt; int lda, ldb, K; long zA, zB; };

struct StaticOrder {
    int nM, nN, nwg, G, c, nz;
    __device__ void init(int nM_, int nN_, int G_, int c_, int nz_) { nM = nM_; nN = nN_; nwg = nM * nN; G = G_; c = c_; nz = nz_; }
    __device__ bool next(int i, Unit& u) const {
        const int it = i / nz; u.z = i - it * nz;
        const long L = (long)it * G + c; if (L >= nwg) return false;
        int wgid = (int)L; { const int q = nwg / NXCD, r = nwg % NXCD, xcd = wgid % NXCD, off = wgid / NXCD; wgid = (xcd < r ? xcd * (q + 1) : r * (q + 1) + (xcd - r) * q) + off; }
        const int nig = WGM * nN, gid = wgid / nig, fm = gid * WGM, gsz = (nM - fm) < WGM ? (nM - fm) : WGM;
        u.pm = fm + ((wgid % nig) % gsz); u.pn = (wgid % nig) / gsz; return true;
    }
};

template <class Epi, bool MIDHOOK = false>
__device__ __forceinline__ void gemm_phase(LAS unsigned char* lds, const Gemm g, const StaticOrder& S, const Epi& E, const int tid) {
    const int wid = __builtin_amdgcn_readfirstlane(tid >> 6), lane = tid & 63, wr = wid >> 2, wc = wid & 3, fr = lane & 15, fq = lane >> 4;
    const int K = g.K, nt = K / BK;
    unsigned voffA[2], voffB[2];
#pragma unroll
    for (int i = 0; i < 2; ++i) { int R, C; stage_rc(tid * 16 + i * 8192, R, C); const int Rb = (R & ~31) + perm32(R & 31);
        voffA[i] = (unsigned)(R * g.lda + C) * 2u; voffB[i] = (unsigned)(Rb * g.ldb + C) * 2u; }
    const size_t kstep = (size_t)(BK * 2);
    const size_t hstepA = (size_t)HALF * g.lda * 2, hstepB = (size_t)HALF * g.ldb * 2;
    const size_t tstepA = 2 * hstepA, tstepB = 2 * hstepB;
    const unsigned ldsw = (unsigned)wid * 1024u;
    const int aoff = lds_byte(wr * 64 + fr, fq * 8), boff = lds_byte(wc * 32 + fr, fq * 8);
#define PG8_SA(b, h) (((b) * 2 + (h)) * HTB)
#define PG8_SB(b, h) ((4 + (b) * 2 + (h)) * HTB)
#define PG8_STAGE(bufoff, gbase, voff) do { _Pragma("unroll") for (int _i = 0; _i < 2; ++_i) \
        __builtin_amdgcn_global_load_lds((const unsigned*)((const char*)(gbase) + (voff)[_i]), (LAS unsigned*)(lds + (bufoff) + ldsw + _i * 8192), 16, 0, 0); } while (0)
#define PG8_LDA(dst, b, h) do { _Pragma("unroll") for (int m = 0; m < 4; ++m) _Pragma("unroll") for (int k = 0; k < 2; ++k) dst[m][k] = *(const LAS bf16x8*)(lds + PG8_SA(b, h) + aoff + m * 2048 + k * 1024); } while (0)
#define PG8_LDB(dst, b, h) do { _Pragma("unroll") for (int n = 0; n < 2; ++n) _Pragma("unroll") for (int k = 0; k < 2; ++k) dst[n][k] = *(const LAS bf16x8*)(lds + PG8_SB(b, h) + boff + n * 2048 + k * 1024); } while (0)
#define PG8_MMA(ai, bj, At, Bt) do { __builtin_amdgcn_s_setprio(1); _Pragma("unroll") for (int m = 0; m < 4; ++m) _Pragma("unroll") for (int n = 0; n < 2; ++n) _Pragma("unroll") for (int k = 0; k < 2; ++k) \
        acc[ai][bj][m][n] = __builtin_amdgcn_mfma_f32_16x16x32_bf16(Bt[n][k], At[m][k], acc[ai][bj][m][n], 0, 0, 0); __builtin_amdgcn_s_setprio(0); } while (0)
#define PG8_WAIT_V(n) asm volatile("s_waitcnt vmcnt(" #n ")" ::: "memory")
#define PG8_WAIT_L(n) asm volatile("s_waitcnt lgkmcnt(" #n ")" ::: "memory")
#define PG8_BAR __builtin_amdgcn_s_barrier()
#define PG8_SCHED __builtin_amdgcn_sched_barrier(0)
    Unit cur, nxt; int ui = 0;
    if (!S.next(0, cur)) return;
    f32x4 acc[2][2][4][2];
#pragma unroll
    for (int a = 0; a < 2; ++a)
#pragma unroll
        for (int b = 0; b < 2; ++b)
#pragma unroll
            for (int m = 0; m < 4; ++m)
#pragma unroll
                for (int n = 0; n < 2; ++n) acc[a][b][m][n] = (f32x4){0.f, 0.f, 0.f, 0.f};
    bf16x8 At[4][2], B0[2][2], B1[2][2];
    const char* cA = (const char*)g.A + (size_t)cur.pm * tstepA + (size_t)cur.z * g.zA; const char* cB = (const char*)g.Bt + (size_t)cur.pn * tstepB + (size_t)cur.z * g.zB;
    PG8_STAGE(PG8_SB(0, 0), cB, voffB); PG8_STAGE(PG8_SB(0, 1), cB + hstepB, voffB); PG8_STAGE(PG8_SA(0, 0), cA, voffA); PG8_STAGE(PG8_SA(0, 1), cA + hstepA, voffA);
    if (wr == 1) PG8_BAR;
    PG8_WAIT_V(2); PG8_BAR;
    PG8_STAGE(PG8_SB(1, 0), cB + kstep, voffB); PG8_STAGE(PG8_SA(1, 0), cA + kstep, voffA); PG8_STAGE(PG8_SB(1, 1), cB + hstepB + kstep, voffB);
    PG8_WAIT_V(6); PG8_BAR;
    for (;;) {
        const bool has_next = S.next(ui + 1, nxt);
        const char* nA = has_next ? (const char*)g.A + (size_t)nxt.pm * tstepA + (size_t)nxt.z * g.zA : cA; const char* nB = has_next ? (const char*)g.Bt + (size_t)nxt.pn * tstepB + (size_t)nxt.z * g.zB : cB;
        for (int t = 0; t < nt; t += 2) {
            if constexpr (MIDHOOK) { if (t == nt / 2) E.mid(acc, cur, wr, wc, fr, fq); }
            const bool last = (t == nt - 2);
            const char* a1 = cA + (size_t)(t + 1) * kstep;
            const char* a2 = last ? nA : cA + (size_t)(t + 2) * kstep; const char* b2 = last ? nB : cB + (size_t)(t + 2) * kstep;
            const char* a3 = a2 + kstep; const char* b3 = b2 + kstep;
            PG8_LDB(B0, 0, 0); PG8_LDB(B1, 0, 1); PG8_SCHED; PG8_LDA(At, 0, 0); PG8_STAGE(PG8_SA(1, 1), a1 + hstepA, voffA);
            PG8_WAIT_V(8); PG8_WAIT_L(0); PG8_BAR; PG8_MMA(0, 0, At, B0); PG8_MMA(0, 1, At, B1); PG8_BAR; PG8_SCHED;
            PG8_LDA(At, 0, 1); PG8_STAGE(PG8_SB(0, 0), b2, voffB); PG8_STAGE(PG8_SB(0, 1), b2 + hstepB, voffB); PG8_STAGE(PG8_SA(0, 0), a2, voffA);
            PG8_WAIT_V(8); PG8_WAIT_L(0); PG8_BAR; PG8_MMA(1, 0, At, B0); PG8_MMA(1, 1, At, B1); PG8_BAR; PG8_SCHED;
            PG8_LDB(B0, 1, 0); PG8_LDB(B1, 1, 1); PG8_SCHED; PG8_LDA(At, 1, 0); PG8_STAGE(PG8_SA(0, 1), a2 + hstepA, voffA);
            PG8_WAIT_V(8); PG8_WAIT_L(0); PG8_BAR; PG8_MMA(0, 0, At, B0); PG8_MMA(0, 1, At, B1); PG8_BAR; PG8_SCHED;
            PG8_LDA(At, 1, 1); PG8_STAGE(PG8_SB(1, 0), b3, voffB); PG8_STAGE(PG8_SB(1, 1), b3 + hstepB, voffB); PG8_STAGE(PG8_SA(1, 0), a3, voffA);
            PG8_WAIT_V(8); PG8_WAIT_L(0); PG8_BAR; PG8_MMA(1, 0, At, B0); PG8_MMA(1, 1, At, B1); PG8_BAR; PG8_SCHED;
        }
        if (wr == 0) PG8_BAR;
        E(acc, cur, wr, wc, fr, fq);
        if (PROBE_EPI == Epi::PROBE_ID) { const Epi E2 = E.probe_copy(); E2(acc, cur, wr, wc, fr, fq); }
        if (!has_next) break;
#pragma unroll
        for (int a = 0; a < 2; ++a)
#pragma unroll
            for (int b = 0; b < 2; ++b)
#pragma unroll
                for (int m = 0; m < 4; ++m)
#pragma unroll
                    for (int n = 0; n < 2; ++n) acc[a][b][m][n] = (f32x4){0.f, 0.f, 0.f, 0.f};
        cur = nxt; cA = nA; cB = nB; ++ui;
        if (wr == 1) PG8_BAR;
    }
    PG8_WAIT_V(0);
    PG8_BAR;
#undef PG8_SA
#undef PG8_SB
#undef PG8_STAGE
#undef PG8_LDA
#undef PG8_LDB
#undef PG8_MMA
#undef PG8_WAIT_V
#undef PG8_WAIT_L
#undef PG8_BAR
#undef PG8_SCHED
}
}

__device__ __forceinline__ float row_rs(const float* ssq, int row, int fq) {
    const f32x4 v = *(const f32x4*)(ssq + (size_t)row * 16 + 4 * fq);
    float s = (v[0] + v[1]) + (v[2] + v[3]);
    s = xsum_16_32(s);
    return __builtin_amdgcn_rsqf(s * (1.0f / 1024.0f) + EPS);
}

__device__ __forceinline__ void row_rs8(const float* ssq, int row0, int fq, float (&rsv)[2][4]) {
    f32x4 sv[2][4];
#pragma unroll
    for (int ai = 0; ai < 2; ++ai)
#pragma unroll
        for (int m = 0; m < 4; ++m) sv[ai][m] = *(const f32x4*)(ssq + (size_t)(row0 + ai * 128 + m * 16) * 16 + 4 * fq);
#pragma unroll
    for (int ai = 0; ai < 2; ++ai)
#pragma unroll
        for (int m = 0; m < 4; ++m) {
            float s = (sv[ai][m][0] + sv[ai][m][1]) + (sv[ai][m][2] + sv[ai][m][3]);
            s = xsum_16_32(s);
            rsv[ai][m] = __builtin_amdgcn_rsqf(s * (1.0f / 1024.0f) + EPS);
        }
}

struct EpiUp {
    static constexpr int PROBE_ID = 1; __device__ __forceinline__ EpiUp probe_copy() const { return *this; }
    bf16_t* H; const float* ssq;
    __device__ __forceinline__ void operator()(const f32x4 (&acc)[2][2][4][2], const pg8::Unit& u, int wr, int wc, int fr, int fq) const {
        const int row0 = u.pm * 256 + wr * 64 + fr, hc0 = u.pn * 128 + wc * 32 + 8 * fq;
        float rsv[2][4]; row_rs8(ssq, row0, fq, rsv);
#pragma unroll
        for (int ai = 0; ai < 2; ++ai)
#pragma unroll
            for (int m = 0; m < 4; ++m) {
                const int row = row0 + ai * 128 + m * 16; const float rs = rsv[ai][m];
                float h[8];
#pragma unroll
                for (int n = 0; n < 2; ++n) {
                    const f32x4 gg = acc[ai][0][m][n] * rs, uu = acc[ai][1][m][n] * rs;
#pragma unroll
                    for (int i = 0; i < 4; ++i) h[4 * n + i] = gg[i] * fast_sigmoid(gg[i]) * uu[i];
                }
                u32x4 w; w.x = cvt_pk_bf16(h[0], h[1]); w.y = cvt_pk_bf16(h[2], h[3]); w.z = cvt_pk_bf16(h[4], h[5]); w.w = cvt_pk_bf16(h[6], h[7]);
                *(u32x4*)(H + (size_t)row * DFF + hc0) = w;
            }
    }
    __device__ __forceinline__ void small(const f32x4 (&acc)[1][2][2], int row, int h0, int fr, int fq) const {
        const float rs = row_rs(ssq, row, fq); float h[8];
#pragma unroll
        for (int n = 0; n < 2; ++n) {
            const f32x4 gg = acc[0][0][n] * rs, uu = acc[0][1][n] * rs;
#pragma unroll
            for (int i = 0; i < 4; ++i) h[4 * n + i] = gg[i] * fast_sigmoid(gg[i]) * uu[i];
        }
        u32x4 w; w.x = cvt_pk_bf16(h[0], h[1]); w.y = cvt_pk_bf16(h[2], h[3]); w.z = cvt_pk_bf16(h[4], h[5]); w.w = cvt_pk_bf16(h[6], h[7]);
        *(u32x4*)(H + (size_t)row * DFF + h0 + 8 * fq) = w;
    }
};

struct EpiRes {
    static constexpr int PROBE_ID = 2; __device__ __forceinline__ EpiRes probe_copy() const { EpiRes e = *this; e.scale = 0.f; return e; }
    bf16_t* XB; float* ssq; float scale;
    __device__ __forceinline__ void operator()(const f32x4 (&acc)[2][2][4][2], const pg8::Unit& u, int wr, int wc, int fr, int fq) const {
        const int row0 = u.pm * 256 + wr * 64 + fr, col0 = u.pn * 256 + wc * 32 + 8 * fq;
#pragma unroll
        for (int ai = 0; ai < 2; ++ai) {
            u32x4 xw[4][2];
#pragma unroll
            for (int m = 0; m < 4; ++m)
#pragma unroll
                for (int bj = 0; bj < 2; ++bj) xw[m][bj] = *(const u32x4*)(XB + (size_t)(row0 + ai * 128 + m * 16) * DM + col0 + bj * 128);
#pragma unroll
            for (int m = 0; m < 4; ++m) {
                const int row = row0 + ai * 128 + m * 16; float s = 0.f;
#pragma unroll
                for (int bj = 0; bj < 2; ++bj) {
                    const u32x4 o = xw[m][bj];
                    f32x4 x0 = (f32x4){bf_lo(o.x), bf_hi(o.x), bf_lo(o.y), bf_hi(o.y)}, x1 = (f32x4){bf_lo(o.z), bf_hi(o.z), bf_lo(o.w), bf_hi(o.w)};
                    x0 += acc[ai][bj][m][0] * scale; x1 += acc[ai][bj][m][1] * scale;
                    u32x4 w; w.x = cvt_pk_bf16(x0[0], x0[1]); w.y = cvt_pk_bf16(x0[2], x0[3]); w.z = cvt_pk_bf16(x1[0], x1[1]); w.w = cvt_pk_bf16(x1[2], x1[3]);
                    *(u32x4*)(XB + (size_t)row * DM + col0 + bj * 128) = w;
                    s += (x0[0] * x0[0] + x0[1] * x0[1]) + (x0[2] * x0[2] + x0[3] * x0[3]) + (x1[0] * x1[0] + x1[1] * x1[1]) + (x1[2] * x1[2] + x1[3] * x1[3]);
                }
                s = xsum_16_32(s);
                if (fq == 0) ssq[(size_t)row * 16 + u.pn * 4 + wc] = s;
            }
        }
    }
    __device__ __forceinline__ void small(const f32x4 (&acc)[1][2][2], int row, int c0, int fr, int fq) const {
        float s = 0.f;
#pragma unroll
        for (int j = 0; j < 2; ++j) {
            bf16_t* xp = XB + (size_t)row * DM + c0 + 32 * j + 8 * fq;
            const u32x4 o = *(const u32x4*)xp;
            f32x4 x0 = (f32x4){bf_lo(o.x), bf_hi(o.x), bf_lo(o.y), bf_hi(o.y)}, x1 = (f32x4){bf_lo(o.z), bf_hi(o.z), bf_lo(o.w), bf_hi(o.w)};
            x0 += acc[0][j][0] * scale; x1 += acc[0][j][1] * scale;
            u32x4 w; w.x = cvt_pk_bf16(x0[0], x0[1]); w.y = cvt_pk_bf16(x0[2], x0[3]); w.z = cvt_pk_bf16(x1[0], x1[1]); w.w = cvt_pk_bf16(x1[2], x1[3]);
            *(u32x4*)xp = w;
            s += (x0[0] * x0[0] + x0[1] * x0[1]) + (x0[2] * x0[2] + x0[3] * x0[3]) + (x1[0] * x1[0] + x1[1] * x1[1]) + (x1[2] * x1[2] + x1[3] * x1[3]);
        }
        s = xsum_16_32(s);
        if (fq == 0) ssq[(size_t)row * 16 + (c0 >> 6)] = s;
    }
};

struct EpiIn {
    static constexpr int PROBE_ID = 3; __device__ __forceinline__ EpiIn probe_copy() const { return *this; }
    bf16_t* Z; const float* ssq; const float* bgate; float* okp; float* ovp; float* oks; float* ovs;
    __device__ __forceinline__ void operator()(const f32x4 (&acc)[2][2][4][2], const pg8::Unit& u, int wr, int wc, int fr, int fq) const {
        const int row0 = u.pm * 256 + wr * 64 + fr, col0 = u.pn * 256 + wc * 32 + 8 * fq;
        const int pn = u.pn;
        const bool isq = (pn == 2 || pn == 3), iskv = (pn >= 8 && pn < 12), isg = (pn >= 12);
        const bool kvp = iskv && ((u.pm & 15) >= 14);
        f32x4 bg[2][2];
#pragma unroll
        for (int bj = 0; bj < 2; ++bj) { if (isg) { bg[bj][0] = *(const f32x4*)(bgate + col0 - ZC_GC + bj * 128); bg[bj][1] = *(const f32x4*)(bgate + col0 - ZC_GC + bj * 128 + 4); } else { bg[bj][0] = (f32x4){0.f, 0.f, 0.f, 0.f}; bg[bj][1] = bg[bj][0]; } }
        float rsv[2][4]; row_rs8(ssq, row0, fq, rsv);
#pragma unroll
        for (int ai = 0; ai < 2; ++ai)
#pragma unroll
            for (int m = 0; m < 4; ++m) {
                const int row = row0 + ai * 128 + m * 16; float rs = rsv[ai][m];
                if (isq) rs *= QSCALE;
#pragma unroll
                for (int bj = 0; bj < 2; ++bj) {
                    f32x4 v0 = acc[ai][bj][m][0] * rs, v1 = acc[ai][bj][m][1] * rs;
                    const int c = col0 + bj * 128;
                    if (isg) {
                        v0 += bg[bj][0]; v1 += bg[bj][1];
#pragma unroll
                        for (int i = 0; i < 4; ++i) { v0[i] = fast_sigmoid(v0[i]); v1[i] = fast_sigmoid(v1[i]); }
                    }
                    u32x4 w; w.x = cvt_pk_bf16(v0[0], v0[1]); w.y = cvt_pk_bf16(v0[2], v0[3]); w.z = cvt_pk_bf16(v1[0], v1[1]); w.w = cvt_pk_bf16(v1[2], v1[3]);
                    *(u32x4*)(Z + (size_t)row * INC + c) = w;
                    if (kvp) {
                        const int b = row >> 12, t = row & 4095;
                        float* dst = ((pn < 10) ? okp : ovp) + ((size_t)(b * 512 + (t - 3584)) * 512 + (c - ((pn < 10) ? ZC_K : ZC_V)));
                        __builtin_nontemporal_store(v0, (f32x4*)dst); __builtin_nontemporal_store(v1, (f32x4*)(dst + 4));
                    }
                }
            }
    }
    __device__ __forceinline__ void small(const f32x4 (&acc)[1][2][2], int row, int c0, int fr, int fq) const {
        const int pn = c0 >> 8;
        const bool isq = (pn == 2 || pn == 3), iskv = (pn >= 8 && pn < 12), isg = (pn >= 12);
        float rs = row_rs(ssq, row, fq);
        if (isq) rs *= QSCALE;
#pragma unroll
        for (int j = 0; j < 2; ++j) {
            f32x4 v0 = acc[0][j][0] * rs, v1 = acc[0][j][1] * rs;
            const int c = c0 + 32 * j + 8 * fq;
            if (isg) {
                v0 += *(const f32x4*)(bgate + c - ZC_GC); v1 += *(const f32x4*)(bgate + c - ZC_GC + 4);
#pragma unroll
                for (int i = 0; i < 4; ++i) { v0[i] = fast_sigmoid(v0[i]); v1[i] = fast_sigmoid(v1[i]); }
            }
            u32x4 w; w.x = cvt_pk_bf16(v0[0], v0[1]); w.y = cvt_pk_bf16(v0[2], v0[3]); w.z = cvt_pk_bf16(v1[0], v1[1]); w.w = cvt_pk_bf16(v1[2], v1[3]);
            *(u32x4*)(Z + (size_t)row * INC + c) = w;
            if (iskv) {
                float* dst = ((pn < 10) ? oks : ovs) + ((size_t)(row - MP) * 512 + (c - ((pn < 10) ? ZC_K : ZC_V)));
                __builtin_nontemporal_store(v0, (f32x4*)dst); __builtin_nontemporal_store(v1, (f32x4*)(dst + 4));
            }
        }
    }
};

struct EpiMix {
    static constexpr int PROBE_ID = 4; __device__ __forceinline__ EpiMix probe_copy() const { return *this; }
    bf16_t* Z;
    __device__ __forceinline__ void mid(f32x4 (&acc)[2][2][4][2], const pg8::Unit& u, int wr, int wc, int fr, int fq) const {
        int row0 = u.pm * 256 + wr * 64 + fr, col0 = u.pn * 256 + wc * 32 + 8 * fq;
        asm volatile("" : "+v"(row0), "+v"(col0));
#pragma unroll
        for (int g4 = 0; g4 < 4; ++g4) {
            const int ai = g4 >> 1, mb = (g4 & 1) * 2;
            u32x4 gcv[2][2], gav[2][2];
#pragma unroll
            for (int mm = 0; mm < 2; ++mm)
#pragma unroll
                for (int bj = 0; bj < 2; ++bj) { const bf16_t* zr = Z + (size_t)(row0 + ai * 128 + (mb + mm) * 16) * INC + col0 + bj * 128; gcv[mm][bj] = *(const u32x4*)(zr + ZC_GC); gav[mm][bj] = *(const u32x4*)(zr + ZC_GA); }
#pragma unroll
            for (int mm = 0; mm < 2; ++mm)
#pragma unroll
                for (int bj = 0; bj < 2; ++bj) {
                    const u32x4 gc = gcv[mm][bj], ga = gav[mm][bj]; const int m = mb + mm;
                    f32x4 r0, r1;
                    r0[0] = bf_lo(gc.x) * __builtin_amdgcn_rcpf(fmaxf(bf_lo(ga.x), 1e-12f)); r0[1] = bf_hi(gc.x) * __builtin_amdgcn_rcpf(fmaxf(bf_hi(ga.x), 1e-12f));
                    r0[2] = bf_lo(gc.y) * __builtin_amdgcn_rcpf(fmaxf(bf_lo(ga.y), 1e-12f)); r0[3] = bf_hi(gc.y) * __builtin_amdgcn_rcpf(fmaxf(bf_hi(ga.y), 1e-12f));
                    r1[0] = bf_lo(gc.z) * __builtin_amdgcn_rcpf(fmaxf(bf_lo(ga.z), 1e-12f)); r1[1] = bf_hi(gc.z) * __builtin_amdgcn_rcpf(fmaxf(bf_hi(ga.z), 1e-12f));
                    r1[2] = bf_lo(gc.w) * __builtin_amdgcn_rcpf(fmaxf(bf_lo(ga.w), 1e-12f)); r1[3] = bf_hi(gc.w) * __builtin_amdgcn_rcpf(fmaxf(bf_hi(ga.w), 1e-12f));
                    acc[ai][bj][m][0] *= r0; acc[ai][bj][m][1] *= r1;
                }
        }
    }
    __device__ __forceinline__ void operator()(const f32x4 (&acc)[2][2][4][2], const pg8::Unit& u, int wr, int wc, int fr, int fq) const {
        const int row0 = u.pm * 256 + wr * 64 + fr, col0 = u.pn * 256 + wc * 32 + 8 * fq;
#pragma unroll
        for (int ai = 0; ai < 2; ++ai) {
            u32x4 gav[4][2];
#pragma unroll
            for (int m = 0; m < 4; ++m)
#pragma unroll
                for (int bj = 0; bj < 2; ++bj) gav[m][bj] = *(const u32x4*)(Z + (size_t)(row0 + ai * 128 + m * 16) * INC + ZC_GA + col0 + bj * 128);
#pragma unroll
            for (int m = 0; m < 4; ++m)
#pragma unroll
                for (int bj = 0; bj < 2; ++bj) {
                    const u32x4 ga = gav[m][bj];
                    f32x4 v0 = acc[ai][bj][m][0], v1 = acc[ai][bj][m][1];
                    v0[0] *= fmaxf(bf_lo(ga.x), 1e-12f); v0[1] *= fmaxf(bf_hi(ga.x), 1e-12f); v0[2] *= fmaxf(bf_lo(ga.y), 1e-12f); v0[3] *= fmaxf(bf_hi(ga.y), 1e-12f);
                    v1[0] *= fmaxf(bf_lo(ga.z), 1e-12f); v1[1] *= fmaxf(bf_hi(ga.z), 1e-12f); v1[2] *= fmaxf(bf_lo(ga.w), 1e-12f); v1[3] *= fmaxf(bf_hi(ga.w), 1e-12f);
                    u32x4 w; w.x = cvt_pk_bf16(v0[0], v0[1]); w.y = cvt_pk_bf16(v0[2], v0[3]); w.z = cvt_pk_bf16(v1[0], v1[1]); w.w = cvt_pk_bf16(v1[2], v1[3]);
                    *(u32x4*)(Z + (size_t)(row0 + ai * 128 + m * 16) * INC + ZC_MB + col0 + bj * 128) = w;
                }
        }
    }
    __device__ __forceinline__ void small(const f32x4 (&acc)[2][2][2], int row, int c0, int fr, int fq) const {
#pragma unroll
        for (int j = 0; j < 2; ++j) {
            const int c = c0 + 32 * j + 8 * fq;
            const u32x4 gc = *(const u32x4*)(Z + (size_t)row * INC + ZC_GC + c), ga = *(const u32x4*)(Z + (size_t)row * INC + ZC_GA + c);
            const f32x4 a0 = acc[0][j][0], a1 = acc[0][j][1], b0 = acc[1][j][0], b1 = acc[1][j][1];
            float m[8];
            m[0] = a0[0] * bf_lo(gc.x) + b0[0] * bf_lo(ga.x); m[1] = a0[1] * bf_hi(gc.x) + b0[1] * bf_hi(ga.x);
            m[2] = a0[2] * bf_lo(gc.y) + b0[2] * bf_lo(ga.y); m[3] = a0[3] * bf_hi(gc.y) + b0[3] * bf_hi(ga.y);
            m[4] = a1[0] * bf_lo(gc.z) + b1[0] * bf_lo(ga.z); m[5] = a1[1] * bf_hi(gc.z) + b1[1] * bf_hi(ga.z);
            m[6] = a1[2] * bf_lo(gc.w) + b1[2] * bf_lo(ga.w); m[7] = a1[3] * bf_hi(gc.w) + b1[3] * bf_hi(ga.w);
            u32x4 w; w.x = cvt_pk_bf16(m[0], m[1]); w.y = cvt_pk_bf16(m[2], m[3]); w.z = cvt_pk_bf16(m[4], m[5]); w.w = cvt_pk_bf16(m[6], m[7]);
            *(u32x4*)(Z + (size_t)row * INC + ZC_MB + c) = w;
        }
    }
};

template <int NSET, int NSTEP  , class Epi, bool UPMODE = false, int KSPLIT = 8  >
__device__ __forceinline__ void small_gemm(LAS unsigned char* lds, const bf16_t* A0, const bf16_t* A1, int lda, const bf16_t* W0, const bf16_t* W1, int ldb, int ncg, const Epi& E, int bx, int G, int wave, int lane) {
    constexpr int UPR = 8 / KSPLIT;
    const int fr = lane & 15, fq = lane >> 4, us = wave / KSPLIT, kp = wave % KSPLIT;
    LAS f32x4* part = (LAS f32x4*)lds;
#pragma unroll 1
    for (int u0 = bx * UPR; u0 < 8 * ncg; u0 += G * UPR) {
        const int u = u0 + us; const bool valid = (u < 8 * ncg);
        const int uc = valid ? u : 0;
        const int rb = uc & 7, cg = uc >> 3;
        const int row = MP + 16 * rb + fr;
        f32x4 acc[NSET][2][2];
#pragma unroll
        for (int st = 0; st < NSET; ++st) {
            const bf16_t* Ap = (st ? A1 : A0) + (size_t)row * lda + kp * (NSTEP * 32) + 8 * fq;
            const int cb0 = UPMODE ? 256 * (cg >> 2) + 32 * (cg & 3) : 64 * cg;
            const bf16_t* Wp = (st ? W1 : W0) + (size_t)(cb0 + 8 * (fr >> 2) + (fr & 3)) * ldb + kp * (NSTEP * 32) + 8 * fq;
#pragma unroll
            for (int j = 0; j < 2; ++j)
#pragma unroll
                for (int n = 0; n < 2; ++n) acc[st][j][n] = (f32x4){0.f, 0.f, 0.f, 0.f};
            constexpr int KBMAX = (NSTEP == 11) ? 6 : 4;
#pragma unroll
            for (int k0 = 0; k0 < NSTEP; k0 += KBMAX) {
                bf16x8 av[KBMAX], bv[KBMAX][2][2];
#pragma unroll
                for (int kk = 0; kk < KBMAX; ++kk) if (k0 + kk < NSTEP) {
                    av[kk] = *(const bf16x8*)(Ap + 32 * (k0 + kk));
#pragma unroll
                    for (int j = 0; j < 2; ++j)
#pragma unroll
                        for (int n = 0; n < 2; ++n) bv[kk][j][n] = *(const bf16x8*)(Wp + (size_t)((UPMODE ? 128 : 32) * j + 4 * n) * ldb + 32 * (k0 + kk));
                }
                __builtin_amdgcn_sched_barrier(0);
#pragma unroll
                for (int kk = 0; kk < KBMAX; ++kk) if (k0 + kk < NSTEP) {
#pragma unroll
                    for (int j = 0; j < 2; ++j)
#pragma unroll
                        for (int n = 0; n < 2; ++n) acc[st][j][n] = __builtin_amdgcn_mfma_f32_16x16x32_bf16(bv[kk][j][n], av[kk], acc[st][j][n], 0, 0, 0);
                }
                __builtin_amdgcn_sched_barrier(0);
            }
        }
        if (kp != 0) {
#pragma unroll
            for (int st = 0; st < NSET; ++st)
#pragma unroll
                for (int j = 0; j < 2; ++j)
#pragma unroll
                    for (int n = 0; n < 2; ++n) part[((wave * NSET + st) * 4 + j * 2 + n) * 64 + lane] = acc[st][j][n];
        }
        __syncthreads();
        if (kp == 0 && valid) {
#pragma unroll
            for (int w = 1; w < KSPLIT; ++w)
#pragma unroll
                for (int st = 0; st < NSET; ++st)
#pragma unroll
                    for (int j = 0; j < 2; ++j)
#pragma unroll
                        for (int n = 0; n < 2; ++n) acc[st][j][n] += part[(((wave + w) * NSET + st) * 4 + j * 2 + n) * 64 + lane];
            E.small(acc, row, UPMODE ? 128 * (cg >> 2) + 32 * (cg & 3) : 64 * cg, fr, fq);
        }
        __syncthreads();
    }
}

struct TileD { const bf16_t* K; const bf16_t* V; int pitch; int nkeys; int delta0; };

__device__ __forceinline__ void attn_dma_v(const TileD& td, LAS unsigned char* vb, int lane) {
#pragma unroll
    for (int i = 0; i < 8; ++i) {
        const int row = 8 * i + (lane >> 3), chs = lane & 7, ch = chs ^ (((row >> 1) & 3) << 1);
        __builtin_amdgcn_global_load_lds((const unsigned*)(td.V + (size_t)row * td.pitch + ch * 8), (LAS unsigned*)(vb + i * 1024), 16, 0, 0);
    }
}
template <int NQB, class TF>
__device__ __forceinline__ void attn_wave(const bf16_t* Qp, bf16_t* Op, int qpitch, int opitch, int nt, const TF& tilef, LAS unsigned char* vbuf, const LAS float* rb, int lane) {
    const int fr = lane & 15, fq = lane >> 4;
    bf16x8 qf[NQB][2];
#pragma unroll
    for (int qb = 0; qb < NQB; ++qb)
#pragma unroll
        for (int dh = 0; dh < 2; ++dh) qf[qb][dh] = ldg16b(Qp + (size_t)(16 * qb + fr) * qpitch + dh * 32 + 8 * fq);
    f32x4 O[NQB][4]; float mrow[NQB], lrow[NQB];
#pragma unroll
    for (int qb = 0; qb < NQB; ++qb) { mrow[qb] = -1e30f; lrow[qb] = 0.f;
#pragma unroll
        for (int db = 0; db < 4; ++db) O[qb][db] = (f32x4){0.f, 0.f, 0.f, 0.f}; }
    const int qp = fr >> 2, pp = fr & 3, rowl = 4 * fq + qp, sw = ((rowl >> 1) & 3) << 1;
    const int vrow = rowl * 128 + (pp & 1) * 8, vch = (pp >> 1) ^ sw;
    bf16x8 kf[2][2];
    { const TileD td = tilef(0); attn_dma_v(td, vbuf, lane);
#pragma unroll
      for (int kb = 0; kb < 2; ++kb)
#pragma unroll
          for (int dh = 0; dh < 2; ++dh) kf[kb][dh] = ldg16b(td.K + (size_t)(16 * kb + fr) * td.pitch + dh * 32 + 8 * fq); }
    const int nht = 2 * nt;
#pragma unroll 1
    for (int ht = 0; ht < nht; ++ht) {
        const int t = ht >> 1, half = ht & 1;
        asm volatile("s_waitcnt vmcnt(0)" ::: "memory");
        const TileD td = tilef(t);
        if (half == 0 && t + 1 < nt) { const TileD tn = tilef(t + 1); attn_dma_v(tn, vbuf + ((t + 1) & 1) * 8192, lane); }
        f32x4 S[2][NQB];
#pragma unroll
        for (int kb = 0; kb < 2; ++kb)
#pragma unroll
            for (int qb = 0; qb < NQB; ++qb) {
                f32x4 s = __builtin_amdgcn_mfma_f32_16x16x32_bf16(kf[kb][0], qf[qb][0], (f32x4){0.f, 0.f, 0.f, 0.f}, 0, 0, 0);
                S[kb][qb] = __builtin_amdgcn_mfma_f32_16x16x32_bf16(kf[kb][1], qf[qb][1], s, 0, 0, 0);
            }
        if (ht + 1 < nht) {
            const TileD tk = tilef((ht + 1) >> 1); const int r0 = 32 * ((ht + 1) & 1);
#pragma unroll
            for (int kb = 0; kb < 2; ++kb)
#pragma unroll
                for (int dh = 0; dh < 2; ++dh) kf[kb][dh] = ldg16b(tk.K + (size_t)(r0 + 16 * kb + fr) * tk.pitch + dh * 32 + 8 * fq);
        }
        const int delta0 = td.delta0 - 32 * half, nkeys = td.nkeys - 32 * half;
        if (delta0 < 160) {
#pragma unroll
            for (int kb = 0; kb < 2; ++kb)
#pragma unroll
                for (int qb = 0; qb < NQB; ++qb)
#pragma unroll
                    for (int i = 0; i < 4; ++i) {
                        int d = delta0 + (16 * qb + fr) - (16 * kb + 4 * fq + i);
                        d = d < -128 ? -128 : (d > 128 ? 128 : d);
                        S[kb][qb][i] += rb[d + 128];
                    }
        }
        if (nkeys < 32) {
#pragma unroll
            for (int kb = 0; kb < 2; ++kb)
#pragma unroll
                for (int qb = 0; qb < NQB; ++qb)
#pragma unroll
                    for (int i = 0; i < 4; ++i) if (16 * kb + 4 * fq + i >= nkeys) S[kb][qb][i] = -INFINITY;
        }
        float mxq[NQB]; bool grow = false;
#pragma unroll
        for (int qb = 0; qb < NQB; ++qb) {
            float mx = fmaxf(fmaxf(fmaxf(S[0][qb][0], S[0][qb][1]), fmaxf(S[0][qb][2], S[0][qb][3])), fmaxf(fmaxf(S[1][qb][0], S[1][qb][1]), fmaxf(S[1][qb][2], S[1][qb][3])));
            mx = xmax_16_32(mx);
            mxq[qb] = mx; grow = grow || (mx > mrow[qb]);
        }
        if (__any(grow)) {
#pragma unroll
            for (int qb = 0; qb < NQB; ++qb) {
                const float mn = fmaxf(mrow[qb], mxq[qb]), alpha = __builtin_amdgcn_exp2f(mrow[qb] - mn);
                mrow[qb] = mn; lrow[qb] *= alpha;
#pragma unroll
                for (int db = 0; db < 4; ++db) O[qb][db] *= alpha;
            }
        }
        bf16x8 pf[NQB];
#pragma unroll
        for (int qb = 0; qb < NQB; ++qb) {
            const float mn = mrow[qb]; float ps = 0.f; float p[2][4];
#pragma unroll
            for (int kb = 0; kb < 2; ++kb)
#pragma unroll
                for (int i = 0; i < 4; ++i) { p[kb][i] = __builtin_amdgcn_exp2f(S[kb][qb][i] - mn); ps += p[kb][i]; }
            lrow[qb] += ps;
            u32x4 w; w.x = cvt_pk_bf16(p[0][0], p[0][1]); w.y = cvt_pk_bf16(p[0][2], p[0][3]); w.z = cvt_pk_bf16(p[1][0], p[1][1]); w.w = cvt_pk_bf16(p[1][2], p[1][3]);
            pf[qb] = __builtin_bit_cast(bf16x8, w);
        }
        const LAS unsigned char* vb = vbuf + (t & 1) * 8192 + half * 4096 + vrow;
#pragma unroll
        for (int db = 0; db < 4; ++db) {
            const int off = ((2 * db) ^ vch) << 4;
            const s16x4 lo = __builtin_amdgcn_ds_read_tr16_b64_v4i16((LAS s16x4*)(vb + off));
            const s16x4 hi = __builtin_amdgcn_ds_read_tr16_b64_v4i16((LAS s16x4*)(vb + off + 2048));
            const bf16x8 vf = (bf16x8){lo[0], lo[1], lo[2], lo[3], hi[0], hi[1], hi[2], hi[3]};
#pragma unroll
            for (int qb = 0; qb < NQB; ++qb) O[qb][db] = __builtin_amdgcn_mfma_f32_16x16x32_bf16(vf, pf[qb], O[qb][db], 0, 0, 0);
        }
    }
    asm volatile("s_waitcnt lgkmcnt(0)" ::: "memory");
#pragma unroll
    for (int qb = 0; qb < NQB; ++qb) {
        float l = xsum_16_32(lrow[qb]);
        const float inv = 1.0f / l;
#pragma unroll
        for (int db = 0; db < 4; ++db) {
            const f32x4 o = O[qb][db] * inv; u32x2 w; w.x = cvt_pk_bf16(o[0], o[1]); w.y = cvt_pk_bf16(o[2], o[3]);
            *(GAS u32x2*)(Op + (size_t)(16 * qb + fr) * opitch + 16 * db + 4 * fq) = w;
        }
    }
}


#define XB_TMO      128
#define XB_XCNT(j)  (256  + 64 * (j))
#define XB_XSUB(j)  (1280 + 64 * (j))
#define XB_XGEN(j)  (2304 + 64 * (j))
#define XB_TOP      3328
#define XB_TOPGEN   3392
#define XCD_BAR_WORDS 3456
#define XB_SPIN_CAP (1u << 20)
__device__ __forceinline__ unsigned xb_ld(unsigned* p)              { return __hip_atomic_load(p, __ATOMIC_RELAXED, __HIP_MEMORY_SCOPE_AGENT); }
__device__ __forceinline__ unsigned xb_add(unsigned* p, unsigned v) { return __hip_atomic_fetch_add(p, v, __ATOMIC_RELAXED, __HIP_MEMORY_SCOPE_AGENT); }
__device__ __forceinline__ unsigned xb_xcc_id() { return (unsigned)__builtin_amdgcn_s_getreg((3 << 11) | 20) & 0xFu; }
#define XB_SPIN(cond, bar) do { unsigned _sp = 0; while (cond) { __builtin_amdgcn_s_sleep(1); \
    if ((++_sp & 255u) == 0u) { if (xb_ld(&(bar)[XB_TMO])) break; if (_sp > XB_SPIN_CAP) { atomicAdd(&(bar)[XB_TMO], 1u); break; } } } } while (0)
struct XcdBarrier { unsigned* bar; unsigned x; volatile LAS unsigned* st; };
__device__ __forceinline__ XcdBarrier xcd_barrier_post(unsigned* bar, volatile LAS unsigned* st) {
    XcdBarrier b; b.bar = bar; b.x = xb_xcc_id(); b.st = st;
    if (threadIdx.x == 0) (void)xb_add(&bar[XB_XCNT(b.x)], 1u);
    return b;
}
__device__ __forceinline__ void xcd_barrier_complete(unsigned* bar, unsigned x, unsigned& nloc, unsigned& nx) {
    const unsigned G = gridDim.x * gridDim.y * gridDim.z;
    unsigned sum, cnt, mine, sp = 0u;
    for (;;) {
        sum = 0u; cnt = 0u; mine = 0u;
#pragma unroll
        for (unsigned j = 0; j < 16; ++j) { const unsigned c = xb_ld(&bar[XB_XCNT(j)]); sum += c; cnt += (c > 0u) ? 1u : 0u; mine = (j == x) ? c : mine; }
        if (sum == G) break;
        __builtin_amdgcn_s_sleep(1);
        if ((++sp & 255u) == 0u) { if (xb_ld(&bar[XB_TMO])) break; if (sp > XB_SPIN_CAP) { atomicAdd(&bar[XB_TMO], 1u); break; } }
    }
    nloc = mine > 0u ? mine : 1u; nx = cnt > 0u ? cnt : 1u;
}
__device__ __forceinline__ void xcd_barrier(const XcdBarrier& b) {
    asm volatile("s_waitcnt vmcnt(0)" ::: "memory");
    __syncthreads();
    if (threadIdx.x == 0) {
        unsigned* bar = b.bar;
        __builtin_amdgcn_s_waitcnt(0);
        unsigned nloc = b.st[0], nx = b.st[1];
        if (nloc == 0u) { xcd_barrier_complete(bar, b.x, nloc, nx); b.st[0] = nloc; b.st[1] = nx; }
        const unsigned old = xb_add(&bar[XB_XSUB(b.x)], 1u);
        const unsigned gen = old / nloc;
        if (old + 1u == (gen + 1u) * nloc) {
            __builtin_amdgcn_fence(__ATOMIC_RELEASE, "agent");
            asm volatile("s_waitcnt vmcnt(0)" ::: "memory");
            const unsigned og = xb_add(&bar[XB_TOP], 1u);
            const unsigned tg = og / nx;
            if (og + 1u == (tg + 1u) * nx) xb_add(&bar[XB_TOPGEN], 1u);
            else XB_SPIN(xb_ld(&bar[XB_TOPGEN]) == tg, bar);
            __builtin_amdgcn_fence(__ATOMIC_ACQUIRE, "agent");
            xb_add(&bar[XB_XGEN(b.x)], 1u);
            asm volatile("s_waitcnt vmcnt(0)" ::: "memory");
        } else {
            XB_SPIN(xb_ld(&bar[XB_XGEN(b.x)]) == gen, bar);
            __builtin_amdgcn_fence(__ATOMIC_ACQUIRE, "agent");
            asm volatile("s_waitcnt vmcnt(0)" ::: "memory");
        }
    }
    __syncthreads();
}

struct Args {
    const float* x_prompt; const float* x_sample; const float* cache_k; const float* cache_v; const float* state_conv;
    const float* norm_ffn1; const float* w_ffn1_gu; const float* w_ffn1_down; const float* norm_mix; const float* w_in; const float* b_gate; const float* w_conv;
    const float* rel_bias; const float* w_conv_out; const float* w_attn_out; const float* w_o; const float* norm_ffn2; const float* w_ffn2_gu; const float* w_ffn2_down; const float* norm_final;
    float* out; unsigned char* ws; int ph_lo, ph_hi;
};

__device__ __forceinline__ void transpose_item(const float* W, int N, const float* gain, bf16_t* WT, int dpitch, int dkoff, int mode, int kb, int nb, int scol0, LAS float* scr, int lane) {
    const int k0 = 64 * kb, n0 = 32 * nb, c = lane & 31;
    const int scol = (mode == 1) ? ((c < 16) ? 16 * nb + c : DFF + 16 * nb + (c - 16)) : scol0 + c;
    float wv[32];
#pragma unroll
    for (int i = 0; i < 32; ++i) wv[i] = __builtin_nontemporal_load(W + (size_t)(k0 + 2 * i + (lane >> 5)) * N + scol);
    if (gain) {
#pragma unroll
        for (int i = 0; i < 32; ++i) wv[i] *= gain[k0 + 2 * i + (lane >> 5)];
    }
#pragma unroll
    for (int i = 0; i < 32; ++i) scr[(2 * i + (lane >> 5)) * 33 + c] = wv[i];
    asm volatile("s_waitcnt lgkmcnt(0)" ::: "memory");
    const int c8 = lane & 7;
#pragma unroll
    for (int j = 0; j < 4; ++j) { const int n = (lane >> 3) + 8 * j; const LAS float* s = scr + (8 * c8) * 33 + n;
        u32x4 o; o.x = pk2(s[0 * 33], s[1 * 33]); o.y = pk2(s[2 * 33], s[3 * 33]); o.z = pk2(s[4 * 33], s[5 * 33]); o.w = pk2(s[6 * 33], s[7 * 33]);
        int drow;
        if (mode == 1) { const int jj = n & 15, isu = n >> 4; drow = n0 + 8 * (jj >> 2) + 4 * isu + (jj & 3); } else drow = n0 + n;
        *(u32x4*)(WT + (size_t)drow * dpitch + dkoff + k0 + 8 * c8) = o; }
    asm volatile("s_waitcnt lgkmcnt(0)" ::: "memory");
}

__device__ __forceinline__ float wave_sum(float v) {
#pragma unroll
    for (int o = 1; o < 64; o <<= 1) v += __shfl_xor(v, o);
    return v;
}

__global__ void __launch_bounds__(NWAVES * 64, 2) mega_fwd(Args a) {
    extern __shared__ __attribute__((aligned(16))) unsigned char lds_raw[];
    LAS unsigned char* lds = (LAS unsigned char*)lds_raw;
    cg::grid_group grid = cg::this_grid();
    typedef const __attribute__((address_space(4))) Args* ArgP;
    ArgP ap = (ArgP)__builtin_amdgcn_kernarg_segment_ptr();
    const int G = gridDim.x, bx = blockIdx.x;
    const int wave0 = __builtin_amdgcn_readfirstlane((int)threadIdx.x >> 6);
    unsigned* barw = (unsigned*)(ap->ws + WS_BAR);
    if (bx == 0) for (int i = threadIdx.x; i < 4096; i += NWAVES * 64) barw[i] = 0u;
    if (threadIdx.x < 16) ((LAS unsigned*)(lds + BARST_OFF))[threadIdx.x] = 0u;
    XcdBarrier xbar; xbar.bar = barw; xbar.x = 0; xbar.st = (volatile LAS unsigned*)(lds + BARST_OFF);
    bool xposted = false; unsigned wait_ticks = 0; (void)wait_ticks;
    const int lo = ap->ph_lo, hi = ap->ph_hi;
#define PHASE_VARS \
    asm volatile("" : "+s"(ap)); \
    int lane_ = (int)__builtin_amdgcn_mbcnt_hi(~0u, __builtin_amdgcn_mbcnt_lo(~0u, 0u)); asm volatile("" : "+v"(lane_)); \
    int wave_ = wave0; asm volatile("" : "+s"(wave_)); \
    const int lane = lane_, wave = wave_, tid = wave * 64 + lane; \
    const int vcu = (G % 8 == 0) ? (bx % 8) * (G / 8) + bx / 8 : bx; \
    const int gw = vcu * NWAVES + wave, NGW = G * NWAVES; \
    const int gt = gw * 64 + lane, NGT = NGW * 64; \
    unsigned char* ws = ap->ws; \
    bf16_t* WT = (bf16_t*)(ws + ((l & 1) ? WS_WT2 : WS_WT)); bf16_t* WTN = (bf16_t*)(ws + ((l & 1) ? WS_WT : WS_WT2)); bf16_t* XB = (bf16_t*)(ws + WS_XB); float* SSQ = (float*)(ws + WS_SSQ); \
    bf16_t* CK = (bf16_t*)(ws + ((l & 1) ? WS_CK2 : WS_CK)); bf16_t* CV = (bf16_t*)(ws + ((l & 1) ? WS_CV2 : WS_CV)); \
    bf16_t* CKN = (bf16_t*)(ws + ((l & 1) ? WS_CK : WS_CK2)); bf16_t* CVN = (bf16_t*)(ws + ((l & 1) ? WS_CV : WS_CV2)); bf16_t* Z = (bf16_t*)(ws + WS_Z); bf16_t* HB = Z; \
    float* X = ap->out; \
    (void)WTN; (void)CKN; (void)CVN; (void)tid; (void)lane; (void)wave; (void)gw; (void)NGW; (void)gt; (void)NGT; (void)WT; (void)XB; (void)SSQ; (void)CK; (void)CV; (void)Z; (void)HB; (void)X;
#define IN(k) (lo <= (k) && (k) < hi)
#define GSYNC() do { unsigned long long t0_ = 0; if (PROBE_WAIT) t0_ = __builtin_amdgcn_s_memrealtime(); if (!xposted) { grid.sync(); xbar = xcd_barrier_post(barw, (volatile LAS unsigned*)(lds + BARST_OFF)); xposted = true; } else xcd_barrier(xbar); if (PROBE_WAIT) wait_ticks += (unsigned)(__builtin_amdgcn_s_memrealtime() - t0_); } while (0)
#define SEAM(k) do { if (IN(k) && IN((k) + 1)) { const unsigned w0_ = wait_ticks; GSYNC(); if (PROBE_WAIT >= 100 && ((k) % 9) != PROBE_WAIT - 100) wait_ticks = w0_; if (PROBE_REP == 9) GSYNC(); } } while (0)
#define REPS(k) for (int rep = (PROBE_REP == (k)) ? 0 : 1; rep < 2; ++rep)
#define REPSYNC() do { if (rep == 0) GSYNC(); } while (0)

#define CONVERT_LAYER(LC, WTD, CKD, CVD) do { \
            LAS float* scr = (LAS float*)(lds + wave * 16384); \
            constexpr int I_GU = 16 * 176, I_D = 44 * 32, I_IN = 16 * 160, I_C = 8 * 32, I_O = 16 * 32; \
            constexpr int NITEMS = 2 * I_GU + 2 * I_D + I_IN + 2 * I_C + I_O; \
            for (int it = gw; it < NITEMS; it += NGW) { \
                int r = it; \
                if (r < I_GU) { transpose_item(ap->w_ffn1_gu + (size_t)(LC) * DM * 2 * DFF, 2 * DFF, ap->norm_ffn1 + (LC) * DM, (WTD) + W_GU1, DM, 0, 0, r / 176, r % 176, (((r % 176) >> 2) & 1) * DFF + 128 * ((r % 176) >> 3) + 32 * ((r % 176) & 3), scr, lane); continue; } r -= I_GU; \
                if (r < I_GU) { transpose_item(ap->w_ffn2_gu + (size_t)(LC) * DM * 2 * DFF, 2 * DFF, ap->norm_ffn2 + (LC) * DM, (WTD) + W_GU2, DM, 0, 0, r / 176, r % 176, (((r % 176) >> 2) & 1) * DFF + 128 * ((r % 176) >> 3) + 32 * ((r % 176) & 3), scr, lane); continue; } r -= I_GU; \
                if (r < I_D) { transpose_item(ap->w_ffn1_down + (size_t)(LC) * DFF * DM, DM, nullptr, (WTD) + W_D1, DFF, 0, 0, r / 32, r % 32, 32 * (r % 32), scr, lane); continue; } r -= I_D; \
                if (r < I_D) { transpose_item(ap->w_ffn2_down + (size_t)(LC) * DFF * DM, DM, nullptr, (WTD) + W_D2, DFF, 0, 0, r / 32, r % 32, 32 * (r % 32), scr, lane); continue; } r -= I_D; \
                if (r < I_IN) { const int nb = r % 160, kb = r / 160, blk = nb >> 4; \
                    const int ob = (blk == 1) ? 3 : (blk == 2) ? 1 : (blk == 3) ? 2 : blk; \
                    transpose_item(ap->w_in + (size_t)(LC) * DM * INC, INC, ap->norm_mix + (LC) * DM, (WTD) + W_IN, DM, 0, 0, kb, nb, ob * 512 + 32 * (nb & 15), scr, lane); continue; } r -= I_IN; \
                if (r < I_C) { transpose_item(ap->w_conv_out + (size_t)(LC) * 512 * DM, DM, nullptr, (WTD) + W_CAT, DM, 0, 0, r / 32, r % 32, 32 * (r % 32), scr, lane); continue; } r -= I_C; \
                if (r < I_C) { transpose_item(ap->w_attn_out + (size_t)(LC) * 512 * DM, DM, nullptr, (WTD) + W_CAT, DM, 512, 0, r / 32, r % 32, 32 * (r % 32), scr, lane); continue; } r -= I_C; \
                transpose_item(ap->w_o + (size_t)(LC) * DM * DM, DM, nullptr, (WTD) + W_O, DM, 0, 0, r / 32, r % 32, 32 * (r % 32), scr, lane); \
            } \
 \
            for (int i = gt; i < 2 * (NBATCH * 512 * 512 / 8); i += NGT) { \
                const int which = i / (NBATCH * 512 * 512 / 8), e = (i % (NBATCH * 512 * 512 / 8)) * 8; \
                const float* src = (which ? ap->cache_v : ap->cache_k) + (size_t)(LC) * NBATCH * 512 * 512 + e; \
                const f32x4 v0 = __builtin_nontemporal_load((const f32x4*)src), v1 = __builtin_nontemporal_load((const f32x4*)(src + 4)); \
                u32x4 w; w.x = pk2(v0[0], v0[1]); w.y = pk2(v0[2], v0[3]); w.z = pk2(v1[0], v1[1]); w.w = pk2(v1[2], v1[3]); \
                *(u32x4*)((which ? (CVD) : (CKD)) + e) = w; \
            } \
} while (0)

#pragma unroll 1
    for (int l = 0; l < DEPTH; ++l) {
        const int pb = 9 * l;
        if (l == 0 && IN(pb + 0)) REPS(0) { PHASE_VARS
            CONVERT_LAYER(0, WT, CK, CV);
            if (l == 0) {
                for (int m = gw; m < MPAD; m += NGW) {
                    bf16_t* xb = XB + (size_t)m * DM; float* sq = SSQ + (size_t)m * 16;
                    if (m < MR) {
                        const float* src = (m < MP) ? ap->x_prompt + (size_t)m * DM : ap->x_sample + (size_t)(m - MP) * DM;
                        float s = 0.f;
#pragma unroll
                        for (int j = 0; j < 4; ++j) { const f32x4 v = *(const f32x4*)(src + 256 * j + 4 * lane);
                            u32x2 w; w.x = pk2(v[0], v[1]); w.y = pk2(v[2], v[3]); *(u32x2*)(xb + 256 * j + 4 * lane) = w; s += (v[0] * v[0] + v[1] * v[1]) + (v[2] * v[2] + v[3] * v[3]); }
                        s = wave_sum(s);
                        if (lane < 16) sq[lane] = (lane == 0) ? s : 0.f;
                    } else {
#pragma unroll
                        for (int j = 0; j < 4; ++j) *(u32x2*)(xb + 256 * j + 4 * lane) = (u32x2){0u, 0u};
                        if (lane < 16) sq[lane] = 0.f;
                    }
                }
            }
        REPSYNC(); }
        if (l == 0) SEAM(pb + 0);
        if (IN(pb + 1)) REPS(1) { PHASE_VARS
            pg8::Gemm g{XB, WT + W_GU1, DM, DM, DM, 0, 0}; pg8::StaticOrder S; S.init(NTM, 2 * DFF / 256, G, bx, 1);
            EpiUp E{HB, SSQ};
            small_gemm<1, 16, EpiUp, true, 2>(lds, XB, XB, DM, WT + W_GU1, WT + W_GU1, DM, 2 * DFF / 64, E, bx, G, wave, lane);
            pg8::gemm_phase<EpiUp>(lds, g, S, E, tid);
        REPSYNC(); }
        SEAM(pb + 1);
        if (IN(pb + 2)) REPS(2) { PHASE_VARS
            pg8::Gemm g{HB, WT + W_D1, DFF, DFF, DFF, 0, 0}; pg8::StaticOrder S; S.init(NTM, DM / 256, G, bx, 1);
            EpiRes E{XB, SSQ, rep ? 0.5f : 0.0f};
            small_gemm<1, 11, EpiRes>(lds, HB, HB, DFF, WT + W_D1, WT + W_D1, DFF, DM / 64, E, bx, G, wave, lane);
            pg8::gemm_phase<EpiRes>(lds, g, S, E, tid);
        REPSYNC(); }
        SEAM(pb + 2);
        if (IN(pb + 3)) REPS(3) { PHASE_VARS
            pg8::Gemm g{XB, WT + W_IN, DM, DM, DM, 0, 0}; pg8::StaticOrder S; S.init(NTM, INC / 256, G, bx, 1);
            EpiIn E{Z, SSQ, ap->b_gate + (size_t)l * 2 * DM, ap->out + O_KP + (size_t)l * NBATCH * 512 * 512, ap->out + O_VP + (size_t)l * NBATCH * 512 * 512,
                    ap->out + O_KS + (size_t)l * MS * 512, ap->out + O_VS + (size_t)l * MS * 512};
            small_gemm<1, 16, EpiIn, false, 2>(lds, XB, XB, DM, WT + W_IN, WT + W_IN, DM, INC / 64, E, bx, G, wave, lane);
            pg8::gemm_phase<EpiIn>(lds, g, S, E, tid);
        REPSYNC(); }
        SEAM(pb + 3);
        if (IN(pb + 4)) REPS(4) { PHASE_VARS
            LAS float* rbl = (LAS float*)(lds + RB_OFF);
            for (int i = tid; i < NH * NREL; i += NWAVES * 64) { const int h = i / NREL, j = i - h * NREL; rbl[h * 264 + j] = (ap->rel_bias[(size_t)l * NH * NREL + i] - ap->rel_bias[(size_t)l * NH * NREL + h * NREL + 256]) * LOG2E; }
            __syncthreads();
            LAS unsigned char* vbuf = lds + wave * 16384;
#pragma unroll 1
            for (int u = gw; u < 4096; u += NGW) {
                const int c = u & 63, h = (u >> 6) & 7, b = u >> 9;
                const int jlo = (c > 8) ? c - 8 : 0;
                const bf16_t* base = Z + (size_t)(b * SEQ) * INC + h * 64;
                auto tf = [&](int j) { TileD td; const size_t ro = (size_t)(64 * (jlo + j)) * INC; td.K = base + ro + ZC_K; td.V = base + ro + ZC_V; td.pitch = INC; td.nkeys = 64; td.delta0 = 64 * (c - jlo - j); return td; };
                bf16_t* qp = Z + (size_t)(b * SEQ + 64 * c) * INC + ZC_Q + h * 64;
                bf16_t* op = rep ? qp : XB + (size_t)(b * SEQ + 64 * c) * DM + h * 64;
                attn_wave<4>(qp, op, INC, rep ? INC : DM, c - jlo + 1, tf, vbuf, rbl + h * 264, lane);
            }
            { int l2 = lane; asm volatile("" : "+v"(l2)); asm volatile("" : "+s"(Z), "+s"(CK), "+s"(CV));
#pragma unroll 1
            for (int us = ((gw & 63) < 2) ? ((gw >> 6) * 2 + (gw & 63)) : 64; us < 64; us += 64) {
                const int h = us & 7, b = us >> 3;
                const bf16_t* zrow = Z + (size_t)(MP + 16 * b) * INC + h * 64;
                auto tf = [&](int j) { TileD td;
                    if (j < 8) { const size_t ro = (size_t)(b * 512 + 64 * j) * 512 + h * 64; td.K = CK + ro; td.V = CV + ro; td.pitch = 512; td.nkeys = 64; td.delta0 = 512 - 64 * j; }
                    else { td.K = zrow + ZC_K; td.V = zrow + ZC_V; td.pitch = INC; td.nkeys = 16; td.delta0 = 0; }
                    return td; };
                bf16_t* qp = Z + (size_t)(MP + 16 * b) * INC + ZC_Q + h * 64;
                bf16_t* op = rep ? qp : XB + (size_t)(16 * b) * DM + h * 64;
                attn_wave<1>(qp, op, INC, rep ? INC : DM, 9, tf, vbuf, rbl + h * 264, l2);
            } }
            for (int cu = (NGW - 1 - gw); cu < MR / 16; cu += NGW) {
                const int row0 = cu * 16, ch = 8 * lane;
                const bool samp = (row0 >= MP);
                const int bb = samp ? (row0 - MP) / 16 : (row0 >> 12), t0 = samp ? 0 : (row0 & 4095);
                float w0[8], w1[8], w2[8], um2[8], um1[8];
                { const float* wc = ap->w_conv + (size_t)l * 3 * 512 + ch;
#pragma unroll
                  for (int i = 0; i < 8; ++i) { w0[i] = wc[i]; w1[i] = wc[512 + i]; w2[i] = wc[1024 + i]; } }
                if (samp) { const float* sc = ap->state_conv + ((size_t)(l * NBATCH + bb) * 2) * 512 + ch;
#pragma unroll
                    for (int i = 0; i < 8; ++i) { um2[i] = sc[i]; um1[i] = sc[512 + i]; }
                } else if (t0 == 0) {
#pragma unroll
                    for (int i = 0; i < 8; ++i) { um2[i] = 0.f; um1[i] = 0.f; }
                } else {
                    const bf16_t* z2 = Z + (size_t)(row0 - 2) * INC + ch; const bf16_t* z1 = Z + (size_t)(row0 - 1) * INC + ch;
                    const u32x4 c2 = ldg16(z2 + ZC_CC), v2 = ldg16(z2 + ZC_CV), c1 = ldg16(z1 + ZC_CC), v1 = ldg16(z1 + ZC_CV);
#pragma unroll
                    for (int i = 0; i < 4; ++i) { um2[2 * i] = bf_lo(c2[i]) * bf_lo(v2[i]); um2[2 * i + 1] = bf_hi(c2[i]) * bf_hi(v2[i]); um1[2 * i] = bf_lo(c1[i]) * bf_lo(v1[i]); um1[2 * i + 1] = bf_hi(c1[i]) * bf_hi(v1[i]); }
                }
#pragma unroll
                for (int rb8 = 0; rb8 < 2; ++rb8) {
                    u32x4 cbv[8], ccv[8], cvv[8];
#pragma unroll
                    for (int r = 0; r < 8; ++r) { const bf16_t* zr = Z + (size_t)(row0 + rb8 * 8 + r) * INC + ch; cbv[r] = ldg16(zr + ZC_CB); ccv[r] = ldg16(zr + ZC_CC); cvv[r] = ldg16(zr + ZC_CV); }
#pragma unroll
                    for (int r = 0; r < 8; ++r) {
                        bf16_t* zr = Z + (size_t)(row0 + rb8 * 8 + r) * INC + ch;
                        const u32x4 cbw = cbv[r], ccw = ccv[r], cvw = cvv[r];
                        float y[8];
#pragma unroll
                        for (int i = 0; i < 4; ++i) {
                            const float u0 = bf_lo(ccw[i]) * bf_lo(cvw[i]), u1 = bf_hi(ccw[i]) * bf_hi(cvw[i]);
                            y[2 * i] = bf_lo(cbw[i]) * (w0[2 * i] * um2[2 * i] + w1[2 * i] * um1[2 * i] + w2[2 * i] * u0);
                            y[2 * i + 1] = bf_hi(cbw[i]) * (w0[2 * i + 1] * um2[2 * i + 1] + w1[2 * i + 1] * um1[2 * i + 1] + w2[2 * i + 1] * u1);
                            um2[2 * i] = um1[2 * i]; um1[2 * i] = u0; um2[2 * i + 1] = um1[2 * i + 1]; um1[2 * i + 1] = u1;
                        }
                        u32x4 w; w.x = cvt_pk_bf16(y[0], y[1]); w.y = cvt_pk_bf16(y[2], y[3]); w.z = cvt_pk_bf16(y[4], y[5]); w.w = cvt_pk_bf16(y[6], y[7]);
                        stg16(rep ? zr + ZC_CB : XB + (size_t)(row0 + rb8 * 8 + r) * DM + 512 + ch, w);
                    }
                }
                if (samp || t0 == SEQ - 16) {
                    float* dst = ap->out + (samp ? O_CS : O_CP) + ((size_t)(l * NBATCH + bb) * 2) * 512 + ch;
                    *(f32x4*)dst = (f32x4){um2[0], um2[1], um2[2], um2[3]}; *(f32x4*)(dst + 4) = (f32x4){um2[4], um2[5], um2[6], um2[7]};
                    *(f32x4*)(dst + 512) = (f32x4){um1[0], um1[1], um1[2], um1[3]}; *(f32x4*)(dst + 516) = (f32x4){um1[4], um1[5], um1[6], um1[7]};
                }
            }
            if (rep && l + 1 < DEPTH) { asm volatile("s_waitcnt vmcnt(0) lgkmcnt(0)" ::: "memory"); asm volatile("" : "+s"(ap)); CONVERT_LAYER(l + 1, WTN, CKN, CVN); }
            asm volatile("s_waitcnt vmcnt(0) lgkmcnt(0)" ::: "memory");
            __syncthreads();
        REPSYNC(); }
        SEAM(pb + 4);
        if (IN(pb + 5)) REPS(5) { PHASE_VARS
            pg8::Gemm g{Z, WT + W_CAT, INC, DM, DM, 0, 0}; pg8::StaticOrder S; S.init(NTM, DM / 256, G, bx, 1);
            EpiMix E{Z};
            small_gemm<2, 2, EpiMix>(lds, Z + ZC_CB, Z + ZC_Q, INC, WT + W_CAT, WT + W_CAT + 512, DM, DM / 64, E, bx, G, wave, lane);
            pg8::gemm_phase<EpiMix, true>(lds, g, S, E, tid);
        REPSYNC(); }
        SEAM(pb + 5);
        if (IN(pb + 6)) REPS(6) { PHASE_VARS
            pg8::Gemm g{Z + ZC_MB, WT + W_O, INC, DM, DM, 0, 0}; pg8::StaticOrder S; S.init(NTM, DM / 256, G, bx, 1);
            EpiRes E{XB, SSQ, rep ? 1.0f : 0.0f};
            small_gemm<1, 4, EpiRes>(lds, Z + ZC_MB, Z + ZC_MB, INC, WT + W_O, WT + W_O, DM, DM / 64, E, bx, G, wave, lane);
            pg8::gemm_phase<EpiRes>(lds, g, S, E, tid);
        REPSYNC(); }
        SEAM(pb + 6);
        if (IN(pb + 7)) REPS(7) { PHASE_VARS
            pg8::Gemm g{XB, WT + W_GU2, DM, DM, DM, 0, 0}; pg8::StaticOrder S; S.init(NTM, 2 * DFF / 256, G, bx, 1);
            EpiUp E{HB, SSQ};
            small_gemm<1, 16, EpiUp, true, 2>(lds, XB, XB, DM, WT + W_GU2, WT + W_GU2, DM, 2 * DFF / 64, E, bx, G, wave, lane);
            pg8::gemm_phase<EpiUp>(lds, g, S, E, tid);
        REPSYNC(); }
        SEAM(pb + 7);
        if (IN(pb + 8)) REPS(8) { PHASE_VARS
            pg8::Gemm g{HB, WT + W_D2, DFF, DFF, DFF, 0, 0}; pg8::StaticOrder S; S.init(NTM, DM / 256, G, bx, 1);
            EpiRes E{XB, SSQ, rep ? 0.5f : 0.0f};
            small_gemm<1, 11, EpiRes>(lds, HB, HB, DFF, WT + W_D2, WT + W_D2, DFF, DM / 64, E, bx, G, wave, lane);
            pg8::gemm_phase<EpiRes>(lds, g, S, E, tid);
        REPSYNC(); }
        SEAM(pb + 8);
    }
    if (IN(36)) { const int l = 0; PHASE_VARS
        for (int m = gw; m < MR; m += NGW) {
            float* yr = X + (size_t)m * DM; const bf16_t* xb = XB + (size_t)m * DM;
            const float sv = (lane < 16) ? SSQ[(size_t)m * 16 + lane] : 0.f;
            const float rs = __builtin_amdgcn_rsqf(wave_sum(sv) * (1.0f / 1024.0f) + EPS);
#pragma unroll
            for (int j = 0; j < 4; ++j) { const u32x2 o = *(const u32x2*)(xb + 256 * j + 4 * lane); const f32x4 v = (f32x4){bf_lo(o.x), bf_hi(o.x), bf_lo(o.y), bf_hi(o.y)}, gn = *(const f32x4*)(ap->norm_final + 256 * j + 4 * lane); __builtin_nontemporal_store(v * rs * gn, (f32x4*)(yr + 256 * j + 4 * lane)); }
        }
    }
    if (PROBE_WAIT) {
        unsigned* acc_w = barw + 3500;
        if (threadIdx.x == 0) atomicAdd(acc_w, wait_ticks);
        GSYNC();
        if (threadIdx.x == 0) { const unsigned avg = __hip_atomic_load(acc_w, __ATOMIC_RELAXED, __HIP_MEMORY_SCOPE_AGENT) / gridDim.x;
            const unsigned long long t0 = __builtin_amdgcn_s_memrealtime(); while (__builtin_amdgcn_s_memrealtime() - t0 < 8ull * avg) __builtin_amdgcn_s_sleep(8); }
        __syncthreads();
    }
#undef IN
#undef SEAM
}

extern "C" void kernel_launch(void* const* d_in, const int* in_sizes, int n_in, void* d_out, int out_size, void* d_ws, size_t ws_size, hipStream_t stream) {
    static int grid = 0;
    if (grid == 0) {
        if (n_in != 20 || (size_t)out_size != O_END || ws_size < WS_END) { fprintf(stderr, "kernel_launch: unexpected shapes: n_in %d out %d (want %zu) ws %zu (need %zu)\n", n_in, out_size, (size_t)O_END, ws_size, (size_t)WS_END); grid = -1; return; }
        int dev = 0, cus = 0, per_cu = 0;
        hipGetDevice(&dev); hipDeviceGetAttribute(&cus, hipDeviceAttributeMultiprocessorCount, dev);
        if (hipFuncSetAttribute((const void*)mega_fwd, hipFuncAttributeMaxDynamicSharedMemorySize, LDS_BYTES) != hipSuccess) { fprintf(stderr, "kernel_launch: hipFuncSetAttribute failed\n"); grid = -1; return; }
        if (hipOccupancyMaxActiveBlocksPerMultiprocessor(&per_cu, (const void*)mega_fwd, NWAVES * 64, LDS_BYTES) != hipSuccess || per_cu < 1) { fprintf(stderr, "kernel_launch: occupancy query says %d\n", per_cu); per_cu = 1; }
        (void)hipGetLastError();
        grid = cus;
    }
    if (grid < 0) return;
    Args a{};
    const float** ap = (const float**)&a;
    for (int i = 0; i < 20; ++i) ap[i] = (const float*)d_in[i];
    a.out = (float*)d_out; a.ws = (unsigned char*)d_ws; a.ph_lo = 0; a.ph_hi = 37;
    void* args[] = {&a};
    hipError_t e = hipLaunchCooperativeKernel((const void*)mega_fwd, dim3(grid), dim3(NWAVES * 64), args, LDS_BYTES, stream);
    if (e != hipSuccess) fprintf(stderr, "kernel_launch: cooperative launch failed: %s (grid %d)\n", hipGetErrorString(e), grid);
}
```

```cpp
#include <hip/hip_runtime.h>
#include <hip/hip_cooperative_groups.h>
#include <cstdio>
#include <cstdint>
namespace cg = cooperative_groups;
#ifndef PROBE_REP
#define PROBE_REP (-1)
#endif
#ifndef PROBE_EPI
#define PROBE_EPI 0
#endif
#ifndef PROBE_WAIT
#define PROBE_WAIT 0
#endif

#define LAS __attribute__((address_space(3)))
typedef unsigned short bf16_t;
typedef short bf16x8 __attribute__((ext_vector_type(8)));
typedef short s16x4 __attribute__((ext_vector_type(4)));
typedef float f32x4 __attribute__((ext_vector_type(4)));
typedef unsigned u32x4 __attribute__((ext_vector_type(4)));
typedef unsigned u32x2 __attribute__((ext_vector_type(2)));

constexpr int DM = 1024, NBATCH = 8, SEQ = 4096, DEPTH = 4, DSEQ = 16;
constexpr int NH = 8, DFF = 2816, INC = 5120, NREL = 257;
constexpr int MP = NBATCH * SEQ;
constexpr int MS = NBATCH * DSEQ;
constexpr int MR = MP + MS;
constexpr int MPAD = 33024;
constexpr int NTM = MP / 256;
constexpr float EPS = 1e-6f;
constexpr float LOG2E = 1.4426950408889634f;
constexpr float QSCALE = 0.125f * LOG2E;
constexpr int ZC_CB = 0, ZC_Q = 512, ZC_CC = 1024, ZC_CV = 1536, ZC_K = 2048, ZC_V = 2560, ZC_GC = 3072, ZC_GA = 4096, ZC_MB = 1024;

constexpr size_t O_Y = 0;
constexpr size_t O_KP = (size_t)MR * DM;
constexpr size_t O_VP = O_KP + (size_t)DEPTH * NBATCH * 512 * 512;
constexpr size_t O_CP = O_VP + (size_t)DEPTH * NBATCH * 512 * 512;
constexpr size_t O_KS = O_CP + (size_t)DEPTH * NBATCH * 2 * 512;
constexpr size_t O_VS = O_KS + (size_t)DEPTH * NBATCH * DSEQ * 512;
constexpr size_t O_CS = O_VS + (size_t)DEPTH * NBATCH * DSEQ * 512;
constexpr size_t O_END = O_CS + (size_t)DEPTH * NBATCH * 2 * 512;

constexpr size_t W_GU1 = 0;
constexpr size_t W_D1 = W_GU1 + (size_t)2 * DFF * DM;
constexpr size_t W_IN = W_D1 + (size_t)DM * DFF;
constexpr size_t W_CAT = W_IN + (size_t)INC * DM;
constexpr size_t W_O = W_CAT + (size_t)DM * DM;
constexpr size_t W_GU2 = W_O + (size_t)DM * DM;
constexpr size_t W_D2 = W_GU2 + (size_t)2 * DFF * DM;
constexpr size_t W_TOTAL = W_D2 + (size_t)DM * DFF;

constexpr size_t WS_WT = 0;
constexpr size_t WS_XB = WS_WT + ((W_TOTAL * 2 + 4095) / 4096) * 4096;
constexpr size_t WS_SSQ = WS_XB + (size_t)MPAD * DM * 2;
constexpr size_t WS_CK = WS_SSQ + (size_t)MPAD * 16 * 4;
constexpr size_t WS_CV = WS_CK + (size_t)NBATCH * 512 * 512 * 2;
constexpr size_t WS_Z = WS_CV + (size_t)NBATCH * 512 * 512 * 2;
constexpr size_t WS_WT2 = WS_Z + (size_t)MPAD * INC * 2;
constexpr size_t WS_BAR = WS_WT2 + ((W_TOTAL * 2 + 4095) / 4096) * 4096;
constexpr size_t WS_CK2 = WS_BAR + 16384;
constexpr size_t WS_CV2 = WS_CK2 + (size_t)NBATCH * 512 * 512 * 2;
constexpr size_t WS_END = WS_CV2 + (size_t)NBATCH * 512 * 512 * 2;

constexpr int NWAVES = 8;
constexpr int RING_BYTES = 131072;
constexpr int RB_OFF = RING_BYTES + 1024;
constexpr int LDS_BYTES = 147456;
constexpr int BARST_OFF = LDS_BYTES - 64;

__device__ __forceinline__ unsigned cvt_pk_bf16(float lo, float hi) { unsigned r; asm volatile("v_cvt_pk_bf16_f32 %0, %1, %2" : "=v"(r) : "v"(lo), "v"(hi)); return r; }
__device__ __forceinline__ float bf_lo(unsigned w) { return __uint_as_float(w << 16); }
__device__ __forceinline__ float bf_hi(unsigned w) { return __uint_as_float(w & 0xffff0000u); }
__device__ __forceinline__ unsigned f2bf(float f) { unsigned u = __float_as_uint(f); return (u + 0x7fffu + ((u >> 16) & 1u)) >> 16; }
__device__ __forceinline__ unsigned pk2(float lo, float hi) { return f2bf(lo) | (f2bf(hi) << 16); }
#define GAS __attribute__((address_space(1)))
__device__ __forceinline__ u32x4 ldg16(const void* p) { return *(const GAS u32x4*)p; }
__device__ __forceinline__ bf16x8 ldg16b(const void* p) { return *(const GAS bf16x8*)p; }
__device__ __forceinline__ void stg16(void* p, u32x4 v) { *(GAS u32x4*)p = v; }
__device__ __forceinline__ float xsum_16_32(float s) {
    auto r = __builtin_amdgcn_permlane16_swap(__float_as_uint(s), __float_as_uint(s), false, false);
    s = __uint_as_float(r[0]) + __uint_as_float(r[1]);
    auto q = __builtin_amdgcn_permlane32_swap(__float_as_uint(s), __float_as_uint(s), false, false);
    return __uint_as_float(q[0]) + __uint_as_float(q[1]);
}
__device__ __forceinline__ float xmax_16_32(float s) {
    auto r = __builtin_amdgcn_permlane16_swap(__float_as_uint(s), __float_as_uint(s), false, false);
    s = fmaxf(__uint_as_float(r[0]), __uint_as_float(r[1]));
    auto q = __builtin_amdgcn_permlane32_swap(__float_as_uint(s), __float_as_uint(s), false, false);
    return fmaxf(__uint_as_float(q[0]), __uint_as_float(q[1]));
}
__device__ __forceinline__ float fast_sigmoid(float x) { return __builtin_amdgcn_rcpf(1.0f + __builtin_amdgcn_exp2f(-x * LOG2E)); }

namespace pg8 {
constexpr int BM = 256, BK = 64, HALF = 128, HTB = HALF * BK * 2, STAGE_BYTES = 8 * HTB, NXCD = 8, WGM = 8;
__host__ __device__ __forceinline__ int lds_byte(int r, int c) { const int st = (r >> 4) * 2 + (c >> 5), rr = r & 15, cc = c & 31, ob = rr * 64 + cc * 2; return st * 1024 + (ob ^ (((ob >> 9) & 1) << 5)); }
__host__ __device__ __forceinline__ void stage_rc(int b, int& R, int& C) { const int st = b / 1024, sb = b % 1024, swz = sb ^ (((sb >> 9) & 1) << 5); R = (st >> 1) * 16 + swz / 64; C = (st & 1) * 32 + (swz % 64) / 2; }
__host__ __device__ __forceinline__ int perm32(int rho) { const int n = rho >> 4, i = rho & 15; return 8 * (i >> 2) + 4 * n + (i & 3); }

struct Unit { int pm, pn, z; };
struct Gemm { const bf16_t* A; const bf16_t* Bt; int lda, ldb, K; long zA, zB; };

struct StaticOrder {
    int nM, nN, nwg, G, c, nz;
    __device__ void init(int nM_, int nN_, int G_, int c_, int nz_) { nM = nM_; nN = nN_; nwg = nM * nN; G = G_; c = c_; nz = nz_; }
    __device__ bool next(int i, Unit& u) const {
        const int it = i / nz; u.z = i - it * nz;
        const long L = (long)it * G + c; if (L >= nwg) return false;
        int wgid = (int)L; { const int q = nwg / NXCD, r = nwg % NXCD, xcd = wgid % NXCD, off = wgid / NXCD; wgid = (xcd < r ? xcd * (q + 1) : r * (q + 1) + (xcd - r) * q) + off; }
        const int nig = WGM * nN, gid = wgid / nig, fm = gid * WGM, gsz = (nM - fm) < WGM ? (nM - fm) : WGM;
        u.pm = fm + ((wgid % nig) % gsz); u.pn = (wgid % nig) / gsz; return true;
    }
};

template <class Epi, bool MIDHOOK = false>
__device__ __forceinline__ void gemm_phase(LAS unsigned char* lds, const Gemm g, const StaticOrder& S, const Epi& E, const int tid) {
    const int wid = __builtin_amdgcn_readfirstlane(tid >> 6), lane = tid & 63, wr = wid >> 2, wc = wid & 3, fr = lane & 15, fq = lane >> 4;
    const int K = g.K, nt = K / BK;
    unsigned voffA[2], voffB[2];
#pragma unroll
    for (int i = 0; i < 2; ++i) { int R, C; stage_rc(tid * 16 + i * 8192, R, C); const int Rb = (R & ~31) + perm32(R & 31);
        voffA[i] = (unsigned)(R * g.lda + C) * 2u; voffB[i] = (unsigned)(Rb * g.ldb + C) * 2u; }
    const size_t kstep = (size_t)(BK * 2);
    const size_t hstepA = (size_t)HALF * g.lda * 2, hstepB = (size_t)HALF * g.ldb * 2;
    const size_t tstepA = 2 * hstepA, tstepB = 2 * hstepB;
    const unsigned ldsw = (unsigned)wid * 1024u;
    const int aoff = lds_byte(wr * 64 + fr, fq * 8), boff = lds_byte(wc * 32 + fr, fq * 8);
#define PG8_SA(b, h) (((b) * 2 + (h)) * HTB)
#define PG8_SB(b, h) ((4 + (b) * 2 + (h)) * HTB)
#define PG8_STAGE(bufoff, gbase, voff) do { _Pragma("unroll") for (int _i = 0; _i < 2; ++_i) \
        __builtin_amdgcn_global_load_lds((const unsigned*)((const char*)(gbase) + (voff)[_i]), (LAS unsigned*)(lds + (bufoff) + ldsw + _i * 8192), 16, 0, 0); } while (0)
#define PG8_LDA(dst, b, h) do { _Pragma("unroll") for (int m = 0; m < 4; ++m) _Pragma("unroll") for (int k = 0; k < 2; ++k) dst[m][k] = *(const LAS bf16x8*)(lds + PG8_SA(b, h) + aoff + m * 2048 + k * 1024); } while (0)
#define PG8_LDB(dst, b, h) do { _Pragma("unroll") for (int n = 0; n < 2; ++n) _Pragma("unroll") for (int k = 0; k < 2; ++k) dst[n][k] = *(const LAS bf16x8*)(lds + PG8_SB(b, h) + boff + n * 2048 + k * 1024); } while (0)
#define PG8_MMA(ai, bj, At, Bt) do { __builtin_amdgcn_s_setprio(1); _Pragma("unroll") for (int m = 0; m < 4; ++m) _Pragma("unroll") for (int n = 0; n < 2; ++n) _Pragma("unroll") for (int k = 0; k < 2; ++k) \
        acc[ai][bj][m][n] = __builtin_amdgcn_mfma_f32_16x16x32_bf16(Bt[n][k], At[m][k], acc[ai][bj][m][n], 0, 0, 0); __builtin_amdgcn_s_setprio(0); } while (0)
#define PG8_WAIT_V(n) asm volatile("s_waitcnt vmcnt(" #n ")" ::: "memory")
#define PG8_WAIT_L(n) asm volatile("s_waitcnt lgkmcnt(" #n ")" ::: "memory")
#define PG8_BAR __builtin_amdgcn_s_barrier()
#define PG8_SCHED __builtin_amdgcn_sched_barrier(0)
    Unit cur, nxt; int ui = 0;
    if (!S.next(0, cur)) return;
    f32x4 acc[2][2][4][2];
#pragma unroll
    for (int a = 0; a < 2; ++a)
#pragma unroll
        for (int b = 0; b < 2; ++b)
#pragma unroll
            for (int m = 0; m < 4; ++m)
#pragma unroll
                for (int n = 0; n < 2; ++n) acc[a][b][m][n] = (f32x4){0.f, 0.f, 0.f, 0.f};
    bf16x8 At[4][2], B0[2][2], B1[2][2];
    const char* cA = (const char*)g.A + (size_t)cur.pm * tstepA + (size_t)cur.z * g.zA; const char* cB = (const char*)g.Bt + (size_t)cur.pn * tstepB + (size_t)cur.z * g.zB;
    PG8_STAGE(PG8_SB(0, 0), cB, voffB); PG8_STAGE(PG8_SB(0, 1), cB + hstepB, voffB); PG8_STAGE(PG8_SA(0, 0), cA, voffA); PG8_STAGE(PG8_SA(0, 1), cA + hstepA, voffA);
    if (wr == 1) PG8_BAR;
    PG8_WAIT_V(2); PG8_BAR;
    PG8_STAGE(PG8_SB(1, 0), cB + kstep, voffB); PG8_STAGE(PG8_SA(1, 0), cA + kstep, voffA); PG8_STAGE(PG8_SB(1, 1), cB + hstepB + kstep, voffB);
    PG8_WAIT_V(6); PG8_BAR;
    for (;;) {
        const bool has_next = S.next(ui + 1, nxt);
        const char* nA = has_next ? (const char*)g.A + (size_t)nxt.pm * tstepA + (size_t)nxt.z * g.zA : cA; const char* nB = has_next ? (const char*)g.Bt + (size_t)nxt.pn * tstepB + (size_t)nxt.z * g.zB : cB;
        for (int t = 0; t < nt; t += 2) {
            if constexpr (MIDHOOK) { if (t == nt / 2) E.mid(acc, cur, wr, wc, fr, fq); }
            const bool last = (t == nt - 2);
            const char* a1 = cA + (size_t)(t + 1) * kstep;
            const char* a2 = last ? nA : cA + (size_t)(t + 2) * kstep; const char* b2 = last ? nB : cB + (size_t)(t + 2) * kstep;
            const char* a3 = a2 + kstep; const char* b3 = b2 + kstep;
            PG8_LDB(B0, 0, 0); PG8_LDB(B1, 0, 1); PG8_SCHED; PG8_LDA(At, 0, 0); PG8_STAGE(PG8_SA(1, 1), a1 + hstepA, voffA);
            PG8_WAIT_V(8); PG8_WAIT_L(0); PG8_BAR; PG8_MMA(0, 0, At, B0); PG8_MMA(0, 1, At, B1); PG8_BAR; PG8_SCHED;
            PG8_LDA(At, 0, 1); PG8_STAGE(PG8_SB(0, 0), b2, voffB); PG8_STAGE(PG8_SB(0, 1), b2 + hstepB, voffB); PG8_STAGE(PG8_SA(0, 0), a2, voffA);
            PG8_WAIT_V(8); PG8_WAIT_L(0); PG8_BAR; PG8_MMA(1, 0, At, B0); PG8_MMA(1, 1, At, B1); PG8_BAR; PG8_SCHED;
            PG8_LDB(B0, 1, 0); PG8_LDB(B1, 1, 1); PG8_SCHED; PG8_LDA(At, 1, 0); PG8_STAGE(PG8_SA(0, 1), a2 + hstepA, voffA);
            PG8_WAIT_V(8); PG8_WAIT_L(0); PG8_BAR; PG8_MMA(0, 0, At, B0); PG8_MMA(0, 1, At, B1); PG8_BAR; PG8_SCHED;
            PG8_LDA(At, 1, 1); PG8_STAGE(PG8_SB(1, 0), b3, voffB); PG8_STAGE(PG8_SB(1, 1), b3 + hstepB, voffB); PG8_STAGE(PG8_SA(1, 0), a3, voffA);
            PG8_WAIT_V(8); PG8_WAIT_L(0); PG8_BAR; PG8_MMA(1, 0, At, B0); PG8_MMA(1, 1, At, B1); PG8_BAR; PG8_SCHED;
        }
        if (wr == 0) PG8_BAR;
        E(acc, cur, wr, wc, fr, fq);
        if (PROBE_EPI == Epi::PROBE_ID) { const Epi E2 = E.probe_copy(); E2(acc, cur, wr, wc, fr, fq); }
        if (!has_next) break;
#pragma unroll
        for (int a = 0; a < 2; ++a)
#pragma unroll
            for (int b = 0; b < 2; ++b)
#pragma unroll
                for (int m = 0; m < 4; ++m)
#pragma unroll
                    for (int n = 0; n < 2; ++n) acc[a][b][m][n] = (f32x4){0.f, 0.f, 0.f, 0.f};
        cur = nxt; cA = nA; cB = nB; ++ui;
        if (wr == 1) PG8_BAR;
    }
    PG8_WAIT_V(0);
    PG8_BAR;
#undef PG8_SA
#undef PG8_SB
#undef PG8_STAGE
#undef PG8_LDA
#undef PG8_LDB
#undef PG8_MMA
#undef PG8_WAIT_V
#undef PG8_WAIT_L
#undef PG8_BAR
#undef PG8_SCHED
}
}

__device__ __forceinline__ float row_rs(const float* ssq, int row, int fq) {
    const f32x4 v = *(const f32x4*)(ssq + (size_t)row * 16 + 4 * fq);
    float s = (v[0] + v[1]) + (v[2] + v[3]);
    s = xsum_16_32(s);
    return __builtin_amdgcn_rsqf(s * (1.0f / 1024.0f) + EPS);
}

__device__ __forceinline__ void row_rs8(const float* ssq, int row0, int fq, float (&rsv)[2][4]) {
    f32x4 sv[2][4];
#pragma unroll
    for (int ai = 0; ai < 2; ++ai)
#pragma unroll
        for (int m = 0; m < 4; ++m) sv[ai][m] = *(const f32x4*)(ssq + (size_t)(row0 + ai * 128 + m * 16) * 16 + 4 * fq);
#pragma unroll
    for (int ai = 0; ai < 2; ++ai)
#pragma unroll
        for (int m = 0; m < 4; ++m) {
            float s = (sv[ai][m][0] + sv[ai][m][1]) + (sv[ai][m][2] + sv[ai][m][3]);
            s = xsum_16_32(s);
            rsv[ai][m] = __builtin_amdgcn_rsqf(s * (1.0f / 1024.0f) + EPS);
        }
}

struct EpiUp {
    static constexpr int PROBE_ID = 1; __device__ __forceinline__ EpiUp probe_copy() const { return *this; }
    bf16_t* H; const float* ssq;
    __device__ __forceinline__ void operator()(const f32x4 (&acc)[2][2][4][2], const pg8::Unit& u, int wr, int wc, int fr, int fq) const {
        const int row0 = u.pm * 256 + wr * 64 + fr, hc0 = u.pn * 128 + wc * 32 + 8 * fq;
        float rsv[2][4]; row_rs8(ssq, row0, fq, rsv);
#pragma unroll
        for (int ai = 0; ai < 2; ++ai)
#pragma unroll
            for (int m = 0; m < 4; ++m) {
                const int row = row0 + ai * 128 + m * 16; const float rs = rsv[ai][m];
                float h[8];
#pragma unroll
                for (int n = 0; n < 2; ++n) {
                    const f32x4 gg = acc[ai][0][m][n] * rs, uu = acc[ai][1][m][n] * rs;
#pragma unroll
                    for (int i = 0; i < 4; ++i) h[4 * n + i] = gg[i] * fast_sigmoid(gg[i]) * uu[i];
                }
                u32x4 w; w.x = cvt_pk_bf16(h[0], h[1]); w.y = cvt_pk_bf16(h[2], h[3]); w.z = cvt_pk_bf16(h[4], h[5]); w.w = cvt_pk_bf16(h[6], h[7]);
                *(u32x4*)(H + (size_t)row * DFF + hc0) = w;
            }
    }
    __device__ __forceinline__ void small(const f32x4 (&acc)[1][2][2], int row, int h0, int fr, int fq) const {
        const float rs = row_rs(ssq, row, fq); float h[8];
#pragma unroll
        for (int n = 0; n < 2; ++n) {
            const f32x4 gg = acc[0][0][n] * rs, uu = acc[0][1][n] * rs;
#pragma unroll
            for (int i = 0; i < 4; ++i) h[4 * n + i] = gg[i] * fast_sigmoid(gg[i]) * uu[i];
        }
        u32x4 w; w.x = cvt_pk_bf16(h[0], h[1]); w.y = cvt_pk_bf16(h[2], h[3]); w.z = cvt_pk_bf16(h[4], h[5]); w.w = cvt_pk_bf16(h[6], h[7]);
        *(u32x4*)(H + (size_t)row * DFF + h0 + 8 * fq) = w;
    }
};

struct EpiRes {
    static constexpr int PROBE_ID = 2; __device__ __forceinline__ EpiRes probe_copy() const { EpiRes e = *this; e.scale = 0.f; return e; }
    bf16_t* XB; float* ssq; float scale;
    __device__ __forceinline__ void operator()(const f32x4 (&acc)[2][2][4][2], const pg8::Unit& u, int wr, int wc, int fr, int fq) const {
        const int row0 = u.pm * 256 + wr * 64 + fr, col0 = u.pn * 256 + wc * 32 + 8 * fq;
#pragma unroll
        for (int ai = 0; ai < 2; ++ai) {
            u32x4 xw[4][2];
#pragma unroll
            for (int m = 0; m < 4; ++m)
#pragma unroll
                for (int bj = 0; bj < 2; ++bj) xw[m][bj] = *(const u32x4*)(XB + (size_t)(row0 + ai * 128 + m * 16) * DM + col0 + bj * 128);
#pragma unroll
            for (int m = 0; m < 4; ++m) {
                const int row = row0 + ai * 128 + m * 16; float s = 0.f;
#pragma unroll
                for (int bj = 0; bj < 2; ++bj) {
                    const u32x4 o = xw[m][bj];
                    f32x4 x0 = (f32x4){bf_lo(o.x), bf_hi(o.x), bf_lo(o.y), bf_hi(o.y)}, x1 = (f32x4){bf_lo(o.z), bf_hi(o.z), bf_lo(o.w), bf_hi(o.w)};
                    x0 += acc[ai][bj][m][0] * scale; x1 += acc[ai][bj][m][1] * scale;
                    u32x4 w; w.x = cvt_pk_bf16(x0[0], x0[1]); w.y = cvt_pk_bf16(x0[2], x0[3]); w.z = cvt_pk_bf16(x1[0], x1[1]); w.w = cvt_pk_bf16(x1[2], x1[3]);
                    *(u32x4*)(XB + (size_t)row * DM + col0 + bj * 128) = w;
                    s += (x0[0] * x0[0] + x0[1] * x0[1]) + (x0[2] * x0[2] + x0[3] * x0[3]) + (x1[0] * x1[0] + x1[1] * x1[1]) + (x1[2] * x1[2] + x1[3] * x1[3]);
                }
                s = xsum_16_32(s);
                if (fq == 0) ssq[(size_t)row * 16 + u.pn * 4 + wc] = s;
            }
        }
    }
    __device__ __forceinline__ void small(const f32x4 (&acc)[1][2][2], int row, int c0, int fr, int fq) const {
        float s = 0.f;
#pragma unroll
        for (int j = 0; j < 2; ++j) {
            bf16_t* xp = XB + (size_t)row * DM + c0 + 32 * j + 8 * fq;
            const u32x4 o = *(const u32x4*)xp;
            f32x4 x0 = (f32x4){bf_lo(o.x), bf_hi(o.x), bf_lo(o.y), bf_hi(o.y)}, x1 = (f32x4){bf_lo(o.z), bf_hi(o.z), bf_lo(o.w), bf_hi(o.w)};
            x0 += acc[0][j][0] * scale; x1 += acc[0][j][1] * scale;
            u32x4 w; w.x = cvt_pk_bf16(x0[0], x0[1]); w.y = cvt_pk_bf16(x0[2], x0[3]); w.z = cvt_pk_bf16(x1[0], x1[1]); w.w = cvt_pk_bf16(x1[2], x1[3]);
            *(u32x4*)xp = w;
            s += (x0[0] * x0[0] + x0[1] * x0[1]) + (x0[2] * x0[2] + x0[3] * x0[3]) + (x1[0] * x1[0] + x1[1] * x1[1]) + (x1[2] * x1[2] + x1[3] * x1[3]);
        }
        s = xsum_16_32(s);
        if (fq == 0) ssq[(size_t)row * 16 + (c0 >> 6)] = s;
    }
};

struct EpiIn {
    static constexpr int PROBE_ID = 3; __device__ __forceinline__ EpiIn probe_copy() const { return *this; }
    bf16_t* Z; const float* ssq; const float* bgate; float* okp; float* ovp; float* oks; float* ovs;
    __device__ __forceinline__ void operator()(const f32x4 (&acc)[2][2][4][2], const pg8::Unit& u, int wr, int wc, int fr, int fq) const {
        const int row0 = u.pm * 256 + wr * 64 + fr, col0 = u.pn * 256 + wc * 32 + 8 * fq;
        const int pn = u.pn;
        const bool isq = (pn == 2 || pn == 3), iskv = (pn >= 8 && pn < 12), isg = (pn >= 12);
        const bool kvp = iskv && ((u.pm & 15) >= 14);
        f32x4 bg[2][2];
#pragma unroll
        for (int bj = 0; bj < 2; ++bj) { if (isg) { bg[bj][0] = *(const f32x4*)(bgate + col0 - ZC_GC + bj * 128); bg[bj][1] = *(const f32x4*)(bgate + col0 - ZC_GC + bj * 128 + 4); } else { bg[bj][0] = (f32x4){0.f, 0.f, 0.f, 0.f}; bg[bj][1] = bg[bj][0]; } }
        float rsv[2][4]; row_rs8(ssq, row0, fq, rsv);
#pragma unroll
        for (int ai = 0; ai < 2; ++ai)
#pragma unroll
            for (int m = 0; m < 4; ++m) {
                const int row = row0 + ai * 128 + m * 16; float rs = rsv[ai][m];
                if (isq) rs *= QSCALE;
#pragma unroll
                for (int bj = 0; bj < 2; ++bj) {
                    f32x4 v0 = acc[ai][bj][m][0] * rs, v1 = acc[ai][bj][m][1] * rs;
                    const int c = col0 + bj * 128;
                    if (isg) {
                        v0 += bg[bj][0]; v1 += bg[bj][1];
#pragma unroll
                        for (int i = 0; i < 4; ++i) { v0[i] = fast_sigmoid(v0[i]); v1[i] = fast_sigmoid(v1[i]); }
                    }
                    u32x4 w; w.x = cvt_pk_bf16(v0[0], v0[1]); w.y = cvt_pk_bf16(v0[2], v0[3]); w.z = cvt_pk_bf16(v1[0], v1[1]); w.w = cvt_pk_bf16(v1[2], v1[3]);
                    *(u32x4*)(Z + (size_t)row * INC + c) = w;
                    if (kvp) {
                        const int b = row >> 12, t = row & 4095;
                        float* dst = ((pn < 10) ? okp : ovp) + ((size_t)(b * 512 + (t - 3584)) * 512 + (c - ((pn < 10) ? ZC_K : ZC_V)));
                        __builtin_nontemporal_store(v0, (f32x4*)dst); __builtin_nontemporal_store(v1, (f32x4*)(dst + 4));
                    }
                }
            }
    }
    __device__ __forceinline__ void small(const f32x4 (&acc)[1][2][2], int row, int c0, int fr, int fq) const {
        const int pn = c0 >> 8;
        const bool isq = (pn == 2 || pn == 3), iskv = (pn >= 8 && pn < 12), isg = (pn >= 12);
        float rs = row_rs(ssq, row, fq);
        if (isq) rs *= QSCALE;
#pragma unroll
        for (int j = 0; j < 2; ++j) {
            f32x4 v0 = acc[0][j][0] * rs, v1 = acc[0][j][1] * rs;
            const int c = c0 + 32 * j + 8 * fq;
            if (isg) {
                v0 += *(const f32x4*)(bgate + c - ZC_GC); v1 += *(const f32x4*)(bgate + c - ZC_GC + 4);
#pragma unroll
                for (int i = 0; i < 4; ++i) { v0[i] = fast_sigmoid(v0[i]); v1[i] = fast_sigmoid(v1[i]); }
            }
            u32x4 w; w.x = cvt_pk_bf16(v0[0], v0[1]); w.y = cvt_pk_bf16(v0[2], v0[3]); w.z = cvt_pk_bf16(v1[0], v1[1]); w.w = cvt_pk_bf16(v1[2], v1[3]);
            *(u32x4*)(Z + (size_t)row * INC + c) = w;
            if (iskv) {
                float* dst = ((pn < 10) ? oks : ovs) + ((size_t)(row - MP) * 512 + (c - ((pn < 10) ? ZC_K : ZC_V)));
                __builtin_nontemporal_store(v0, (f32x4*)dst); __builtin_nontemporal_store(v1, (f32x4*)(dst + 4));
            }
        }
    }
};

struct EpiMix {
    static constexpr int PROBE_ID = 4; __device__ __forceinline__ EpiMix probe_copy() const { return *this; }
    bf16_t* Z;
    __device__ __forceinline__ void mid(f32x4 (&acc)[2][2][4][2], const pg8::Unit& u, int wr, int wc, int fr, int fq) const {
        int row0 = u.pm * 256 + wr * 64 + fr, col0 = u.pn * 256 + wc * 32 + 8 * fq;
        asm volatile("" : "+v"(row0), "+v"(col0));
#pragma unroll
        for (int g4 = 0; g4 < 4; ++g4) {
            const int ai = g4 >> 1, mb = (g4 & 1) * 2;
            u32x4 gcv[2][2], gav[2][2];
#pragma unroll
            for (int mm = 0; mm < 2; ++mm)
#pragma unroll
                for (int bj = 0; bj < 2; ++bj) { const bf16_t* zr = Z + (size_t)(row0 + ai * 128 + (mb + mm) * 16) * INC + col0 + bj * 128; gcv[mm][bj] = *(const u32x4*)(zr + ZC_GC); gav[mm][bj] = *(const u32x4*)(zr + ZC_GA); }
#pragma unroll
            for (int mm = 0; mm < 2; ++mm)
#pragma unroll
                for (int bj = 0; bj < 2; ++bj) {
                    const u32x4 gc = gcv[mm][bj], ga = gav[mm][bj]; const int m = mb + mm;
                    f32x4 r0, r1;
                    r0[0] = bf_lo(gc.x) * __builtin_amdgcn_rcpf(fmaxf(bf_lo(ga.x), 1e-12f)); r0[1] = bf_hi(gc.x) * __builtin_amdgcn_rcpf(fmaxf(bf_hi(ga.x), 1e-12f));
                    r0[2] = bf_lo(gc.y) * __builtin_amdgcn_rcpf(fmaxf(bf_lo(ga.y), 1e-12f)); r0[3] = bf_hi(gc.y) * __builtin_amdgcn_rcpf(fmaxf(bf_hi(ga.y), 1e-12f));
                    r1[0] = bf_lo(gc.z) * __builtin_amdgcn_rcpf(fmaxf(bf_lo(ga.z), 1e-12f)); r1[1] = bf_hi(gc.z) * __builtin_amdgcn_rcpf(fmaxf(bf_hi(ga.z), 1e-12f));
                    r1[2] = bf_lo(gc.w) * __builtin_amdgcn_rcpf(fmaxf(bf_lo(ga.w), 1e-12f)); r1[3] = bf_hi(gc.w) * __builtin_amdgcn_rcpf(fmaxf(bf_hi(ga.w), 1e-12f));
                    acc[ai][bj][m][0] *= r0; acc[ai][bj][m][1] *= r1;
                }
        }
    }
    __device__ __forceinline__ void operator()(const f32x4 (&acc)[2][2][4][2], const pg8::Unit& u, int wr, int wc, int fr, int fq) const {
        const int row0 = u.pm * 256 + wr * 64 + fr, col0 = u.pn * 256 + wc * 32 + 8 * fq;
#pragma unroll
        for (int ai = 0; ai < 2; ++ai) {
            u32x4 gav[4][2];
#pragma unroll
            for (int m = 0; m < 4; ++m)
#pragma unroll
                for (int bj = 0; bj < 2; ++bj) gav[m][bj] = *(const u32x4*)(Z + (size_t)(row0 + ai * 128 + m * 16) * INC + ZC_GA + col0 + bj * 128);
#pragma unroll
            for (int m = 0; m < 4; ++m)
#pragma unroll
                for (int bj = 0; bj < 2; ++bj) {
                    const u32x4 ga = gav[m][bj];
                    f32x4 v0 = acc[ai][bj][m][0], v1 = acc[ai][bj][m][1];
                    v0[0] *= fmaxf(bf_lo(ga.x), 1e-12f); v0[1] *= fmaxf(bf_hi(ga.x), 1e-12f); v0[2] *= fmaxf(bf_lo(ga.y), 1e-12f); v0[3] *= fmaxf(bf_hi(ga.y), 1e-12f);
                    v1[0] *= fmaxf(bf_lo(ga.z), 1e-12f); v1[1] *= fmaxf(bf_hi(ga.z), 1e-12f); v1[2] *= fmaxf(bf_lo(ga.w), 1e-12f); v1[3] *= fmaxf(bf_hi(ga.w), 1e-12f);
                    u32x4 w; w.x = cvt_pk_bf16(v0[0], v0[1]); w.y = cvt_pk_bf16(v0[2], v0[3]); w.z = cvt_pk_bf16(v1[0], v1[1]); w.w = cvt_pk_bf16(v1[2], v1[3]);
                    *(u32x4*)(Z + (size_t)(row0 + ai * 128 + m * 16) * INC + ZC_MB + col0 + bj * 128) = w;
                }
        }
    }
    __device__ __forceinline__ void small(const f32x4 (&acc)[2][2][2], int row, int c0, int fr, int fq) const {
#pragma unroll
        for (int j = 0; j < 2; ++j) {
            const int c = c0 + 32 * j + 8 * fq;
            const u32x4 gc = *(const u32x4*)(Z + (size_t)row * INC + ZC_GC + c), ga = *(const u32x4*)(Z + (size_t)row * INC + ZC_GA + c);
            const f32x4 a0 = acc[0][j][0], a1 = acc[0][j][1], b0 = acc[1][j][0], b1 = acc[1][j][1];
            float m[8];
            m[0] = a0[0] * bf_lo(gc.x) + b0[0] * bf_lo(ga.x); m[1] = a0[1] * bf_hi(gc.x) + b0[1] * bf_hi(ga.x);
            m[2] = a0[2] * bf_lo(gc.y) + b0[2] * bf_lo(ga.y); m[3] = a0[3] * bf_hi(gc.y) + b0[3] * bf_hi(ga.y);
            m[4] = a1[0] * bf_lo(gc.z) + b1[0] * bf_lo(ga.z); m[5] = a1[1] * bf_hi(gc.z) + b1[1] * bf_hi(ga.z);
            m[6] = a1[2] * bf_lo(gc.w) + b1[2] * bf_lo(ga.w); m[7] = a1[3] * bf_hi(gc.w) + b1[3] * bf_hi(ga.w);
            u32x4 w; w.x = cvt_pk_bf16(m[0], m[1]); w.y = cvt_pk_bf16(m[2], m[3]); w.z = cvt_pk_bf16(m[4], m[5]); w.w = cvt_pk_bf16(m[6], m[7]);
            *(u32x4*)(Z + (size_t)row * INC + ZC_MB + c) = w;
        }
    }
};

template <int NSET, int NSTEP  , class Epi, bool UPMODE = false, int KSPLIT = 8  >
__device__ __forceinline__ void small_gemm(LAS unsigned char* lds, const bf16_t* A0, const bf16_t* A1, int lda, const bf16_t* W0, const bf16_t* W1, int ldb, int ncg, const Epi& E, int bx, int G, int wave, int lane) {
    constexpr int UPR = 8 / KSPLIT;
    const int fr = lane & 15, fq = lane >> 4, us = wave / KSPLIT, kp = wave % KSPLIT;
    LAS f32x4* part = (LAS f32x4*)lds;
#pragma unroll 1
    for (int u0 = bx * UPR; u0 < 8 * ncg; u0 += G * UPR) {
        const int u = u0 + us; const bool valid = (u < 8 * ncg);
        const int uc = valid ? u : 0;
        const int rb = uc & 7, cg = uc >> 3;
        const int row = MP + 16 * rb + fr;
        f32x4 acc[NSET][2][2];
#pragma unroll
        for (int st = 0; st < NSET; ++st) {
            const bf16_t* Ap = (st ? A1 : A0) + (size_t)row * lda + kp * (NSTEP * 32) + 8 * fq;
            const int cb0 = UPMODE ? 256 * (cg >> 2) + 32 * (cg & 3) : 64 * cg;
            const bf16_t* Wp = (st ? W1 : W0) + (size_t)(cb0 + 8 * (fr >> 2) + (fr & 3)) * ldb + kp * (NSTEP * 32) + 8 * fq;
#pragma unroll
            for (int j = 0; j < 2; ++j)
#pragma unroll
                for (int n = 0; n < 2; ++n) acc[st][j][n] = (f32x4){0.f, 0.f, 0.f, 0.f};
#pragma unroll
            for (int k0 = 0; k0 < NSTEP; k0 += 4) {
                constexpr int KBMAX = 4;
                bf16x8 av[KBMAX], bv[KBMAX][2][2];
#pragma unroll
                for (int kk = 0; kk < KBMAX; ++kk) if (k0 + kk < NSTEP) {
                    av[kk] = *(const bf16x8*)(Ap + 32 * (k0 + kk));
#pragma unroll
                    for (int j = 0; j < 2; ++j)
#pragma unroll
                        for (int n = 0; n < 2; ++n) bv[kk][j][n] = *(const bf16x8*)(Wp + (size_t)((UPMODE ? 128 : 32) * j + 4 * n) * ldb + 32 * (k0 + kk));
                }
                __builtin_amdgcn_sched_barrier(0);
#pragma unroll
                for (int kk = 0; kk < KBMAX; ++kk) if (k0 + kk < NSTEP) {
#pragma unroll
                    for (int j = 0; j < 2; ++j)
#pragma unroll
                        for (int n = 0; n < 2; ++n) acc[st][j][n] = __builtin_amdgcn_mfma_f32_16x16x32_bf16(bv[kk][j][n], av[kk], acc[st][j][n], 0, 0, 0);
                }
                __builtin_amdgcn_sched_barrier(0);
            }
        }
        if (kp != 0) {
#pragma unroll
            for (int st = 0; st < NSET; ++st)
#pragma unroll
                for (int j = 0; j < 2; ++j)
#pragma unroll
                    for (int n = 0; n < 2; ++n) part[((wave * NSET + st) * 4 + j * 2 + n) * 64 + lane] = acc[st][j][n];
        }
        __syncthreads();
        if (kp == 0 && valid) {
#pragma unroll
            for (int w = 1; w < KSPLIT; ++w)
#pragma unroll
                for (int st = 0; st < NSET; ++st)
#pragma unroll
                    for (int j = 0; j < 2; ++j)
#pragma unroll
                        for (int n = 0; n < 2; ++n) acc[st][j][n] += part[(((wave + w) * NSET + st) * 4 + j * 2 + n) * 64 + lane];
            E.small(acc, row, UPMODE ? 128 * (cg >> 2) + 32 * (cg & 3) : 64 * cg, fr, fq);
        }
        __syncthreads();
    }
}

struct TileD { const bf16_t* K; const bf16_t* V; int pitch; int nkeys; int delta0; };

__device__ __forceinline__ void attn_dma_v(const TileD& td, LAS unsigned char* vb, int lane) {
#pragma unroll
    for (int i = 0; i < 8; ++i) {
        const int row = 8 * i + (lane >> 3), chs = lane & 7, ch = chs ^ (((row >> 1) & 3) << 1);
        __builtin_amdgcn_global_load_lds((const unsigned*)(td.V + (size_t)row * td.pitch + ch * 8), (LAS unsigned*)(vb + i * 1024), 16, 0, 0);
    }
}
template <int NQB, class TF>
__device__ __forceinline__ void attn_wave(const bf16_t* Qp, bf16_t* Op, int qpitch, int opitch, int nt, const TF& tilef, LAS unsigned char* vbuf, const LAS float* rb, int lane) {
    const int fr = lane & 15, fq = lane >> 4;
    bf16x8 qf[NQB][2];
#pragma unroll
    for (int qb = 0; qb < NQB; ++qb)
#pragma unroll
        for (int dh = 0; dh < 2; ++dh) qf[qb][dh] = ldg16b(Qp + (size_t)(16 * qb + fr) * qpitch + dh * 32 + 8 * fq);
    f32x4 O[NQB][4]; float mrow[NQB], lrow[NQB];
#pragma unroll
    for (int qb = 0; qb < NQB; ++qb) { mrow[qb] = -1e30f; lrow[qb] = 0.f;
#pragma unroll
        for (int db = 0; db < 4; ++db) O[qb][db] = (f32x4){0.f, 0.f, 0.f, 0.f}; }
    const int qp = fr >> 2, pp = fr & 3, rowl = 4 * fq + qp, sw = ((rowl >> 1) & 3) << 1;
    const int vrow = rowl * 128 + (pp & 1) * 8, vch = (pp >> 1) ^ sw;
    bf16x8 kf[2][2];
    { const TileD td = tilef(0); attn_dma_v(td, vbuf, lane);
#pragma unroll
      for (int kb = 0; kb < 2; ++kb)
#pragma unroll
          for (int dh = 0; dh < 2; ++dh) kf[kb][dh] = ldg16b(td.K + (size_t)(16 * kb + fr) * td.pitch + dh * 32 + 8 * fq); }
    const int nht = 2 * nt;
#pragma unroll 1
    for (int ht = 0; ht < nht; ++ht) {
        const int t = ht >> 1, half = ht & 1;
        asm volatile("s_waitcnt vmcnt(0)" ::: "memory");
        const TileD td = tilef(t);
        if (half == 0 && t + 1 < nt) { const TileD tn = tilef(t + 1); attn_dma_v(tn, vbuf + ((t + 1) & 1) * 8192, lane); }
        f32x4 S[2][NQB];
#pragma unroll
        for (int kb = 0; kb < 2; ++kb)
#pragma unroll
            for (int qb = 0; qb < NQB; ++qb) {
                f32x4 s = __builtin_amdgcn_mfma_f32_16x16x32_bf16(kf[kb][0], qf[qb][0], (f32x4){0.f, 0.f, 0.f, 0.f}, 0, 0, 0);
                S[kb][qb] = __builtin_amdgcn_mfma_f32_16x16x32_bf16(kf[kb][1], qf[qb][1], s, 0, 0, 0);
            }
        if (ht + 1 < nht) {
            const TileD tk = tilef((ht + 1) >> 1); const int r0 = 32 * ((ht + 1) & 1);
#pragma unroll
            for (int kb = 0; kb < 2; ++kb)
#pragma unroll
                for (int dh = 0; dh < 2; ++dh) kf[kb][dh] = ldg16b(tk.K + (size_t)(r0 + 16 * kb + fr) * tk.pitch + dh * 32 + 8 * fq);
        }
        const int delta0 = td.delta0 - 32 * half, nkeys = td.nkeys - 32 * half;
        if (delta0 < 160) {
#pragma unroll
            for (int kb = 0; kb < 2; ++kb)
#pragma unroll
                for (int qb = 0; qb < NQB; ++qb)
#pragma unroll
                    for (int i = 0; i < 4; ++i) {
                        int d = delta0 + (16 * qb + fr) - (16 * kb + 4 * fq + i);
                        d = d < -128 ? -128 : (d > 128 ? 128 : d);
                        S[kb][qb][i] += rb[d + 128];
                    }
        }
        if (nkeys < 32) {
#pragma unroll
            for (int kb = 0; kb < 2; ++kb)
#pragma unroll
                for (int qb = 0; qb < NQB; ++qb)
#pragma unroll
                    for (int i = 0; i < 4; ++i) if (16 * kb + 4 * fq + i >= nkeys) S[kb][qb][i] = -INFINITY;
        }
        float mxq[NQB]; bool grow = false;
#pragma unroll
        for (int qb = 0; qb < NQB; ++qb) {
            float mx = fmaxf(fmaxf(fmaxf(S[0][qb][0], S[0][qb][1]), fmaxf(S[0][qb][2], S[0][qb][3])), fmaxf(fmaxf(S[1][qb][0], S[1][qb][1]), fmaxf(S[1][qb][2], S[1][qb][3])));
            mx = xmax_16_32(mx);
            mxq[qb] = mx; grow = grow || (mx > mrow[qb]);
        }
        if (__any(grow)) {
#pragma unroll
            for (int qb = 0; qb < NQB; ++qb) {
                const float mn = fmaxf(mrow[qb], mxq[qb]), alpha = __builtin_amdgcn_exp2f(mrow[qb] - mn);
                mrow[qb] = mn; lrow[qb] *= alpha;
#pragma unroll
                for (int db = 0; db < 4; ++db) O[qb][db] *= alpha;
            }
        }
        bf16x8 pf[NQB];
#pragma unroll
        for (int qb = 0; qb < NQB; ++qb) {
            const float mn = mrow[qb]; float ps = 0.f; float p[2][4];
#pragma unroll
            for (int kb = 0; kb < 2; ++kb)
#pragma unroll
                for (int i = 0; i < 4; ++i) { p[kb][i] = __builtin_amdgcn_exp2f(S[kb][qb][i] - mn); ps += p[kb][i]; }
            lrow[qb] += ps;
            u32x4 w; w.x = cvt_pk_bf16(p[0][0], p[0][1]); w.y = cvt_pk_bf16(p[0][2], p[0][3]); w.z = cvt_pk_bf16(p[1][0], p[1][1]); w.w = cvt_pk_bf16(p[1][2], p[1][3]);
            pf[qb] = __builtin_bit_cast(bf16x8, w);
        }
        const LAS unsigned char* vb = vbuf + (t & 1) * 8192 + half * 4096 + vrow;
#pragma unroll
        for (int db = 0; db < 4; ++db) {
            const int off = ((2 * db) ^ vch) << 4;
            const s16x4 lo = __builtin_amdgcn_ds_read_tr16_b64_v4i16((LAS s16x4*)(vb + off));
            const s16x4 hi = __builtin_amdgcn_ds_read_tr16_b64_v4i16((LAS s16x4*)(vb + off + 2048));
            const bf16x8 vf = (bf16x8){lo[0], lo[1], lo[2], lo[3], hi[0], hi[1], hi[2], hi[3]};
#pragma unroll
            for (int qb = 0; qb < NQB; ++qb) O[qb][db] = __builtin_amdgcn_mfma_f32_16x16x32_bf16(vf, pf[qb], O[qb][db], 0, 0, 0);
        }
    }
    asm volatile("s_waitcnt lgkmcnt(0)" ::: "memory");
#pragma unroll
    for (int qb = 0; qb < NQB; ++qb) {
        float l = xsum_16_32(lrow[qb]);
        const float inv = 1.0f / l;
#pragma unroll
        for (int db = 0; db < 4; ++db) {
            const f32x4 o = O[qb][db] * inv; u32x2 w; w.x = cvt_pk_bf16(o[0], o[1]); w.y = cvt_pk_bf16(o[2], o[3]);
            *(GAS u32x2*)(Op + (size_t)(16 * qb + fr) * opitch + 16 * db + 4 * fq) = w;
        }
    }
}


#define XB_TMO      128
#define XB_XCNT(j)  (256  + 64 * (j))
#define XB_XSUB(j)  (1280 + 64 * (j))
#define XB_XGEN(j)  (2304 + 64 * (j))
#define XB_TOP      3328
#define XB_TOPGEN   3392
#define XCD_BAR_WORDS 3456
#define XB_SPIN_CAP (1u << 20)
__device__ __forceinline__ unsigned xb_ld(unsigned* p)              { return __hip_atomic_load(p, __ATOMIC_RELAXED, __HIP_MEMORY_SCOPE_AGENT); }
__device__ __forceinline__ unsigned xb_add(unsigned* p, unsigned v) { return __hip_atomic_fetch_add(p, v, __ATOMIC_RELAXED, __HIP_MEMORY_SCOPE_AGENT); }
__device__ __forceinline__ unsigned xb_xcc_id() { return (unsigned)__builtin_amdgcn_s_getreg((3 << 11) | 20) & 0xFu; }
#define XB_SPIN(cond, bar) do { unsigned _sp = 0; while (cond) { __builtin_amdgcn_s_sleep(1); \
    if ((++_sp & 255u) == 0u) { if (xb_ld(&(bar)[XB_TMO])) break; if (_sp > XB_SPIN_CAP) { atomicAdd(&(bar)[XB_TMO], 1u); break; } } } } while (0)
struct XcdBarrier { unsigned* bar; unsigned x; volatile LAS unsigned* st; };
__device__ __forceinline__ XcdBarrier xcd_barrier_post(unsigned* bar, volatile LAS unsigned* st) {
    XcdBarrier b; b.bar = bar; b.x = xb_xcc_id(); b.st = st;
    if (threadIdx.x == 0) (void)xb_add(&bar[XB_XCNT(b.x)], 1u);
    return b;
}
__device__ __forceinline__ void xcd_barrier_complete(unsigned* bar, unsigned x, unsigned& nloc, unsigned& nx) {
    const unsigned G = gridDim.x * gridDim.y * gridDim.z;
    unsigned sum, cnt, mine, sp = 0u;
    for (;;) {
        sum = 0u; cnt = 0u; mine = 0u;
#pragma unroll
        for (unsigned j = 0; j < 16; ++j) { const unsigned c = xb_ld(&bar[XB_XCNT(j)]); sum += c; cnt += (c > 0u) ? 1u : 0u; mine = (j == x) ? c : mine; }
        if (sum == G) break;
        __builtin_amdgcn_s_sleep(1);
        if ((++sp & 255u) == 0u) { if (xb_ld(&bar[XB_TMO])) break; if (sp > XB_SPIN_CAP) { atomicAdd(&bar[XB_TMO], 1u); break; } }
    }
    nloc = mine > 0u ? mine : 1u; nx = cnt > 0u ? cnt : 1u;
}
__device__ __forceinline__ void xcd_barrier(const XcdBarrier& b) {
    asm volatile("s_waitcnt vmcnt(0)" ::: "memory");
    __syncthreads();
    if (threadIdx.x == 0) {
        unsigned* bar = b.bar;
        __builtin_amdgcn_s_waitcnt(0);
        unsigned nloc = b.st[0], nx = b.st[1];
        if (nloc == 0u) { xcd_barrier_complete(bar, b.x, nloc, nx); b.st[0] = nloc; b.st[1] = nx; }
        const unsigned old = xb_add(&bar[XB_XSUB(b.x)], 1u);
        const unsigned gen = old / nloc;
        if (old + 1u == (gen + 1u) * nloc) {
            __builtin_amdgcn_fence(__ATOMIC_RELEASE, "agent");
            asm volatile("s_waitcnt vmcnt(0)" ::: "memory");
            const unsigned og = xb_add(&bar[XB_TOP], 1u);
            const unsigned tg = og / nx;
            if (og + 1u == (tg + 1u) * nx) xb_add(&bar[XB_TOPGEN], 1u);
            else XB_SPIN(xb_ld(&bar[XB_TOPGEN]) == tg, bar);
            __builtin_amdgcn_fence(__ATOMIC_ACQUIRE, "agent");
            xb_add(&bar[XB_XGEN(b.x)], 1u);
            asm volatile("s_waitcnt vmcnt(0)" ::: "memory");
        } else {
            XB_SPIN(xb_ld(&bar[XB_XGEN(b.x)]) == gen, bar);
            __builtin_amdgcn_fence(__ATOMIC_ACQUIRE, "agent");
            asm volatile("s_waitcnt vmcnt(0)" ::: "memory");
        }
    }
    __syncthreads();
}

struct Args {
    const float* x_prompt; const float* x_sample; const float* cache_k; const float* cache_v; const float* state_conv;
    const float* norm_ffn1; const float* w_ffn1_gu; const float* w_ffn1_down; const float* norm_mix; const float* w_in; const float* b_gate; const float* w_conv;
    const float* rel_bias; const float* w_conv_out; const float* w_attn_out; const float* w_o; const float* norm_ffn2; const float* w_ffn2_gu; const float* w_ffn2_down; const float* norm_final;
    float* out; unsigned char* ws; int ph_lo, ph_hi;
};

__device__ __forceinline__ void transpose_item(const float* W, int N, const float* gain, bf16_t* WT, int dpitch, int dkoff, int mode, int kb, int nb, int scol0, LAS float* scr, int lane) {
    const int k0 = 64 * kb, n0 = 32 * nb, c = lane & 31;
    const int scol = (mode == 1) ? ((c < 16) ? 16 * nb + c : DFF + 16 * nb + (c - 16)) : scol0 + c;
    float wv[32];
#pragma unroll
    for (int i = 0; i < 32; ++i) wv[i] = __builtin_nontemporal_load(W + (size_t)(k0 + 2 * i + (lane >> 5)) * N + scol);
    if (gain) {
#pragma unroll
        for (int i = 0; i < 32; ++i) wv[i] *= gain[k0 + 2 * i + (lane >> 5)];
    }
#pragma unroll
    for (int i = 0; i < 32; ++i) scr[(2 * i + (lane >> 5)) * 33 + c] = wv[i];
    asm volatile("s_waitcnt lgkmcnt(0)" ::: "memory");
    const int c8 = lane & 7;
#pragma unroll
    for (int j = 0; j < 4; ++j) { const int n = (lane >> 3) + 8 * j; const LAS float* s = scr + (8 * c8) * 33 + n;
        u32x4 o; o.x = pk2(s[0 * 33], s[1 * 33]); o.y = pk2(s[2 * 33], s[3 * 33]); o.z = pk2(s[4 * 33], s[5 * 33]); o.w = pk2(s[6 * 33], s[7 * 33]);
        int drow;
        if (mode == 1) { const int jj = n & 15, isu = n >> 4; drow = n0 + 8 * (jj >> 2) + 4 * isu + (jj & 3); } else drow = n0 + n;
        *(u32x4*)(WT + (size_t)drow * dpitch + dkoff + k0 + 8 * c8) = o; }
    asm volatile("s_waitcnt lgkmcnt(0)" ::: "memory");
}

__device__ __forceinline__ float wave_sum(float v) {
#pragma unroll
    for (int o = 1; o < 64; o <<= 1) v += __shfl_xor(v, o);
    return v;
}

__global__ void __launch_bounds__(NWAVES * 64, 2) mega_fwd(Args a) {
    extern __shared__ __attribute__((aligned(16))) unsigned char lds_raw[];
    LAS unsigned char* lds = (LAS unsigned char*)lds_raw;
    cg::grid_group grid = cg::this_grid();
    typedef const __attribute__((address_space(4))) Args* ArgP;
    ArgP ap = (ArgP)__builtin_amdgcn_kernarg_segment_ptr();
    const int G = gridDim.x, bx = blockIdx.x;
    const int wave0 = __builtin_amdgcn_readfirstlane((int)threadIdx.x >> 6);
    unsigned* barw = (unsigned*)(ap->ws + WS_BAR);
    if (bx == 0) for (int i = threadIdx.x; i < 4096; i += NWAVES * 64) barw[i] = 0u;
    if (threadIdx.x < 16) ((LAS unsigned*)(lds + BARST_OFF))[threadIdx.x] = 0u;
    XcdBarrier xbar; xbar.bar = barw; xbar.x = 0; xbar.st = (volatile LAS unsigned*)(lds + BARST_OFF);
    bool xposted = false; unsigned wait_ticks = 0; (void)wait_ticks;
    const int lo = ap->ph_lo, hi = ap->ph_hi;
#define PHASE_VARS \
    asm volatile("" : "+s"(ap)); \
    int lane_ = (int)__builtin_amdgcn_mbcnt_hi(~0u, __builtin_amdgcn_mbcnt_lo(~0u, 0u)); asm volatile("" : "+v"(lane_)); \
    int wave_ = wave0; asm volatile("" : "+s"(wave_)); \
    const int lane = lane_, wave = wave_, tid = wave * 64 + lane; \
    const int vcu = (G % 8 == 0) ? (bx % 8) * (G / 8) + bx / 8 : bx; \
    const int gw = vcu * NWAVES + wave, NGW = G * NWAVES; \
    const int gt = gw * 64 + lane, NGT = NGW * 64; \
    unsigned char* ws = ap->ws; \
    bf16_t* WT = (bf16_t*)(ws + ((l & 1) ? WS_WT2 : WS_WT)); bf16_t* WTN = (bf16_t*)(ws + ((l & 1) ? WS_WT : WS_WT2)); bf16_t* XB = (bf16_t*)(ws + WS_XB); float* SSQ = (float*)(ws + WS_SSQ); \
    bf16_t* CK = (bf16_t*)(ws + ((l & 1) ? WS_CK2 : WS_CK)); bf16_t* CV = (bf16_t*)(ws + ((l & 1) ? WS_CV2 : WS_CV)); \
    bf16_t* CKN = (bf16_t*)(ws + ((l & 1) ? WS_CK : WS_CK2)); bf16_t* CVN = (bf16_t*)(ws + ((l & 1) ? WS_CV : WS_CV2)); bf16_t* Z = (bf16_t*)(ws + WS_Z); bf16_t* HB = Z; \
    float* X = ap->out; \
    (void)WTN; (void)CKN; (void)CVN; (void)tid; (void)lane; (void)wave; (void)gw; (void)NGW; (void)gt; (void)NGT; (void)WT; (void)XB; (void)SSQ; (void)CK; (void)CV; (void)Z; (void)HB; (void)X;
#define IN(k) (lo <= (k) && (k) < hi)
#define GSYNC() do { unsigned long long t0_ = 0; if (PROBE_WAIT) t0_ = __builtin_amdgcn_s_memrealtime(); if (!xposted) { grid.sync(); xbar = xcd_barrier_post(barw, (volatile LAS unsigned*)(lds + BARST_OFF)); xposted = true; } else xcd_barrier(xbar); if (PROBE_WAIT) wait_ticks += (unsigned)(__builtin_amdgcn_s_memrealtime() - t0_); } while (0)
#define SEAM(k) do { if (IN(k) && IN((k) + 1)) { const unsigned w0_ = wait_ticks; GSYNC(); if (PROBE_WAIT >= 100 && ((k) % 9) != PROBE_WAIT - 100) wait_ticks = w0_; if (PROBE_REP == 9) GSYNC(); } } while (0)
#define REPS(k) for (int rep = (PROBE_REP == (k)) ? 0 : 1; rep < 2; ++rep)
#define REPSYNC() do { if (rep == 0) GSYNC(); } while (0)

#define CONVERT_LAYER(LC, WTD, CKD, CVD) do { \
            LAS float* scr = (LAS float*)(lds + wave * 16384); \
            constexpr int I_GU = 16 * 176, I_D = 44 * 32, I_IN = 16 * 160, I_C = 8 * 32, I_O = 16 * 32; \
            constexpr int NITEMS = 2 * I_GU + 2 * I_D + I_IN + 2 * I_C + I_O; \
            for (int it = gw; it < NITEMS; it += NGW) { \
                int r = it; \
                if (r < I_GU) { transpose_item(ap->w_ffn1_gu + (size_t)(LC) * DM * 2 * DFF, 2 * DFF, ap->norm_ffn1 + (LC) * DM, (WTD) + W_GU1, DM, 0, 0, r / 176, r % 176, (((r % 176) >> 2) & 1) * DFF + 128 * ((r % 176) >> 3) + 32 * ((r % 176) & 3), scr, lane); continue; } r -= I_GU; \
                if (r < I_GU) { transpose_item(ap->w_ffn2_gu + (size_t)(LC) * DM * 2 * DFF, 2 * DFF, ap->norm_ffn2 + (LC) * DM, (WTD) + W_GU2, DM, 0, 0, r / 176, r % 176, (((r % 176) >> 2) & 1) * DFF + 128 * ((r % 176) >> 3) + 32 * ((r % 176) & 3), scr, lane); continue; } r -= I_GU; \
                if (r < I_D) { transpose_item(ap->w_ffn1_down + (size_t)(LC) * DFF * DM, DM, nullptr, (WTD) + W_D1, DFF, 0, 0, r / 32, r % 32, 32 * (r % 32), scr, lane); continue; } r -= I_D; \
                if (r < I_D) { transpose_item(ap->w_ffn2_down + (size_t)(LC) * DFF * DM, DM, nullptr, (WTD) + W_D2, DFF, 0, 0, r / 32, r % 32, 32 * (r % 32), scr, lane); continue; } r -= I_D; \
                if (r < I_IN) { const int nb = r % 160, kb = r / 160, blk = nb >> 4; \
                    const int ob = (blk == 1) ? 3 : (blk == 2) ? 1 : (blk == 3) ? 2 : blk; \
                    transpose_item(ap->w_in + (size_t)(LC) * DM * INC, INC, ap->norm_mix + (LC) * DM, (WTD) + W_IN, DM, 0, 0, kb, nb, ob * 512 + 32 * (nb & 15), scr, lane); continue; } r -= I_IN; \
                if (r < I_C) { transpose_item(ap->w_conv_out + (size_t)(LC) * 512 * DM, DM, nullptr, (WTD) + W_CAT, DM, 0, 0, r / 32, r % 32, 32 * (r % 32), scr, lane); continue; } r -= I_C; \
                if (r < I_C) { transpose_item(ap->w_attn_out + (size_t)(LC) * 512 * DM, DM, nullptr, (WTD) + W_CAT, DM, 512, 0, r / 32, r % 32, 32 * (r % 32), scr, lane); continue; } r -= I_C; \
                transpose_item(ap->w_o + (size_t)(LC) * DM * DM, DM, nullptr, (WTD) + W_O, DM, 0, 0, r / 32, r % 32, 32 * (r % 32), scr, lane); \
            } \
 \
            for (int i = gt; i < 2 * (NBATCH * 512 * 512 / 8); i += NGT) { \
                const int which = i / (NBATCH * 512 * 512 / 8), e = (i % (NBATCH * 512 * 512 / 8)) * 8; \
                const float* src = (which ? ap->cache_v : ap->cache_k) + (size_t)(LC) * NBATCH * 512 * 512 + e; \
                const f32x4 v0 = __builtin_nontemporal_load((const f32x4*)src), v1 = __builtin_nontemporal_load((const f32x4*)(src + 4)); \
                u32x4 w; w.x = pk2(v0[0], v0[1]); w.y = pk2(v0[2], v0[3]); w.z = pk2(v1[0], v1[1]); w.w = pk2(v1[2], v1[3]); \
                *(u32x4*)((which ? (CVD) : (CKD)) + e) = w; \
            } \
} while (0)

#pragma unroll 1
    for (int l = 0; l < DEPTH; ++l) {
        const int pb = 9 * l;
        if (l == 0 && IN(pb + 0)) REPS(0) { PHASE_VARS
            CONVERT_LAYER(0, WT, CK, CV);
            if (l == 0) {
                for (int m0 = gw * 4; m0 < MPAD; m0 += NGW * 4) {
                    f32x4 v[4][4];
#pragma unroll
                    for (int r = 0; r < 4; ++r) { const int m = m0 + r;
                        const float* src = (m < MP) ? ap->x_prompt + (size_t)m * DM : ap->x_sample + (size_t)((m < MR ? m : MR - 1) - MP) * DM;
#pragma unroll
                        for (int j = 0; j < 4; ++j) v[r][j] = __builtin_nontemporal_load((const f32x4*)(src + 256 * j + 4 * lane)); }
#pragma unroll
                    for (int r = 0; r < 4; ++r) { const int m = m0 + r;
                        bf16_t* xb = XB + (size_t)m * DM; float* sq = SSQ + (size_t)m * 16;
                        if (m < MR) {
                            float s = 0.f;
#pragma unroll
                            for (int j = 0; j < 4; ++j) { const f32x4 x = v[r][j]; u32x2 w; w.x = pk2(x[0], x[1]); w.y = pk2(x[2], x[3]); *(u32x2*)(xb + 256 * j + 4 * lane) = w; s += (x[0] * x[0] + x[1] * x[1]) + (x[2] * x[2] + x[3] * x[3]); }
                            s = wave_sum(s);
                            if (lane < 16) sq[lane] = (lane == 0) ? s : 0.f;
                        } else {
#pragma unroll
                            for (int j = 0; j < 4; ++j) *(u32x2*)(xb + 256 * j + 4 * lane) = (u32x2){0u, 0u};
                            if (lane < 16) sq[lane] = 0.f;
                        }
                    }
                }
            }
        REPSYNC(); }
        if (l == 0) SEAM(pb + 0);
        if (IN(pb + 1)) REPS(1) { PHASE_VARS
            pg8::Gemm g{XB, WT + W_GU1, DM, DM, DM, 0, 0}; pg8::StaticOrder S; S.init(NTM, 2 * DFF / 256, G, bx, 1);
            EpiUp E{HB, SSQ};
            small_gemm<1, 16, EpiUp, true, 2>(lds, XB, XB, DM, WT + W_GU1, WT + W_GU1, DM, 2 * DFF / 64, E, bx, G, wave, lane);
            pg8::gemm_phase<EpiUp>(lds, g, S, E, tid);
        REPSYNC(); }
        SEAM(pb + 1);
        if (IN(pb + 2)) REPS(2) { PHASE_VARS
            pg8::Gemm g{HB, WT + W_D1, DFF, DFF, DFF, 0, 0}; pg8::StaticOrder S; S.init(NTM, DM / 256, G, bx, 1);
            EpiRes E{XB, SSQ, rep ? 0.5f : 0.0f};
            small_gemm<1, 11, EpiRes>(lds, HB, HB, DFF, WT + W_D1, WT + W_D1, DFF, DM / 64, E, bx, G, wave, lane);
            pg8::gemm_phase<EpiRes>(lds, g, S, E, tid);
        REPSYNC(); }
        SEAM(pb + 2);
        if (IN(pb + 3)) REPS(3) { PHASE_VARS
            pg8::Gemm g{XB, WT + W_IN, DM, DM, DM, 0, 0}; pg8::StaticOrder S; S.init(NTM, INC / 256, G, bx, 1);
            EpiIn E{Z, SSQ, ap->b_gate + (size_t)l * 2 * DM, ap->out + O_KP + (size_t)l * NBATCH * 512 * 512, ap->out + O_VP + (size_t)l * NBATCH * 512 * 512,
                    ap->out + O_KS + (size_t)l * MS * 512, ap->out + O_VS + (size_t)l * MS * 512};
            small_gemm<1, 16, EpiIn, false, 2>(lds, XB, XB, DM, WT + W_IN, WT + W_IN, DM, INC / 64, E, bx, G, wave, lane);
            pg8::gemm_phase<EpiIn>(lds, g, S, E, tid);
        REPSYNC(); }
        SEAM(pb + 3);
        if (IN(pb + 4)) REPS(4) { PHASE_VARS
            LAS float* rbl = (LAS float*)(lds + RB_OFF);
            for (int i = tid; i < NH * NREL; i += NWAVES * 64) { const int h = i / NREL, j = i - h * NREL; rbl[h * 264 + j] = (ap->rel_bias[(size_t)l * NH * NREL + i] - ap->rel_bias[(size_t)l * NH * NREL + h * NREL + 256]) * LOG2E; }
            __syncthreads();
            LAS unsigned char* vbuf = lds + wave * 16384;
#pragma unroll 1
            for (int u = gw; u < 4096; u += NGW) {
                const int c = u & 63, h = (u >> 6) & 7, b = u >> 9;
                const int jlo = (c > 8) ? c - 8 : 0;
                const bf16_t* base = Z + (size_t)(b * SEQ) * INC + h * 64;
                auto tf = [&](int j) { TileD td; const size_t ro = (size_t)(64 * (jlo + j)) * INC; td.K = base + ro + ZC_K; td.V = base + ro + ZC_V; td.pitch = INC; td.nkeys = 64; td.delta0 = 64 * (c - jlo - j); return td; };
                bf16_t* qp = Z + (size_t)(b * SEQ + 64 * c) * INC + ZC_Q + h * 64;
                bf16_t* op = rep ? qp : XB + (size_t)(b * SEQ + 64 * c) * DM + h * 64;
                attn_wave<4>(qp, op, INC, rep ? INC : DM, c - jlo + 1, tf, vbuf, rbl + h * 264, lane);
            }
            { int l2 = lane; asm volatile("" : "+v"(l2)); asm volatile("" : "+s"(Z), "+s"(CK), "+s"(CV));
#pragma unroll 1
            for (int us = ((gw & 63) < 2) ? ((gw >> 6) * 2 + (gw & 63)) : 64; us < 64; us += 64) {
                const int h = us & 7, b = us >> 3;
                const bf16_t* zrow = Z + (size_t)(MP + 16 * b) * INC + h * 64;
                auto tf = [&](int j) { TileD td;
                    if (j < 8) { const size_t ro = (size_t)(b * 512 + 64 * j) * 512 + h * 64; td.K = CK + ro; td.V = CV + ro; td.pitch = 512; td.nkeys = 64; td.delta0 = 512 - 64 * j; }
                    else { td.K = zrow + ZC_K; td.V = zrow + ZC_V; td.pitch = INC; td.nkeys = 16; td.delta0 = 0; }
                    return td; };
                bf16_t* qp = Z + (size_t)(MP + 16 * b) * INC + ZC_Q + h * 64;
                bf16_t* op = rep ? qp : XB + (size_t)(16 * b) * DM + h * 64;
                attn_wave<1>(qp, op, INC, rep ? INC : DM, 9, tf, vbuf, rbl + h * 264, l2);
            } }
            for (int cu = (NGW - 1 - gw); cu < MR / 16; cu += NGW) {
                const int row0 = cu * 16, ch = 8 * lane;
                const bool samp = (row0 >= MP);
                const int bb = samp ? (row0 - MP) / 16 : (row0 >> 12), t0 = samp ? 0 : (row0 & 4095);
                float w0[8], w1[8], w2[8], um2[8], um1[8];
                { const float* wc = ap->w_conv + (size_t)l * 3 * 512 + ch;
#pragma unroll
                  for (int i = 0; i < 8; ++i) { w0[i] = wc[i]; w1[i] = wc[512 + i]; w2[i] = wc[1024 + i]; } }
                if (samp) { const float* sc = ap->state_conv + ((size_t)(l * NBATCH + bb) * 2) * 512 + ch;
#pragma unroll
                    for (int i = 0; i < 8; ++i) { um2[i] = sc[i]; um1[i] = sc[512 + i]; }
                } else if (t0 == 0) {
#pragma unroll
                    for (int i = 0; i < 8; ++i) { um2[i] = 0.f; um1[i] = 0.f; }
                } else {
                    const bf16_t* z2 = Z + (size_t)(row0 - 2) * INC + ch; const bf16_t* z1 = Z + (size_t)(row0 - 1) * INC + ch;
                    const u32x4 c2 = ldg16(z2 + ZC_CC), v2 = ldg16(z2 + ZC_CV), c1 = ldg16(z1 + ZC_CC), v1 = ldg16(z1 + ZC_CV);
#pragma unroll
                    for (int i = 0; i < 4; ++i) { um2[2 * i] = bf_lo(c2[i]) * bf_lo(v2[i]); um2[2 * i + 1] = bf_hi(c2[i]) * bf_hi(v2[i]); um1[2 * i] = bf_lo(c1[i]) * bf_lo(v1[i]); um1[2 * i + 1] = bf_hi(c1[i]) * bf_hi(v1[i]); }
                }
#pragma unroll
                for (int rb8 = 0; rb8 < 2; ++rb8) {
                    u32x4 cbv[8], ccv[8], cvv[8];
#pragma unroll
                    for (int r = 0; r < 8; ++r) { const bf16_t* zr = Z + (size_t)(row0 + rb8 * 8 + r) * INC + ch; cbv[r] = ldg16(zr + ZC_CB); ccv[r] = ldg16(zr + ZC_CC); cvv[r] = ldg16(zr + ZC_CV); }
#pragma unroll
                    for (int r = 0; r < 8; ++r) {
                        bf16_t* zr = Z + (size_t)(row0 + rb8 * 8 + r) * INC + ch;
                        const u32x4 cbw = cbv[r], ccw = ccv[r], cvw = cvv[r];
                        float y[8];
#pragma unroll
                        for (int i = 0; i < 4; ++i) {
                            const float u0 = bf_lo(ccw[i]) * bf_lo(cvw[i]), u1 = bf_hi(ccw[i]) * bf_hi(cvw[i]);
                            y[2 * i] = bf_lo(cbw[i]) * (w0[2 * i] * um2[2 * i] + w1[2 * i] * um1[2 * i] + w2[2 * i] * u0);
                            y[2 * i + 1] = bf_hi(cbw[i]) * (w0[2 * i + 1] * um2[2 * i + 1] + w1[2 * i + 1] * um1[2 * i + 1] + w2[2 * i + 1] * u1);
                            um2[2 * i] = um1[2 * i]; um1[2 * i] = u0; um2[2 * i + 1] = um1[2 * i + 1]; um1[2 * i + 1] = u1;
                        }
                        u32x4 w; w.x = cvt_pk_bf16(y[0], y[1]); w.y = cvt_pk_bf16(y[2], y[3]); w.z = cvt_pk_bf16(y[4], y[5]); w.w = cvt_pk_bf16(y[6], y[7]);
                        stg16(rep ? zr + ZC_CB : XB + (size_t)(row0 + rb8 * 8 + r) * DM + 512 + ch, w);
                    }
                }
                if (samp || t0 == SEQ - 16) {
                    float* dst = ap->out + (samp ? O_CS : O_CP) + ((size_t)(l * NBATCH + bb) * 2) * 512 + ch;
                    *(f32x4*)dst = (f32x4){um2[0], um2[1], um2[2], um2[3]}; *(f32x4*)(dst + 4) = (f32x4){um2[4], um2[5], um2[6], um2[7]};
                    *(f32x4*)(dst + 512) = (f32x4){um1[0], um1[1], um1[2], um1[3]}; *(f32x4*)(dst + 516) = (f32x4){um1[4], um1[5], um1[6], um1[7]};
                }
            }
            if (rep && l + 1 < DEPTH) { asm volatile("s_waitcnt vmcnt(0) lgkmcnt(0)" ::: "memory"); asm volatile("" : "+s"(ap)); CONVERT_LAYER(l + 1, WTN, CKN, CVN); }
            asm volatile("s_waitcnt vmcnt(0) lgkmcnt(0)" ::: "memory");
            __syncthreads();
        REPSYNC(); }
        SEAM(pb + 4);
        if (IN(pb + 5)) REPS(5) { PHASE_VARS
            pg8::Gemm g{Z, WT + W_CAT, INC, DM, DM, 0, 0}; pg8::StaticOrder S; S.init(NTM, DM / 256, G, bx, 1);
            EpiMix E{Z};
            small_gemm<2, 2, EpiMix>(lds, Z + ZC_CB, Z + ZC_Q, INC, WT + W_CAT, WT + W_CAT + 512, DM, DM / 64, E, bx, G, wave, lane);
            pg8::gemm_phase<EpiMix, true>(lds, g, S, E, tid);
        REPSYNC(); }
        SEAM(pb + 5);
        if (IN(pb + 6)) REPS(6) { PHASE_VARS
            pg8::Gemm g{Z + ZC_MB, WT + W_O, INC, DM, DM, 0, 0}; pg8::StaticOrder S; S.init(NTM, DM / 256, G, bx, 1);
            EpiRes E{XB, SSQ, rep ? 1.0f : 0.0f};
            small_gemm<1, 4, EpiRes>(lds, Z + ZC_MB, Z + ZC_MB, INC, WT + W_O, WT + W_O, DM, DM / 64, E, bx, G, wave, lane);
            pg8::gemm_phase<EpiRes>(lds, g, S, E, tid);
        REPSYNC(); }
        SEAM(pb + 6);
        if (IN(pb + 7)) REPS(7) { PHASE_VARS
            pg8::Gemm g{XB, WT + W_GU2, DM, DM, DM, 0, 0}; pg8::StaticOrder S; S.init(NTM, 2 * DFF / 256, G, bx, 1);
            EpiUp E{HB, SSQ};
            small_gemm<1, 16, EpiUp, true, 2>(lds, XB, XB, DM, WT + W_GU2, WT + W_GU2, DM, 2 * DFF / 64, E, bx, G, wave, lane);
            pg8::gemm_phase<EpiUp>(lds, g, S, E, tid);
        REPSYNC(); }
        SEAM(pb + 7);
        if (IN(pb + 8)) REPS(8) { PHASE_VARS
            pg8::Gemm g{HB, WT + W_D2, DFF, DFF, DFF, 0, 0}; pg8::StaticOrder S; S.init(NTM, DM / 256, G, bx, 1);
            EpiRes E{XB, SSQ, rep ? 0.5f : 0.0f};
            small_gemm<1, 11, EpiRes>(lds, HB, HB, DFF, WT + W_D2, WT + W_D2, DFF, DM / 64, E, bx, G, wave, lane);
            pg8::gemm_phase<EpiRes>(lds, g, S, E, tid);
        REPSYNC(); }
        SEAM(pb + 8);
    }
    if (IN(36)) { const int l = 0; PHASE_VARS
        f32x4 gn[4];
#pragma unroll
        for (int j = 0; j < 4; ++j) gn[j] = *(const f32x4*)(ap->norm_final + 256 * j + 4 * lane);
        for (int m0 = gw * 4; m0 < MR; m0 += NGW * 4) {
            u32x2 o[4][4]; float sv[4];
#pragma unroll
            for (int r = 0; r < 4; ++r) { const bf16_t* xb = XB + (size_t)(m0 + r) * DM; sv[r] = (lane < 16) ? SSQ[(size_t)(m0 + r) * 16 + lane] : 0.f;
#pragma unroll
                for (int j = 0; j < 4; ++j) o[r][j] = *(const u32x2*)(xb + 256 * j + 4 * lane); }
#pragma unroll
            for (int r = 0; r < 4; ++r) { float* yr = X + (size_t)(m0 + r) * DM;
                const float rs = __builtin_amdgcn_rsqf(wave_sum(sv[r]) * (1.0f / 1024.0f) + EPS);
#pragma unroll
                for (int j = 0; j < 4; ++j) { const f32x4 x = (f32x4){bf_lo(o[r][j].x), bf_hi(o[r][j].x), bf_lo(o[r][j].y), bf_hi(o[r][j].y)}; __builtin_nontemporal_store(x * rs * gn[j], (f32x4*)(yr + 256 * j + 4 * lane)); } }
        }
    }
    if (PROBE_WAIT) {
        unsigned* acc_w = barw + 3500;
        if (threadIdx.x == 0) atomicAdd(acc_w, wait_ticks);
        GSYNC();
        if (threadIdx.x == 0) { const unsigned avg = __hip_atomic_load(acc_w, __ATOMIC_RELAXED, __HIP_MEMORY_SCOPE_AGENT) / gridDim.x;
            const unsigned long long t0 = __builtin_amdgcn_s_memrealtime(); while (__builtin_amdgcn_s_memrealtime() - t0 < 8ull * avg) __builtin_amdgcn_s_sleep(8); }
        __syncthreads();
    }
#undef IN
#undef SEAM
}

extern "C" void kernel_launch(void* const* d_in, const int* in_sizes, int n_in, void* d_out, int out_size, void* d_ws, size_t ws_size, hipStream_t stream) {
    static int grid = 0;
    if (grid == 0) {
        if (n_in != 20 || (size_t)out_size != O_END || ws_size < WS_END) { fprintf(stderr, "kernel_launch: unexpected shapes: n_in %d out %d (want %zu) ws %zu (need %zu)\n", n_in, out_size, (size_t)O_END, ws_size, (size_t)WS_END); grid = -1; return; }
        int dev = 0, cus = 0, per_cu = 0;
        hipGetDevice(&dev); hipDeviceGetAttribute(&cus, hipDeviceAttributeMultiprocessorCount, dev);
        if (hipFuncSetAttribute((const void*)mega_fwd, hipFuncAttributeMaxDynamicSharedMemorySize, LDS_BYTES) != hipSuccess) { fprintf(stderr, "kernel_launch: hipFuncSetAttribute failed\n"); grid = -1; return; }
        if (hipOccupancyMaxActiveBlocksPerMultiprocessor(&per_cu, (const void*)mega_fwd, NWAVES * 64, LDS_BYTES) != hipSuccess || per_cu < 1) { fprintf(stderr, "kernel_launch: occupancy query says %d\n", per_cu); per_cu = 1; }
        (void)hipGetLastError();
        grid = cus;
    }
    if (grid < 0) return;
    Args a{};
    const float** ap = (const float**)&a;
    for (int i = 0; i < 20; ++i) ap[i] = (const float*)d_in[i];
    a.out = (float*)d_out; a.ws = (unsigned char*)d_ws; a.ph_lo = 0; a.ph_hi = 37;
    void* args[] = {&a};
    hipError_t e = hipLaunchCooperativeKernel((const void*)mega_fwd, dim3(grid), dim3(NWAVES * 64), args, LDS_BYTES, stream);
    if (e != hipSuccess) fprintf(stderr, "kernel_launch: cooperative launch failed: %s (grid %d)\n", hipGetErrorString(e), grid);
}
```

```cpp
#include <hip/hip_runtime.h>
#include <hip/hip_cooperative_groups.h>
#include <cstdio>
#include <cstdint>
namespace cg = cooperative_groups;
#ifndef PROBE_REP
#define PROBE_REP (-1)
#endif
#ifndef PROBE_EPI
#define PROBE_EPI 0
#endif
#ifndef PROBE_WAIT
#define PROBE_WAIT 0
#endif

#define LAS __attribute__((address_space(3)))
typedef unsigned short bf16_t;
typedef short bf16x8 __attribute__((ext_vector_type(8)));
typedef short s16x4 __attribute__((ext_vector_type(4)));
typedef float f32x4 __attribute__((ext_vector_type(4)));
typedef unsigned u32x4 __attribute__((ext_vector_type(4)));
typedef unsigned u32x2 __attribute__((ext_vector_type(2)));

constexpr int DM = 1024, NBATCH = 8, SEQ = 4096, DEPTH = 4, DSEQ = 16;
constexpr int NH = 8, DFF = 2816, INC = 5120, NREL = 257;
constexpr int MP = NBATCH * SEQ;
constexpr int MS = NBATCH * DSEQ;
constexpr int MR = MP + MS;
constexpr int MPAD = 33024;
constexpr int NTM = MP / 256;
constexpr float EPS = 1e-6f;
constexpr float LOG2E = 1.4426950408889634f;
constexpr float QSCALE = 0.125f * LOG2E;
constexpr int ZC_CB = 0, ZC_Q = 512, ZC_CC = 1024, ZC_CV = 1536, ZC_K = 2048, ZC_V = 2560, ZC_GC = 3072, ZC_GA = 4096, ZC_MB = 1024;

constexpr size_t O_Y = 0;
constexpr size_t O_KP = (size_t)MR * DM;
constexpr size_t O_VP = O_KP + (size_t)DEPTH * NBATCH * 512 * 512;
constexpr size_t O_CP = O_VP + (size_t)DEPTH * NBATCH * 512 * 512;
constexpr size_t O_KS = O_CP + (size_t)DEPTH * NBATCH * 2 * 512;
constexpr size_t O_VS = O_KS + (size_t)DEPTH * NBATCH * DSEQ * 512;
constexpr size_t O_CS = O_VS + (size_t)DEPTH * NBATCH * DSEQ * 512;
constexpr size_t O_END = O_CS + (size_t)DEPTH * NBATCH * 2 * 512;

constexpr size_t W_GU1 = 0;
constexpr size_t W_D1 = W_GU1 + (size_t)2 * DFF * DM;
constexpr size_t W_IN = W_D1 + (size_t)DM * DFF;
constexpr size_t W_CAT = W_IN + (size_t)INC * DM;
constexpr size_t W_O = W_CAT + (size_t)DM * DM;
constexpr size_t W_GU2 = W_O + (size_t)DM * DM;
constexpr size_t W_D2 = W_GU2 + (size_t)2 * DFF * DM;
constexpr size_t W_TOTAL = W_D2 + (size_t)DM * DFF;

constexpr size_t WS_WT = 0;
constexpr size_t WS_XB = WS_WT + ((W_TOTAL * 2 + 4095) / 4096) * 4096;
constexpr size_t WS_SSQ = WS_XB + (size_t)MPAD * DM * 2;
constexpr size_t WS_CK = WS_SSQ + (size_t)MPAD * 16 * 4;
constexpr size_t WS_CV = WS_CK + (size_t)NBATCH * 512 * 512 * 2;
constexpr size_t WS_Z = WS_CV + (size_t)NBATCH * 512 * 512 * 2;
constexpr size_t WS_WT2 = WS_Z + (size_t)MPAD * INC * 2;
constexpr size_t WS_BAR = WS_WT2 + ((W_TOTAL * 2 + 4095) / 4096) * 4096;
constexpr size_t WS_CK2 = WS_BAR + 16384;
constexpr size_t WS_CV2 = WS_CK2 + (size_t)NBATCH * 512 * 512 * 2;
constexpr size_t WS_END = WS_CV2 + (size_t)NBATCH * 512 * 512 * 2;

constexpr int NWAVES = 8;
constexpr int RING_BYTES = 131072;
constexpr int RB_OFF = RING_BYTES + 1024;
constexpr int LDS_BYTES = 147456;
constexpr int BARST_OFF = LDS_BYTES - 64;

__device__ __forceinline__ unsigned cvt_pk_bf16(float lo, float hi) { unsigned r; asm volatile("v_cvt_pk_bf16_f32 %0, %1, %2" : "=v"(r) : "v"(lo), "v"(hi)); return r; }
__device__ __forceinline__ float bf_lo(unsigned w) { return __uint_as_float(w << 16); }
__device__ __forceinline__ float bf_hi(unsigned w) { return __uint_as_float(w & 0xffff0000u); }
__device__ __forceinline__ unsigned f2bf(float f) { unsigned u = __float_as_uint(f); return (u + 0x7fffu + ((u >> 16) & 1u)) >> 16; }
__device__ __forceinline__ unsigned pk2(float lo, float hi) { return f2bf(lo) | (f2bf(hi) << 16); }
#define GAS __attribute__((address_space(1)))
__device__ __forceinline__ u32x4 ldg16(const void* p) { return *(const GAS u32x4*)p; }
__device__ __forceinline__ bf16x8 ldg16b(const void* p) { return *(const GAS bf16x8*)p; }
__device__ __forceinline__ void stg16(void* p, u32x4 v) { *(GAS u32x4*)p = v; }
__device__ __forceinline__ float xsum_16_32(float s) {
    auto r = __builtin_amdgcn_permlane16_swap(__float_as_uint(s), __float_as_uint(s), false, false);
    s = __uint_as_float(r[0]) + __uint_as_float(r[1]);
    auto q = __builtin_amdgcn_permlane32_swap(__float_as_uint(s), __float_as_uint(s), false, false);
    return __uint_as_float(q[0]) + __uint_as_float(q[1]);
}
__device__ __forceinline__ float xmax_16_32(float s) {
    auto r = __builtin_amdgcn_permlane16_swap(__float_as_uint(s), __float_as_uint(s), false, false);
    s = fmaxf(__uint_as_float(r[0]), __uint_as_float(r[1]));
    auto q = __builtin_amdgcn_permlane32_swap(__float_as_uint(s), __float_as_uint(s), false, false);
    return fmaxf(__uint_as_float(q[0]), __uint_as_float(q[1]));
}
__device__ __forceinline__ float fast_sigmoid(float x) { return __builtin_amdgcn_rcpf(1.0f + __builtin_amdgcn_exp2f(-x * LOG2E)); }

namespace pg8 {
constexpr int BM = 256, BK = 64, HALF = 128, HTB = HALF * BK * 2, STAGE_BYTES = 8 * HTB, NXCD = 8, WGM = 8;
__host__ __device__ __forceinline__ int lds_byte(int r, int c) { const int st = (r >> 4) * 2 + (c >> 5), rr = r & 15, cc = c & 31, ob = rr * 64 + cc * 2; return st * 1024 + (ob ^ (((ob >> 9) & 1) << 5)); }
__host__ __device__ __forceinline__ void stage_rc(int b, int& R, int& C) { const int st = b / 1024, sb = b % 1024, swz = sb ^ (((sb >> 9) & 1) << 5); R = (st >> 1) * 16 + swz / 64; C = (st & 1) * 32 + (swz % 64) / 2; }
__host__ __device__ __forceinline__ int perm32(int rho) { const int n = rho >> 4, i = rho & 15; return 8 * (i >> 2) + 4 * n + (i & 3); }

struct Unit { int pm, pn, z; };
struct Gemm { const bf16_t* A; const bf16_t* Bt; int lda, ldb, K; long zA, zB; };

struct StaticOrder {
    int nM, nN, nwg, G, c, nz;
    __device__ void init(int nM_, int nN_, int G_, int c_, int nz_) { nM = nM_; nN = nN_; nwg = nM * nN; G = G_; c = c_; nz = nz_; }
    __device__ bool next(int i, Unit& u) const {
        const int it = i / nz; u.z = i - it * nz;
        const long L = (long)it * G + c; if (L >= nwg) return false;
        int wgid = (int)L; { const int q = nwg / NXCD, r = nwg % NXCD, xcd = wgid % NXCD, off = wgid / NXCD; wgid = (xcd < r ? xcd * (q + 1) : r * (q + 1) + (xcd - r) * q) + off; }
        const int nig = WGM * nN, gid = wgid / nig, fm = gid * WGM, gsz = (nM - fm) < WGM ? (nM - fm) : WGM;
        u.pm = fm + ((wgid % nig) % gsz); u.pn = (wgid % nig) / gsz; return true;
    }
};

template <class Epi, bool MIDHOOK = false>
__device__ __forceinline__ void gemm_phase(LAS unsigned char* lds, const Gemm g, const StaticOrder& S, const Epi& E, const int tid) {
    const int wid = __builtin_amdgcn_readfirstlane(tid >> 6), lane = tid & 63, wr = wid >> 2, wc = wid & 3, fr = lane & 15, fq = lane >> 4;
    const int K = g.K, nt = K / BK;
    unsigned voffA[2], voffB[2];
#pragma unroll
    for (int i = 0; i < 2; ++i) { int R, C; stage_rc(tid * 16 + i * 8192, R, C); const int Rb = (R & ~31) + perm32(R & 31);
        voffA[i] = (unsigned)(R * g.lda + C) * 2u; voffB[i] = (unsigned)(Rb * g.ldb + C) * 2u; }
    const size_t kstep = (size_t)(BK * 2);
    const size_t hstepA = (size_t)HALF * g.lda * 2, hstepB = (size_t)HALF * g.ldb * 2;
    const size_t tstepA = 2 * hstepA, tstepB = 2 * hstepB;
    const unsigned ldsw = (unsigned)wid * 1024u;
    const int aoff = lds_byte(wr * 64 + fr, fq * 8), boff = lds_byte(wc * 32 + fr, fq * 8);
#define PG8_SA(b, h) (((b) * 2 + (h)) * HTB)
#define PG8_SB(b, h) ((4 + (b) * 2 + (h)) * HTB)
#define PG8_STAGE(bufoff, gbase, voff) do { _Pragma("unroll") for (int _i = 0; _i < 2; ++_i) \
        __builtin_amdgcn_global_load_lds((const unsigned*)((const char*)(gbase) + (voff)[_i]), (LAS unsigned*)(lds + (bufoff) + ldsw + _i * 8192), 16, 0, 0); } while (0)
#define PG8_LDA(dst, b, h) do { _Pragma("unroll") for (int m = 0; m < 4; ++m) _Pragma("unroll") for (int k = 0; k < 2; ++k) dst[m][k] = *(const LAS bf16x8*)(lds + PG8_SA(b, h) + aoff + m * 2048 + k * 1024); } while (0)
#define PG8_LDB(dst, b, h) do { _Pragma("unroll") for (int n = 0; n < 2; ++n) _Pragma("unroll") for (int k = 0; k < 2; ++k) dst[n][k] = *(const LAS bf16x8*)(lds + PG8_SB(b, h) + boff + n * 2048 + k * 1024); } while (0)
#define PG8_MMA(ai, bj, At, Bt) do { __builtin_amdgcn_s_setprio(1); _Pragma("unroll") for (int m = 0; m < 4; ++m) _Pragma("unroll") for (int n = 0; n < 2; ++n) _Pragma("unroll") for (int k = 0; k < 2; ++k) \
        acc[ai][bj][m][n] = __builtin_amdgcn_mfma_f32_16x16x32_bf16(Bt[n][k], At[m][k], acc[ai][bj][m][n], 0, 0, 0); __builtin_amdgcn_s_setprio(0); } while (0)
#define PG8_WAIT_V(n) asm volatile("s_waitcnt vmcnt(" #n ")" ::: "memory")
#define PG8_WAIT_L(n) asm volatile("s_waitcnt lgkmcnt(" #n ")" ::: "memory")
#define PG8_BAR __builtin_amdgcn_s_barrier()
#define PG8_SCHED __builtin_amdgcn_sched_barrier(0)
    Unit cur, nxt; int ui = 0;
    if (!S.next(0, cur)) return;
    f32x4 acc[2][2][4][2];
#pragma unroll
    for (int a = 0; a < 2; ++a)
#pragma unroll
        for (int b = 0; b < 2; ++b)
#pragma unroll
            for (int m = 0; m < 4; ++m)
#pragma unroll
                for (int n = 0; n < 2; ++n) acc[a][b][m][n] = (f32x4){0.f, 0.f, 0.f, 0.f};
    bf16x8 At[4][2], B0[2][2], B1[2][2];
    const char* cA = (const char*)g.A + (size_t)cur.pm * tstepA + (size_t)cur.z * g.zA; const char* cB = (const char*)g.Bt + (size_t)cur.pn * tstepB + (size_t)cur.z * g.zB;
    PG8_STAGE(PG8_SB(0, 0), cB, voffB); PG8_STAGE(PG8_SB(0, 1), cB + hstepB, voffB); PG8_STAGE(PG8_SA(0, 0), cA, voffA); PG8_STAGE(PG8_SA(0, 1), cA + hstepA, voffA);
    if (wr == 1) PG8_BAR;
    PG8_WAIT_V(2); PG8_BAR;
    PG8_STAGE(PG8_SB(1, 0), cB + kstep, voffB); PG8_STAGE(PG8_SA(1, 0), cA + kstep, voffA); PG8_STAGE(PG8_SB(1, 1), cB + hstepB + kstep, voffB);
    PG8_WAIT_V(6); PG8_BAR;
    for (;;) {
        const bool has_next = S.next(ui + 1, nxt);
        const char* nA = has_next ? (const char*)g.A + (size_t)nxt.pm * tstepA + (size_t)nxt.z * g.zA : cA; const char* nB = has_next ? (const char*)g.Bt + (size_t)nxt.pn * tstepB + (size_t)nxt.z * g.zB : cB;
        for (int t = 0; t < nt; t += 2) {
            if constexpr (MIDHOOK) { if (t == nt / 2) E.mid(acc, cur, wr, wc, fr, fq); }
            const bool last = (t == nt - 2);
            const char* a1 = cA + (size_t)(t + 1) * kstep;
            const char* a2 = last ? nA : cA + (size_t)(t + 2) * kstep; const char* b2 = last ? nB : cB + (size_t)(t + 2) * kstep;
            const char* a3 = a2 + kstep; const char* b3 = b2 + kstep;
            PG8_LDB(B0, 0, 0); PG8_LDB(B1, 0, 1); PG8_SCHED; PG8_LDA(At, 0, 0); PG8_STAGE(PG8_SA(1, 1), a1 + hstepA, voffA);
            PG8_WAIT_V(8); PG8_WAIT_L(0); PG8_BAR; PG8_MMA(0, 0, At, B0); PG8_MMA(0, 1, At, B1); PG8_BAR; PG8_SCHED;
            PG8_LDA(At, 0, 1); PG8_STAGE(PG8_SB(0, 0), b2, voffB); PG8_STAGE(PG8_SB(0, 1), b2 + hstepB, voffB); PG8_STAGE(PG8_SA(0, 0), a2, voffA);
            PG8_WAIT_V(8); PG8_WAIT_L(0); PG8_BAR; PG8_MMA(1, 0, At, B0); PG8_MMA(1, 1, At, B1); PG8_BAR; PG8_SCHED;
            PG8_LDB(B0, 1, 0); PG8_LDB(B1, 1, 1); PG8_SCHED; PG8_LDA(At, 1, 0); PG8_STAGE(PG8_SA(0, 1), a2 + hstepA, voffA);
            PG8_WAIT_V(8); PG8_WAIT_L(0); PG8_BAR; PG8_MMA(0, 0, At, B0); PG8_MMA(0, 1, At, B1); PG8_BAR; PG8_SCHED;
            PG8_LDA(At, 1, 1); PG8_STAGE(PG8_SB(1, 0), b3, voffB); PG8_STAGE(PG8_SB(1, 1), b3 + hstepB, voffB); PG8_STAGE(PG8_SA(1, 0), a3, voffA);
            PG8_WAIT_V(8); PG8_WAIT_L(0); PG8_BAR; PG8_MMA(1, 0, At, B0); PG8_MMA(1, 1, At, B1); PG8_BAR; PG8_SCHED;
        }
        if (wr == 0) PG8_BAR;
        E(acc, cur, wr, wc, fr, fq);
        if (PROBE_EPI == Epi::PROBE_ID) { const Epi E2 = E.probe_copy(); E2(acc, cur, wr, wc, fr, fq); }
        if (!has_next) break;
#pragma unroll
        for (int a = 0; a < 2; ++a)
#pragma unroll
            for (int b = 0; b < 2; ++b)
#pragma unroll
                for (int m = 0; m < 4; ++m)
#pragma unroll
                    for (int n = 0; n < 2; ++n) acc[a][b][m][n] = (f32x4){0.f, 0.f, 0.f, 0.f};
        cur = nxt; cA = nA; cB = nB; ++ui;
        if (wr == 1) PG8_BAR;
    }
    PG8_WAIT_V(0);
    PG8_BAR;
#undef PG8_SA
#undef PG8_SB
#undef PG8_STAGE
#undef PG8_LDA
#undef PG8_LDB
#undef PG8_MMA
#undef PG8_WAIT_V
#undef PG8_WAIT_L
#undef PG8_BAR
#undef PG8_SCHED
}
}

__device__ __forceinline__ float row_rs(const float* ssq, int row, int fq) {
    const f32x4 v = *(const f32x4*)(ssq + (size_t)row * 16 + 4 * fq);
    float s = (v[0] + v[1]) + (v[2] + v[3]);
    s = xsum_16_32(s);
    return __builtin_amdgcn_rsqf(s * (1.0f / 1024.0f) + EPS);
}

__device__ __forceinline__ void row_rs8(const float* ssq, int row0, int fq, float (&rsv)[2][4]) {
    f32x4 sv[2][4];
#pragma unroll
    for (int ai = 0; ai < 2; ++ai)
#pragma unroll
        for (int m = 0; m < 4; ++m) sv[ai][m] = *(const f32x4*)(ssq + (size_t)(row0 + ai * 128 + m * 16) * 16 + 4 * fq);
#pragma unroll
    for (int ai = 0; ai < 2; ++ai)
#pragma unroll
        for (int m = 0; m < 4; ++m) {
            float s = (sv[ai][m][0] + sv[ai][m][1]) + (sv[ai][m][2] + sv[ai][m][3]);
            s = xsum_16_32(s);
            rsv[ai][m] = __builtin_amdgcn_rsqf(s * (1.0f / 1024.0f) + EPS);
        }
}

struct EpiUp {
    static constexpr int PROBE_ID = 1; __device__ __forceinline__ EpiUp probe_copy() const { return *this; }
    bf16_t* H; const float* ssq;
    __device__ __forceinline__ void operator()(const f32x4 (&acc)[2][2][4][2], const pg8::Unit& u, int wr, int wc, int fr, int fq) const {
        const int row0 = u.pm * 256 + wr * 64 + fr, hc0 = u.pn * 128 + wc * 32 + 8 * fq;
        float rsv[2][4]; row_rs8(ssq, row0, fq, rsv);
#pragma unroll
        for (int ai = 0; ai < 2; ++ai)
#pragma unroll
            for (int m = 0; m < 4; ++m) {
                const int row = row0 + ai * 128 + m * 16; const float rs = rsv[ai][m];
                float h[8];
#pragma unroll
                for (int n = 0; n < 2; ++n) {
                    const f32x4 gg = acc[ai][0][m][n] * rs, uu = acc[ai][1][m][n] * rs;
#pragma unroll
                    for (int i = 0; i < 4; ++i) h[4 * n + i] = gg[i] * fast_sigmoid(gg[i]) * uu[i];
                }
                u32x4 w; w.x = cvt_pk_bf16(h[0], h[1]); w.y = cvt_pk_bf16(h[2], h[3]); w.z = cvt_pk_bf16(h[4], h[5]); w.w = cvt_pk_bf16(h[6], h[7]);
                *(u32x4*)(H + (size_t)row * DFF + hc0) = w;
            }
    }
    __device__ __forceinline__ void small(const f32x4 (&acc)[1][2][2], int row, int h0, int fr, int fq) const {
        const float rs = row_rs(ssq, row, fq); float h[8];
#pragma unroll
        for (int n = 0; n < 2; ++n) {
            const f32x4 gg = acc[0][0][n] * rs, uu = acc[0][1][n] * rs;
#pragma unroll
            for (int i = 0; i < 4; ++i) h[4 * n + i] = gg[i] * fast_sigmoid(gg[i]) * uu[i];
        }
        u32x4 w; w.x = cvt_pk_bf16(h[0], h[1]); w.y = cvt_pk_bf16(h[2], h[3]); w.z = cvt_pk_bf16(h[4], h[5]); w.w = cvt_pk_bf16(h[6], h[7]);
        *(u32x4*)(H + (size_t)row * DFF + h0 + 8 * fq) = w;
    }
};

struct EpiRes {
    static constexpr int PROBE_ID = 2; __device__ __forceinline__ EpiRes probe_copy() const { EpiRes e = *this; e.scale = 0.f; return e; }
    bf16_t* XB; float* ssq; float scale;
    __device__ __forceinline__ void operator()(const f32x4 (&acc)[2][2][4][2], const pg8::Unit& u, int wr, int wc, int fr, int fq) const {
        const int row0 = u.pm * 256 + wr * 64 + fr, col0 = u.pn * 256 + wc * 32 + 8 * fq;
#pragma unroll
        for (int ai = 0; ai < 2; ++ai) {
            u32x4 xw[4][2];
#pragma unroll
            for (int m = 0; m < 4; ++m)
#pragma unroll
                for (int bj = 0; bj < 2; ++bj) xw[m][bj] = *(const u32x4*)(XB + (size_t)(row0 + ai * 128 + m * 16) * DM + col0 + bj * 128);
#pragma unroll
            for (int m = 0; m < 4; ++m) {
                const int row = row0 + ai * 128 + m * 16; float s = 0.f;
#pragma unroll
                for (int bj = 0; bj < 2; ++bj) {
                    const u32x4 o = xw[m][bj];
                    f32x4 x0 = (f32x4){bf_lo(o.x), bf_hi(o.x), bf_lo(o.y), bf_hi(o.y)}, x1 = (f32x4){bf_lo(o.z), bf_hi(o.z), bf_lo(o.w), bf_hi(o.w)};
                    x0 += acc[ai][bj][m][0] * scale; x1 += acc[ai][bj][m][1] * scale;
                    u32x4 w; w.x = cvt_pk_bf16(x0[0], x0[1]); w.y = cvt_pk_bf16(x0[2], x0[3]); w.z = cvt_pk_bf16(x1[0], x1[1]); w.w = cvt_pk_bf16(x1[2], x1[3]);
                    *(u32x4*)(XB + (size_t)row * DM + col0 + bj * 128) = w;
                    s += (x0[0] * x0[0] + x0[1] * x0[1]) + (x0[2] * x0[2] + x0[3] * x0[3]) + (x1[0] * x1[0] + x1[1] * x1[1]) + (x1[2] * x1[2] + x1[3] * x1[3]);
                }
                s = xsum_16_32(s);
                if (fq == 0) ssq[(size_t)row * 16 + u.pn * 4 + wc] = s;
            }
        }
    }
    __device__ __forceinline__ void small(const f32x4 (&acc)[1][2][2], int row, int c0, int fr, int fq) const {
        float s = 0.f;
#pragma unroll
        for (int j = 0; j < 2; ++j) {
            bf16_t* xp = XB + (size_t)row * DM + c0 + 32 * j + 8 * fq;
            const u32x4 o = *(const u32x4*)xp;
            f32x4 x0 = (f32x4){bf_lo(o.x), bf_hi(o.x), bf_lo(o.y), bf_hi(o.y)}, x1 = (f32x4){bf_lo(o.z), bf_hi(o.z), bf_lo(o.w), bf_hi(o.w)};
            x0 += acc[0][j][0] * scale; x1 += acc[0][j][1] * scale;
            u32x4 w; w.x = cvt_pk_bf16(x0[0], x0[1]); w.y = cvt_pk_bf16(x0[2], x0[3]); w.z = cvt_pk_bf16(x1[0], x1[1]); w.w = cvt_pk_bf16(x1[2], x1[3]);
            *(u32x4*)xp = w;
            s += (x0[0] * x0[0] + x0[1] * x0[1]) + (x0[2] * x0[2] + x0[3] * x0[3]) + (x1[0] * x1[0] + x1[1] * x1[1]) + (x1[2] * x1[2] + x1[3] * x1[3]);
        }
        s = xsum_16_32(s);
        if (fq == 0) ssq[(size_t)row * 16 + (c0 >> 6)] = s;
    }
};

struct EpiIn {
    static constexpr int PROBE_ID = 3; __device__ __forceinline__ EpiIn probe_copy() const { return *this; }
    bf16_t* Z; const float* ssq; const float* bgate; float* okp; float* ovp; float* oks; float* ovs;
    __device__ __forceinline__ void operator()(const f32x4 (&acc)[2][2][4][2], const pg8::Unit& u, int wr, int wc, int fr, int fq) const {
        const int row0 = u.pm * 256 + wr * 64 + fr, col0 = u.pn * 256 + wc * 32 + 8 * fq;
        const int pn = u.pn;
        const bool isq = (pn == 2 || pn == 3), iskv = (pn >= 8 && pn < 12), isg = (pn >= 12);
        const bool kvp = iskv && ((u.pm & 15) >= 14);
        f32x4 bg[2][2];
#pragma unroll
        for (int bj = 0; bj < 2; ++bj) { if (isg) { bg[bj][0] = *(const f32x4*)(bgate + col0 - ZC_GC + bj * 128); bg[bj][1] = *(const f32x4*)(bgate + col0 - ZC_GC + bj * 128 + 4); } else { bg[bj][0] = (f32x4){0.f, 0.f, 0.f, 0.f}; bg[bj][1] = bg[bj][0]; } }
        float rsv[2][4]; row_rs8(ssq, row0, fq, rsv);
#pragma unroll
        for (int ai = 0; ai < 2; ++ai)
#pragma unroll
            for (int m = 0; m < 4; ++m) {
                const int row = row0 + ai * 128 + m * 16; float rs = rsv[ai][m];
                if (isq) rs *= QSCALE;
#pragma unroll
                for (int bj = 0; bj < 2; ++bj) {
                    f32x4 v0 = acc[ai][bj][m][0] * rs, v1 = acc[ai][bj][m][1] * rs;
                    const int c = col0 + bj * 128;
                    if (isg) {
                        v0 += bg[bj][0]; v1 += bg[bj][1];
#pragma unroll
                        for (int i = 0; i < 4; ++i) { v0[i] = fast_sigmoid(v0[i]); v1[i] = fast_sigmoid(v1[i]); }
                    }
                    u32x4 w; w.x = cvt_pk_bf16(v0[0], v0[1]); w.y = cvt_pk_bf16(v0[2], v0[3]); w.z = cvt_pk_bf16(v1[0], v1[1]); w.w = cvt_pk_bf16(v1[2], v1[3]);
                    *(u32x4*)(Z + (size_t)row * INC + c) = w;
                    if (kvp) {
                        const int b = row >> 12, t = row & 4095;
                        float* dst = ((pn < 10) ? okp : ovp) + ((size_t)(b * 512 + (t - 3584)) * 512 + (c - ((pn < 10) ? ZC_K : ZC_V)));
                        __builtin_nontemporal_store(v0, (f32x4*)dst); __builtin_nontemporal_store(v1, (f32x4*)(dst + 4));
                    }
                }
            }
    }
    __device__ __forceinline__ void small(const f32x4 (&acc)[1][2][2], int row, int c0, int fr, int fq) const {
        const int pn = c0 >> 8;
        const bool isq = (pn == 2 || pn == 3), iskv = (pn >= 8 && pn < 12), isg = (pn >= 12);
        float rs = row_rs(ssq, row, fq);
        if (isq) rs *= QSCALE;
#pragma unroll
        for (int j = 0; j < 2; ++j) {
            f32x4 v0 = acc[0][j][0] * rs, v1 = acc[0][j][1] * rs;
            const int c = c0 + 32 * j + 8 * fq;
            if (isg) {
                v0 += *(const f32x4*)(bgate + c - ZC_GC); v1 += *(const f32x4*)(bgate + c - ZC_GC + 4);
#pragma unroll
                for (int i = 0; i < 4; ++i) { v0[i] = fast_sigmoid(v0[i]); v1[i] = fast_sigmoid(v1[i]); }
            }
            u32x4 w; w.x = cvt_pk_bf16(v0[0], v0[1]); w.y = cvt_pk_bf16(v0[2], v0[3]); w.z = cvt_pk_bf16(v1[0], v1[1]); w.w = cvt_pk_bf16(v1[2], v1[3]);
            *(u32x4*)(Z + (size_t)row * INC + c) = w;
            if (iskv) {
                float* dst = ((pn < 10) ? oks : ovs) + ((size_t)(row - MP) * 512 + (c - ((pn < 10) ? ZC_K : ZC_V)));
                __builtin_nontemporal_store(v0, (f32x4*)dst); __builtin_nontemporal_store(v1, (f32x4*)(dst + 4));
            }
        }
    }
};

struct EpiMix {
    static constexpr int PROBE_ID = 4; __device__ __forceinline__ EpiMix probe_copy() const { return *this; }
    bf16_t* Z;
    __device__ __forceinline__ void mid(f32x4 (&acc)[2][2][4][2], const pg8::Unit& u, int wr, int wc, int fr, int fq) const {
        int row0 = u.pm * 256 + wr * 64 + fr, col0 = u.pn * 256 + wc * 32 + 8 * fq;
        asm volatile("" : "+v"(row0), "+v"(col0));
#pragma unroll
        for (int g4 = 0; g4 < 4; ++g4) {
            const int ai = g4 >> 1, mb = (g4 & 1) * 2;
            u32x4 gcv[2][2], gav[2][2];
#pragma unroll
            for (int mm = 0; mm < 2; ++mm)
#pragma unroll
                for (int bj = 0; bj < 2; ++bj) { const bf16_t* zr = Z + (size_t)(row0 + ai * 128 + (mb + mm) * 16) * INC + col0 + bj * 128; gcv[mm][bj] = *(const u32x4*)(zr + ZC_GC); gav[mm][bj] = *(const u32x4*)(zr + ZC_GA); }
#pragma unroll
            for (int mm = 0; mm < 2; ++mm)
#pragma unroll
                for (int bj = 0; bj < 2; ++bj) {
                    const u32x4 gc = gcv[mm][bj], ga = gav[mm][bj]; const int m = mb + mm;
                    f32x4 r0, r1;
                    r0[0] = bf_lo(gc.x) * __builtin_amdgcn_rcpf(fmaxf(bf_lo(ga.x), 1e-12f)); r0[1] = bf_hi(gc.x) * __builtin_amdgcn_rcpf(fmaxf(bf_hi(ga.x), 1e-12f));
                    r0[2] = bf_lo(gc.y) * __builtin_amdgcn_rcpf(fmaxf(bf_lo(ga.y), 1e-12f)); r0[3] = bf_hi(gc.y) * __builtin_amdgcn_rcpf(fmaxf(bf_hi(ga.y), 1e-12f));
                    r1[0] = bf_lo(gc.z) * __builtin_amdgcn_rcpf(fmaxf(bf_lo(ga.z), 1e-12f)); r1[1] = bf_hi(gc.z) * __builtin_amdgcn_rcpf(fmaxf(bf_hi(ga.z), 1e-12f));
                    r1[2] = bf_lo(gc.w) * __builtin_amdgcn_rcpf(fmaxf(bf_lo(ga.w), 1e-12f)); r1[3] = bf_hi(gc.w) * __builtin_amdgcn_rcpf(fmaxf(bf_hi(ga.w), 1e-12f));
                    acc[ai][bj][m][0] *= r0; acc[ai][bj][m][1] *= r1;
                }
        }
    }
    __device__ __forceinline__ void operator()(const f32x4 (&acc)[2][2][4][2], const pg8::Unit& u, int wr, int wc, int fr, int fq) const {
        const int row0 = u.pm * 256 + wr * 64 + fr, col0 = u.pn * 256 + wc * 32 + 8 * fq;
#pragma unroll
        for (int ai = 0; ai < 2; ++ai) {
            u32x4 gav[4][2];
#pragma unroll
            for (int m = 0; m < 4; ++m)
#pragma unroll
                for (int bj = 0; bj < 2; ++bj) gav[m][bj] = *(const u32x4*)(Z + (size_t)(row0 + ai * 128 + m * 16) * INC + ZC_GA + col0 + bj * 128);
#pragma unroll
            for (int m = 0; m < 4; ++m)
#pragma unroll
                for (int bj = 0; bj < 2; ++bj) {
                    const u32x4 ga = gav[m][bj];
                    f32x4 v0 = acc[ai][bj][m][0], v1 = acc[ai][bj][m][1];
                    v0[0] *= fmaxf(bf_lo(ga.x), 1e-12f); v0[1] *= fmaxf(bf_hi(ga.x), 1e-12f); v0[2] *= fmaxf(bf_lo(ga.y), 1e-12f); v0[3] *= fmaxf(bf_hi(ga.y), 1e-12f);
                    v1[0] *= fmaxf(bf_lo(ga.z), 1e-12f); v1[1] *= fmaxf(bf_hi(ga.z), 1e-12f); v1[2] *= fmaxf(bf_lo(ga.w), 1e-12f); v1[3] *= fmaxf(bf_hi(ga.w), 1e-12f);
                    u32x4 w; w.x = cvt_pk_bf16(v0[0], v0[1]); w.y = cvt_pk_bf16(v0[2], v0[3]); w.z = cvt_pk_bf16(v1[0], v1[1]); w.w = cvt_pk_bf16(v1[2], v1[3]);
                    *(u32x4*)(Z + (size_t)(row0 + ai * 128 + m * 16) * INC + ZC_MB + col0 + bj * 128) = w;
                }
        }
    }
    __device__ __forceinline__ void small(const f32x4 (&acc)[2][2][2], int row, int c0, int fr, int fq) const {
#pragma unroll
        for (int j = 0; j < 2; ++j) {
            const int c = c0 + 32 * j + 8 * fq;
            const u32x4 gc = *(const u32x4*)(Z + (size_t)row * INC + ZC_GC + c), ga = *(const u32x4*)(Z + (size_t)row * INC + ZC_GA + c);
            const f32x4 a0 = acc[0][j][0], a1 = acc[0][j][1], b0 = acc[1][j][0], b1 = acc[1][j][1];
            float m[8];
            m[0] = a0[0] * bf_lo(gc.x) + b0[0] * bf_lo(ga.x); m[1] = a0[1] * bf_hi(gc.x) + b0[1] * bf_hi(ga.x);
            m[2] = a0[2] * bf_lo(gc.y) + b0[2] * bf_lo(ga.y); m[3] = a0[3] * bf_hi(gc.y) + b0[3] * bf_hi(ga.y);
            m[4] = a1[0] * bf_lo(gc.z) + b1[0] * bf_lo(ga.z); m[5] = a1[1] * bf_hi(gc.z) + b1[1] * bf_hi(ga.z);
            m[6] = a1[2] * bf_lo(gc.w) + b1[2] * bf_lo(ga.w); m[7] = a1[3] * bf_hi(gc.w) + b1[3] * bf_hi(ga.w);
            u32x4 w; w.x = cvt_pk_bf16(m[0], m[1]); w.y = cvt_pk_bf16(m[2], m[3]); w.z = cvt_pk_bf16(m[4], m[5]); w.w = cvt_pk_bf16(m[6], m[7]);
            *(u32x4*)(Z + (size_t)row * INC + ZC_MB + c) = w;
        }
    }
};

template <int NSET, int NSTEP  , class Epi, bool UPMODE = false, int KSPLIT = 8  >
__device__ __forceinline__ void small_gemm(LAS unsigned char* lds, const bf16_t* A0, const bf16_t* A1, int lda, const bf16_t* W0, const bf16_t* W1, int ldb, int ncg, const Epi& E, int bx, int G, int wave, int lane) {
    constexpr int UPR = 8 / KSPLIT;
    const int fr = lane & 15, fq = lane >> 4, us = wave / KSPLIT, kp = wave % KSPLIT;
    LAS f32x4* part = (LAS f32x4*)lds;
#pragma unroll 1
    for (int u0 = bx * UPR; u0 < 8 * ncg; u0 += G * UPR) {
        const int u = u0 + us; const bool valid = (u < 8 * ncg);
        const int uc = valid ? u : 0;
        const int rb = uc & 7, cg = uc >> 3;
        const int row = MP + 16 * rb + fr;
        f32x4 acc[NSET][2][2];
#pragma unroll
        for (int st = 0; st < NSET; ++st) {
            const bf16_t* Ap = (st ? A1 : A0) + (size_t)row * lda + kp * (NSTEP * 32) + 8 * fq;
            const int cb0 = UPMODE ? 256 * (cg >> 2) + 32 * (cg & 3) : 64 * cg;
            const bf16_t* Wp = (st ? W1 : W0) + (size_t)(cb0 + 8 * (fr >> 2) + (fr & 3)) * ldb + kp * (NSTEP * 32) + 8 * fq;
#pragma unroll
            for (int j = 0; j < 2; ++j)
#pragma unroll
                for (int n = 0; n < 2; ++n) acc[st][j][n] = (f32x4){0.f, 0.f, 0.f, 0.f};
#pragma unroll
            for (int k0 = 0; k0 < NSTEP; k0 += 4) {
                constexpr int KBMAX = 4;
                bf16x8 av[KBMAX], bv[KBMAX][2][2];
#pragma unroll
                for (int kk = 0; kk < KBMAX; ++kk) if (k0 + kk < NSTEP) {
                    av[kk] = *(const bf16x8*)(Ap + 32 * (k0 + kk));
#pragma unroll
                    for (int j = 0; j < 2; ++j)
#pragma unroll
                        for (int n = 0; n < 2; ++n) bv[kk][j][n] = *(const bf16x8*)(Wp + (size_t)((UPMODE ? 128 : 32) * j + 4 * n) * ldb + 32 * (k0 + kk));
                }
                __builtin_amdgcn_sched_barrier(0);
#pragma unroll
                for (int kk = 0; kk < KBMAX; ++kk) if (k0 + kk < NSTEP) {
#pragma unroll
                    for (int j = 0; j < 2; ++j)
#pragma unroll
                        for (int n = 0; n < 2; ++n) acc[st][j][n] = __builtin_amdgcn_mfma_f32_16x16x32_bf16(bv[kk][j][n], av[kk], acc[st][j][n], 0, 0, 0);
                }
                __builtin_amdgcn_sched_barrier(0);
            }
        }
        if (kp != 0) {
#pragma unroll
            for (int st = 0; st < NSET; ++st)
#pragma unroll
                for (int j = 0; j < 2; ++j)
#pragma unroll
                    for (int n = 0; n < 2; ++n) part[((wave * NSET + st) * 4 + j * 2 + n) * 64 + lane] = acc[st][j][n];
        }
        __syncthreads();
        if (kp == 0 && valid) {
#pragma unroll
            for (int w = 1; w < KSPLIT; ++w)
#pragma unroll
                for (int st = 0; st < NSET; ++st)
#pragma unroll
                    for (int j = 0; j < 2; ++j)
#pragma unroll
                        for (int n = 0; n < 2; ++n) acc[st][j][n] += part[(((wave + w) * NSET + st) * 4 + j * 2 + n) * 64 + lane];
            E.small(acc, row, UPMODE ? 128 * (cg >> 2) + 32 * (cg & 3) : 64 * cg, fr, fq);
        }
        __syncthreads();
    }
}

struct TileD { const bf16_t* K; const bf16_t* V; int pitch; int nkeys; int delta0; };

__device__ __forceinline__ void attn_dma_v(const TileD& td, LAS unsigned char* vb, int lane) {
#pragma unroll
    for (int i = 0; i < 8; ++i) {
        const int row = 8 * i + (lane >> 3), chs = lane & 7, ch = chs ^ (((row >> 1) & 3) << 1);
        __builtin_amdgcn_global_load_lds((const unsigned*)(td.V + (size_t)row * td.pitch + ch * 8), (LAS unsigned*)(vb + i * 1024), 16, 0, 0);
    }
}
template <int NQB, class TF>
__device__ __forceinline__ void attn_wave(const bf16_t* Qp, bf16_t* Op, int qpitch, int opitch, int nt, const TF& tilef, LAS unsigned char* vbuf, const LAS float* rb, int lane) {
    const int fr = lane & 15, fq = lane >> 4;
    bf16x8 qf[NQB][2];
#pragma unroll
    for (int qb = 0; qb < NQB; ++qb)
#pragma unroll
        for (int dh = 0; dh < 2; ++dh) qf[qb][dh] = ldg16b(Qp + (size_t)(16 * qb + fr) * qpitch + dh * 32 + 8 * fq);
    f32x4 O[NQB][4]; float mrow[NQB], lrow[NQB];
#pragma unroll
    for (int qb = 0; qb < NQB; ++qb) { mrow[qb] = -1e30f; lrow[qb] = 0.f;
#pragma unroll
        for (int db = 0; db < 4; ++db) O[qb][db] = (f32x4){0.f, 0.f, 0.f, 0.f}; }
    const int qp = fr >> 2, pp = fr & 3, rowl = 4 * fq + qp, sw = ((rowl >> 1) & 3) << 1;
    const int vrow = rowl * 128 + (pp & 1) * 8, vch = (pp >> 1) ^ sw;
    bf16x8 kf[2][2];
    { const TileD td = tilef(0); attn_dma_v(td, vbuf, lane);
#pragma unroll
      for (int kb = 0; kb < 2; ++kb)
#pragma unroll
          for (int dh = 0; dh < 2; ++dh) kf[kb][dh] = ldg16b(td.K + (size_t)(16 * kb + fr) * td.pitch + dh * 32 + 8 * fq); }
    const int nht = 2 * nt;
#pragma unroll 1
    for (int ht = 0; ht < nht; ++ht) {
        const int t = ht >> 1, half = ht & 1;
        asm volatile("s_waitcnt vmcnt(0)" ::: "memory");
        const TileD td = tilef(t);
        if (half == 0 && t + 1 < nt) { const TileD tn = tilef(t + 1); attn_dma_v(tn, vbuf + ((t + 1) & 1) * 8192, lane); }
        f32x4 S[2][NQB];
#pragma unroll
        for (int kb = 0; kb < 2; ++kb)
#pragma unroll
            for (int qb = 0; qb < NQB; ++qb) {
                f32x4 s = __builtin_amdgcn_mfma_f32_16x16x32_bf16(kf[kb][0], qf[qb][0], (f32x4){0.f, 0.f, 0.f, 0.f}, 0, 0, 0);
                S[kb][qb] = __builtin_amdgcn_mfma_f32_16x16x32_bf16(kf[kb][1], qf[qb][1], s, 0, 0, 0);
            }
        if (ht + 1 < nht) {
            const TileD tk = tilef((ht + 1) >> 1); const int r0 = 32 * ((ht + 1) & 1);
#pragma unroll
            for (int kb = 0; kb < 2; ++kb)
#pragma unroll
                for (int dh = 0; dh < 2; ++dh) kf[kb][dh] = ldg16b(tk.K + (size_t)(r0 + 16 * kb + fr) * tk.pitch + dh * 32 + 8 * fq);
        }
        const int delta0 = td.delta0 - 32 * half, nkeys = td.nkeys - 32 * half;
        if (delta0 < 160) {
#pragma unroll
            for (int kb = 0; kb < 2; ++kb)
#pragma unroll
                for (int qb = 0; qb < NQB; ++qb)
#pragma unroll
                    for (int i = 0; i < 4; ++i) {
                        int d = delta0 + (16 * qb + fr) - (16 * kb + 4 * fq + i);
                        d = d < -128 ? -128 : (d > 128 ? 128 : d);
                        S[kb][qb][i] += rb[d + 128];
                    }
        }
        if (nkeys < 32) {
#pragma unroll
            for (int kb = 0; kb < 2; ++kb)
#pragma unroll
                for (int qb = 0; qb < NQB; ++qb)
#pragma unroll
                    for (int i = 0; i < 4; ++i) if (16 * kb + 4 * fq + i >= nkeys) S[kb][qb][i] = -INFINITY;
        }
        float mxq[NQB]; bool grow = false;
#pragma unroll
        for (int qb = 0; qb < NQB; ++qb) {
            float mx = fmaxf(fmaxf(fmaxf(S[0][qb][0], S[0][qb][1]), fmaxf(S[0][qb][2], S[0][qb][3])), fmaxf(fmaxf(S[1][qb][0], S[1][qb][1]), fmaxf(S[1][qb][2], S[1][qb][3])));
            mx = xmax_16_32(mx);
            mxq[qb] = mx; grow = grow || (mx > mrow[qb]);
        }
        if (__any(grow)) {
#pragma unroll
            for (int qb = 0; qb < NQB; ++qb) {
                const float mn = fmaxf(mrow[qb], mxq[qb]), alpha = __builtin_amdgcn_exp2f(mrow[qb] - mn);
                mrow[qb] = mn; lrow[qb] *= alpha;
#pragma unroll
                for (int db = 0; db < 4; ++db) O[qb][db] *= alpha;
            }
        }
        bf16x8 pf[NQB];
#pragma unroll
        for (int qb = 0; qb < NQB; ++qb) {
            const float mn = mrow[qb]; float ps = 0.f; float p[2][4];
#pragma unroll
            for (int kb = 0; kb < 2; ++kb)
#pragma unroll
                for (int i = 0; i < 4; ++i) { p[kb][i] = __builtin_amdgcn_exp2f(S[kb][qb][i] - mn); ps += p[kb][i]; }
            lrow[qb] += ps;
            u32x4 w; w.x = cvt_pk_bf16(p[0][0], p[0][1]); w.y = cvt_pk_bf16(p[0][2], p[0][3]); w.z = cvt_pk_bf16(p[1][0], p[1][1]); w.w = cvt_pk_bf16(p[1][2], p[1][3]);
            pf[qb] = __builtin_bit_cast(bf16x8, w);
        }
        const LAS unsigned char* vb = vbuf + (t & 1) * 8192 + half * 4096 + vrow;
#pragma unroll
        for (int db = 0; db < 4; ++db) {
            const int off = ((2 * db) ^ vch) << 4;
            const s16x4 lo = __builtin_amdgcn_ds_read_tr16_b64_v4i16((LAS s16x4*)(vb + off));
            const s16x4 hi = __builtin_amdgcn_ds_read_tr16_b64_v4i16((LAS s16x4*)(vb + off + 2048));
            const bf16x8 vf = (bf16x8){lo[0], lo[1], lo[2], lo[3], hi[0], hi[1], hi[2], hi[3]};
#pragma unroll
            for (int qb = 0; qb < NQB; ++qb) O[qb][db] = __builtin_amdgcn_mfma_f32_16x16x32_bf16(vf, pf[qb], O[qb][db], 0, 0, 0);
        }
    }
    asm volatile("s_waitcnt lgkmcnt(0)" ::: "memory");
#pragma unroll
    for (int qb = 0; qb < NQB; ++qb) {
        float l = xsum_16_32(lrow[qb]);
        const float inv = 1.0f / l;
#pragma unroll
        for (int db = 0; db < 4; ++db) {
            const f32x4 o = O[qb][db] * inv; u32x2 w; w.x = cvt_pk_bf16(o[0], o[1]); w.y = cvt_pk_bf16(o[2], o[3]);
            *(GAS u32x2*)(Op + (size_t)(16 * qb + fr) * opitch + 16 * db + 4 * fq) = w;
        }
    }
}


#define XB_TMO      128
#define XB_XCNT(j)  (256  + 64 * (j))
#define XB_XSUB(j)  (1280 + 64 * (j))
#define XB_XGEN(j)  (2304 + 64 * (j))
#define XB_TOP      3328
#define XB_TOPGEN   3392
#define XCD_BAR_WORDS 3456
#define XB_SPIN_CAP (1u << 20)
__device__ __forceinline__ unsigned xb_ld(unsigned* p)              { return __hip_atomic_load(p, __ATOMIC_RELAXED, __HIP_MEMORY_SCOPE_AGENT); }
__device__ __forceinline__ unsigned xb_add(unsigned* p, unsigned v) { return __hip_atomic_fetch_add(p, v, __ATOMIC_RELAXED, __HIP_MEMORY_SCOPE_AGENT); }
__device__ __forceinline__ unsigned xb_xcc_id() { return (unsigned)__builtin_amdgcn_s_getreg((3 << 11) | 20) & 0xFu; }
#define XB_SPIN(cond, bar) do { unsigned _sp = 0; while (cond) { __builtin_amdgcn_s_sleep(1); \
    if ((++_sp & 255u) == 0u) { if (xb_ld(&(bar)[XB_TMO])) break; if (_sp > XB_SPIN_CAP) { atomicAdd(&(bar)[XB_TMO], 1u); break; } } } } while (0)
struct XcdBarrier { unsigned* bar; unsigned x; volatile LAS unsigned* st; };
__device__ __forceinline__ XcdBarrier xcd_barrier_post(unsigned* bar, volatile LAS unsigned* st) {
    XcdBarrier b; b.bar = bar; b.x = xb_xcc_id(); b.st = st;
    if (threadIdx.x == 0) (void)xb_add(&bar[XB_XCNT(b.x)], 1u);
    return b;
}
__device__ __forceinline__ void xcd_barrier_complete(unsigned* bar, unsigned x, unsigned& nloc, unsigned& nx) {
    const unsigned G = gridDim.x * gridDim.y * gridDim.z;
    unsigned sum, cnt, mine, sp = 0u;
    for (;;) {
        sum = 0u; cnt = 0u; mine = 0u;
#pragma unroll
        for (unsigned j = 0; j < 16; ++j) { const unsigned c = xb_ld(&bar[XB_XCNT(j)]); sum += c; cnt += (c > 0u) ? 1u : 0u; mine = (j == x) ? c : mine; }
        if (sum == G) break;
        __builtin_amdgcn_s_sleep(1);
        if ((++sp & 255u) == 0u) { if (xb_ld(&bar[XB_TMO])) break; if (sp > XB_SPIN_CAP) { atomicAdd(&bar[XB_TMO], 1u); break; } }
    }
    nloc = mine > 0u ? mine : 1u; nx = cnt > 0u ? cnt : 1u;
}
__device__ __forceinline__ void xcd_barrier(const XcdBarrier& b) {
    asm volatile("s_waitcnt vmcnt(0)" ::: "memory");
    __syncthreads();
    if (threadIdx.x == 0) {
        unsigned* bar = b.bar;
        __builtin_amdgcn_s_waitcnt(0);
        unsigned nloc = b.st[0], nx = b.st[1];
        if (nloc == 0u) { xcd_barrier_complete(bar, b.x, nloc, nx); b.st[0] = nloc; b.st[1] = nx; }
        const unsigned old = xb_add(&bar[XB_XSUB(b.x)], 1u);
        const unsigned gen = old / nloc;
        if (old + 1u == (gen + 1u) * nloc) {
            __builtin_amdgcn_fence(__ATOMIC_RELEASE, "agent");
            asm volatile("s_waitcnt vmcnt(0)" ::: "memory");
            const unsigned og = xb_add(&bar[XB_TOP], 1u);
            const unsigned tg = og / nx;
            if (og + 1u == (tg + 1u) * nx) xb_add(&bar[XB_TOPGEN], 1u);
            else XB_SPIN(xb_ld(&bar[XB_TOPGEN]) == tg, bar);
            __builtin_amdgcn_fence(__ATOMIC_ACQUIRE, "agent");
            xb_add(&bar[XB_XGEN(b.x)], 1u);
            asm volatile("s_waitcnt vmcnt(0)" ::: "memory");
        } else {
            XB_SPIN(xb_ld(&bar[XB_XGEN(b.x)]) == gen, bar);
            __builtin_amdgcn_fence(__ATOMIC_ACQUIRE, "agent");
            asm volatile("s_waitcnt vmcnt(0)" ::: "memory");
        }
    }
    __syncthreads();
}

struct Args {
    const float* x_prompt; const float* x_sample; const float* cache_k; const float* cache_v; const float* state_conv;
    const float* norm_ffn1; const float* w_ffn1_gu; const float* w_ffn1_down; const float* norm_mix; const float* w_in; const float* b_gate; const float* w_conv;
    const float* rel_bias; const float* w_conv_out; const float* w_attn_out; const float* w_o; const float* norm_ffn2; const float* w_ffn2_gu; const float* w_ffn2_down; const float* norm_final;
    float* out; unsigned char* ws; int ph_lo, ph_hi;
};

__device__ __forceinline__ void transpose_item(const float* W, int N, const float* gain, bf16_t* WT, int dpitch, int dkoff, int mode, int kb, int nb, int scol0, LAS float* scr, int lane) {
    const int k0 = 64 * kb, n0 = 32 * nb, c = lane & 31;
    const int scol = (mode == 1) ? ((c < 16) ? 16 * nb + c : DFF + 16 * nb + (c - 16)) : scol0 + c;
    float wv[32];
#pragma unroll
    for (int i = 0; i < 32; ++i) wv[i] = __builtin_nontemporal_load(W + (size_t)(k0 + 2 * i + (lane >> 5)) * N + scol);
    if (gain) {
#pragma unroll
        for (int i = 0; i < 32; ++i) wv[i] *= gain[k0 + 2 * i + (lane >> 5)];
    }
#pragma unroll
    for (int i = 0; i < 32; ++i) scr[(2 * i + (lane >> 5)) * 33 + c] = wv[i];
    asm volatile("s_waitcnt lgkmcnt(0)" ::: "memory");
    const int c8 = lane & 7;
#pragma unroll
    for (int j = 0; j < 4; ++j) { const int n = (lane >> 3) + 8 * j; const LAS float* s = scr + (8 * c8) * 33 + n;
        u32x4 o; o.x = pk2(s[0 * 33], s[1 * 33]); o.y = pk2(s[2 * 33], s[3 * 33]); o.z = pk2(s[4 * 33], s[5 * 33]); o.w = pk2(s[6 * 33], s[7 * 33]);
        int drow;
        if (mode == 1) { const int jj = n & 15, isu = n >> 4; drow = n0 + 8 * (jj >> 2) + 4 * isu + (jj & 3); } else drow = n0 + n;
        *(u32x4*)(WT + (size_t)drow * dpitch + dkoff + k0 + 8 * c8) = o; }
    asm volatile("s_waitcnt lgkmcnt(0)" ::: "memory");
}

__device__ __forceinline__ float wave_sum(float v) {
#pragma unroll
    for (int o = 1; o < 64; o <<= 1) v += __shfl_xor(v, o);
    return v;
}

__global__ void __launch_bounds__(NWAVES * 64, 2) mega_fwd(Args a) {
    extern __shared__ __attribute__((aligned(16))) unsigned char lds_raw[];
    LAS unsigned char* lds = (LAS unsigned char*)lds_raw;
    cg::grid_group grid = cg::this_grid();
    typedef const __attribute__((address_space(4))) Args* ArgP;
    ArgP ap = (ArgP)__builtin_amdgcn_kernarg_segment_ptr();
    const int G = gridDim.x, bx = blockIdx.x;
    const int wave0 = __builtin_amdgcn_readfirstlane((int)threadIdx.x >> 6);
    unsigned* barw = (unsigned*)(ap->ws + WS_BAR);
    if (bx == 0) for (int i = threadIdx.x; i < 4096; i += NWAVES * 64) barw[i] = 0u;
    if (threadIdx.x < 16) ((LAS unsigned*)(lds + BARST_OFF))[threadIdx.x] = 0u;
    XcdBarrier xbar; xbar.bar = barw; xbar.x = 0; xbar.st = (volatile LAS unsigned*)(lds + BARST_OFF);
    bool xposted = false; unsigned wait_ticks = 0; (void)wait_ticks;
    const int lo = ap->ph_lo, hi = ap->ph_hi;
#define PHASE_VARS \
    asm volatile("" : "+s"(ap)); \
    int lane_ = (int)__builtin_amdgcn_mbcnt_hi(~0u, __builtin_amdgcn_mbcnt_lo(~0u, 0u)); asm volatile("" : "+v"(lane_)); \
    int wave_ = wave0; asm volatile("" : "+s"(wave_)); \
    const int lane = lane_, wave = wave_, tid = wave * 64 + lane; \
    const int vcu = (G % 8 == 0) ? (bx % 8) * (G / 8) + bx / 8 : bx; \
    const int gw = vcu * NWAVES + wave, NGW = G * NWAVES; \
    const int gt = gw * 64 + lane, NGT = NGW * 64; \
    unsigned char* ws = ap->ws; \
    bf16_t* WT = (bf16_t*)(ws + ((l & 1) ? WS_WT2 : WS_WT)); bf16_t* WTN = (bf16_t*)(ws + ((l & 1) ? WS_WT : WS_WT2)); bf16_t* XB = (bf16_t*)(ws + WS_XB); float* SSQ = (float*)(ws + WS_SSQ); \
    bf16_t* CK = (bf16_t*)(ws + ((l & 1) ? WS_CK2 : WS_CK)); bf16_t* CV = (bf16_t*)(ws + ((l & 1) ? WS_CV2 : WS_CV)); \
    bf16_t* CKN = (bf16_t*)(ws + ((l & 1) ? WS_CK : WS_CK2)); bf16_t* CVN = (bf16_t*)(ws + ((l & 1) ? WS_CV : WS_CV2)); bf16_t* Z = (bf16_t*)(ws + WS_Z); bf16_t* HB = Z; \
    float* X = ap->out; \
    (void)WTN; (void)CKN; (void)CVN; (void)tid; (void)lane; (void)wave; (void)gw; (void)NGW; (void)gt; (void)NGT; (void)WT; (void)XB; (void)SSQ; (void)CK; (void)CV; (void)Z; (void)HB; (void)X;
#define IN(k) (lo <= (k) && (k) < hi)
#define GSYNC() do { unsigned long long t0_ = 0; if (PROBE_WAIT) t0_ = __builtin_amdgcn_s_memrealtime(); if (!xposted) { grid.sync(); xbar = xcd_barrier_post(barw, (volatile LAS unsigned*)(lds + BARST_OFF)); xposted = true; } else xcd_barrier(xbar); if (PROBE_WAIT) wait_ticks += (unsigned)(__builtin_amdgcn_s_memrealtime() - t0_); } while (0)
#define SEAM(k) do { if (IN(k) && IN((k) + 1)) { const unsigned w0_ = wait_ticks; GSYNC(); if (PROBE_WAIT >= 100 && ((k) % 9) != PROBE_WAIT - 100) wait_ticks = w0_; if (PROBE_REP == 9) GSYNC(); } } while (0)
#define REPS(k) for (int rep = (PROBE_REP == (k)) ? 0 : 1; rep < 2; ++rep)
#define REPSYNC() do { if (rep == 0) GSYNC(); } while (0)

#define CONVERT_LAYER(LC, WTD, CKD, CVD) do { \
            LAS float* scr = (LAS float*)(lds + wave * 16384); \
            constexpr int I_GU = 16 * 176, I_D = 44 * 32, I_IN = 16 * 160, I_C = 8 * 32, I_O = 16 * 32; \
            constexpr int NITEMS = 2 * I_GU + 2 * I_D + I_IN + 2 * I_C + I_O; \
            for (int it = gw; it < NITEMS; it += NGW) { \
                int r = it; \
                if (r < I_GU) { transpose_item(ap->w_ffn1_gu + (size_t)(LC) * DM * 2 * DFF, 2 * DFF, ap->norm_ffn1 + (LC) * DM, (WTD) + W_GU1, DM, 0, 0, r / 176, r % 176, (((r % 176) >> 2) & 1) * DFF + 128 * ((r % 176) >> 3) + 32 * ((r % 176) & 3), scr, lane); continue; } r -= I_GU; \
                if (r < I_GU) { transpose_item(ap->w_ffn2_gu + (size_t)(LC) * DM * 2 * DFF, 2 * DFF, ap->norm_ffn2 + (LC) * DM, (WTD) + W_GU2, DM, 0, 0, r / 176, r % 176, (((r % 176) >> 2) & 1) * DFF + 128 * ((r % 176) >> 3) + 32 * ((r % 176) & 3), scr, lane); continue; } r -= I_GU; \
                if (r < I_D) { transpose_item(ap->w_ffn1_down + (size_t)(LC) * DFF * DM, DM, nullptr, (WTD) + W_D1, DFF, 0, 0, r / 32, r % 32, 32 * (r % 32), scr, lane); continue; } r -= I_D; \
                if (r < I_D) { transpose_item(ap->w_ffn2_down + (size_t)(LC) * DFF * DM, DM, nullptr, (WTD) + W_D2, DFF, 0, 0, r / 32, r % 32, 32 * (r % 32), scr, lane); continue; } r -= I_D; \
                if (r < I_IN) { const int nb = r % 160, kb = r / 160, blk = nb >> 4; \
                    const int ob = (blk == 1) ? 3 : (blk == 2) ? 1 : (blk == 3) ? 2 : blk; \
                    transpose_item(ap->w_in + (size_t)(LC) * DM * INC, INC, ap->norm_mix + (LC) * DM, (WTD) + W_IN, DM, 0, 0, kb, nb, ob * 512 + 32 * (nb & 15), scr, lane); continue; } r -= I_IN; \
                if (r < I_C) { transpose_item(ap->w_conv_out + (size_t)(LC) * 512 * DM, DM, nullptr, (WTD) + W_CAT, DM, 0, 0, r / 32, r % 32, 32 * (r % 32), scr, lane); continue; } r -= I_C; \
                if (r < I_C) { transpose_item(ap->w_attn_out + (size_t)(LC) * 512 * DM, DM, nullptr, (WTD) + W_CAT, DM, 512, 0, r / 32, r % 32, 32 * (r % 32), scr, lane); continue; } r -= I_C; \
                transpose_item(ap->w_o + (size_t)(LC) * DM * DM, DM, nullptr, (WTD) + W_O, DM, 0, 0, r / 32, r % 32, 32 * (r % 32), scr, lane); \
            } \
 \
            for (int i0 = gt; i0 < 2 * (NBATCH * 512 * 512 / 8); i0 += 2 * NGT) {   \
                constexpr int NG_ = 2 * (NBATCH * 512 * 512 / 8); \
                const int i1 = i0 + NGT; const bool h1 = i1 < NG_; const int i1c = h1 ? i1 : i0; \
                const int wa = i0 / (NG_ / 2), ea = (i0 % (NG_ / 2)) * 8, wb = i1c / (NG_ / 2), eb = (i1c % (NG_ / 2)) * 8; \
                const float* sa = (wa ? ap->cache_v : ap->cache_k) + (size_t)(LC) * NBATCH * 512 * 512 + ea; \
                const float* sb = (wb ? ap->cache_v : ap->cache_k) + (size_t)(LC) * NBATCH * 512 * 512 + eb; \
                const f32x4 a0 = __builtin_nontemporal_load((const f32x4*)sa), a1 = __builtin_nontemporal_load((const f32x4*)(sa + 4)); \
                const f32x4 b0 = __builtin_nontemporal_load((const f32x4*)sb), b1 = __builtin_nontemporal_load((const f32x4*)(sb + 4)); \
                u32x4 w; w.x = pk2(a0[0], a0[1]); w.y = pk2(a0[2], a0[3]); w.z = pk2(a1[0], a1[1]); w.w = pk2(a1[2], a1[3]); \
                *(u32x4*)((wa ? (CVD) : (CKD)) + ea) = w; \
                if (h1) { u32x4 x; x.x = pk2(b0[0], b0[1]); x.y = pk2(b0[2], b0[3]); x.z = pk2(b1[0], b1[1]); x.w = pk2(b1[2], b1[3]); *(u32x4*)((wb ? (CVD) : (CKD)) + eb) = x; } \
            } \
} while (0)

#pragma unroll 1
    for (int l = 0; l < DEPTH; ++l) {
        const int pb = 9 * l;
        if (l == 0 && IN(pb + 0)) REPS(0) { PHASE_VARS
            CONVERT_LAYER(0, WT, CK, CV);
            if (l == 0) {
                for (int m0 = gw * 4; m0 < MPAD; m0 += NGW * 4) {
                    f32x4 v[4][4];
#pragma unroll
                    for (int r = 0; r < 4; ++r) { const int m = m0 + r;
                        const float* src = (m < MP) ? ap->x_prompt + (size_t)m * DM : ap->x_sample + (size_t)((m < MR ? m : MR - 1) - MP) * DM;
#pragma unroll
                        for (int j = 0; j < 4; ++j) v[r][j] = __builtin_nontemporal_load((const f32x4*)(src + 256 * j + 4 * lane)); }
#pragma unroll
                    for (int r = 0; r < 4; ++r) { const int m = m0 + r;
                        bf16_t* xb = XB + (size_t)m * DM; float* sq = SSQ + (size_t)m * 16;
                        if (m < MR) {
                            float s = 0.f;
#pragma unroll
                            for (int j = 0; j < 4; ++j) { const f32x4 x = v[r][j]; u32x2 w; w.x = pk2(x[0], x[1]); w.y = pk2(x[2], x[3]); *(u32x2*)(xb + 256 * j + 4 * lane) = w; s += (x[0] * x[0] + x[1] * x[1]) + (x[2] * x[2] + x[3] * x[3]); }
                            s = wave_sum(s);
                            if (lane < 16) sq[lane] = (lane == 0) ? s : 0.f;
                        } else {
#pragma unroll
                            for (int j = 0; j < 4; ++j) *(u32x2*)(xb + 256 * j + 4 * lane) = (u32x2){0u, 0u};
                            if (lane < 16) sq[lane] = 0.f;
                        }
                    }
                }
            }
        REPSYNC(); }
        if (l == 0) SEAM(pb + 0);
        if (IN(pb + 1)) REPS(1) { PHASE_VARS
            pg8::Gemm g{XB, WT + W_GU1, DM, DM, DM, 0, 0}; pg8::StaticOrder S; S.init(NTM, 2 * DFF / 256, G, bx, 1);
            EpiUp E{HB, SSQ};
            small_gemm<1, 16, EpiUp, true, 2>(lds, XB, XB, DM, WT + W_GU1, WT + W_GU1, DM, 2 * DFF / 64, E, bx, G, wave, lane);
            pg8::gemm_phase<EpiUp>(lds, g, S, E, tid);
        REPSYNC(); }
        SEAM(pb + 1);
        if (IN(pb + 2)) REPS(2) { PHASE_VARS
            pg8::Gemm g{HB, WT + W_D1, DFF, DFF, DFF, 0, 0}; pg8::StaticOrder S; S.init(NTM, DM / 256, G, bx, 1);
            EpiRes E{XB, SSQ, rep ? 0.5f : 0.0f};
            small_gemm<1, 11, EpiRes>(lds, HB, HB, DFF, WT + W_D1, WT + W_D1, DFF, DM / 64, E, bx, G, wave, lane);
            pg8::gemm_phase<EpiRes>(lds, g, S, E, tid);
        REPSYNC(); }
        SEAM(pb + 2);
        if (IN(pb + 3)) REPS(3) { PHASE_VARS
            pg8::Gemm g{XB, WT + W_IN, DM, DM, DM, 0, 0}; pg8::StaticOrder S; S.init(NTM, INC / 256, G, bx, 1);
            EpiIn E{Z, SSQ, ap->b_gate + (size_t)l * 2 * DM, ap->out + O_KP + (size_t)l * NBATCH * 512 * 512, ap->out + O_VP + (size_t)l * NBATCH * 512 * 512,
                    ap->out + O_KS + (size_t)l * MS * 512, ap->out + O_VS + (size_t)l * MS * 512};
            small_gemm<1, 16, EpiIn, false, 2>(lds, XB, XB, DM, WT + W_IN, WT + W_IN, DM, INC / 64, E, bx, G, wave, lane);
            pg8::gemm_phase<EpiIn>(lds, g, S, E, tid);
        REPSYNC(); }
        SEAM(pb + 3);
        if (IN(pb + 4)) REPS(4) { PHASE_VARS
            LAS float* rbl = (LAS float*)(lds + RB_OFF);
            for (int i = tid; i < NH * NREL; i += NWAVES * 64) { const int h = i / NREL, j = i - h * NREL; rbl[h * 264 + j] = (ap->rel_bias[(size_t)l * NH * NREL + i] - ap->rel_bias[(size_t)l * NH * NREL + h * NREL + 256]) * LOG2E; }
            __syncthreads();
            LAS unsigned char* vbuf = lds + wave * 16384;
#pragma unroll 1
            for (int u = gw; u < 4096; u += NGW) {
                const int c = u & 63, h = (u >> 6) & 7, b = u >> 9;
                const int jlo = (c > 8) ? c - 8 : 0;
                const bf16_t* base = Z + (size_t)(b * SEQ) * INC + h * 64;
                auto tf = [&](int j) { TileD td; const size_t ro = (size_t)(64 * (jlo + j)) * INC; td.K = base + ro + ZC_K; td.V = base + ro + ZC_V; td.pitch = INC; td.nkeys = 64; td.delta0 = 64 * (c - jlo - j); return td; };
                bf16_t* qp = Z + (size_t)(b * SEQ + 64 * c) * INC + ZC_Q + h * 64;
                bf16_t* op = rep ? qp : XB + (size_t)(b * SEQ + 64 * c) * DM + h * 64;
                attn_wave<4>(qp, op, INC, rep ? INC : DM, c - jlo + 1, tf, vbuf, rbl + h * 264, lane);
            }
            { int l2 = lane; asm volatile("" : "+v"(l2)); asm volatile("" : "+s"(Z), "+s"(CK), "+s"(CV));
#pragma unroll 1
            for (int us = ((gw & 63) < 2) ? ((gw >> 6) * 2 + (gw & 63)) : 64; us < 64; us += 64) {
                const int h = us & 7, b = us >> 3;
                const bf16_t* zrow = Z + (size_t)(MP + 16 * b) * INC + h * 64;
                auto tf = [&](int j) { TileD td;
                    if (j < 8) { const size_t ro = (size_t)(b * 512 + 64 * j) * 512 + h * 64; td.K = CK + ro; td.V = CV + ro; td.pitch = 512; td.nkeys = 64; td.delta0 = 512 - 64 * j; }
                    else { td.K = zrow + ZC_K; td.V = zrow + ZC_V; td.pitch = INC; td.nkeys = 16; td.delta0 = 0; }
                    return td; };
                bf16_t* qp = Z + (size_t)(MP + 16 * b) * INC + ZC_Q + h * 64;
                bf16_t* op = rep ? qp : XB + (size_t)(16 * b) * DM + h * 64;
                attn_wave<1>(qp, op, INC, rep ? INC : DM, 9, tf, vbuf, rbl + h * 264, l2);
            } }
            for (int cu = (NGW - 1 - gw); cu < MR / 16; cu += NGW) {
                const int row0 = cu * 16, ch = 8 * lane;
                const bool samp = (row0 >= MP);
                const int bb = samp ? (row0 - MP) / 16 : (row0 >> 12), t0 = samp ? 0 : (row0 & 4095);
                float w0[8], w1[8], w2[8], um2[8], um1[8];
                { const float* wc = ap->w_conv + (size_t)l * 3 * 512 + ch;
#pragma unroll
                  for (int i = 0; i < 8; ++i) { w0[i] = wc[i]; w1[i] = wc[512 + i]; w2[i] = wc[1024 + i]; } }
                if (samp) { const float* sc = ap->state_conv + ((size_t)(l * NBATCH + bb) * 2) * 512 + ch;
#pragma unroll
                    for (int i = 0; i < 8; ++i) { um2[i] = sc[i]; um1[i] = sc[512 + i]; }
                } else if (t0 == 0) {
#pragma unroll
                    for (int i = 0; i < 8; ++i) { um2[i] = 0.f; um1[i] = 0.f; }
                } else {
                    const bf16_t* z2 = Z + (size_t)(row0 - 2) * INC + ch; const bf16_t* z1 = Z + (size_t)(row0 - 1) * INC + ch;
                    const u32x4 c2 = ldg16(z2 + ZC_CC), v2 = ldg16(z2 + ZC_CV), c1 = ldg16(z1 + ZC_CC), v1 = ldg16(z1 + ZC_CV);
#pragma unroll
                    for (int i = 0; i < 4; ++i) { um2[2 * i] = bf_lo(c2[i]) * bf_lo(v2[i]); um2[2 * i + 1] = bf_hi(c2[i]) * bf_hi(v2[i]); um1[2 * i] = bf_lo(c1[i]) * bf_lo(v1[i]); um1[2 * i + 1] = bf_hi(c1[i]) * bf_hi(v1[i]); }
                }
#pragma unroll
                for (int rb8 = 0; rb8 < 2; ++rb8) {
                    u32x4 cbv[8], ccv[8], cvv[8];
#pragma unroll
                    for (int r = 0; r < 8; ++r) { const bf16_t* zr = Z + (size_t)(row0 + rb8 * 8 + r) * INC + ch; cbv[r] = ldg16(zr + ZC_CB); ccv[r] = ldg16(zr + ZC_CC); cvv[r] = ldg16(zr + ZC_CV); }
#pragma unroll
                    for (int r = 0; r < 8; ++r) {
                        bf16_t* zr = Z + (size_t)(row0 + rb8 * 8 + r) * INC + ch;
                        const u32x4 cbw = cbv[r], ccw = ccv[r], cvw = cvv[r];
                        float y[8];
#pragma unroll
                        for (int i = 0; i < 4; ++i) {
                            const float u0 = bf_lo(ccw[i]) * bf_lo(cvw[i]), u1 = bf_hi(ccw[i]) * bf_hi(cvw[i]);
                            y[2 * i] = bf_lo(cbw[i]) * (w0[2 * i] * um2[2 * i] + w1[2 * i] * um1[2 * i] + w2[2 * i] * u0);
                            y[2 * i + 1] = bf_hi(cbw[i]) * (w0[2 * i + 1] * um2[2 * i + 1] + w1[2 * i + 1] * um1[2 * i + 1] + w2[2 * i + 1] * u1);
                            um2[2 * i] = um1[2 * i]; um1[2 * i] = u0; um2[2 * i + 1] = um1[2 * i + 1]; um1[2 * i + 1] = u1;
                        }
                        u32x4 w; w.x = cvt_pk_bf16(y[0], y[1]); w.y = cvt_pk_bf16(y[2], y[3]); w.z = cvt_pk_bf16(y[4], y[5]); w.w = cvt_pk_bf16(y[6], y[7]);
                        stg16(rep ? zr + ZC_CB : XB + (size_t)(row0 + rb8 * 8 + r) * DM + 512 + ch, w);
                    }
                }
                if (samp || t0 == SEQ - 16) {
                    float* dst = ap->out + (samp ? O_CS : O_CP) + ((size_t)(l * NBATCH + bb) * 2) * 512 + ch;
                    *(f32x4*)dst = (f32x4){um2[0], um2[1], um2[2], um2[3]}; *(f32x4*)(dst + 4) = (f32x4){um2[4], um2[5], um2[6], um2[7]};
                    *(f32x4*)(dst + 512) = (f32x4){um1[0], um1[1], um1[2], um1[3]}; *(f32x4*)(dst + 516) = (f32x4){um1[4], um1[5], um1[6], um1[7]};
                }
            }
            if (rep && l + 1 < DEPTH) { asm volatile("s_waitcnt vmcnt(0) lgkmcnt(0)" ::: "memory"); asm volatile("" : "+s"(ap)); CONVERT_LAYER(l + 1, WTN, CKN, CVN); }
            asm volatile("s_waitcnt vmcnt(0) lgkmcnt(0)" ::: "memory");
            __syncthreads();
        REPSYNC(); }
        SEAM(pb + 4);
        if (IN(pb + 5)) REPS(5) { PHASE_VARS
            pg8::Gemm g{Z, WT + W_CAT, INC, DM, DM, 0, 0}; pg8::StaticOrder S; S.init(NTM, DM / 256, G, bx, 1);
            EpiMix E{Z};
            small_gemm<2, 2, EpiMix>(lds, Z + ZC_CB, Z + ZC_Q, INC, WT + W_CAT, WT + W_CAT + 512, DM, DM / 64, E, bx, G, wave, lane);
            pg8::gemm_phase<EpiMix, true>(lds, g, S, E, tid);
        REPSYNC(); }
        SEAM(pb + 5);
        if (IN(pb + 6)) REPS(6) { PHASE_VARS
            pg8::Gemm g{Z + ZC_MB, WT + W_O, INC, DM, DM, 0, 0}; pg8::StaticOrder S; S.init(NTM, DM / 256, G, bx, 1);
            EpiRes E{XB, SSQ, rep ? 1.0f : 0.0f};
            small_gemm<1, 4, EpiRes>(lds, Z + ZC_MB, Z + ZC_MB, INC, WT + W_O, WT + W_O, DM, DM / 64, E, bx, G, wave, lane);
            pg8::gemm_phase<EpiRes>(lds, g, S, E, tid);
        REPSYNC(); }
        SEAM(pb + 6);
        if (IN(pb + 7)) REPS(7) { PHASE_VARS
            pg8::Gemm g{XB, WT + W_GU2, DM, DM, DM, 0, 0}; pg8::StaticOrder S; S.init(NTM, 2 * DFF / 256, G, bx, 1);
            EpiUp E{HB, SSQ};
            small_gemm<1, 16, EpiUp, true, 2>(lds, XB, XB, DM, WT + W_GU2, WT + W_GU2, DM, 2 * DFF / 64, E, bx, G, wave, lane);
            pg8::gemm_phase<EpiUp>(lds, g, S, E, tid);
        REPSYNC(); }
        SEAM(pb + 7);
        if (IN(pb + 8)) REPS(8) { PHASE_VARS
            pg8::Gemm g{HB, WT + W_D2, DFF, DFF, DFF, 0, 0}; pg8::StaticOrder S; S.init(NTM, DM / 256, G, bx, 1);
            EpiRes E{XB, SSQ, rep ? 0.5f : 0.0f};
            small_gemm<1, 11, EpiRes>(lds, HB, HB, DFF, WT + W_D2, WT + W_D2, DFF, DM / 64, E, bx, G, wave, lane);
            pg8::gemm_phase<EpiRes>(lds, g, S, E, tid);
        REPSYNC(); }
        SEAM(pb + 8);
    }
    if (IN(36)) { const int l = 0; PHASE_VARS
        f32x4 gn[4];
#pragma unroll
        for (int j = 0; j < 4; ++j) gn[j] = *(const f32x4*)(ap->norm_final + 256 * j + 4 * lane);
        for (int m0 = gw * 4; m0 < MR; m0 += NGW * 4) {
            u32x2 o[4][4]; float sv[4];
#pragma unroll
            for (int r = 0; r < 4; ++r) { const bf16_t* xb = XB + (size_t)(m0 + r) * DM; sv[r] = (lane < 16) ? SSQ[(size_t)(m0 + r) * 16 + lane] : 0.f;
#pragma unroll
                for (int j = 0; j < 4; ++j) o[r][j] = *(const u32x2*)(xb + 256 * j + 4 * lane); }
#pragma unroll
            for (int r = 0; r < 4; ++r) { float* yr = X + (size_t)(m0 + r) * DM;
                const float rs = __builtin_amdgcn_rsqf(wave_sum(sv[r]) * (1.0f / 1024.0f) + EPS);
#pragma unroll
                for (int j = 0; j < 4; ++j) { const f32x4 x = (f32x4){bf_lo(o[r][j].x), bf_hi(o[r][j].x), bf_lo(o[r][j].y), bf_hi(o[r][j].y)}; __builtin_nontemporal_store(x * rs * gn[j], (f32x4*)(yr + 256 * j + 4 * lane)); } }
        }
    }
    if (PROBE_WAIT) {
        unsigned* acc_w = barw + 3500;
        if (threadIdx.x == 0) atomicAdd(acc_w, wait_ticks);
        GSYNC();
        if (threadIdx.x == 0) { const unsigned avg = __hip_atomic_load(acc_w, __ATOMIC_RELAXED, __HIP_MEMORY_SCOPE_AGENT) / gridDim.x;
            const unsigned long long t0 = __builtin_amdgcn_s_memrealtime(); while (__builtin_amdgcn_s_memrealtime() - t0 < 8ull * avg) __builtin_amdgcn_s_sleep(8); }
        __syncthreads();
    }
#undef IN
#undef SEAM
}

extern "C" void kernel_launch(void* const* d_in, const int* in_sizes, int n_in, void* d_out, int out_size, void* d_ws, size_t ws_size, hipStream_t stream) {
    static int grid = 0;
    if (grid == 0) {
        if (n_in != 20 || (size_t)out_size != O_END || ws_size < WS_END) { fprintf(stderr, "kernel_launch: unexpected shapes: n_in %d out %d (want %zu) ws %zu (need %zu)\n", n_in, out_size, (size_t)O_END, ws_size, (size_t)WS_END); grid = -1; return; }
        int dev = 0, cus = 0, per_cu = 0;
        hipGetDevice(&dev); hipDeviceGetAttribute(&cus, hipDeviceAttributeMultiprocessorCount, dev);
        if (hipFuncSetAttribute((const void*)mega_fwd, hipFuncAttributeMaxDynamicSharedMemorySize, LDS_BYTES) != hipSuccess) { fprintf(stderr, "kernel_launch: hipFuncSetAttribute failed\n"); grid = -1; return; }
        if (hipOccupancyMaxActiveBlocksPerMultiprocessor(&per_cu, (const void*)mega_fwd, NWAVES * 64, LDS_BYTES) != hipSuccess || per_cu < 1) { fprintf(stderr, "kernel_launch: occupancy query says %d\n", per_cu); per_cu = 1; }
        (void)hipGetLastError();
        grid = cus;
    }
    if (grid < 0) return;
    Args a{};
    const float** ap = (const float**)&a;
    for (int i = 0; i < 20; ++i) ap[i] = (const float*)d_in[i];
    a.out = (float*)d_out; a.ws = (unsigned char*)d_ws; a.ph_lo = 0; a.ph_hi = 37;
    void* args[] = {&a};
    hipError_t e = hipLaunchCooperativeKernel((const void*)mega_fwd, dim3(grid), dim3(NWAVES * 64), args, LDS_BYTES, stream);
    if (e != hipSuccess) fprintf(stderr, "kernel_launch: cooperative launch failed: %s (grid %d)\n", hipGetErrorString(e), grid);
}
```

```cpp
#include <hip/hip_runtime.h>
#include <hip/hip_cooperative_groups.h>
#include <cstdio>
#include <cstdint>
namespace cg = cooperative_groups;
#ifndef PROBE_REP
#define PROBE_REP (-1)
#endif
#ifndef PROBE_EPI
#define PROBE_EPI 0
#endif
#ifndef PROBE_WAIT
#define PROBE_WAIT 0
#endif

#define LAS __attribute__((address_space(3)))
typedef unsigned short bf16_t;
typedef short bf16x8 __attribute__((ext_vector_type(8)));
typedef short s16x4 __attribute__((ext_vector_type(4)));
typedef float f32x4 __attribute__((ext_vector_type(4)));
typedef unsigned u32x4 __attribute__((ext_vector_type(4)));
typedef unsigned u32x2 __attribute__((ext_vector_type(2)));

constexpr int DM = 1024, NBATCH = 8, SEQ = 4096, DEPTH = 4, DSEQ = 16;
constexpr int NH = 8, DFF = 2816, INC = 5120, NREL = 257;
constexpr int MP = NBATCH * SEQ;
constexpr int MS = NBATCH * DSEQ;
constexpr int MR = MP + MS;
constexpr int MPAD = 33024;
constexpr int NTM = MP / 256;
constexpr float EPS = 1e-6f;
constexpr float LOG2E = 1.4426950408889634f;
constexpr float QSCALE = 0.125f * LOG2E;
constexpr int ZC_CB = 0, ZC_Q = 512, ZC_CC = 1024, ZC_CV = 1536, ZC_K = 2048, ZC_V = 2560, ZC_GC = 3072, ZC_GA = 4096, ZC_MB = 1024;

constexpr size_t O_Y = 0;
constexpr size_t O_KP = (size_t)MR * DM;
constexpr size_t O_VP = O_KP + (size_t)DEPTH * NBATCH * 512 * 512;
constexpr size_t O_CP = O_VP + (size_t)DEPTH * NBATCH * 512 * 512;
constexpr size_t O_KS = O_CP + (size_t)DEPTH * NBATCH * 2 * 512;
constexpr size_t O_VS = O_KS + (size_t)DEPTH * NBATCH * DSEQ * 512;
constexpr size_t O_CS = O_VS + (size_t)DEPTH * NBATCH * DSEQ * 512;
constexpr size_t O_END = O_CS + (size_t)DEPTH * NBATCH * 2 * 512;

constexpr size_t W_GU1 = 0;
constexpr size_t W_D1 = W_GU1 + (size_t)2 * DFF * DM;
constexpr size_t W_IN = W_D1 + (size_t)DM * DFF;
constexpr size_t W_CAT = W_IN + (size_t)INC * DM;
constexpr size_t W_O = W_CAT + (size_t)DM * DM;
constexpr size_t W_GU2 = W_O + (size_t)DM * DM;
constexpr size_t W_D2 = W_GU2 + (size_t)2 * DFF * DM;
constexpr size_t W_TOTAL = W_D2 + (size_t)DM * DFF;

constexpr size_t WS_WT = 0;
constexpr size_t WS_XB = WS_WT + ((W_TOTAL * 2 + 4095) / 4096) * 4096;
constexpr size_t WS_SSQ = WS_XB + (size_t)MPAD * DM * 2;
constexpr size_t WS_CK = WS_SSQ + (size_t)MPAD * 16 * 4;
constexpr size_t WS_CV = WS_CK + (size_t)NBATCH * 512 * 512 * 2;
constexpr size_t WS_Z = WS_CV + (size_t)NBATCH * 512 * 512 * 2;
constexpr size_t WS_WT2 = WS_Z + (size_t)MPAD * INC * 2;
constexpr size_t WS_BAR = WS_WT2 + ((W_TOTAL * 2 + 4095) / 4096) * 4096;
constexpr size_t WS_CK2 = WS_BAR + 16384;
constexpr size_t WS_CV2 = WS_CK2 + (size_t)NBATCH * 512 * 512 * 2;
constexpr size_t WS_END = WS_CV2 + (size_t)NBATCH * 512 * 512 * 2;

constexpr int NWAVES = 8;
constexpr int RING_BYTES = 131072;
constexpr int RB_OFF = RING_BYTES + 1024;
constexpr int LDS_BYTES = 147456;
constexpr int BARST_OFF = LDS_BYTES - 64;

__device__ __forceinline__ unsigned cvt_pk_bf16(float lo, float hi) { unsigned r; asm volatile("v_cvt_pk_bf16_f32 %0, %1, %2" : "=v"(r) : "v"(lo), "v"(hi)); return r; }
__device__ __forceinline__ float bf_lo(unsigned w) { return __uint_as_float(w << 16); }
__device__ __forceinline__ float bf_hi(unsigned w) { return __uint_as_float(w & 0xffff0000u); }
__device__ __forceinline__ unsigned f2bf(float f) { unsigned u = __float_as_uint(f); return (u + 0x7fffu + ((u >> 16) & 1u)) >> 16; }
__device__ __forceinline__ unsigned pk2(float lo, float hi) { return f2bf(lo) | (f2bf(hi) << 16); }
#define GAS __attribute__((address_space(1)))
__device__ __forceinline__ u32x4 ldg16(const void* p) { return *(const GAS u32x4*)p; }
__device__ __forceinline__ bf16x8 ldg16b(const void* p) { return *(const GAS bf16x8*)p; }
__device__ __forceinline__ void stg16(void* p, u32x4 v) { *(GAS u32x4*)p = v; }
__device__ __forceinline__ float xsum_16_32(float s) {
    auto r = __builtin_amdgcn_permlane16_swap(__float_as_uint(s), __float_as_uint(s), false, false);
    s = __uint_as_float(r[0]) + __uint_as_float(r[1]);
    auto q = __builtin_amdgcn_permlane32_swap(__float_as_uint(s), __float_as_uint(s), false, false);
    return __uint_as_float(q[0]) + __uint_as_float(q[1]);
}
__device__ __forceinline__ float xmax_16_32(float s) {
    auto r = __builtin_amdgcn_permlane16_swap(__float_as_uint(s), __float_as_uint(s), false, false);
    s = fmaxf(__uint_as_float(r[0]), __uint_as_float(r[1]));
    auto q = __builtin_amdgcn_permlane32_swap(__float_as_uint(s), __float_as_uint(s), false, false);
    return fmaxf(__uint_as_float(q[0]), __uint_as_float(q[1]));
}
__device__ __forceinline__ float fast_sigmoid(float x) { return __builtin_amdgcn_rcpf(1.0f + __builtin_amdgcn_exp2f(-x * LOG2E)); }

namespace pg8 {
constexpr int BM = 256, BK = 64, HALF = 128, HTB = HALF * BK * 2, STAGE_BYTES = 8 * HTB, NXCD = 8, WGM = 8;
__host__ __device__ __forceinline__ int lds_byte(int r, int c) { const int st = (r >> 4) * 2 + (c >> 5), rr = r & 15, cc = c & 31, ob = rr * 64 + cc * 2; return st * 1024 + (ob ^ (((ob >> 9) & 1) << 5)); }
__host__ __device__ __forceinline__ void stage_rc(int b, int& R, int& C) { const int st = b / 1024, sb = b % 1024, swz = sb ^ (((sb >> 9) & 1) << 5); R = (st >> 1) * 16 + swz / 64; C = (st & 1) * 32 + (swz % 64) / 2; }
__host__ __device__ __forceinline__ int perm32(int rho) { const int n = rho >> 4, i = rho & 15; return 8 * (i >> 2) + 4 * n + (i & 3); }

struct Unit { int pm, pn, z; };
struct Gemm { const bf16_t* A; const bf16_t* Bt; int lda, ldb, K; long zA, zB; };

struct StaticOrder {
    int nM, nN, nwg, G, c, nz;
    __device__ void init(int nM_, int nN_, int G_, int c_, int nz_) { nM = nM_; nN = nN_; nwg = nM * nN; G = G_; c = c_; nz = nz_; }
    __device__ bool next(int i, Unit& u) const {
        const int it = i / nz; u.z = i - it * nz;
        const long L = (long)it * G + c; if (L >= nwg) return false;
        int wgid = (int)L; { const int q = nwg / NXCD, r = nwg % NXCD, xcd = wgid % NXCD, off = wgid / NXCD; wgid = (xcd < r ? xcd * (q + 1) : r * (q + 1) + (xcd - r) * q) + off; }
        const int nig = WGM * nN, gid = wgid / nig, fm = gid * WGM, gsz = (nM - fm) < WGM ? (nM - fm) : WGM;
        u.pm = fm + ((wgid % nig) % gsz); u.pn = (wgid % nig) / gsz; return true;
    }
};

template <class Epi, bool MIDHOOK = false>
__device__ __forceinline__ void gemm_phase(LAS unsigned char* lds, const Gemm g, const StaticOrder& S, const Epi& E, const int tid) {
    const int wid = __builtin_amdgcn_readfirstlane(tid >> 6), lane = tid & 63, wr = wid >> 2, wc = wid & 3, fr = lane & 15, fq = lane >> 4;
    const int K = g.K, nt = K / BK;
    unsigned voffA[2], voffB[2];
#pragma unroll
    for (int i = 0; i < 2; ++i) { int R, C; stage_rc(tid * 16 + i * 8192, R, C); const int Rb = (R & ~31) + perm32(R & 31);
        voffA[i] = (unsigned)(R * g.lda + C) * 2u; voffB[i] = (unsigned)(Rb * g.ldb + C) * 2u; }
    const size_t kstep = (size_t)(BK * 2);
    const size_t hstepA = (size_t)HALF * g.lda * 2, hstepB = (size_t)HALF * g.ldb * 2;
    const size_t tstepA = 2 * hstepA, tstepB = 2 * hstepB;
    const unsigned ldsw = (unsigned)wid * 1024u;
    const int aoff = lds_byte(wr * 64 + fr, fq * 8), boff = lds_byte(wc * 32 + fr, fq * 8);
#define PG8_SA(b, h) (((b) * 2 + (h)) * HTB)
#define PG8_SB(b, h) ((4 + (b) * 2 + (h)) * HTB)
#define PG8_STAGE(bufoff, gbase, voff) do { _Pragma("unroll") for (int _i = 0; _i < 2; ++_i) \
        __builtin_amdgcn_global_load_lds((const unsigned*)((const char*)(gbase) + (voff)[_i]), (LAS unsigned*)(lds + (bufoff) + ldsw + _i * 8192), 16, 0, 0); } while (0)
#define PG8_LDA(dst, b, h) do { _Pragma("unroll") for (int m = 0; m < 4; ++m) _Pragma("unroll") for (int k = 0; k < 2; ++k) dst[m][k] = *(const LAS bf16x8*)(lds + PG8_SA(b, h) + aoff + m * 2048 + k * 1024); } while (0)
#define PG8_LDB(dst, b, h) do { _Pragma("unroll") for (int n = 0; n < 2; ++n) _Pragma("unroll") for (int k = 0; k < 2; ++k) dst[n][k] = *(const LAS bf16x8*)(lds + PG8_SB(b, h) + boff + n * 2048 + k * 1024); } while (0)
#define PG8_MMA(ai, bj, At, Bt) do { __builtin_amdgcn_s_setprio(1); _Pragma("unroll") for (int m = 0; m < 4; ++m) _Pragma("unroll") for (int n = 0; n < 2; ++n) _Pragma("unroll") for (int k = 0; k < 2; ++k) \
        acc[ai][bj][m][n] = __builtin_amdgcn_mfma_f32_16x16x32_bf16(Bt[n][k], At[m][k], acc[ai][bj][m][n], 0, 0, 0); __builtin_amdgcn_s_setprio(0); } while (0)
#define PG8_WAIT_V(n) asm volatile("s_waitcnt vmcnt(" #n ")" ::: "memory")
#define PG8_WAIT_L(n) asm volatile("s_waitcnt lgkmcnt(" #n ")" ::: "memory")
#define PG8_BAR __builtin_amdgcn_s_barrier()
#define PG8_SCHED __builtin_amdgcn_sched_barrier(0)
    Unit cur, nxt; int ui = 0;
    if (!S.next(0, cur)) return;
    f32x4 acc[2][2][4][2];
#pragma unroll
    for (int a = 0; a < 2; ++a)
#pragma unroll
        for (int b = 0; b < 2; ++b)
#pragma unroll
            for (int m = 0; m < 4; ++m)
#pragma unroll
                for (int n = 0; n < 2; ++n) acc[a][b][m][n] = (f32x4){0.f, 0.f, 0.f, 0.f};
    bf16x8 At[4][2], B0[2][2], B1[2][2];
    const char* cA = (const char*)g.A + (size_t)cur.pm * tstepA + (size_t)cur.z * g.zA; const char* cB = (const char*)g.Bt + (size_t)cur.pn * tstepB + (size_t)cur.z * g.zB;
    PG8_STAGE(PG8_SB(0, 0), cB, voffB); PG8_STAGE(PG8_SB(0, 1), cB + hstepB, voffB); PG8_STAGE(PG8_SA(0, 0), cA, voffA); PG8_STAGE(PG8_SA(0, 1), cA + hstepA, voffA);
    if (wr == 1) PG8_BAR;
    PG8_WAIT_V(2); PG8_BAR;
    PG8_STAGE(PG8_SB(1, 0), cB + kstep, voffB); PG8_STAGE(PG8_SA(1, 0), cA + kstep, voffA); PG8_STAGE(PG8_SB(1, 1), cB + hstepB + kstep, voffB);
    PG8_WAIT_V(6); PG8_BAR;
    for (;;) {
        const bool has_next = S.next(ui + 1, nxt);
        const char* nA = has_next ? (const char*)g.A + (size_t)nxt.pm * tstepA + (size_t)nxt.z * g.zA : cA; const char* nB = has_next ? (const char*)g.Bt + (size_t)nxt.pn * tstepB + (size_t)nxt.z * g.zB : cB;
        for (int t = 0; t < nt; t += 2) {
            if constexpr (MIDHOOK) { if (t == nt / 2) E.mid(acc, cur, wr, wc, fr, fq); }
            const bool last = (t == nt - 2);
            const char* a1 = cA + (size_t)(t + 1) * kstep;
            const char* a2 = last ? nA : cA + (size_t)(t + 2) * kstep; const char* b2 = last ? nB : cB + (size_t)(t + 2) * kstep;
            const char* a3 = a2 + kstep; const char* b3 = b2 + kstep;
            PG8_LDB(B0, 0, 0); PG8_LDB(B1, 0, 1); PG8_SCHED; PG8_LDA(At, 0, 0); PG8_STAGE(PG8_SA(1, 1), a1 + hstepA, voffA);
            PG8_WAIT_V(8); PG8_WAIT_L(0); PG8_BAR; PG8_MMA(0, 0, At, B0); PG8_MMA(0, 1, At, B1); PG8_BAR; PG8_SCHED;
            PG8_LDA(At, 0, 1); PG8_STAGE(PG8_SB(0, 0), b2, voffB); PG8_STAGE(PG8_SB(0, 1), b2 + hstepB, voffB); PG8_STAGE(PG8_SA(0, 0), a2, voffA);
            PG8_WAIT_V(8); PG8_WAIT_L(0); PG8_BAR; PG8_MMA(1, 0, At, B0); PG8_MMA(1, 1, At, B1); PG8_BAR; PG8_SCHED;
            PG8_LDB(B0, 1, 0); PG8_LDB(B1, 1, 1); PG8_SCHED; PG8_LDA(At, 1, 0); PG8_STAGE(PG8_SA(0, 1), a2 + hstepA, voffA);
            PG8_WAIT_V(8); PG8_WAIT_L(0); PG8_BAR; PG8_MMA(0, 0, At, B0); PG8_MMA(0, 1, At, B1); PG8_BAR; PG8_SCHED;
            PG8_LDA(At, 1, 1); PG8_STAGE(PG8_SB(1, 0), b3, voffB); PG8_STAGE(PG8_SB(1, 1), b3 + hstepB, voffB); PG8_STAGE(PG8_SA(1, 0), a3, voffA);
            PG8_WAIT_V(8); PG8_WAIT_L(0); PG8_BAR; PG8_MMA(1, 0, At, B0); PG8_MMA(1, 1, At, B1); PG8_BAR; PG8_SCHED;
        }
        if (wr == 0) PG8_BAR;
        E(acc, cur, wr, wc, fr, fq);
        if (PROBE_EPI == Epi::PROBE_ID) { const Epi E2 = E.probe_copy(); E2(acc, cur, wr, wc, fr, fq); }
        if (!has_next) break;
#pragma unroll
        for (int a = 0; a < 2; ++a)
#pragma unroll
            for (int b = 0; b < 2; ++b)
#pragma unroll
                for (int m = 0; m < 4; ++m)
#pragma unroll
                    for (int n = 0; n < 2; ++n) acc[a][b][m][n] = (f32x4){0.f, 0.f, 0.f, 0.f};
        cur = nxt; cA = nA; cB = nB; ++ui;
        if (wr == 1) PG8_BAR;
    }
    PG8_WAIT_V(0);
    PG8_BAR;
#undef PG8_SA
#undef PG8_SB
#undef PG8_STAGE
#undef PG8_LDA
#undef PG8_LDB
#undef PG8_MMA
#undef PG8_WAIT_V
#undef PG8_WAIT_L
#undef PG8_BAR
#undef PG8_SCHED
}
}

__device__ __forceinline__ float row_rs(const float* ssq, int row, int fq) {
    const f32x4 v = *(const f32x4*)(ssq + (size_t)row * 16 + 4 * fq);
    float s = (v[0] + v[1]) + (v[2] + v[3]);
    s = xsum_16_32(s);
    return __builtin_amdgcn_rsqf(s * (1.0f / 1024.0f) + EPS);
}

__device__ __forceinline__ void row_rs8(const float* ssq, int row0, int fq, float (&rsv)[2][4]) {
    f32x4 sv[2][4];
#pragma unroll
    for (int ai = 0; ai < 2; ++ai)
#pragma unroll
        for (int m = 0; m < 4; ++m) sv[ai][m] = *(const f32x4*)(ssq + (size_t)(row0 + ai * 128 + m * 16) * 16 + 4 * fq);
#pragma unroll
    for (int ai = 0; ai < 2; ++ai)
#pragma unroll
        for (int m = 0; m < 4; ++m) {
            float s = (sv[ai][m][0] + sv[ai][m][1]) + (sv[ai][m][2] + sv[ai][m][3]);
            s = xsum_16_32(s);
            rsv[ai][m] = __builtin_amdgcn_rsqf(s * (1.0f / 1024.0f) + EPS);
        }
}

struct EpiUp {
    static constexpr int PROBE_ID = 1; __device__ __forceinline__ EpiUp probe_copy() const { return *this; }
    bf16_t* H; const float* ssq;
    __device__ __forceinline__ void operator()(const f32x4 (&acc)[2][2][4][2], const pg8::Unit& u, int wr, int wc, int fr, int fq) const {
        const int row0 = u.pm * 256 + wr * 64 + fr, hc0 = u.pn * 128 + wc * 32 + 8 * fq;
        float rsv[2][4]; row_rs8(ssq, row0, fq, rsv);
#pragma unroll
        for (int ai = 0; ai < 2; ++ai)
#pragma unroll
            for (int m = 0; m < 4; ++m) {
                const int row = row0 + ai * 128 + m * 16; const float rs = rsv[ai][m];
                float h[8];
#pragma unroll
                for (int n = 0; n < 2; ++n) {
                    const f32x4 gg = acc[ai][0][m][n] * rs, uu = acc[ai][1][m][n] * rs;
#pragma unroll
                    for (int i = 0; i < 4; ++i) h[4 * n + i] = gg[i] * fast_sigmoid(gg[i]) * uu[i];
                }
                u32x4 w; w.x = cvt_pk_bf16(h[0], h[1]); w.y = cvt_pk_bf16(h[2], h[3]); w.z = cvt_pk_bf16(h[4], h[5]); w.w = cvt_pk_bf16(h[6], h[7]);
                *(u32x4*)(H + (size_t)row * DFF + hc0) = w;
            }
    }
    __device__ __forceinline__ void small(const f32x4 (&acc)[1][2][2], int row, int h0, int fr, int fq) const {
        const float rs = row_rs(ssq, row, fq); float h[8];
#pragma unroll
        for (int n = 0; n < 2; ++n) {
            const f32x4 gg = acc[0][0][n] * rs, uu = acc[0][1][n] * rs;
#pragma unroll
            for (int i = 0; i < 4; ++i) h[4 * n + i] = gg[i] * fast_sigmoid(gg[i]) * uu[i];
        }
        u32x4 w; w.x = cvt_pk_bf16(h[0], h[1]); w.y = cvt_pk_bf16(h[2], h[3]); w.z = cvt_pk_bf16(h[4], h[5]); w.w = cvt_pk_bf16(h[6], h[7]);
        *(u32x4*)(H + (size_t)row * DFF + h0 + 8 * fq) = w;
    }
};

struct EpiRes {
    static constexpr int PROBE_ID = 2; __device__ __forceinline__ EpiRes probe_copy() const { EpiRes e = *this; e.scale = 0.f; return e; }
    bf16_t* XB; float* ssq; float scale;
    __device__ __forceinline__ void operator()(const f32x4 (&acc)[2][2][4][2], const pg8::Unit& u, int wr, int wc, int fr, int fq) const {
        const int row0 = u.pm * 256 + wr * 64 + fr, col0 = u.pn * 256 + wc * 32 + 8 * fq;
#pragma unroll
        for (int ai = 0; ai < 2; ++ai) {
            u32x4 xw[4][2];
#pragma unroll
            for (int m = 0; m < 4; ++m)
#pragma unroll
                for (int bj = 0; bj < 2; ++bj) xw[m][bj] = *(const u32x4*)(XB + (size_t)(row0 + ai * 128 + m * 16) * DM + col0 + bj * 128);
#pragma unroll
            for (int m = 0; m < 4; ++m) {
                const int row = row0 + ai * 128 + m * 16; float s = 0.f;
#pragma unroll
                for (int bj = 0; bj < 2; ++bj) {
                    const u32x4 o = xw[m][bj];
                    f32x4 x0 = (f32x4){bf_lo(o.x), bf_hi(o.x), bf_lo(o.y), bf_hi(o.y)}, x1 = (f32x4){bf_lo(o.z), bf_hi(o.z), bf_lo(o.w), bf_hi(o.w)};
                    x0 += acc[ai][bj][m][0] * scale; x1 += acc[ai][bj][m][1] * scale;
                    u32x4 w; w.x = cvt_pk_bf16(x0[0], x0[1]); w.y = cvt_pk_bf16(x0[2], x0[3]); w.z = cvt_pk_bf16(x1[0], x1[1]); w.w = cvt_pk_bf16(x1[2], x1[3]);
                    *(u32x4*)(XB + (size_t)row * DM + col0 + bj * 128) = w;
                    s += (x0[0] * x0[0] + x0[1] * x0[1]) + (x0[2] * x0[2] + x0[3] * x0[3]) + (x1[0] * x1[0] + x1[1] * x1[1]) + (x1[2] * x1[2] + x1[3] * x1[3]);
                }
                s = xsum_16_32(s);
                if (fq == 0) ssq[(size_t)row * 16 + u.pn * 4 + wc] = s;
            }
        }
    }
    __device__ __forceinline__ void small(const f32x4 (&acc)[1][2][2], int row, int c0, int fr, int fq) const {
        float s = 0.f;
#pragma unroll
        for (int j = 0; j < 2; ++j) {
            bf16_t* xp = XB + (size_t)row * DM + c0 + 32 * j + 8 * fq;
            const u32x4 o = *(const u32x4*)xp;
            f32x4 x0 = (f32x4){bf_lo(o.x), bf_hi(o.x), bf_lo(o.y), bf_hi(o.y)}, x1 = (f32x4){bf_lo(o.z), bf_hi(o.z), bf_lo(o.w), bf_hi(o.w)};
            x0 += acc[0][j][0] * scale; x1 += acc[0][j][1] * scale;
            u32x4 w; w.x = cvt_pk_bf16(x0[0], x0[1]); w.y = cvt_pk_bf16(x0[2], x0[3]); w.z = cvt_pk_bf16(x1[0], x1[1]); w.w = cvt_pk_bf16(x1[2], x1[3]);
            *(u32x4*)xp = w;
            s += (x0[0] * x0[0] + x0[1] * x0[1]) + (x0[2] * x0[2] + x0[3] * x0[3]) + (x1[0] * x1[0] + x1[1] * x1[1]) + (x1[2] * x1[2] + x1[3] * x1[3]);
        }
        s = xsum_16_32(s);
        if (fq == 0) ssq[(size_t)row * 16 + (c0 >> 6)] = s;
    }
};

struct EpiIn {
    static constexpr int PROBE_ID = 3; __device__ __forceinline__ EpiIn probe_copy() const { return *this; }
    bf16_t* Z; const float* ssq; const float* bgate; float* okp; float* ovp; float* oks; float* ovs;
    __device__ __forceinline__ void operator()(const f32x4 (&acc)[2][2][4][2], const pg8::Unit& u, int wr, int wc, int fr, int fq) const {
        const int row0 = u.pm * 256 + wr * 64 + fr, col0 = u.pn * 256 + wc * 32 + 8 * fq;
        const int pn = u.pn;
        const bool isq = (pn == 2 || pn == 3), iskv = (pn >= 8 && pn < 12), isg = (pn >= 12);
        const bool kvp = iskv && ((u.pm & 15) >= 14);
        f32x4 bg[2][2];
#pragma unroll
        for (int bj = 0; bj < 2; ++bj) { if (isg) { bg[bj][0] = *(const f32x4*)(bgate + col0 - ZC_GC + bj * 128); bg[bj][1] = *(const f32x4*)(bgate + col0 - ZC_GC + bj * 128 + 4); } else { bg[bj][0] = (f32x4){0.f, 0.f, 0.f, 0.f}; bg[bj][1] = bg[bj][0]; } }
        float rsv[2][4]; row_rs8(ssq, row0, fq, rsv);
#pragma unroll
        for (int ai = 0; ai < 2; ++ai)
#pragma unroll
            for (int m = 0; m < 4; ++m) {
                const int row = row0 + ai * 128 + m * 16; float rs = rsv[ai][m];
                if (isq) rs *= QSCALE;
#pragma unroll
                for (int bj = 0; bj < 2; ++bj) {
                    f32x4 v0 = acc[ai][bj][m][0] * rs, v1 = acc[ai][bj][m][1] * rs;
                    const int c = col0 + bj * 128;
                    if (isg) {
                        v0 += bg[bj][0]; v1 += bg[bj][1];
#pragma unroll
                        for (int i = 0; i < 4; ++i) { v0[i] = fast_sigmoid(v0[i]); v1[i] = fast_sigmoid(v1[i]); }
                    }
                    u32x4 w; w.x = cvt_pk_bf16(v0[0], v0[1]); w.y = cvt_pk_bf16(v0[2], v0[3]); w.z = cvt_pk_bf16(v1[0], v1[1]); w.w = cvt_pk_bf16(v1[2], v1[3]);
                    *(u32x4*)(Z + (size_t)row * INC + c) = w;
                    if (kvp) {
                        const int b = row >> 12, t = row & 4095;
                        float* dst = ((pn < 10) ? okp : ovp) + ((size_t)(b * 512 + (t - 3584)) * 512 + (c - ((pn < 10) ? ZC_K : ZC_V)));
                        __builtin_nontemporal_store(v0, (f32x4*)dst); __builtin_nontemporal_store(v1, (f32x4*)(dst + 4));
                    }
                }
            }
    }
    __device__ __forceinline__ void small(const f32x4 (&acc)[1][2][2], int row, int c0, int fr, int fq) const {
        const int pn = c0 >> 8;
        const bool isq = (pn == 2 || pn == 3), iskv = (pn >= 8 && pn < 12), isg = (pn >= 12);
        float rs = row_rs(ssq, row, fq);
        if (isq) rs *= QSCALE;
#pragma unroll
        for (int j = 0; j < 2; ++j) {
            f32x4 v0 = acc[0][j][0] * rs, v1 = acc[0][j][1] * rs;
            const int c = c0 + 32 * j + 8 * fq;
            if (isg) {
                v0 += *(const f32x4*)(bgate + c - ZC_GC); v1 += *(const f32x4*)(bgate + c - ZC_GC + 4);
#pragma unroll
                for (int i = 0; i < 4; ++i) { v0[i] = fast_sigmoid(v0[i]); v1[i] = fast_sigmoid(v1[i]); }
            }
            u32x4 w; w.x = cvt_pk_bf16(v0[0], v0[1]); w.y = cvt_pk_bf16(v0[2], v0[3]); w.z = cvt_pk_bf16(v1[0], v1[1]); w.w = cvt_pk_bf16(v1[2], v1[3]);
            *(u32x4*)(Z + (size_t)row * INC + c) = w;
            if (iskv) {
                float* dst = ((pn < 10) ? oks : ovs) + ((size_t)(row - MP) * 512 + (c - ((pn < 10) ? ZC_K : ZC_V)));
                __builtin_nontemporal_store(v0, (f32x4*)dst); __builtin_nontemporal_store(v1, (f32x4*)(dst + 4));
            }
        }
    }
};

struct EpiMix {
    static constexpr int PROBE_ID = 4; __device__ __forceinline__ EpiMix probe_copy() const { return *this; }
    bf16_t* Z;
    __device__ __forceinline__ void mid(f32x4 (&acc)[2][2][4][2], const pg8::Unit& u, int wr, int wc, int fr, int fq) const {
        int row0 = u.pm * 256 + wr * 64 + fr, col0 = u.pn * 256 + wc * 32 + 8 * fq;
        asm volatile("" : "+v"(row0), "+v"(col0));
#pragma unroll
        for (int g4 = 0; g4 < 4; ++g4) {
            const int ai = g4 >> 1, mb = (g4 & 1) * 2;
            u32x4 gcv[2][2], gav[2][2];
#pragma unroll
            for (int mm = 0; mm < 2; ++mm)
#pragma unroll
                for (int bj = 0; bj < 2; ++bj) { const bf16_t* zr = Z + (size_t)(row0 + ai * 128 + (mb + mm) * 16) * INC + col0 + bj * 128; gcv[mm][bj] = *(const u32x4*)(zr + ZC_GC); gav[mm][bj] = *(const u32x4*)(zr + ZC_GA); }
#pragma unroll
            for (int mm = 0; mm < 2; ++mm)
#pragma unroll
                for (int bj = 0; bj < 2; ++bj) {
                    const u32x4 gc = gcv[mm][bj], ga = gav[mm][bj]; const int m = mb + mm;
                    f32x4 r0, r1;
                    r0[0] = bf_lo(gc.x) * __builtin_amdgcn_rcpf(fmaxf(bf_lo(ga.x), 1e-12f)); r0[1] = bf_hi(gc.x) * __builtin_amdgcn_rcpf(fmaxf(bf_hi(ga.x), 1e-12f));
                    r0[2] = bf_lo(gc.y) * __builtin_amdgcn_rcpf(fmaxf(bf_lo(ga.y), 1e-12f)); r0[3] = bf_hi(gc.y) * __builtin_amdgcn_rcpf(fmaxf(bf_hi(ga.y), 1e-12f));
                    r1[0] = bf_lo(gc.z) * __builtin_amdgcn_rcpf(fmaxf(bf_lo(ga.z), 1e-12f)); r1[1] = bf_hi(gc.z) * __builtin_amdgcn_rcpf(fmaxf(bf_hi(ga.z), 1e-12f));
                    r1[2] = bf_lo(gc.w) * __builtin_amdgcn_rcpf(fmaxf(bf_lo(ga.w), 1e-12f)); r1[3] = bf_hi(gc.w) * __builtin_amdgcn_rcpf(fmaxf(bf_hi(ga.w), 1e-12f));
                    acc[ai][bj][m][0] *= r0; acc[ai][bj][m][1] *= r1;
                }
        }
    }
    __device__ __forceinline__ void operator()(const f32x4 (&acc)[2][2][4][2], const pg8::Unit& u, int wr, int wc, int fr, int fq) const {
        const int row0 = u.pm * 256 + wr * 64 + fr, col0 = u.pn * 256 + wc * 32 + 8 * fq;
#pragma unroll
        for (int ai = 0; ai < 2; ++ai) {
            u32x4 gav[4][2];
#pragma unroll
            for (int m = 0; m < 4; ++m)
#pragma unroll
                for (int bj = 0; bj < 2; ++bj) gav[m][bj] = *(const u32x4*)(Z + (size_t)(row0 + ai * 128 + m * 16) * INC + ZC_GA + col0 + bj * 128);
#pragma unroll
            for (int m = 0; m < 4; ++m)
#pragma unroll
                for (int bj = 0; bj < 2; ++bj) {
                    const u32x4 ga = gav[m][bj];
                    f32x4 v0 = acc[ai][bj][m][0], v1 = acc[ai][bj][m][1];
                    v0[0] *= fmaxf(bf_lo(ga.x), 1e-12f); v0[1] *= fmaxf(bf_hi(ga.x), 1e-12f); v0[2] *= fmaxf(bf_lo(ga.y), 1e-12f); v0[3] *= fmaxf(bf_hi(ga.y), 1e-12f);
                    v1[0] *= fmaxf(bf_lo(ga.z), 1e-12f); v1[1] *= fmaxf(bf_hi(ga.z), 1e-12f); v1[2] *= fmaxf(bf_lo(ga.w), 1e-12f); v1[3] *= fmaxf(bf_hi(ga.w), 1e-12f);
                    u32x4 w; w.x = cvt_pk_bf16(v0[0], v0[1]); w.y = cvt_pk_bf16(v0[2], v0[3]); w.z = cvt_pk_bf16(v1[0], v1[1]); w.w = cvt_pk_bf16(v1[2], v1[3]);
                    *(u32x4*)(Z + (size_t)(row0 + ai * 128 + m * 16) * INC + ZC_MB + col0 + bj * 128) = w;
                }
        }
    }
    __device__ __forceinline__ void small(const f32x4 (&acc)[2][2][2], int row, int c0, int fr, int fq) const {
#pragma unroll
        for (int j = 0; j < 2; ++j) {
            const int c = c0 + 32 * j + 8 * fq;
            const u32x4 gc = *(const u32x4*)(Z + (size_t)row * INC + ZC_GC + c), ga = *(const u32x4*)(Z + (size_t)row * INC + ZC_GA + c);
            const f32x4 a0 = acc[0][j][0], a1 = acc[0][j][1], b0 = acc[1][j][0], b1 = acc[1][j][1];
            float m[8];
            m[0] = a0[0] * bf_lo(gc.x) + b0[0] * bf_lo(ga.x); m[1] = a0[1] * bf_hi(gc.x) + b0[1] * bf_hi(ga.x);
            m[2] = a0[2] * bf_lo(gc.y) + b0[2] * bf_lo(ga.y); m[3] = a0[3] * bf_hi(gc.y) + b0[3] * bf_hi(ga.y);
            m[4] = a1[0] * bf_lo(gc.z) + b1[0] * bf_lo(ga.z); m[5] = a1[1] * bf_hi(gc.z) + b1[1] * bf_hi(ga.z);
            m[6] = a1[2] * bf_lo(gc.w) + b1[2] * bf_lo(ga.w); m[7] = a1[3] * bf_hi(gc.w) + b1[3] * bf_hi(ga.w);
            u32x4 w; w.x = cvt_pk_bf16(m[0], m[1]); w.y = cvt_pk_bf16(m[2], m[3]); w.z = cvt_pk_bf16(m[4], m[5]); w.w = cvt_pk_bf16(m[6], m[7]);
            *(u32x4*)(Z + (size_t)row * INC + ZC_MB + c) = w;
        }
    }
};

template <int NSET, int NSTEP  , class Epi, bool UPMODE = false, int KSPLIT = 8  >
__device__ __forceinline__ void small_gemm(LAS unsigned char* lds, const bf16_t* A0, const bf16_t* A1, int lda, const bf16_t* W0, const bf16_t* W1, int ldb, int ncg, const Epi& E, int bx, int G, int wave, int lane) {
    constexpr int UPR = 8 / KSPLIT;
    const int fr = lane & 15, fq = lane >> 4, us = wave / KSPLIT, kp = wave % KSPLIT;
    LAS f32x4* part = (LAS f32x4*)lds;
#pragma unroll 1
    for (int u0 = bx * UPR; u0 < 8 * ncg; u0 += G * UPR) {
        const int u = u0 + us; const bool valid = (u < 8 * ncg);
        const int uc = valid ? u : 0;
        const int rb = uc & 7, cg = uc >> 3;
        const int row = MP + 16 * rb + fr;
        f32x4 acc[NSET][2][2];
#pragma unroll
        for (int st = 0; st < NSET; ++st) {
            const bf16_t* Ap = (st ? A1 : A0) + (size_t)row * lda + kp * (NSTEP * 32) + 8 * fq;
            const int cb0 = UPMODE ? 256 * (cg >> 2) + 32 * (cg & 3) : 64 * cg;
            const bf16_t* Wp = (st ? W1 : W0) + (size_t)(cb0 + 8 * (fr >> 2) + (fr & 3)) * ldb + kp * (NSTEP * 32) + 8 * fq;
#pragma unroll
            for (int j = 0; j < 2; ++j)
#pragma unroll
                for (int n = 0; n < 2; ++n) acc[st][j][n] = (f32x4){0.f, 0.f, 0.f, 0.f};
#pragma unroll
            for (int k0 = 0; k0 < NSTEP; k0 += 4) {
                constexpr int KBMAX = 4;
                bf16x8 av[KBMAX], bv[KBMAX][2][2];
#pragma unroll
                for (int kk = 0; kk < KBMAX; ++kk) if (k0 + kk < NSTEP) {
                    av[kk] = *(const bf16x8*)(Ap + 32 * (k0 + kk));
#pragma unroll
                    for (int j = 0; j < 2; ++j)
#pragma unroll
                        for (int n = 0; n < 2; ++n) bv[kk][j][n] = *(const bf16x8*)(Wp + (size_t)((UPMODE ? 128 : 32) * j + 4 * n) * ldb + 32 * (k0 + kk));
                }
                __builtin_amdgcn_sched_barrier(0);
#pragma unroll
                for (int kk = 0; kk < KBMAX; ++kk) if (k0 + kk < NSTEP) {
#pragma unroll
                    for (int j = 0; j < 2; ++j)
#pragma unroll
                        for (int n = 0; n < 2; ++n) acc[st][j][n] = __builtin_amdgcn_mfma_f32_16x16x32_bf16(bv[kk][j][n], av[kk], acc[st][j][n], 0, 0, 0);
                }
                __builtin_amdgcn_sched_barrier(0);
            }
        }
        if (kp != 0) {
#pragma unroll
            for (int st = 0; st < NSET; ++st)
#pragma unroll
                for (int j = 0; j < 2; ++j)
#pragma unroll
                    for (int n = 0; n < 2; ++n) part[((wave * NSET + st) * 4 + j * 2 + n) * 64 + lane] = acc[st][j][n];
        }
        __syncthreads();
        if (kp == 0 && valid) {
#pragma unroll
            for (int w = 1; w < KSPLIT; ++w)
#pragma unroll
                for (int st = 0; st < NSET; ++st)
#pragma unroll
                    for (int j = 0; j < 2; ++j)
#pragma unroll
                        for (int n = 0; n < 2; ++n) acc[st][j][n] += part[(((wave + w) * NSET + st) * 4 + j * 2 + n) * 64 + lane];
            E.small(acc, row, UPMODE ? 128 * (cg >> 2) + 32 * (cg & 3) : 64 * cg, fr, fq);
        }
        __syncthreads();
    }
}

struct TileD { const bf16_t* K; const bf16_t* V; int pitch; int nkeys; int delta0; };

__device__ __forceinline__ void attn_dma_v(const TileD& td, LAS unsigned char* vb, int lane) {
#pragma unroll
    for (int i = 0; i < 8; ++i) {
        const int row = 8 * i + (lane >> 3), chs = lane & 7, ch = chs ^ (((row >> 1) & 3) << 1);
        __builtin_amdgcn_global_load_lds((const unsigned*)(td.V + (size_t)row * td.pitch + ch * 8), (LAS unsigned*)(vb + i * 1024), 16, 0, 0);
    }
}
template <int NQB, class TF>
__device__ __forceinline__ void attn_wave(const bf16_t* Qp, bf16_t* Op, int qpitch, int opitch, int nt, const TF& tilef, LAS unsigned char* vbuf, const LAS float* rb, int lane) {
    const int fr = lane & 15, fq = lane >> 4;
    bf16x8 qf[NQB][2];
#pragma unroll
    for (int qb = 0; qb < NQB; ++qb)
#pragma unroll
        for (int dh = 0; dh < 2; ++dh) qf[qb][dh] = ldg16b(Qp + (size_t)(16 * qb + fr) * qpitch + dh * 32 + 8 * fq);
    f32x4 O[NQB][4]; float mrow[NQB], lrow[NQB];
#pragma unroll
    for (int qb = 0; qb < NQB; ++qb) { mrow[qb] = -1e30f; lrow[qb] = 0.f;
#pragma unroll
        for (int db = 0; db < 4; ++db) O[qb][db] = (f32x4){0.f, 0.f, 0.f, 0.f}; }
    const int qp = fr >> 2, pp = fr & 3, rowl = 4 * fq + qp, sw = ((rowl >> 1) & 3) << 1;
    const int vrow = rowl * 128 + (pp & 1) * 8, vch = (pp >> 1) ^ sw;
    bf16x8 kf[2][2];
    { const TileD td = tilef(0); attn_dma_v(td, vbuf, lane);
#pragma unroll
      for (int kb = 0; kb < 2; ++kb)
#pragma unroll
          for (int dh = 0; dh < 2; ++dh) kf[kb][dh] = ldg16b(td.K + (size_t)(16 * kb + fr) * td.pitch + dh * 32 + 8 * fq); }
    const int nht = 2 * nt;
#pragma unroll 1
    for (int ht = 0; ht < nht; ++ht) {
        const int t = ht >> 1, half = ht & 1;
        asm volatile("s_waitcnt vmcnt(0)" ::: "memory");
        const TileD td = tilef(t);
        if (half == 0 && t + 1 < nt) { const TileD tn = tilef(t + 1); attn_dma_v(tn, vbuf + ((t + 1) & 1) * 8192, lane); }
        f32x4 S[2][NQB];
#pragma unroll
        for (int kb = 0; kb < 2; ++kb)
#pragma unroll
            for (int qb = 0; qb < NQB; ++qb) {
                f32x4 s = __builtin_amdgcn_mfma_f32_16x16x32_bf16(kf[kb][0], qf[qb][0], (f32x4){0.f, 0.f, 0.f, 0.f}, 0, 0, 0);
                S[kb][qb] = __builtin_amdgcn_mfma_f32_16x16x32_bf16(kf[kb][1], qf[qb][1], s, 0, 0, 0);
            }
        if (ht + 1 < nht) {
            const TileD tk = tilef((ht + 1) >> 1); const int r0 = 32 * ((ht + 1) & 1);
#pragma unroll
            for (int kb = 0; kb < 2; ++kb)
#pragma unroll
                for (int dh = 0; dh < 2; ++dh) kf[kb][dh] = ldg16b(tk.K + (size_t)(r0 + 16 * kb + fr) * tk.pitch + dh * 32 + 8 * fq);
        }
        const int delta0 = td.delta0 - 32 * half, nkeys = td.nkeys - 32 * half;
        if (delta0 < 160) {
#pragma unroll
            for (int kb = 0; kb < 2; ++kb)
#pragma unroll
                for (int qb = 0; qb < NQB; ++qb)
#pragma unroll
                    for (int i = 0; i < 4; ++i) {
                        int d = delta0 + (16 * qb + fr) - (16 * kb + 4 * fq + i);
                        d = d < -128 ? -128 : (d > 128 ? 128 : d);
                        S[kb][qb][i] += rb[d + 128];
                    }
        }
        if (nkeys < 32) {
#pragma unroll
            for (int kb = 0; kb < 2; ++kb)
#pragma unroll
                for (int qb = 0; qb < NQB; ++qb)
#pragma unroll
                    for (int i = 0; i < 4; ++i) if (16 * kb + 4 * fq + i >= nkeys) S[kb][qb][i] = -INFINITY;
        }
        float mxq[NQB]; bool grow = false;
#pragma unroll
        for (int qb = 0; qb < NQB; ++qb) {
            float mx = fmaxf(fmaxf(fmaxf(S[0][qb][0], S[0][qb][1]), fmaxf(S[0][qb][2], S[0][qb][3])), fmaxf(fmaxf(S[1][qb][0], S[1][qb][1]), fmaxf(S[1][qb][2], S[1][qb][3])));
            mx = xmax_16_32(mx);
            mxq[qb] = mx; grow = grow || (mx > mrow[qb]);
        }
        if (__any(grow)) {
#pragma unroll
            for (int qb = 0; qb < NQB; ++qb) {
                const float mn = fmaxf(mrow[qb], mxq[qb]), alpha = __builtin_amdgcn_exp2f(mrow[qb] - mn);
                mrow[qb] = mn; lrow[qb] *= alpha;
#pragma unroll
                for (int db = 0; db < 4; ++db) O[qb][db] *= alpha;
            }
        }
        bf16x8 pf[NQB];
#pragma unroll
        for (int qb = 0; qb < NQB; ++qb) {
            const float mn = mrow[qb]; float ps = 0.f; float p[2][4];
#pragma unroll
            for (int kb = 0; kb < 2; ++kb)
#pragma unroll
                for (int i = 0; i < 4; ++i) { p[kb][i] = __builtin_amdgcn_exp2f(S[kb][qb][i] - mn); ps += p[kb][i]; }
            lrow[qb] += ps;
            u32x4 w; w.x = cvt_pk_bf16(p[0][0], p[0][1]); w.y = cvt_pk_bf16(p[0][2], p[0][3]); w.z = cvt_pk_bf16(p[1][0], p[1][1]); w.w = cvt_pk_bf16(p[1][2], p[1][3]);
            pf[qb] = __builtin_bit_cast(bf16x8, w);
        }
        const LAS unsigned char* vb = vbuf + (t & 1) * 8192 + half * 4096 + vrow;
#pragma unroll
        for (int db = 0; db < 4; ++db) {
            const int off = ((2 * db) ^ vch) << 4;
            const s16x4 lo = __builtin_amdgcn_ds_read_tr16_b64_v4i16((LAS s16x4*)(vb + off));
            const s16x4 hi = __builtin_amdgcn_ds_read_tr16_b64_v4i16((LAS s16x4*)(vb + off + 2048));
            const bf16x8 vf = (bf16x8){lo[0], lo[1], lo[2], lo[3], hi[0], hi[1], hi[2], hi[3]};
#pragma unroll
            for (int qb = 0; qb < NQB; ++qb) O[qb][db] = __builtin_amdgcn_mfma_f32_16x16x32_bf16(vf, pf[qb], O[qb][db], 0, 0, 0);
        }
    }
    asm volatile("s_waitcnt lgkmcnt(0)" ::: "memory");
#pragma unroll
    for (int qb = 0; qb < NQB; ++qb) {
        float l = xsum_16_32(lrow[qb]);
        const float inv = 1.0f / l;
#pragma unroll
        for (int db = 0; db < 4; ++db) {
            const f32x4 o = O[qb][db] * inv; u32x2 w; w.x = cvt_pk_bf16(o[0], o[1]); w.y = cvt_pk_bf16(o[2], o[3]);
            *(GAS u32x2*)(Op + (size_t)(16 * qb + fr) * opitch + 16 * db + 4 * fq) = w;
        }
    }
}


#define XB_TMO      128
#define XB_XCNT(j)  (256  + 64 * (j))
#define XB_XSUB(j)  (1280 + 64 * (j))
#define XB_XGEN(j)  (2304 + 64 * (j))
#define XB_TOP      3328
#define XB_TOPGEN   3392
#define XCD_BAR_WORDS 3456
#define XB_SPIN_CAP (1u << 20)
__device__ __forceinline__ unsigned xb_ld(unsigned* p)              { return __hip_atomic_load(p, __ATOMIC_RELAXED, __HIP_MEMORY_SCOPE_AGENT); }
__device__ __forceinline__ unsigned xb_add(unsigned* p, unsigned v) { return __hip_atomic_fetch_add(p, v, __ATOMIC_RELAXED, __HIP_MEMORY_SCOPE_AGENT); }
__device__ __forceinline__ unsigned xb_xcc_id() { return (unsigned)__builtin_amdgcn_s_getreg((3 << 11) | 20) & 0xFu; }
#define XB_SPIN(cond, bar) do { unsigned _sp = 0; while (cond) { __builtin_amdgcn_s_sleep(1); \
    if ((++_sp & 255u) == 0u) { if (xb_ld(&(bar)[XB_TMO])) break; if (_sp > XB_SPIN_CAP) { atomicAdd(&(bar)[XB_TMO], 1u); break; } } } } while (0)
struct XcdBarrier { unsigned* bar; unsigned x; volatile LAS unsigned* st; };
__device__ __forceinline__ XcdBarrier xcd_barrier_post(unsigned* bar, volatile LAS unsigned* st) {
    XcdBarrier b; b.bar = bar; b.x = xb_xcc_id(); b.st = st;
    if (threadIdx.x == 0) (void)xb_add(&bar[XB_XCNT(b.x)], 1u);
    return b;
}
__device__ __forceinline__ void xcd_barrier_complete(unsigned* bar, unsigned x, unsigned& nloc, unsigned& nx) {
    const unsigned G = gridDim.x * gridDim.y * gridDim.z;
    unsigned sum, cnt, mine, sp = 0u;
    for (;;) {
        sum = 0u; cnt = 0u; mine = 0u;
#pragma unroll
        for (unsigned j = 0; j < 16; ++j) { const unsigned c = xb_ld(&bar[XB_XCNT(j)]); sum += c; cnt += (c > 0u) ? 1u : 0u; mine = (j == x) ? c : mine; }
        if (sum == G) break;
        __builtin_amdgcn_s_sleep(1);
        if ((++sp & 255u) == 0u) { if (xb_ld(&bar[XB_TMO])) break; if (sp > XB_SPIN_CAP) { atomicAdd(&bar[XB_TMO], 1u); break; } }
    }
    nloc = mine > 0u ? mine : 1u; nx = cnt > 0u ? cnt : 1u;
}
__device__ __forceinline__ void xcd_barrier(const XcdBarrier& b) {
    asm volatile("s_waitcnt vmcnt(0)" ::: "memory");
    __syncthreads();
    if (threadIdx.x == 0) {
        unsigned* bar = b.bar;
        __builtin_amdgcn_s_waitcnt(0);
        unsigned nloc = b.st[0], nx = b.st[1];
        if (nloc == 0u) { xcd_barrier_complete(bar, b.x, nloc, nx); b.st[0] = nloc; b.st[1] = nx; }
        const unsigned old = xb_add(&bar[XB_XSUB(b.x)], 1u);
        const unsigned gen = old / nloc;
        if (old + 1u == (gen + 1u) * nloc) {
            __builtin_amdgcn_fence(__ATOMIC_RELEASE, "agent");
            asm volatile("s_waitcnt vmcnt(0)" ::: "memory");
            const unsigned og = xb_add(&bar[XB_TOP], 1u);
            const unsigned tg = og / nx;
            if (og + 1u == (tg + 1u) * nx) xb_add(&bar[XB_TOPGEN], 1u);
            else XB_SPIN(xb_ld(&bar[XB_TOPGEN]) == tg, bar);
            __builtin_amdgcn_fence(__ATOMIC_ACQUIRE, "agent");
            xb_add(&bar[XB_XGEN(b.x)], 1u);
            asm volatile("s_waitcnt vmcnt(0)" ::: "memory");
        } else {
            XB_SPIN(xb_ld(&bar[XB_XGEN(b.x)]) == gen, bar);
            __builtin_amdgcn_fence(__ATOMIC_ACQUIRE, "agent");
            asm volatile("s_waitcnt vmcnt(0)" ::: "memory");
        }
    }
    __syncthreads();
}

struct Args {
    const float* x_prompt; const float* x_sample; const float* cache_k; const float* cache_v; const float* state_conv;
    const float* norm_ffn1; const float* w_ffn1_gu; const float* w_ffn1_down; const float* norm_mix; const float* w_in; const float* b_gate; const float* w_conv;
    const float* rel_bias; const float* w_conv_out; const float* w_attn_out; const float* w_o; const float* norm_ffn2; const float* w_ffn2_gu; const float* w_ffn2_down; const float* norm_final;
    float* out; unsigned char* ws; int ph_lo, ph_hi;
};

__device__ __forceinline__ void transpose_item(const float* W, int N, const float* gain, bf16_t* WT, int dpitch, int dkoff, int mode, int kb, int nb, int scol0, LAS float* scr, int lane) {
    const int k0 = 64 * kb, n0 = 32 * nb, c = lane & 31;
    const int scol = (mode == 1) ? ((c < 16) ? 16 * nb + c : DFF + 16 * nb + (c - 16)) : scol0 + c;
    float wv[32];
#pragma unroll
    for (int i = 0; i < 32; ++i) wv[i] = __builtin_nontemporal_load(W + (size_t)(k0 + 2 * i + (lane >> 5)) * N + scol);
    if (gain) {
#pragma unroll
        for (int i = 0; i < 32; ++i) wv[i] *= gain[k0 + 2 * i + (lane >> 5)];
    }
#pragma unroll
    for (int i = 0; i < 32; ++i) scr[(2 * i + (lane >> 5)) * 33 + c] = wv[i];
    asm volatile("s_waitcnt lgkmcnt(0)" ::: "memory");
    const int c8 = lane & 7;
#pragma unroll
    for (int j = 0; j < 4; ++j) { const int n = (lane >> 3) + 8 * j; const LAS float* s = scr + (8 * c8) * 33 + n;
        u32x4 o; o.x = pk2(s[0 * 33], s[1 * 33]); o.y = pk2(s[2 * 33], s[3 * 33]); o.z = pk2(s[4 * 33], s[5 * 33]); o.w = pk2(s[6 * 33], s[7 * 33]);
        int drow;
        if (mode == 1) { const int jj = n & 15, isu = n >> 4; drow = n0 + 8 * (jj >> 2) + 4 * isu + (jj & 3); } else drow = n0 + n;
        *(u32x4*)(WT + (size_t)drow * dpitch + dkoff + k0 + 8 * c8) = o; }
    asm volatile("s_waitcnt lgkmcnt(0)" ::: "memory");
}

__device__ __forceinline__ float wave_sum(float v) {
#pragma unroll
    for (int o = 1; o < 64; o <<= 1) v += __shfl_xor(v, o);
    return v;
}

__global__ void __launch_bounds__(NWAVES * 64, 2) mega_fwd(Args a) {
    extern __shared__ __attribute__((aligned(16))) unsigned char lds_raw[];
    LAS unsigned char* lds = (LAS unsigned char*)lds_raw;
    cg::grid_group grid = cg::this_grid();
    typedef const __attribute__((address_space(4))) Args* ArgP;
    ArgP ap = (ArgP)__builtin_amdgcn_kernarg_segment_ptr();
    const int G = gridDim.x, bx = blockIdx.x;
    const int wave0 = __builtin_amdgcn_readfirstlane((int)threadIdx.x >> 6);
    unsigned* barw = (unsigned*)(ap->ws + WS_BAR);
    if (bx == 0) for (int i = threadIdx.x; i < 4096; i += NWAVES * 64) barw[i] = 0u;
    if (threadIdx.x < 16) ((LAS unsigned*)(lds + BARST_OFF))[threadIdx.x] = 0u;
    XcdBarrier xbar; xbar.bar = barw; xbar.x = 0; xbar.st = (volatile LAS unsigned*)(lds + BARST_OFF);
    bool xposted = false; unsigned wait_ticks = 0; (void)wait_ticks;
    const int lo = ap->ph_lo, hi = ap->ph_hi;
#define PHASE_VARS \
    asm volatile("" : "+s"(ap)); \
    int lane_ = (int)__builtin_amdgcn_mbcnt_hi(~0u, __builtin_amdgcn_mbcnt_lo(~0u, 0u)); asm volatile("" : "+v"(lane_)); \
    int wave_ = wave0; asm volatile("" : "+s"(wave_)); \
    const int lane = lane_, wave = wave_, tid = wave * 64 + lane; \
    const int vcu = (G % 8 == 0) ? (bx % 8) * (G / 8) + bx / 8 : bx; \
    const int gw = vcu * NWAVES + wave, NGW = G * NWAVES; \
    const int gt = gw * 64 + lane, NGT = NGW * 64; \
    unsigned char* ws = ap->ws; \
    bf16_t* WT = (bf16_t*)(ws + ((l & 1) ? WS_WT2 : WS_WT)); bf16_t* WTN = (bf16_t*)(ws + ((l & 1) ? WS_WT : WS_WT2)); bf16_t* XB = (bf16_t*)(ws + WS_XB); float* SSQ = (float*)(ws + WS_SSQ); \
    bf16_t* CK = (bf16_t*)(ws + ((l & 1) ? WS_CK2 : WS_CK)); bf16_t* CV = (bf16_t*)(ws + ((l & 1) ? WS_CV2 : WS_CV)); \
    bf16_t* CKN = (bf16_t*)(ws + ((l & 1) ? WS_CK : WS_CK2)); bf16_t* CVN = (bf16_t*)(ws + ((l & 1) ? WS_CV : WS_CV2)); bf16_t* Z = (bf16_t*)(ws + WS_Z); bf16_t* HB = Z; \
    float* X = ap->out; \
    (void)WTN; (void)CKN; (void)CVN; (void)tid; (void)lane; (void)wave; (void)gw; (void)NGW; (void)gt; (void)NGT; (void)WT; (void)XB; (void)SSQ; (void)CK; (void)CV; (void)Z; (void)HB; (void)X;
#define IN(k) (lo <= (k) && (k) < hi)
#define GSYNC() do { unsigned long long t0_ = 0; if (PROBE_WAIT) t0_ = __builtin_amdgcn_s_memrealtime(); if (!xposted) { grid.sync(); xbar = xcd_barrier_post(barw, (volatile LAS unsigned*)(lds + BARST_OFF)); xposted = true; } else xcd_barrier(xbar); if (PROBE_WAIT) wait_ticks += (unsigned)(__builtin_amdgcn_s_memrealtime() - t0_); } while (0)
#define SEAM(k) do { if (IN(k) && IN((k) + 1)) { const unsigned w0_ = wait_ticks; GSYNC(); if (PROBE_WAIT >= 100 && ((k) % 9) != PROBE_WAIT - 100) wait_ticks = w0_; if (PROBE_REP == 9) GSYNC(); } } while (0)
#define REPS(k) for (int rep = (PROBE_REP == (k)) ? 0 : 1; rep < 2; ++rep)
#define REPSYNC() do { if (rep == 0) GSYNC(); } while (0)

#define CONVERT_LAYER(LC, WTD, CKD, CVD) do { \
            LAS float* scr = (LAS float*)(lds + wave * 16384); \
            constexpr int I_GU = 16 * 176, I_D = 44 * 32, I_IN = 16 * 160, I_C = 8 * 32, I_O = 16 * 32; \
            constexpr int NITEMS = 2 * I_GU + 2 * I_D + I_IN + 2 * I_C + I_O; \
            for (int it = gw; it < NITEMS; it += NGW) { \
                int r = it; \
                if (r < I_GU) { transpose_item(ap->w_ffn1_gu + (size_t)(LC) * DM * 2 * DFF, 2 * DFF, ap->norm_ffn1 + (LC) * DM, (WTD) + W_GU1, DM, 0, 0, r / 176, r % 176, (((r % 176) >> 2) & 1) * DFF + 128 * ((r % 176) >> 3) + 32 * ((r % 176) & 3), scr, lane); continue; } r -= I_GU; \
                if (r < I_GU) { transpose_item(ap->w_ffn2_gu + (size_t)(LC) * DM * 2 * DFF, 2 * DFF, ap->norm_ffn2 + (LC) * DM, (WTD) + W_GU2, DM, 0, 0, r / 176, r % 176, (((r % 176) >> 2) & 1) * DFF + 128 * ((r % 176) >> 3) + 32 * ((r % 176) & 3), scr, lane); continue; } r -= I_GU; \
                if (r < I_D) { transpose_item(ap->w_ffn1_down + (size_t)(LC) * DFF * DM, DM, nullptr, (WTD) + W_D1, DFF, 0, 0, r / 32, r % 32, 32 * (r % 32), scr, lane); continue; } r -= I_D; \
                if (r < I_D) { transpose_item(ap->w_ffn2_down + (size_t)(LC) * DFF * DM, DM, nullptr, (WTD) + W_D2, DFF, 0, 0, r / 32, r % 32, 32 * (r % 32), scr, lane); continue; } r -= I_D; \
                if (r < I_IN) { const int nb = r % 160, kb = r / 160, blk = nb >> 4; \
                    const int ob = (blk == 1) ? 3 : (blk == 2) ? 1 : (blk == 3) ? 2 : blk; \
                    transpose_item(ap->w_in + (size_t)(LC) * DM * INC, INC, ap->norm_mix + (LC) * DM, (WTD) + W_IN, DM, 0, 0, kb, nb, ob * 512 + 32 * (nb & 15), scr, lane); continue; } r -= I_IN; \
                if (r < I_C) { transpose_item(ap->w_conv_out + (size_t)(LC) * 512 * DM, DM, nullptr, (WTD) + W_CAT, DM, 0, 0, r / 32, r % 32, 32 * (r % 32), scr, lane); continue; } r -= I_C; \
                if (r < I_C) { transpose_item(ap->w_attn_out + (size_t)(LC) * 512 * DM, DM, nullptr, (WTD) + W_CAT, DM, 512, 0, r / 32, r % 32, 32 * (r % 32), scr, lane); continue; } r -= I_C; \
                transpose_item(ap->w_o + (size_t)(LC) * DM * DM, DM, nullptr, (WTD) + W_O, DM, 0, 0, r / 32, r % 32, 32 * (r % 32), scr, lane); \
            } \
 \
            for (int i0 = gt; i0 < 2 * (NBATCH * 512 * 512 / 8); i0 += 2 * NGT) {   \
                constexpr int NG_ = 2 * (NBATCH * 512 * 512 / 8); \
                const int i1 = i0 + NGT; const bool h1 = i1 < NG_; const int i1c = h1 ? i1 : i0; \
                const int wa = i0 / (NG_ / 2), ea = (i0 % (NG_ / 2)) * 8, wb = i1c / (NG_ / 2), eb = (i1c % (NG_ / 2)) * 8; \
                const float* sa = (wa ? ap->cache_v : ap->cache_k) + (size_t)(LC) * NBATCH * 512 * 512 + ea; \
                const float* sb = (wb ? ap->cache_v : ap->cache_k) + (size_t)(LC) * NBATCH * 512 * 512 + eb; \
                const f32x4 a0 = __builtin_nontemporal_load((const f32x4*)sa), a1 = __builtin_nontemporal_load((const f32x4*)(sa + 4)); \
                const f32x4 b0 = __builtin_nontemporal_load((const f32x4*)sb), b1 = __builtin_nontemporal_load((const f32x4*)(sb + 4)); \
                u32x4 w; w.x = pk2(a0[0], a0[1]); w.y = pk2(a0[2], a0[3]); w.z = pk2(a1[0], a1[1]); w.w = pk2(a1[2], a1[3]); \
                *(u32x4*)((wa ? (CVD) : (CKD)) + ea) = w; \
                if (h1) { u32x4 x; x.x = pk2(b0[0], b0[1]); x.y = pk2(b0[2], b0[3]); x.z = pk2(b1[0], b1[1]); x.w = pk2(b1[2], b1[3]); *(u32x4*)((wb ? (CVD) : (CKD)) + eb) = x; } \
            } \
} while (0)

#pragma unroll 1
    for (int l = 0; l < DEPTH; ++l) {
        const int pb = 9 * l;
        if (l == 0 && IN(pb + 0)) REPS(0) { PHASE_VARS
            CONVERT_LAYER(0, WT, CK, CV);
            if (l == 0) {
                for (int m0 = gw * 4; m0 < MPAD; m0 += NGW * 4) {
                    f32x4 v[4][4];
#pragma unroll
                    for (int r = 0; r < 4; ++r) { const int m = m0 + r;
                        const float* src = (m < MP) ? ap->x_prompt + (size_t)m * DM : ap->x_sample + (size_t)((m < MR ? m : MR - 1) - MP) * DM;
#pragma unroll
                        for (int j = 0; j < 4; ++j) v[r][j] = __builtin_nontemporal_load((const f32x4*)(src + 256 * j + 4 * lane)); }
#pragma unroll
                    for (int r = 0; r < 4; ++r) { const int m = m0 + r;
                        bf16_t* xb = XB + (size_t)m * DM; float* sq = SSQ + (size_t)m * 16;
                        if (m < MR) {
                            float s = 0.f;
#pragma unroll
                            for (int j = 0; j < 4; ++j) { const f32x4 x = v[r][j]; u32x2 w; w.x = pk2(x[0], x[1]); w.y = pk2(x[2], x[3]); *(u32x2*)(xb + 256 * j + 4 * lane) = w; s += (x[0] * x[0] + x[1] * x[1]) + (x[2] * x[2] + x[3] * x[3]); }
                            s = wave_sum(s);
                            if (lane < 16) sq[lane] = (lane == 0) ? s : 0.f;
                        } else {
#pragma unroll
                            for (int j = 0; j < 4; ++j) *(u32x2*)(xb + 256 * j + 4 * lane) = (u32x2){0u, 0u};
                            if (lane < 16) sq[lane] = 0.f;
                        }
                    }
                }
            }
        REPSYNC(); }
        if (l == 0) SEAM(pb + 0);
        if (IN(pb + 1)) REPS(1) { PHASE_VARS
            pg8::Gemm g{XB, WT + W_GU1, DM, DM, DM, 0, 0}; pg8::StaticOrder S; S.init(NTM, 2 * DFF / 256, G, bx, 1);
            EpiUp E{HB, SSQ};
            small_gemm<1, 16, EpiUp, true, 2>(lds, XB, XB, DM, WT + W_GU1, WT + W_GU1, DM, 2 * DFF / 64, E, bx, G, wave, lane);
            pg8::gemm_phase<EpiUp>(lds, g, S, E, tid);
        REPSYNC(); }
        SEAM(pb + 1);
        if (IN(pb + 2)) REPS(2) { PHASE_VARS
            pg8::Gemm g{HB, WT + W_D1, DFF, DFF, DFF, 0, 0}; pg8::StaticOrder S; S.init(NTM, DM / 256, G, bx, 1);
            EpiRes E{XB, SSQ, rep ? 0.5f : 0.0f};
            small_gemm<1, 11, EpiRes>(lds, HB, HB, DFF, WT + W_D1, WT + W_D1, DFF, DM / 64, E, bx, G, wave, lane);
            pg8::gemm_phase<EpiRes>(lds, g, S, E, tid);
        REPSYNC(); }
        SEAM(pb + 2);
        if (IN(pb + 3)) REPS(3) { PHASE_VARS
            pg8::Gemm g{XB, WT + W_IN, DM, DM, DM, 0, 0}; pg8::StaticOrder S; S.init(NTM, INC / 256, G, bx, 1);
            EpiIn E{Z, SSQ, ap->b_gate + (size_t)l * 2 * DM, ap->out + O_KP + (size_t)l * NBATCH * 512 * 512, ap->out + O_VP + (size_t)l * NBATCH * 512 * 512,
                    ap->out + O_KS + (size_t)l * MS * 512, ap->out + O_VS + (size_t)l * MS * 512};
            small_gemm<1, 16, EpiIn, false, 2>(lds, XB, XB, DM, WT + W_IN, WT + W_IN, DM, INC / 64, E, bx, G, wave, lane);
            pg8::gemm_phase<EpiIn>(lds, g, S, E, tid);
        REPSYNC(); }
        SEAM(pb + 3);
        if (IN(pb + 4)) REPS(4) { PHASE_VARS
            LAS float* rbl = (LAS float*)(lds + RB_OFF);
            for (int i = tid; i < NH * NREL; i += NWAVES * 64) { const int h = i / NREL, j = i - h * NREL; rbl[h * 264 + j] = (ap->rel_bias[(size_t)l * NH * NREL + i] - ap->rel_bias[(size_t)l * NH * NREL + h * NREL + 256]) * LOG2E; }
            __syncthreads();
            LAS unsigned char* vbuf = lds + wave * 16384;
#pragma unroll 1
            for (int u = gw; u < 4096; u += NGW) {
                const int c = u & 63, h = (u >> 6) & 7, b = u >> 9;
                const int jlo = (c > 8) ? c - 8 : 0;
                const bf16_t* base = Z + (size_t)(b * SEQ) * INC + h * 64;
                auto tf = [&](int j) { TileD td; const size_t ro = (size_t)(64 * (jlo + j)) * INC; td.K = base + ro + ZC_K; td.V = base + ro + ZC_V; td.pitch = INC; td.nkeys = 64; td.delta0 = 64 * (c - jlo - j); return td; };
                bf16_t* qp = Z + (size_t)(b * SEQ + 64 * c) * INC + ZC_Q + h * 64;
                bf16_t* op = rep ? qp : XB + (size_t)(b * SEQ + 64 * c) * DM + h * 64;
                attn_wave<4>(qp, op, INC, rep ? INC : DM, c - jlo + 1, tf, vbuf, rbl + h * 264, lane);
            }
            { int l2 = lane; asm volatile("" : "+v"(l2)); asm volatile("" : "+s"(Z), "+s"(CK), "+s"(CV));
#pragma unroll 1
            for (int us = ((gw & 63) < 2) ? ((gw >> 6) * 2 + (gw & 63)) : 64; us < 64; us += 64) {
                const int h = us & 7, b = us >> 3;
                const bf16_t* zrow = Z + (size_t)(MP + 16 * b) * INC + h * 64;
                auto tf = [&](int j) { TileD td;
                    if (j < 8) { const size_t ro = (size_t)(b * 512 + 64 * j) * 512 + h * 64; td.K = CK + ro; td.V = CV + ro; td.pitch = 512; td.nkeys = 64; td.delta0 = 512 - 64 * j; }
                    else { td.K = zrow + ZC_K; td.V = zrow + ZC_V; td.pitch = INC; td.nkeys = 16; td.delta0 = 0; }
                    return td; };
                bf16_t* qp = Z + (size_t)(MP + 16 * b) * INC + ZC_Q + h * 64;
                bf16_t* op = rep ? qp : XB + (size_t)(16 * b) * DM + h * 64;
                attn_wave<1>(qp, op, INC, rep ? INC : DM, 9, tf, vbuf, rbl + h * 264, l2);
            } }
            for (int cu = (NGW - 1 - gw); cu < MR / 16; cu += NGW) {
                const int row0 = cu * 16, ch = 8 * lane;
                const bool samp = (row0 >= MP);
                const int bb = samp ? (row0 - MP) / 16 : (row0 >> 12), t0 = samp ? 0 : (row0 & 4095);
                float w0[8], w1[8], w2[8], um2[8], um1[8];
                { const float* wc = ap->w_conv + (size_t)l * 3 * 512 + ch;
#pragma unroll
                  for (int i = 0; i < 8; ++i) { w0[i] = wc[i]; w1[i] = wc[512 + i]; w2[i] = wc[1024 + i]; } }
                if (samp) { const float* sc = ap->state_conv + ((size_t)(l * NBATCH + bb) * 2) * 512 + ch;
#pragma unroll
                    for (int i = 0; i < 8; ++i) { um2[i] = sc[i]; um1[i] = sc[512 + i]; }
                } else if (t0 == 0) {
#pragma unroll
                    for (int i = 0; i < 8; ++i) { um2[i] = 0.f; um1[i] = 0.f; }
                } else {
                    const bf16_t* z2 = Z + (size_t)(row0 - 2) * INC + ch; const bf16_t* z1 = Z + (size_t)(row0 - 1) * INC + ch;
                    const u32x4 c2 = ldg16(z2 + ZC_CC), v2 = ldg16(z2 + ZC_CV), c1 = ldg16(z1 + ZC_CC), v1 = ldg16(z1 + ZC_CV);
#pragma unroll
                    for (int i = 0; i < 4; ++i) { um2[2 * i] = bf_lo(c2[i]) * bf_lo(v2[i]); um2[2 * i + 1] = bf_hi(c2[i]) * bf_hi(v2[i]); um1[2 * i] = bf_lo(c1[i]) * bf_lo(v1[i]); um1[2 * i + 1] = bf_hi(c1[i]) * bf_hi(v1[i]); }
                }
#pragma unroll
                for (int rb8 = 0; rb8 < 2; ++rb8) {
                    u32x4 cbv[8], ccv[8], cvv[8];
#pragma unroll
                    for (int r = 0; r < 8; ++r) { const bf16_t* zr = Z + (size_t)(row0 + rb8 * 8 + r) * INC + ch; cbv[r] = __builtin_nontemporal_load((const GAS u32x4*)(zr + ZC_CB)); ccv[r] = __builtin_nontemporal_load((const GAS u32x4*)(zr + ZC_CC)); cvv[r] = __builtin_nontemporal_load((const GAS u32x4*)(zr + ZC_CV)); }
#pragma unroll
                    for (int r = 0; r < 8; ++r) {
                        bf16_t* zr = Z + (size_t)(row0 + rb8 * 8 + r) * INC + ch;
                        const u32x4 cbw = cbv[r], ccw = ccv[r], cvw = cvv[r];
                        float y[8];
#pragma unroll
                        for (int i = 0; i < 4; ++i) {
                            const float u0 = bf_lo(ccw[i]) * bf_lo(cvw[i]), u1 = bf_hi(ccw[i]) * bf_hi(cvw[i]);
                            y[2 * i] = bf_lo(cbw[i]) * (w0[2 * i] * um2[2 * i] + w1[2 * i] * um1[2 * i] + w2[2 * i] * u0);
                            y[2 * i + 1] = bf_hi(cbw[i]) * (w0[2 * i + 1] * um2[2 * i + 1] + w1[2 * i + 1] * um1[2 * i + 1] + w2[2 * i + 1] * u1);
                            um2[2 * i] = um1[2 * i]; um1[2 * i] = u0; um2[2 * i + 1] = um1[2 * i + 1]; um1[2 * i + 1] = u1;
                        }
                        u32x4 w; w.x = cvt_pk_bf16(y[0], y[1]); w.y = cvt_pk_bf16(y[2], y[3]); w.z = cvt_pk_bf16(y[4], y[5]); w.w = cvt_pk_bf16(y[6], y[7]);
                        stg16(rep ? zr + ZC_CB : XB + (size_t)(row0 + rb8 * 8 + r) * DM + 512 + ch, w);
                    }
                }
                if (samp || t0 == SEQ - 16) {
                    float* dst = ap->out + (samp ? O_CS : O_CP) + ((size_t)(l * NBATCH + bb) * 2) * 512 + ch;
                    *(f32x4*)dst = (f32x4){um2[0], um2[1], um2[2], um2[3]}; *(f32x4*)(dst + 4) = (f32x4){um2[4], um2[5], um2[6], um2[7]};
                    *(f32x4*)(dst + 512) = (f32x4){um1[0], um1[1], um1[2], um1[3]}; *(f32x4*)(dst + 516) = (f32x4){um1[4], um1[5], um1[6], um1[7]};
                }
            }
            if (rep && l + 1 < DEPTH) { asm volatile("s_waitcnt vmcnt(0) lgkmcnt(0)" ::: "memory"); asm volatile("" : "+s"(ap)); CONVERT_LAYER(l + 1, WTN, CKN, CVN); }
            asm volatile("s_waitcnt vmcnt(0) lgkmcnt(0)" ::: "memory");
            __syncthreads();
        REPSYNC(); }
        SEAM(pb + 4);
        if (IN(pb + 5)) REPS(5) { PHASE_VARS
            pg8::Gemm g{Z, WT + W_CAT, INC, DM, DM, 0, 0}; pg8::StaticOrder S; S.init(NTM, DM / 256, G, bx, 1);
            EpiMix E{Z};
            small_gemm<2, 2, EpiMix>(lds, Z + ZC_CB, Z + ZC_Q, INC, WT + W_CAT, WT + W_CAT + 512, DM, DM / 64, E, bx, G, wave, lane);
            pg8::gemm_phase<EpiMix, true>(lds, g, S, E, tid);
        REPSYNC(); }
        SEAM(pb + 5);
        if (IN(pb + 6)) REPS(6) { PHASE_VARS
            pg8::Gemm g{Z + ZC_MB, WT + W_O, INC, DM, DM, 0, 0}; pg8::StaticOrder S; S.init(NTM, DM / 256, G, bx, 1);
            EpiRes E{XB, SSQ, rep ? 1.0f : 0.0f};
            small_gemm<1, 4, EpiRes>(lds, Z + ZC_MB, Z + ZC_MB, INC, WT + W_O, WT + W_O, DM, DM / 64, E, bx, G, wave, lane);
            pg8::gemm_phase<EpiRes>(lds, g, S, E, tid);
        REPSYNC(); }
        SEAM(pb + 6);
        if (IN(pb + 7)) REPS(7) { PHASE_VARS
            pg8::Gemm g{XB, WT + W_GU2, DM, DM, DM, 0, 0}; pg8::StaticOrder S; S.init(NTM, 2 * DFF / 256, G, bx, 1);
            EpiUp E{HB, SSQ};
            small_gemm<1, 16, EpiUp, true, 2>(lds, XB, XB, DM, WT + W_GU2, WT + W_GU2, DM, 2 * DFF / 64, E, bx, G, wave, lane);
            pg8::gemm_phase<EpiUp>(lds, g, S, E, tid);
        REPSYNC(); }
        SEAM(pb + 7);
        if (IN(pb + 8)) REPS(8) { PHASE_VARS
            pg8::Gemm g{HB, WT + W_D2, DFF, DFF, DFF, 0, 0}; pg8::StaticOrder S; S.init(NTM, DM / 256, G, bx, 1);
            EpiRes E{XB, SSQ, rep ? 0.5f : 0.0f};
            small_gemm<1, 11, EpiRes>(lds, HB, HB, DFF, WT + W_D2, WT + W_D2, DFF, DM / 64, E, bx, G, wave, lane);
            pg8::gemm_phase<EpiRes>(lds, g, S, E, tid);
        REPSYNC(); }
        SEAM(pb + 8);
    }
    if (IN(36)) { const int l = 0; PHASE_VARS
        f32x4 gn[4];
#pragma unroll
        for (int j = 0; j < 4; ++j) gn[j] = *(const f32x4*)(ap->norm_final + 256 * j + 4 * lane);
        for (int m0 = gw * 4; m0 < MR; m0 += NGW * 4) {
            u32x2 o[4][4]; float sv[4];
#pragma unroll
            for (int r = 0; r < 4; ++r) { const bf16_t* xb = XB + (size_t)(m0 + r) * DM; sv[r] = (lane < 16) ? SSQ[(size_t)(m0 + r) * 16 + lane] : 0.f;
#pragma unroll
                for (int j = 0; j < 4; ++j) o[r][j] = *(const u32x2*)(xb + 256 * j + 4 * lane); }
#pragma unroll
            for (int r = 0; r < 4; ++r) { float* yr = X + (size_t)(m0 + r) * DM;
                const float rs = __builtin_amdgcn_rsqf(wave_sum(sv[r]) * (1.0f / 1024.0f) + EPS);
#pragma unroll
                for (int j = 0; j < 4; ++j) { const f32x4 x = (f32x4){bf_lo(o[r][j].x), bf_hi(o[r][j].x), bf_lo(o[r][j].y), bf_hi(o[r][j].y)}; __builtin_nontemporal_store(x * rs * gn[j], (f32x4*)(yr + 256 * j + 4 * lane)); } }
        }
    }
    if (PROBE_WAIT) {
        unsigned* acc_w = barw + 3500;
        if (threadIdx.x == 0) atomicAdd(acc_w, wait_ticks);
        GSYNC();
        if (threadIdx.x == 0) { const unsigned avg = __hip_atomic_load(acc_w, __ATOMIC_RELAXED, __HIP_MEMORY_SCOPE_AGENT) / gridDim.x;
            const unsigned long long t0 = __builtin_amdgcn_s_memrealtime(); while (__builtin_amdgcn_s_memrealtime() - t0 < 8ull * avg) __builtin_amdgcn_s_sleep(8); }
        __syncthreads();
    }
#undef IN
#undef SEAM
}

extern "C" void kernel_launch(void* const* d_in, const int* in_sizes, int n_in, void* d_out, int out_size, void* d_ws, size_t ws_size, hipStream_t stream) {
    static int grid = 0;
    if (grid == 0) {
        if (n_in != 20 || (size_t)out_size != O_END || ws_size < WS_END) { fprintf(stderr, "kernel_launch: unexpected shapes: n_in %d out %d (want %zu) ws %zu (need %zu)\n", n_in, out_size, (size_t)O_END, ws_size, (size_t)WS_END); grid = -1; return; }
        int dev = 0, cus = 0, per_cu = 0;
        hipGetDevice(&dev); hipDeviceGetAttribute(&cus, hipDeviceAttributeMultiprocessorCount, dev);
        if (hipFuncSetAttribute((const void*)mega_fwd, hipFuncAttributeMaxDynamicSharedMemorySize, LDS_BYTES) != hipSuccess) { fprintf(stderr, "kernel_launch: hipFuncSetAttribute failed\n"); grid = -1; return; }
        if (hipOccupancyMaxActiveBlocksPerMultiprocessor(&per_cu, (const void*)mega_fwd, NWAVES * 64, LDS_BYTES) != hipSuccess || per_cu < 1) { fprintf(stderr, "kernel_launch: occupancy query says %d\n", per_cu); per_cu = 1; }
        (void)hipGetLastError();
        grid = cus;
    }
    if (grid < 0) return;
    Args a{};
    const float** ap = (const float**)&a;
    for (int i = 0; i < 20; ++i) ap[i] = (const float*)d_in[i];
    a.out = (float*)d_out; a.ws = (unsigned char*)d_ws; a.ph_lo = 0; a.ph_hi = 37;
    void* args[] = {&a};
    hipError_t e = hipLaunchCooperativeKernel((const void*)mega_fwd, dim3(grid), dim3(NWAVES * 64), args, LDS_BYTES, stream);
    if (e != hipSuccess) fprintf(stderr, "kernel_launch: cooperative launch failed: %s (grid %d)\n", hipGetErrorString(e), grid);
}
```
